# Optimizing an MI355X kernel written in HIP

```python
import jax, jax.numpy as jnp
from jax import lax
import numpy as np

D_MODEL = 1024
BATCH = 16
SEQ = 2048
DEPTH = 2

FOX_HEADS = 8
FOX_HEAD_DIM = 64
FOX_WIDTH = FOX_HEADS * FOX_HEAD_DIM
FOX_Q_BLOCK = 128
MOBA_HEADS = 8
MOBA_HEAD_DIM = 64
MOBA_WIDTH = MOBA_HEADS * MOBA_HEAD_DIM
MOBA_BLOCK = 256
MOBA_TOPK = 3
MOBA_Q_CHUNK = 16
MLSTM_HEADS = 4
MLSTM_QK_DIM = 64
MLSTM_V_DIM = 128
MLSTM_QK_WIDTH = MLSTM_HEADS * MLSTM_QK_DIM
MLSTM_V_WIDTH = MLSTM_HEADS * MLSTM_V_DIM
MLSTM_CHUNK = 64
MLSTM_CONV = 4
N_BRANCHES = 3
BRANCH_WIDTH = 512
RMS_EPS = 1e-6
NEG = -1e30

SPLIT_SIZES = (
    FOX_WIDTH, FOX_WIDTH, FOX_WIDTH, FOX_WIDTH, FOX_HEADS,
    MOBA_WIDTH, MOBA_WIDTH, MOBA_WIDTH, MOBA_WIDTH,
    2 * MLSTM_QK_WIDTH, MLSTM_V_WIDTH, MLSTM_V_WIDTH, MLSTM_V_WIDTH,
    MLSTM_HEADS, MLSTM_HEADS,
    N_BRANCHES * D_MODEL,
)
IN_WIDTH = int(sum(SPLIT_SIZES))
SPLIT_POINTS = tuple(int(v) for v in np.cumsum(SPLIT_SIZES)[:-1])

kernel_name = "hybrid_fox_moba_mlstm_gated_parallel"


def rms_norm(x, g):
    xf = x.astype(jnp.float32)
    y = xf * lax.rsqrt(jnp.mean(xf * xf, axis=-1, keepdims=True) + RMS_EPS)
    return (y * g.astype(jnp.float32)).astype(x.dtype)


def head_rms_norm(y, g, n_heads):
    b, s, w = y.shape
    yf = y.astype(jnp.float32).reshape(b, s, n_heads, w // n_heads)
    yf = yf * lax.rsqrt(jnp.mean(yf * yf, axis=-1, keepdims=True) + RMS_EPS)
    return (yf.reshape(b, s, w) * g.astype(jnp.float32)).astype(y.dtype)


def to_heads(t, n_heads):
    b, s, w = t.shape
    return t.reshape(b, s, n_heads, w // n_heads).transpose(0, 2, 1, 3)


def from_heads(t):
    b, h, s, d = t.shape
    return t.transpose(0, 2, 1, 3).reshape(b, s, h * d)


def alibi_slopes(n_heads):
    return 2.0 ** (-8.0 * (jnp.arange(n_heads, dtype=jnp.float32) + 1.0) / n_heads)


def causal_depthwise_conv(x, w):
    kw = w.shape[0]
    s = x.shape[1]
    xp = jnp.pad(x, ((0, 0), (kw - 1, 0), (0, 0)))
    return sum(xp[:, j:j + s] * w[j] for j in range(kw))


def forgetting_attention(q, k, v, log_f):
    b, h, s, d = q.shape
    nqb = s // FOX_Q_BLOCK
    scale = d ** -0.5
    c = jnp.cumsum(log_f, axis=-1)
    k_pos = jnp.arange(s)
    qb = q.reshape(b, h, nqb, FOX_Q_BLOCK, d).transpose(2, 0, 1, 3, 4)
    cb = c.reshape(b, h, nqb, FOX_Q_BLOCK).transpose(2, 0, 1, 3)
    q_pos = k_pos.reshape(nqb, FOX_Q_BLOCK)

    def one_block(args):
        q_blk, c_blk, pos = args
        logits = jnp.einsum('bhqd,bhkd->bhqk', q_blk, k).astype(jnp.float32) * scale
        logits = logits + c_blk[..., :, None] - c[..., None, :]
        logits = jnp.where(pos[:, None] >= k_pos[None, :], logits, NEG)
        p = jax.nn.softmax(logits, axis=-1)
        return jnp.einsum('bhqk,bhkd->bhqd', p.astype(v.dtype), v)

    out = lax.map(one_block, (qb, cb, q_pos))
    return out.transpose(1, 2, 0, 3, 4).reshape(b, h, s, d)


def moba_attention(q, k, v, slopes):
    b, h, s, d = q.shape
    scale = d ** -0.5
    nb = -(-s // MOBA_BLOCK)
    pad = nb * MOBA_BLOCK - s
    k_p = jnp.pad(k, ((0, 0), (0, 0), (0, pad), (0, 0)))
    v_p = jnp.pad(v, ((0, 0), (0, 0), (0, pad), (0, 0)))
    k_blocks = k_p.reshape(b, h, nb, MOBA_BLOCK, d)
    v_blocks = v_p.reshape(b, h, nb, MOBA_BLOCK, d)
    k_mean = jnp.mean(k_blocks.astype(jnp.float32), axis=3).astype(k.dtype)
    topk = min(MOBA_TOPK, nb)
    n_chunks = s // MOBA_Q_CHUNK
    qc = q.reshape(b, h, n_chunks, MOBA_Q_CHUNK, d).transpose(2, 0, 1, 3, 4)
    blk_ids = jnp.arange(nb)
    offs = jnp.arange(MOBA_BLOCK)
    bi = jnp.arange(b)[:, None, None, None]
    hi = jnp.arange(h)[None, :, None, None]
    m = slopes.astype(jnp.float32)

    def one_chunk(args):
        q_c, c_idx = args
        start = c_idx * MOBA_Q_CHUNK
        q_pos = start + jnp.arange(MOBA_Q_CHUNK)
        own = start // MOBA_BLOCK
        gate = jnp.einsum('bhqd,bhnd->bhqn', q_c, k_mean).astype(jnp.float32)
        gate = jnp.where(blk_ids < own, gate, NEG)
        _, sel = lax.top_k(gate, topk)
        sel_valid = jnp.arange(topk) < own
        k_sel = k_blocks[bi, hi, sel]
        v_sel = v_blocks[bi, hi, sel]
        sel_pos = sel[..., None] * MOBA_BLOCK + offs
        s_sel = jnp.einsum('bhqd,bhqnkd->bhqnk', q_c, k_sel).astype(jnp.float32) * scale
        dist_sel = (q_pos[:, None, None] - sel_pos).astype(jnp.float32)
        s_sel = s_sel - m[None, :, None, None, None] * dist_sel
        s_sel = jnp.where(sel_valid[:, None], s_sel, NEG)
        k_own = lax.dynamic_slice_in_dim(k_p, own * MOBA_BLOCK, MOBA_BLOCK, axis=2)
        v_own = lax.dynamic_slice_in_dim(v_p, own * MOBA_BLOCK, MOBA_BLOCK, axis=2)
        own_pos = own * MOBA_BLOCK + offs
        s_own = jnp.einsum('bhqd,bhkd->bhqk', q_c, k_own).astype(jnp.float32) * scale
        dist_own = (q_pos[:, None] - own_pos[None, :]).astype(jnp.float32)
        s_own = s_own - m[None, :, None, None] * dist_own
        s_own = jnp.where(dist_own >= 0, s_own, NEG)
        nsel = topk * MOBA_BLOCK
        logits = jnp.concatenate(
            [s_sel.reshape(b, h, MOBA_Q_CHUNK, nsel), s_own], axis=-1)
        p = jax.nn.softmax(logits, axis=-1).astype(v.dtype)
        p_sel = p[..., :nsel].reshape(b, h, MOBA_Q_CHUNK, topk, MOBA_BLOCK)
        p_own = p[..., nsel:]
        return (jnp.einsum('bhqnk,bhqnkd->bhqd', p_sel, v_sel)
                + jnp.einsum('bhqk,bhkd->bhqd', p_own, v_own))

    out = lax.map(one_chunk, (qc, jnp.arange(n_chunks)))
    return out.transpose(1, 2, 0, 3, 4).reshape(b, h, s, d)


def mlstm_chunkwise(q, k, v, log_i, log_f):
    b, h, s, dqk = q.shape
    dv = v.shape[-1]
    L = MLSTM_CHUNK
    nc = s // L
    k = k * (dqk ** -0.5)

    def chunks(t):
        return jnp.moveaxis(t.reshape(b, h, nc, L, *t.shape[3:]), 2, 0)

    xs = tuple(chunks(t) for t in (q, k, v, log_i, log_f))
    tri = jnp.tril(jnp.ones((L, L), dtype=bool))

    def step(carry, inp):
        C, n, m = carry
        q_t, k_t, v_t, li, lf = inp
        qf = q_t.astype(jnp.float32)
        kf = k_t.astype(jnp.float32)
        vf = v_t.astype(jnp.float32)
        bcum = jnp.cumsum(lf, axis=-1)
        d_intra = jnp.where(tri, bcum[..., :, None] - bcum[..., None, :] + li[..., None, :], NEG)
        d_inter = bcum + m[..., None]
        m_t = jnp.maximum(d_inter, jnp.max(d_intra, axis=-1))
        w_intra = jnp.exp(d_intra - m_t[..., None])
        w_inter = jnp.exp(d_inter - m_t)
        qk = jnp.einsum('bhtd,bhsd->bhts', qf, kf) * w_intra
        num = (jnp.einsum('bhts,bhsv->bhtv', qk, vf)
               + w_inter[..., None] * jnp.einsum('bhvd,bhtd->bhtv', C, qf))
        den = jnp.sum(qk, axis=-1) + w_inter * jnp.einsum('bhd,bhtd->bht', n, qf)
        h_t = num / jnp.maximum(jnp.abs(den), jnp.exp(-m_t))[..., None]
        b_last = bcum[..., -1]
        d_state = b_last[..., None] - bcum + li
        m_new = jnp.maximum(b_last + m, jnp.max(d_state, axis=-1))
        w_prev = jnp.exp(b_last + m - m_new)
        w_s = jnp.exp(d_state - m_new[..., None])
        C_new = w_prev[..., None, None] * C + jnp.einsum('bhs,bhsv,bhsd->bhvd', w_s, vf, kf)
        n_new = w_prev[..., None] * n + jnp.einsum('bhs,bhsd->bhd', w_s, kf)
        return (C_new, n_new, m_new), h_t

    init = (jnp.zeros((b, h, dv, dqk), jnp.float32),
            jnp.zeros((b, h, dqk), jnp.float32),
            jnp.zeros((b, h), jnp.float32))
    _, hs = lax.scan(step, init, xs)
    return jnp.moveaxis(hs, 0, 2).reshape(b, h, s, dv).astype(v.dtype)


def hybrid_layer(x, norm_g, w_in, fox_b_f, mlstm_conv_w, mlstm_b_i, mlstm_b_f,
                 mlstm_head_g, w_branch, w_out, slopes):
    b, s, _ = x.shape
    hn = rms_norm(x, norm_g)
    proj = jnp.einsum('bsd,dc->bsc', hn, w_in)
    (a_q, a_k, a_v, a_z, a_f, b_q, b_k, b_v, b_z,
     c_qk, c_v, c_o, c_z, c_i, c_f, gates) = jnp.split(proj, SPLIT_POINTS, axis=-1)

    log_f_a = jax.nn.log_sigmoid((a_f + fox_b_f).astype(jnp.float32)).transpose(0, 2, 1)
    y_a = forgetting_attention(to_heads(a_q, FOX_HEADS), to_heads(a_k, FOX_HEADS),
                               to_heads(a_v, FOX_HEADS), log_f_a)
    y_a = from_heads(y_a) * jax.nn.silu(a_z)

    y_b = moba_attention(to_heads(b_q, MOBA_HEADS), to_heads(b_k, MOBA_HEADS),
                         to_heads(b_v, MOBA_HEADS), slopes)
    y_b = from_heads(y_b) * jax.nn.silu(b_z)

    qk = jax.nn.silu(causal_depthwise_conv(c_qk, mlstm_conv_w))
    c_q, c_k = jnp.split(qk, 2, axis=-1)
    log_i = (c_i + mlstm_b_i).astype(jnp.float32).transpose(0, 2, 1)
    log_f_c = jax.nn.log_sigmoid((c_f + mlstm_b_f).astype(jnp.float32)).transpose(0, 2, 1)
    h_c = mlstm_chunkwise(to_heads(c_q, MLSTM_HEADS), to_heads(c_k, MLSTM_HEADS),
                          to_heads(c_v, MLSTM_HEADS), log_i, log_f_c)
    h_c = from_heads(h_c) * jax.nn.sigmoid(c_o)
    y_c = head_rms_norm(h_c, mlstm_head_g, MLSTM_HEADS) * jax.nn.silu(c_z)

    ys = jnp.stack([y_a, y_b, y_c], axis=2)
    branch_out = jnp.einsum('bsnw,nwd->bsnd', ys, w_branch)
    g = jax.nn.sigmoid(gates).reshape(b, s, N_BRANCHES, D_MODEL)
    merged = jnp.sum(g * branch_out, axis=2)
    return x + jnp.einsum('bsd,de->bse', merged, w_out)


def setup_inputs(seed: int = 0) -> dict:
    key = jax.random.key(seed)
    ks = jax.random.split(key, 12)
    f32 = jnp.float32
    x = jax.random.normal(ks[0], (BATCH, SEQ, D_MODEL), f32)
    norm_g = 1.0 + 0.02 * jax.random.normal(ks[1], (DEPTH, D_MODEL), f32)
    w_in = jax.random.normal(ks[2], (DEPTH, D_MODEL, IN_WIDTH), f32) * D_MODEL ** -0.5
    fox_b_f = (jnp.linspace(1.0, 4.0, FOX_HEADS, dtype=f32)[None, :]
               + 0.05 * jax.random.normal(ks[3], (DEPTH, FOX_HEADS), f32))
    mlstm_conv_w = jax.random.normal(ks[4], (DEPTH, MLSTM_CONV, 2 * MLSTM_QK_WIDTH), f32) * MLSTM_CONV ** -0.5
    mlstm_b_i = 0.1 * jax.random.normal(ks[5], (DEPTH, MLSTM_HEADS), f32)
    mlstm_b_f = (jnp.linspace(3.0, 6.0, MLSTM_HEADS, dtype=f32)[None, :]
                 + 0.05 * jax.random.normal(ks[6], (DEPTH, MLSTM_HEADS), f32))
    mlstm_head_g = 1.0 + 0.02 * jax.random.normal(ks[7], (DEPTH, MLSTM_V_WIDTH), f32)
    w_branch = jax.random.normal(ks[8], (DEPTH, N_BRANCHES, BRANCH_WIDTH, D_MODEL), f32) * BRANCH_WIDTH ** -0.5
    w_out = jax.random.normal(ks[9], (DEPTH, D_MODEL, D_MODEL), f32) * (0.5 * D_MODEL ** -0.5)
    final_norm_g = 1.0 + 0.02 * jax.random.normal(ks[10], (D_MODEL,), f32)
    return {"x": x, "norm_g": norm_g, "w_in": w_in, "fox_b_f": fox_b_f,
            "mlstm_conv_w": mlstm_conv_w, "mlstm_b_i": mlstm_b_i, "mlstm_b_f": mlstm_b_f,
            "mlstm_head_g": mlstm_head_g, "w_branch": w_branch, "w_out": w_out,
            "final_norm_g": final_norm_g}


def reference(x, norm_g, w_in, fox_b_f, mlstm_conv_w, mlstm_b_i, mlstm_b_f,
              mlstm_head_g, w_branch, w_out, final_norm_g):
    slopes = alibi_slopes(MOBA_HEADS)
    for layer in range(DEPTH):
        x = hybrid_layer(x, norm_g[layer], w_in[layer], fox_b_f[layer], mlstm_conv_w[layer],
                         mlstm_b_i[layer], mlstm_b_f[layer], mlstm_head_g[layer],
                         w_branch[layer], w_out[layer], slopes)
    return rms_norm(x, final_norm_g)
```

```cpp
#include <hip/hip_runtime.h>
#include <hip/hip_cooperative_groups.h>
#include <cstdio>
#include <cstdint>

namespace cg = cooperative_groups;
typedef _Float16 h16;
typedef _Float16 h16x4 __attribute__((ext_vector_type(4)));
typedef _Float16 h16x8 __attribute__((ext_vector_type(8)));
typedef float f32x4 __attribute__((ext_vector_type(4)));

constexpr int DM = 1024, BATCH = 16, SEQ = 2048, DEPTH = 2;
constexpr int TT = BATCH * SEQ;
constexpr int HB = 8;
constexpr int TH = HB * SEQ;
constexpr int INW = 9232;
constexpr int PW = 9216;
constexpr float RMS_EPS = 1e-6f;
constexpr float LOG2E = 1.4426950408889634f;
constexpr float C2 = 0.125f * LOG2E;
constexpr int PC_AQ = 0, PC_AK = 512, PC_AV = 1024, PC_AZ = 1536, PC_BQ = 2048, PC_BK = 2560, PC_BV = 3072, PC_BZ = 3584,
              PC_CQK = 4096, PC_CV = 4608, PC_CO = 5120, PC_CZ = 5632, PC_G = 6144;
__host__ __device__ inline int orig_col(int j) { return j < 2048 ? j : (j < 6144 ? j + 8 : j + 16); }
__host__ __device__ inline int small_col(int c) { return c < 8 ? 2048 + c : 6152 + (c - 8); }

constexpr size_t MiB = 1u << 20;
constexpr size_t WS_CTL = 0;
constexpr size_t WS_WSMALL = 512 * 1024;
constexpr size_t WS_SMALL = 1 * MiB;
constexpr size_t WS_CB = 3 * MiB;
constexpr size_t WS_KMEAN = 4 * MiB;
constexpr size_t WS_MSC = 5 * MiB;
constexpr size_t WS_MUN = WS_MSC, WS_MNS = WS_MSC + 512 * 1024;
constexpr size_t WS_MAMAX = 4 * MiB + 512 * 1024, WS_MBLAST = WS_MAMAX + 8192, WS_MMS = WS_MAMAX + 16384;
constexpr size_t WS_WBR = 6 * MiB;
constexpr size_t WS_WOUT = 12 * MiB;
constexpr size_t WS_WIN = 16 * MiB;
constexpr size_t WS_HN = 52 * MiB;
constexpr size_t WS_Y = 84 * MiB;
constexpr size_t WS_MRG = WS_HN;
constexpr size_t WS_U = 132 * MiB;
constexpr size_t WS_CS = 164 * MiB;
constexpr size_t WS_QKC = 180 * MiB;
constexpr size_t WS_PROJ = 196 * MiB;
constexpr size_t WS_END = 484 * MiB;

__device__ __forceinline__ float sigmoidf_(float x) { return 1.f / (1.f + __expf(-x)); }
__device__ __forceinline__ float siluf_(float x) { return x / (1.f + __expf(-x)); }
__device__ __forceinline__ float log_sigmoidf_(float x) {
    const float e = __expf(-fabsf(x)); const float l = e < 0.01f ? e * (1.f - 0.5f * e + 0.33333334f * e * e) : __logf(1.f + e); return fminf(x, 0.f) - l; }
__device__ __forceinline__ float wave_sum(float v) {
#pragma unroll
    for (int o = 1; o < 64; o <<= 1) v += __shfl_xor(v, o);
    return v;
}

__global__ void nv_convert_t(const float* __restrict__ src, int ldsrc, int K, h16* __restrict__ dst, int Nd, int mode) {
    __shared__ float tile[32][33];
    const int tx = threadIdx.x & 31, ty = threadIdx.x >> 5;
    const int j0 = blockIdx.x * 32, k0 = blockIdx.y * 32;
#pragma unroll
    for (int i = 0; i < 4; ++i) {
        const int k = k0 + ty + 8 * i, j = j0 + tx;
        const int sc = mode == 1 ? orig_col(j) : j;
        tile[ty + 8 * i][tx] = src[(size_t)k * ldsrc + sc];
    }
    __syncthreads();
#pragma unroll
    for (int i = 0; i < 4; ++i) {
        const int j = j0 + ty + 8 * i, k = k0 + tx;
        float v = tile[tx][ty + 8 * i];
        if (mode == 1 && ((j >= PC_AQ && j < PC_AQ + 512) || (j >= PC_BQ && j < PC_BQ + 512))) v *= C2;
        dst[(size_t)j * K + k] = (h16)v;
    }
}

__global__ void nv_small_w(const float* __restrict__ w_in, float* __restrict__ wsmall) {
    const int i = blockIdx.x * blockDim.x + threadIdx.x;
    if (i >= 16 * DM) return;
    const int c = i >> 10, k = i & 1023;
    wsmall[i] = w_in[(size_t)k * INW + small_col(c)];
}
__global__ void __launch_bounds__(256) nv_rmsnorm_small(const float* __restrict__ x, const float* __restrict__ g, const float* __restrict__ wsmall  ,
                                 const float* __restrict__ fox_bf, const float* __restrict__ ml_bi, const float* __restrict__ ml_bf,
                                 h16* __restrict__ hn, float* __restrict__ small, int row0, int nrows) {
    const int lane = threadIdx.x & 63, wv = (blockIdx.x * blockDim.x + threadIdx.x) >> 6, nw = (gridDim.x * blockDim.x) >> 6;
    for (int r = wv; r < nrows; r += nw) {
        const int row = row0 + r;
        const f32x4* xr = (const f32x4*)(x + (size_t)row * DM) + lane;
        f32x4 v[4]; float s = 0.f;
#pragma unroll
        for (int j = 0; j < 4; ++j) { v[j] = xr[64 * j]; s += v[j].x * v[j].x + v[j].y * v[j].y + v[j].z * v[j].z + v[j].w * v[j].w; }
        const float rstd = rsqrtf(wave_sum(s) * (1.f / DM) + RMS_EPS);
#pragma unroll
        for (int j = 0; j < 4; ++j) {
            const f32x4 gg = ((const f32x4*)g)[lane + 64 * j];
            v[j].x *= rstd * gg.x; v[j].y *= rstd * gg.y; v[j].z *= rstd * gg.z; v[j].w *= rstd * gg.w;
            h16x4 o = {(h16)v[j].x, (h16)v[j].y, (h16)v[j].z, (h16)v[j].w};
            *((h16x4*)(hn + (size_t)r * DM) + lane + 64 * j) = o;
        }
        float mine = 0.f;
#pragma unroll 1
        for (int c = 0; c < 16; ++c) {
            const f32x4* wr = (const f32x4*)(wsmall + c * DM) + lane;
            float a = 0.f;
#pragma unroll
            for (int j = 0; j < 4; ++j) { const f32x4 w = wr[64 * j]; a += v[j].x * w.x + v[j].y * w.y + v[j].z * w.z + v[j].w * w.w; }
            a = wave_sum(a);
            if (lane == c) mine = a;
        }
        if (lane < 16) {
            float o;
            if (lane < 8) o = log_sigmoidf_(mine + fox_bf[lane]);
            else if (lane < 12) o = mine + ml_bi[lane - 8];
            else o = log_sigmoidf_(mine + ml_bf[lane - 12]);
            small[(size_t)row * 16 + lane] = o;
        }
    }
}

struct GemmArgs {
    const h16* A; int lda; const h16* Bt; int ldb; int K;
    h16* C; int ldc;
    const h16* gates; int ldg;
    const float* xin; float* xout;
};
template <int EPI>
__global__ void __launch_bounds__(256) nv_gemm(GemmArgs g) {
    __shared__ float As[16][68], Bs[16][68];
    const int tid = threadIdx.x, tx = tid & 15, ty = tid >> 4;
    const int m0 = blockIdx.y * 64, n0 = blockIdx.x * 64;
    float res[4][4];
#pragma unroll
    for (int i = 0; i < 4; ++i)
#pragma unroll
        for (int j = 0; j < 4; ++j) res[i][j] = 0.f;
    const int NB = EPI == 1 ? 3 : 1;
    for (int nb = 0; nb < NB; ++nb) {
        float acc[4][4];
#pragma unroll
        for (int i = 0; i < 4; ++i)
#pragma unroll
            for (int j = 0; j < 4; ++j) acc[i][j] = 0.f;
        const h16* A = g.A + (EPI == 1 ? nb * 512 : 0);
        const h16* Bt = g.Bt + (EPI == 1 ? (size_t)nb * 1024 * 512 : 0);
        const int lr = tid >> 2, lk = (tid & 3) * 4;
        for (int k0 = 0; k0 < g.K; k0 += 16) {
            const h16x4 av = *(const h16x4*)(A + (size_t)(m0 + lr) * g.lda + k0 + lk);
            const h16x4 bv = *(const h16x4*)(Bt + (size_t)(n0 + lr) * g.ldb + k0 + lk);
            __syncthreads();
#pragma unroll
            for (int e = 0; e < 4; ++e) { As[lk + e][lr] = (float)av[e]; Bs[lk + e][lr] = (float)bv[e]; }
            __syncthreads();
#pragma unroll
            for (int kk = 0; kk < 16; ++kk) {
                float a[4], b[4];
#pragma unroll
                for (int i = 0; i < 4; ++i) { a[i] = As[kk][ty * 4 + i]; b[i] = Bs[kk][tx * 4 + i]; }
#pragma unroll
                for (int i = 0; i < 4; ++i)
#pragma unroll
                    for (int j = 0; j < 4; ++j) acc[i][j] += a[i] * b[j];
            }
        }
#pragma unroll
        for (int i = 0; i < 4; ++i)
#pragma unroll
            for (int j = 0; j < 4; ++j) {
                if (EPI == 1) {
                    const int m = m0 + ty * 4 + i, n = n0 + tx * 4 + j;
                    const float gt = (float)g.gates[(size_t)m * g.ldg + nb * 1024 + n];
                    res[i][j] += sigmoidf_(gt) * acc[i][j];
                } else res[i][j] = acc[i][j];
            }
    }
#pragma unroll
    for (int i = 0; i < 4; ++i)
#pragma unroll
        for (int j = 0; j < 4; ++j) {
            const int m = m0 + ty * 4 + i, n = n0 + tx * 4 + j;
            if (EPI == 2) g.xout[(size_t)m * DM + n] = g.xin[(size_t)m * DM + n] + res[i][j];
            else g.C[(size_t)m * g.ldc + n] = (h16)res[i][j];
        }
}

__global__ void nv_fox_cumsum(const float* __restrict__ small, float* __restrict__ cb, int b0) {
    const int i = blockIdx.x * blockDim.x + threadIdx.x;
    if (i >= HB * 8) return;
    const int bl = i >> 3, h = i & 7;
    const float* s = small + (size_t)(b0 + bl) * SEQ * 16 + h;
    float* o = cb + (size_t)((b0 + bl) * 8 + h) * SEQ;
    float c = 0.f;
    for (int t = 0; t < SEQ; ++t) { c += s[(size_t)t * 16]; o[t] = -c * LOG2E; }
}
__global__ void nv_moba_kmean(const h16* __restrict__ proj, float* __restrict__ kmean, int b0) {
    const int i = blockIdx.x * blockDim.x + threadIdx.x;
    if (i >= HB * 8 * 512) return;
    const int col = i & 511, blk = (i >> 9) & 7, bl = i >> 12;
    const h16* p = proj + (size_t)(bl * SEQ + blk * 256) * PW + PC_BK + col;
    float s = 0.f;
    for (int t = 0; t < 256; ++t) s += (float)p[(size_t)t * PW];
    const int h = col >> 6, d = col & 63;
    kmean[(((size_t)(b0 + bl) * 8 + h) * 8 + blk) * 64 + d] = s * (1.f / 256.f);
}

__global__ void __launch_bounds__(256) nv_fox_attn(const h16* __restrict__ proj, const float* __restrict__ cb, h16* __restrict__ y, int b0) {
    const int bh = blockIdx.y, bl = bh >> 3, h = bh & 7;
    const int t = blockIdx.x * 256 + threadIdx.x;
    const size_t rowb = (size_t)bl * SEQ;
    float q[64], o[64];
    {
        const h16* qp = proj + (rowb + t) * PW + PC_AQ + h * 64;
#pragma unroll
        for (int d = 0; d < 64; ++d) { q[d] = (float)qp[d]; o[d] = 0.f; }
    }
    const float* cbh = cb + (size_t)((b0 + bl) * 8 + h) * SEQ;
    float m = -INFINITY, l = 0.f;
    const int send = blockIdx.x * 256 + 255;
    for (int s = 0; s <= send; ++s) {
        const h16* kp = proj + (rowb + s) * PW + PC_AK + h * 64;
        const h16* vp = proj + (rowb + s) * PW + PC_AV + h * 64;
        float sd = 0.f;
#pragma unroll
        for (int d = 0; d < 64; ++d) sd += q[d] * (float)kp[d];
        sd += cbh[s];
        if (s <= t) {
            const float mn = fmaxf(m, sd), al = exp2f(m - mn), p = exp2f(sd - mn);
            l = l * al + p;
#pragma unroll
            for (int d = 0; d < 64; ++d) o[d] = o[d] * al + p * (float)vp[d];
            m = mn;
        }
    }
    const float il = 1.f / l;
    const h16* zp = proj + (rowb + t) * PW + PC_AZ + h * 64;
    h16* yp = y + (rowb + t) * 1536 + h * 64;
#pragma unroll
    for (int d = 0; d < 64; ++d) yp[d] = (h16)(o[d] * il * siluf_((float)zp[d]));
}

__global__ void __launch_bounds__(256) nv_moba_attn(const h16* __restrict__ proj, const float* __restrict__ kmean, h16* __restrict__ y, int b0) {
    const int bh = blockIdx.y, bl = bh >> 3, h = bh & 7;
    const int own = blockIdx.x;
    const int t = own * 256 + threadIdx.x;
    const size_t rowb = (size_t)bl * SEQ;
    float q[64], o[64];
    {
        const h16* qp = proj + (rowb + t) * PW + PC_BQ + h * 64;
#pragma unroll
        for (int d = 0; d < 64; ++d) { q[d] = (float)qp[d]; o[d] = 0.f; }
    }
    unsigned selmask = 0;
    if (own <= 3) selmask = (1u << own) - 1u;
    else {
        float gate[8];
        const float* km = kmean + ((size_t)(b0 + bl) * 8 + h) * 8 * 64;
#pragma unroll
        for (int n = 0; n < 8; ++n) {
            float sd = 0.f;
#pragma unroll
            for (int d = 0; d < 64; ++d) sd += q[d] * km[n * 64 + d];
            gate[n] = n < own ? sd : -INFINITY;
        }
        for (int r = 0; r < 3; ++r) {
            float best = -INFINITY; int bi = -1;
#pragma unroll
            for (int n = 0; n < 8; ++n) { const bool free_ = !((selmask >> n) & 1u); if (free_ && n < own && gate[n] > best) { best = gate[n]; bi = n; } }
            if (bi >= 0) selmask |= 1u << bi;
        }
    }
    const float slope2 = exp2f(-(float)(h + 1)) * LOG2E;
    float m = -INFINITY, l = 0.f;
    for (int n = 0; n <= own; ++n) {
        const bool isown = n == own;
        const bool sel = isown || ((selmask >> n) & 1u);
        for (int ss = 0; ss < 256; ++ss) {
            const int s = n * 256 + ss;
            const h16* kp = proj + (rowb + s) * PW + PC_BK + h * 64;
            const h16* vp = proj + (rowb + s) * PW + PC_BV + h * 64;
            if (sel && s <= t) {
                float sd = 0.f;
#pragma unroll
                for (int d = 0; d < 64; ++d) sd += q[d] * (float)kp[d];
                sd -= slope2 * (float)(t - s);
                const float mn = fmaxf(m, sd), al = exp2f(m - mn), p = exp2f(sd - mn);
                l = l * al + p;
#pragma unroll
                for (int d = 0; d < 64; ++d) o[d] = o[d] * al + p * (float)vp[d];
                m = mn;
            }
        }
    }
    const float il = 1.f / l;
    const h16* zp = proj + (rowb + t) * PW + PC_BZ + h * 64;
    h16* yp = y + (rowb + t) * 1536 + 512 + h * 64;
#pragma unroll
    for (int d = 0; d < 64; ++d) yp[d] = (h16)(o[d] * il * siluf_((float)zp[d]));
}

__global__ void __launch_bounds__(256) nv_mlstm(const h16* __restrict__ proj, const float* __restrict__ small, const float* __restrict__ convw  ,
                                                const float* __restrict__ headg  , h16* __restrict__ y, int b0) {
    __shared__ float qk[128];
    __shared__ float red[4];
    const int bl = blockIdx.x >> 2, hh = blockIdx.x & 3, tid = threadIdx.x, v = tid >> 1, kh = tid & 1;
    const size_t rowb = (size_t)bl * SEQ;
    float C[32], nn[32];
#pragma unroll
    for (int j = 0; j < 32; ++j) { C[j] = 0.f; nn[j] = 0.f; }
    float m = 0.f;
    const int ccol = tid < 64 ? hh * 64 + tid : 256 + hh * 64 + (tid - 64);
    float cw[4] = {0.f, 0.f, 0.f, 0.f};
    if (tid < 128) {
#pragma unroll
        for (int j = 0; j < 4; ++j) cw[j] = convw[j * 512 + ccol];
    }
    const float hg = headg[hh * 128 + v];
    for (int t = 0; t < SEQ; ++t) {
        if (tid < 128) {
            float a = 0.f;
#pragma unroll
            for (int j = 0; j < 4; ++j) { const int tt = t - 3 + j; if (tt >= 0) a += cw[j] * (float)proj[(rowb + tt) * PW + PC_CQK + ccol]; }
            a = siluf_(a);
            if (tid >= 64) a *= 0.125f;
            qk[tid] = a;
        }
        __syncthreads();
        const size_t row = rowb + t;
        const float li = small[((size_t)b0 * SEQ + row) * 16 + 8 + hh], lf = small[((size_t)b0 * SEQ + row) * 16 + 12 + hh];
        const float vt = (float)proj[row * PW + PC_CV + hh * 128 + v];
        const float mn = fmaxf(lf + m, li), fw = __expf(lf + m - mn), iw = __expf(li - mn);
        float nump = 0.f, denp = 0.f;
#pragma unroll
        for (int j = 0; j < 32; ++j) {
            const float kj = qk[64 + kh * 32 + j], qj = qk[kh * 32 + j];
            C[j] = fw * C[j] + iw * vt * kj; nn[j] = fw * nn[j] + iw * kj;
            nump += C[j] * qj; denp += nn[j] * qj;
        }
        nump += __shfl_xor(nump, 1); denp += __shfl_xor(denp, 1);
        m = mn;
        const float hval = nump / fmaxf(fabsf(denp), __expf(-mn));
        const float hgt = hval * sigmoidf_((float)proj[row * PW + PC_CO + hh * 128 + v]);
        float ss = kh == 0 ? hgt * hgt : 0.f;
        ss = wave_sum(ss);
        if ((tid & 63) == 0) red[tid >> 6] = ss;
        __syncthreads();
        const float tot = red[0] + red[1] + red[2] + red[3];
        if (kh == 0) {
            const float o = hgt * rsqrtf(tot * (1.f / 128.f) + RMS_EPS) * hg * siluf_((float)proj[row * PW + PC_CZ + hh * 128 + v]);
            y[row * 1536 + 1024 + hh * 128 + v] = (h16)o;
        }
    }
}

__global__ void nv_final_norm(float* __restrict__ x, const float* __restrict__ g) {
    const int lane = threadIdx.x & 63, wv = (blockIdx.x * blockDim.x + threadIdx.x) >> 6, nw = (gridDim.x * blockDim.x) >> 6;
    for (int row = wv; row < TT; row += nw) {
        f32x4* xr = (f32x4*)(x + (size_t)row * DM) + lane;
        f32x4 v[4]; float s = 0.f;
#pragma unroll
        for (int j = 0; j < 4; ++j) { v[j] = xr[64 * j]; s += v[j].x * v[j].x + v[j].y * v[j].y + v[j].z * v[j].z + v[j].w * v[j].w; }
        const float rstd = rsqrtf(wave_sum(s) * (1.f / DM) + RMS_EPS);
#pragma unroll
        for (int j = 0; j < 4; ++j) {
            const f32x4 gg = ((const f32x4*)g)[lane + 64 * j];
            f32x4 o = {v[j].x * rstd * gg.x, v[j].y * rstd * gg.y, v[j].z * rstd * gg.z, v[j].w * rstd * gg.w};
            xr[64 * j] = o;
        }
    }
}


namespace pg8 {
#define PG8_LAS __attribute__((address_space(3)))
typedef short s16x8 __attribute__((ext_vector_type(8)));
typedef unsigned u32x4 __attribute__((ext_vector_type(4)));
typedef float f32x2 __attribute__((ext_vector_type(2)));
typedef _Float16 h16x2 __attribute__((ext_vector_type(2)));
constexpr int BM = 256, BK = 64, HALF = 128, HTB = HALF * BK * 2  , STAGE_BYTES = 8 * HTB, NXCD = 8, WGM = 8;
__host__ __device__ __forceinline__ int lds_byte(int r, int c) { const int st = (r >> 4) * 2 + (c >> 5), rr = r & 15, cc = c & 31, ob = rr * 64 + cc * 2; return st * 1024 + (ob ^ (((ob >> 9) & 1) << 5)); }
__host__ __device__ __forceinline__ void stage_rc(int b, int& R, int& C) { const int st = b / 1024, sb = b % 1024, swz = sb ^ (((sb >> 9) & 1) << 5); R = (st >> 1) * 16 + swz / 64; C = (st & 1) * 32 + (swz % 64) / 2; }
__host__ __device__ __forceinline__ int perm32(int rho) { const int n = rho >> 4, i = rho & 15; return 8 * (i >> 2) + 4 * n + (i & 3); }
__device__ __forceinline__ unsigned cvt_pk_f16(float lo, float hi) { f32x2 v = {lo, hi}; h16x2 b = __builtin_convertvector(v, h16x2); return __builtin_bit_cast(unsigned, b); }

struct Unit { int pm, pn, z; };
struct Gemm { const h16* A; const h16* Bt; int lda, ldb, K; long zA, zB; };

__device__ __forceinline__ void tile_of(int L, int nM, int nN, int& pm, int& pn) {
    const int nwg = nM * nN; int wgid = L;
    { const int q = nwg / NXCD, r = nwg % NXCD, xcd = wgid % NXCD, off = wgid / NXCD; wgid = (xcd < r ? xcd * (q + 1) : r * (q + 1) + (xcd - r) * q) + off; }
    const int nig = WGM * nN, gid = wgid / nig, fm = gid * WGM, gsz = (nM - fm) < WGM ? (nM - fm) : WGM;
    pm = fm + ((wgid % nig) % gsz); pn = (wgid % nig) / gsz;
}
struct StaticOrder {
    int nM, nN, nwg, G, c;
    __device__ void init(int M, int N, int G_, int c_) { nM = M / BM; nN = N / BM; nwg = nM * nN; G = G_; c = c_; }
    __device__ bool next(int i, Unit& u) const { const long L = (long)i * G + c; if (L >= nwg) return false; tile_of((int)L, nM, nN, u.pm, u.pn); u.z = 0; return true; }
};
struct BranchOrder {
    int nM, nN, nwg, G, c, NZ;
    __device__ void init(int M, int N, int G_, int c_, int nz) { nM = M / BM; nN = N / BM; nwg = nM * nN; G = G_; c = c_; NZ = nz; }
    __device__ bool next(int i, Unit& u) const { const int j = i / NZ; const long L = (long)j * G + c; if (L >= nwg) return false; tile_of((int)L, nM, nN, u.pm, u.pn); u.z = i - j * NZ; return true; }
};

struct EpiF16 {
    static constexpr bool PERM = true;
    h16* C; int ldc;
    __device__ __forceinline__ void operator()(const f32x4 (&acc)[2][2][4][2], const Unit& u, int wr, int wc, int fr, int fq) const {
        const int row0 = u.pm * BM + wr * 64 + fr, col0 = u.pn * BM + wc * 32 + 8 * fq;
#pragma unroll
        for (int ai = 0; ai < 2; ++ai)
#pragma unroll
            for (int m = 0; m < 4; ++m) { h16* rowp = C + (size_t)(row0 + ai * HALF + m * 16) * ldc + col0;
#pragma unroll
                for (int bj = 0; bj < 2; ++bj) { const f32x4 v0 = acc[ai][bj][m][0], v1 = acc[ai][bj][m][1];
                    u32x4 w; w.x = cvt_pk_f16(v0[0], v0[1]); w.y = cvt_pk_f16(v0[2], v0[3]); w.z = cvt_pk_f16(v1[0], v1[1]); w.w = cvt_pk_f16(v1[2], v1[3]);
                    *(u32x4*)(rowp + bj * HALF) = w; } }
    }
};
struct EpiGate {
    static constexpr bool PERM = true;
    h16* Mg; const h16* G; int ldg;
    __device__ __forceinline__ void operator()(const f32x4 (&acc)[2][2][4][2], const Unit& u, int wr, int wc, int fr, int fq) const {
        const int row0 = u.pm * BM + wr * 64 + fr, col0 = u.pn * BM + wc * 32 + 8 * fq;
#pragma unroll
        for (int ai = 0; ai < 2; ++ai)
#pragma unroll
            for (int mp = 0; mp < 2; ++mp) {
                h16x8 gv[2][2], pv[2][2];
#pragma unroll
                for (int mm = 0; mm < 2; ++mm)
#pragma unroll
                    for (int bj = 0; bj < 2; ++bj) { const size_t row = (size_t)(row0 + ai * HALF + (2 * mp + mm) * 16);
                        gv[mm][bj] = *(const h16x8*)(G + row * ldg + u.z * 1024 + col0 + bj * HALF);
                        if (u.z > 0) pv[mm][bj] = *(const h16x8*)(Mg + row * 1024 + col0 + bj * HALF); }
#pragma unroll
                for (int mm = 0; mm < 2; ++mm)
#pragma unroll
                    for (int bj = 0; bj < 2; ++bj) { const int m = 2 * mp + mm; const size_t row = (size_t)(row0 + ai * HALF + m * 16);
                        float o[8];
#pragma unroll
                        for (int e = 0; e < 8; ++e) { const float a = e < 4 ? acc[ai][bj][m][0][e] : acc[ai][bj][m][1][e - 4]; o[e] = a * __builtin_amdgcn_rcpf(1.f + __expf(-(float)gv[mm][bj][e])); }
                        if (u.z > 0) {
#pragma unroll
                            for (int e = 0; e < 8; ++e) o[e] += (float)pv[mm][bj][e]; }
                        u32x4 w; w.x = cvt_pk_f16(o[0], o[1]); w.y = cvt_pk_f16(o[2], o[3]); w.z = cvt_pk_f16(o[4], o[5]); w.w = cvt_pk_f16(o[6], o[7]);
                        *(u32x4*)(Mg + row * 1024 + col0 + bj * HALF) = w; }
            }
    }
};
struct EpiRes {
    static constexpr bool PERM = false;
    const float* xin; float* out; int ldc;
    __device__ __forceinline__ void operator()(const f32x4 (&acc)[2][2][4][2], const Unit& u, int wr, int wc, int fr, int fq) const {
        const int row0 = u.pm * BM + wr * 64 + fr, col0 = u.pn * BM + wc * 32 + 4 * fq;
#pragma unroll
        for (int ai = 0; ai < 2; ++ai)
#pragma unroll
            for (int mp = 0; mp < 2; ++mp) {
                f32x4 xv[2][2][2];
#pragma unroll
                for (int mm = 0; mm < 2; ++mm) { const size_t off = (size_t)(row0 + ai * HALF + (2 * mp + mm) * 16) * ldc + col0;
#pragma unroll
                    for (int bj = 0; bj < 2; ++bj)
#pragma unroll
                        for (int n = 0; n < 2; ++n) xv[mm][bj][n] = *(const f32x4*)(xin + off + bj * HALF + n * 16); }
#pragma unroll
                for (int mm = 0; mm < 2; ++mm) { const int m = 2 * mp + mm; const size_t off = (size_t)(row0 + ai * HALF + m * 16) * ldc + col0;
#pragma unroll
                    for (int bj = 0; bj < 2; ++bj)
#pragma unroll
                        for (int n = 0; n < 2; ++n) *(f32x4*)(out + off + bj * HALF + n * 16) = xv[mm][bj][n] + acc[ai][bj][m][n]; }
            }
    }
};

template <class Epi, class Sched>
__device__ __forceinline__ void gemm_phase(PG8_LAS unsigned char* lds, const Gemm g, const Sched& S, const Epi& E) {
    int tid_ = threadIdx.x; asm volatile("" : "+v"(tid_));
    const int tid = tid_, wid = __builtin_amdgcn_readfirstlane(tid >> 6), lane = tid & 63, wr = wid >> 2, wc = wid & 3, fr = lane & 15, fq = lane >> 4;
    const int nt = g.K / BK;
    unsigned voffA[2], voffB[2];
#pragma unroll
    for (int i = 0; i < 2; ++i) { int R, C; stage_rc(tid * 16 + i * 8192, R, C); const int Rb = Epi::PERM ? ((R & ~31) + perm32(R & 31)) : R;
        voffA[i] = (unsigned)(R * g.lda + C) * 2u; voffB[i] = (unsigned)(Rb * g.ldb + C) * 2u; }
    const size_t kstep = (size_t)(BK * 2);
    const size_t hA = (size_t)HALF * g.lda * 2, hB = (size_t)HALF * g.ldb * 2;
    const size_t tA = 2 * hA, tB = 2 * hB;
    const unsigned ldsw = (unsigned)wid * 1024u;
    const int aoff = lds_byte(wr * 64 + fr, fq * 8), boff = lds_byte(wc * 32 + fr, fq * 8);
#define PG8_SA(b, h) (((b) * 2 + (h)) * HTB)
#define PG8_SB(b, h) ((4 + (b) * 2 + (h)) * HTB)
#define PG8_STAGE(bufoff, gbase, voff) do { _Pragma("unroll") for (int _i = 0; _i < 2; ++_i) \
        __builtin_amdgcn_global_load_lds((const unsigned*)((const char*)(gbase) + (voff)[_i]), (PG8_LAS unsigned*)(lds + (bufoff) + ldsw + _i * 8192), 16, 0, 0); } while (0)
#define PG8_LDA(dst, b, h) do { _Pragma("unroll") for (int m = 0; m < 4; ++m) _Pragma("unroll") for (int k = 0; k < 2; ++k) dst[m][k] = *(const PG8_LAS s16x8*)(lds + PG8_SA(b, h) + aoff + m * 2048 + k * 1024); } while (0)
#define PG8_LDB(dst, b, h) do { _Pragma("unroll") for (int n = 0; n < 2; ++n) _Pragma("unroll") for (int k = 0; k < 2; ++k) dst[n][k] = *(const PG8_LAS s16x8*)(lds + PG8_SB(b, h) + boff + n * 2048 + k * 1024); } while (0)
#define PG8_MMA(ai, bj, At, Bt) do { __builtin_amdgcn_s_setprio(1); _Pragma("unroll") for (int m = 0; m < 4; ++m) _Pragma("unroll") for (int n = 0; n < 2; ++n) _Pragma("unroll") for (int k = 0; k < 2; ++k) \
        acc[ai][bj][m][n] = __builtin_amdgcn_mfma_f32_16x16x32_f16(__builtin_bit_cast(h16x8, Bt[n][k]), __builtin_bit_cast(h16x8, At[m][k]), acc[ai][bj][m][n], 0, 0, 0); __builtin_amdgcn_s_setprio(0); } while (0)
#define PG8_WAIT_V(n) asm volatile("s_waitcnt vmcnt(" #n ")" ::: "memory")
#define PG8_WAIT_L(n) asm volatile("s_waitcnt lgkmcnt(" #n ")" ::: "memory")
#define PG8_BAR __builtin_amdgcn_s_barrier()
#define PG8_SCHED __builtin_amdgcn_sched_barrier(0)
    Unit cur, nxt; int ui = 0;
    if (!S.next(0, cur)) return;
    f32x4 acc[2][2][4][2];
#pragma unroll
    for (int a = 0; a < 2; ++a)
#pragma unroll
        for (int b = 0; b < 2; ++b)
#pragma unroll
            for (int m = 0; m < 4; ++m)
#pragma unroll
                for (int n = 0; n < 2; ++n) acc[a][b][m][n] = (f32x4){0.f, 0.f, 0.f, 0.f};
    s16x8 At[4][2], B0[2][2], B1[2][2];
    const char* cA = (const char*)(g.A + (long)cur.z * g.zA) + (size_t)cur.pm * tA; const char* cB = (const char*)(g.Bt + (long)cur.z * g.zB) + (size_t)cur.pn * tB;
    PG8_STAGE(PG8_SB(0, 0), cB, voffB); PG8_STAGE(PG8_SB(0, 1), cB + hB, voffB); PG8_STAGE(PG8_SA(0, 0), cA, voffA); PG8_STAGE(PG8_SA(0, 1), cA + hA, voffA);
    if (wr == 1) PG8_BAR;
    PG8_WAIT_V(2); PG8_BAR;
    PG8_STAGE(PG8_SB(1, 0), cB + kstep, voffB); PG8_STAGE(PG8_SA(1, 0), cA + kstep, voffA); PG8_STAGE(PG8_SB(1, 1), cB + hB + kstep, voffB);
    PG8_WAIT_V(6); PG8_BAR;
    for (;;) {
        const bool has_next = S.next(ui + 1, nxt);
        const char* nA = has_next ? (const char*)(g.A + (long)nxt.z * g.zA) + (size_t)nxt.pm * tA : cA; const char* nB = has_next ? (const char*)(g.Bt + (long)nxt.z * g.zB) + (size_t)nxt.pn * tB : cB;
        for (int t = 0; t < nt; t += 2) {
            const bool last = (t == nt - 2);
            const char* a1 = cA + (size_t)(t + 1) * kstep;
            const char* a2 = last ? nA : cA + (size_t)(t + 2) * kstep; const char* b2 = last ? nB : cB + (size_t)(t + 2) * kstep;
            const char* a3 = a2 + kstep; const char* b3 = b2 + kstep;
            PG8_LDB(B0, 0, 0); PG8_LDB(B1, 0, 1); PG8_SCHED; PG8_LDA(At, 0, 0); PG8_STAGE(PG8_SA(1, 1), a1 + hA, voffA);
            PG8_WAIT_V(8); PG8_WAIT_L(0); PG8_BAR; PG8_MMA(0, 0, At, B0); PG8_MMA(0, 1, At, B1); PG8_BAR; PG8_SCHED;
            PG8_LDA(At, 0, 1); PG8_STAGE(PG8_SB(0, 0), b2, voffB); PG8_STAGE(PG8_SB(0, 1), b2 + hB, voffB); PG8_STAGE(PG8_SA(0, 0), a2, voffA);
            PG8_WAIT_V(8); PG8_WAIT_L(0); PG8_BAR; PG8_MMA(1, 0, At, B0); PG8_MMA(1, 1, At, B1); PG8_BAR; PG8_SCHED;
            PG8_LDB(B0, 1, 0); PG8_LDB(B1, 1, 1); PG8_SCHED; PG8_LDA(At, 1, 0); PG8_STAGE(PG8_SA(0, 1), a2 + hA, voffA);
            PG8_WAIT_V(8); PG8_WAIT_L(0); PG8_BAR; PG8_MMA(0, 0, At, B0); PG8_MMA(0, 1, At, B1); PG8_BAR; PG8_SCHED;
            PG8_LDA(At, 1, 1); PG8_STAGE(PG8_SB(1, 0), b3, voffB); PG8_STAGE(PG8_SB(1, 1), b3 + hB, voffB); PG8_STAGE(PG8_SA(1, 0), a3, voffA);
            PG8_WAIT_V(8); PG8_WAIT_L(0); PG8_BAR; PG8_MMA(1, 0, At, B0); PG8_MMA(1, 1, At, B1); PG8_BAR; PG8_SCHED;
        }
        if (wr == 0) PG8_BAR;
        E(acc, cur, wr, wc, fr, fq);
        if (!has_next) break;
#pragma unroll
        for (int a = 0; a < 2; ++a)
#pragma unroll
            for (int b = 0; b < 2; ++b)
#pragma unroll
                for (int m = 0; m < 4; ++m)
#pragma unroll
                    for (int n = 0; n < 2; ++n) acc[a][b][m][n] = (f32x4){0.f, 0.f, 0.f, 0.f};
        cur = nxt; cA = nA; cB = nB; ++ui;
        if (wr == 1) PG8_BAR;
    }
    PG8_WAIT_V(0);
    PG8_BAR;
#undef PG8_SA
#undef PG8_SB
#undef PG8_STAGE
#undef PG8_LDA
#undef PG8_LDB
#undef PG8_MMA
#undef PG8_WAIT_V
#undef PG8_WAIT_L
#undef PG8_BAR
#undef PG8_SCHED
}
}

namespace attn_body {
using s16x8 = __attribute__((ext_vector_type(8))) short;
using s16x4 = __attribute__((ext_vector_type(4))) short;
using f32x16 = __attribute__((ext_vector_type(16))) float;
using u32x4 = __attribute__((ext_vector_type(4))) unsigned;
constexpr int D = 64, NW = 8, QBLK = 32, QB = QBLK * NW, KVBLK = 64;
constexpr int PQ = PW;
__device__ __forceinline__ int crow(int r, int hi) { return (r & 3) + 8 * (r >> 2) + 4 * hi; }
#define SBAR() __builtin_amdgcn_sched_barrier(0)
__device__ __forceinline__ void cmask(f32x16& p0, f32x16& p1, int jb, int qrel, int hi) {
    const float NEG = -INFINITY; int kb = 64 * jb + 4 * hi;
#pragma unroll
    for (int r = 0; r < 16; ++r) { int kv = kb + (r & 3) + 8 * (r >> 2); if (kv > qrel) p0[r] = NEG; if (kv + 32 > qrel) p1[r] = NEG; }
}
constexpr int NSLOT = 3, SLOTB = 8192;
constexpr int LDS_K = 0, LDS_V = NSLOT * SLOTB, LDS_WS = 2 * NSLOT * SLOTB, LDS_OST = LDS_WS + NW * 64 * 4, LDS_BT = LDS_OST + NW * 4096, LDS_INF = LDS_BT + 2048 * 4, LDS_KM = LDS_INF + 256, LDS_BYTES = LDS_KM + 2048;
__device__ __forceinline__ void glds16(const void* gsrc, unsigned lds_dst) { unsigned keep;
    asm volatile("s_mov_b32 %0, m0\n\ts_mov_b32 m0, %2\n\ts_nop 0\n\tglobal_load_lds_dwordx4 %1, off\n\ts_mov_b32 m0, %0" : "=&s"(keep) : "v"(gsrc), "s"(lds_dst) : "memory"); }
__device__ __forceinline__ float max3f(float a, float b, float c) { float r; asm("v_max3_f32 %0, %1, %2, %3" : "=v"(r) : "v"(a), "v"(b), "v"(c)); return r; }
__device__ __forceinline__ float max2f(float a, float b) { float r; asm("v_max_f32_e32 %0, %1, %2" : "=v"(r) : "v"(a), "v"(b)); return r; }
__device__ __forceinline__ float fadd_s(float a, float b) { float r; asm("v_add_f32_e32 %0, %1, %2" : "=v"(r) : "v"(a), "v"(b)); return r; }
__device__ __forceinline__ float fsub_s(float a, float b) { float r; asm("v_sub_f32_e32 %0, %1, %2" : "=v"(r) : "v"(a), "v"(b)); return r; }
__device__ __forceinline__ unsigned cvtpk_s(float lo, float hi) { return pg8::cvt_pk_f16(lo, hi); }
#define MFMA32(a, b, c) __builtin_amdgcn_mfma_f32_32x32x16_f16(__builtin_bit_cast(h16x8, (a)), __builtin_bit_cast(h16x8, (b)), (c), 0, 0, 0)
#define WAIT_BAR(N) asm volatile("s_waitcnt vmcnt(" #N ") lgkmcnt(0)\n\ts_barrier" ::: "memory")
__device__ __forceinline__ void qkt(f32x16& p0, f32x16& p1, const char* Kslot, const s16x8* qr, const f32x16& negm, int r32, int hi) {
    const char* kb = Kslot + hi * 1024 + r32 * 16;
#pragma unroll
    for (int d0 = 0; d0 < 4; ++d0) {
        const s16x8 b0 = *reinterpret_cast<const s16x8*>(kb + d0 * 2048);
        const s16x8 b1 = *reinterpret_cast<const s16x8*>(kb + d0 * 2048 + 512);
        if (d0 == 0) { p0 = MFMA32(b0, qr[0], negm); p1 = MFMA32(b1, qr[0], negm); }
        else { p0 = MFMA32(b0, qr[d0], p0); p1 = MFMA32(b1, qr[d0], p1); } }
}
typedef __attribute__((address_space(3))) const char* lds_cptr;
typedef short v4i16_t __attribute__((ext_vector_type(4)));
#define LDS8(p) (*(const __attribute__((address_space(3))) s16x8*)(p))
__device__ __forceinline__ void kload8(s16x8* kf, lds_cptr kp) {
    kf[0] = LDS8(kp); kf[1] = LDS8(kp + 512); kf[2] = LDS8(kp + 2048); kf[3] = LDS8(kp + 2560);
    kf[4] = LDS8(kp + 4096); kf[5] = LDS8(kp + 4608); kf[6] = LDS8(kp + 6144); kf[7] = LDS8(kp + 6656);
}
__device__ __forceinline__ void kload2(s16x8* kf, lds_cptr kp, int j) { kf[2 * j] = LDS8(kp + j * 2048); kf[2 * j + 1] = LDS8(kp + j * 2048 + 512); }
__device__ __forceinline__ s16x4 vtr(lds_cptr p) { return __builtin_bit_cast(s16x4, __builtin_amdgcn_ds_read_tr16_b64_v4i16((__attribute__((address_space(3))) v4i16_t*)p)); }
__device__ __forceinline__ float rowmax(const f32x16& p0, const f32x16& p1) {
    float a = max3f(p0[0], p0[1], p1[0]), b = max3f(p0[2], p0[3], p1[1]); a = max3f(a, p1[2], p1[3]);
#pragma unroll
    for (int r = 4; r < 16; r += 4) { a = max3f(a, p0[r], p0[r + 1]); b = max3f(b, p0[r + 2], p0[r + 3]); a = max3f(a, p1[r], p1[r + 1]); b = max3f(b, p1[r + 2], p1[r + 3]); }
    const float m = max2f(a, b);
    auto rr = __builtin_amdgcn_permlane32_swap(__float_as_uint(m), __float_as_uint(m), false, false);
    return max2f(__uint_as_float(rr[0]), __uint_as_float(rr[1]));
}
__device__ __forceinline__ void pv(f32x16* o, int vb, s16x8 pa0, s16x8 pa1, s16x8 pa2, s16x8 pa3) {
#pragma unroll
    for (int d0 = 0; d0 < 2; ++d0) { s16x4 lo[4], hi[4];
#pragma unroll
        for (int ks = 0; ks < 4; ++ks) {
            asm volatile("ds_read_b64_tr_b16 %0,%1 offset:%c2" : "=&v"(lo[ks]) : "v"(vb), "i"(d0 * 4096 + ks * 1024) : "memory");
            asm volatile("ds_read_b64_tr_b16 %0,%1 offset:%c2" : "=&v"(hi[ks]) : "v"(vb), "i"(d0 * 4096 + ks * 1024 + 512) : "memory"); }
        asm volatile("s_waitcnt lgkmcnt(0)" ::: "memory"); SBAR();
#define PK(k) (s16x8){lo[k][0], lo[k][1], lo[k][2], lo[k][3], hi[k][0], hi[k][1], hi[k][2], hi[k][3]}
        o[d0] = MFMA32(pa0, PK(0), o[d0]);
        o[d0] = MFMA32(pa1, PK(1), o[d0]);
        o[d0] = MFMA32(pa2, PK(2), o[d0]);
        o[d0] = MFMA32(pa3, PK(3), o[d0]);
#undef PK
    }
}

template <bool MOBA, int THRL>
__device__ __forceinline__ void attn_unit(int bl, int h, int qb, const h16* Q, const h16* __restrict__ K, const h16* __restrict__ V, const h16* __restrict__ Z, h16* Y,
                                          const float* __restrict__ bsrc, float slope2, const float* __restrict__ kmean, char* shm) {
    int tid_ = threadIdx.x; asm volatile("" : "+v"(tid_));
    const int tid = tid_, lane = tid & 63, r32 = lane & 31, hi = lane >> 5; const int wid = __builtin_amdgcn_readfirstlane(tid >> 6);
    const long rowbase = (long)bl * SEQ; const int q0 = qb * QB;
    const h16* Qw = Q + (rowbase + q0 + wid * QBLK) * PQ + h * D;
    const h16* Kh = K + rowbase * PQ + h * D, *Vh = V + rowbase * PQ + h * D;
    const unsigned lds0 = (unsigned)(uintptr_t)shm;
    float* wsf = (float*)(shm + LDS_WS) + wid * 64;
    typedef __attribute__((address_space(3))) float lds_f32;
    typedef __attribute__((address_space(3))) const f32x4 lds_cf32x4;
    const lds_cptr shm3 = (lds_cptr)shm;
    {
        lds_f32* bt = (lds_f32*)(shm3 + LDS_BT);
        const int nkeys = q0 + QB;
        if (MOBA) { for (int i = tid; i < nkeys; i += NW * 64) bt[i] = slope2 * (float)(i - q0); }
        else { for (int i = tid; i < nkeys; i += NW * 64) bt[i] = bsrc[i]; }
        if (tid < 64) ((lds_f32*)(shm3 + LDS_INF))[tid] = -INFINITY;
        if (MOBA) { if (tid < 512) ((lds_f32*)(shm3 + LDS_KM))[tid] = kmean[tid]; }
    }
    const h16* ksrc = Kh + (long)lane * PQ + wid * 8;
    const h16* vsrc = Vh + (long)(16 * (wid & 3) + (lane >> 2)) * PQ + (wid >> 2) * 32 + (lane & 3) * 8;
    const unsigned kdst = lds0 + LDS_K + wid * 1024, vdst = lds0 + LDS_V + wid * 1024;
    const int NT = (q0 + QB) / KVBLK;
#define AMAP(t) (MOBA ? ((t) < 4 ? 4 * qb + (t) : (t) - 4) : (t))
#define DMA_K(t, slot) glds16(ksrc + (long)AMAP(t) * KVBLK * PQ, (unsigned)__builtin_amdgcn_readfirstlane(kdst + (slot)))
#define DMA_V(t, slot) glds16(vsrc + (long)AMAP(t) * KVBLK * PQ, (unsigned)__builtin_amdgcn_readfirstlane(vdst + (slot)))
    const char* Kbase = shm + LDS_K; s16x8 kf[8];
    const lds_cptr kp0 = shm3 + LDS_K + hi * 1024 + r32 * 16; const lds_cptr vp0 = shm3 + LDS_V + ((lane >> 4) & 1) * 32 + (lane & 3) * 8 + (4 * hi + ((lane & 15) >> 2)) * 64;
    DMA_K(0, 0); DMA_V(0, 0); DMA_K(1, SLOTB);
    s16x8 qr[4];
#pragma unroll
    for (int d0 = 0; d0 < 4; ++d0) qr[d0] = *reinterpret_cast<const s16x8*>(&Qw[(long)r32 * PQ + d0 * 16 + hi * 8]);
    float mhat = 0.f, l_reg = 0.f; f32x16 o[2]; o[0] = f32x16{}; o[1] = f32x16{}; f32x16 negm = f32x16{}; asm volatile("" : "+v"(negm));
    const int qrel = wid * QBLK + r32;
    unsigned selbits = 0xffu;
#define ADDB(P0, P1, t) do { const int kt_ = AMAP(t); lds_cptr tb_ = shm3 + LDS_BT + kt_ * 256; \
        if (MOBA) { const bool s_ = ((t) < 4) || ((selbits >> (kt_ >> 2)) & 1u); tb_ = s_ ? tb_ : (shm3 + LDS_INF); } \
        _Pragma("unroll") for (int g_ = 0; g_ < 4; ++g_) { const f32x4 b0_ = *(lds_cf32x4*)(tb_ + 16 * hi + 32 * g_), b1_ = *(lds_cf32x4*)(tb_ + 128 + 16 * hi + 32 * g_); \
            _Pragma("unroll") for (int i_ = 0; i_ < 4; ++i_) { P0[4 * g_ + i_] += b0_[i_]; P1[4 * g_ + i_] += b1_[i_]; } } } while (0)
#define CMASK(P0, P1, t) do { const int jb_ = MOBA ? (t) : (t) - (NT - 4); if (MOBA ? (jb_ < 4) : (jb_ >= 0)) cmask(P0, P1, jb_, qrel, hi); } while (0)
    bool resc = false;
#define START(P0, P1) do { const float rm = rowmax(P0, P1); resc = false; \
    { const float dl = rm; mhat = fadd_s(mhat, dl); \
      _Pragma("unroll") for (int r = 0; r < 16; ++r) { P0[r] = fsub_s(P0[r], dl); P1[r] = fsub_s(P1[r], dl); } \
      _Pragma("unroll") for (int r = 0; r < 16; ++r) negm[r] = -mhat; asm volatile("" : "+v"(negm)); } \
    _Pragma("unroll") for (int r = 0; r < 16; ++r) P0[r] = __builtin_amdgcn_exp2f(P0[r]); } while (0)
#define RESC() do { if (resc) { asm volatile("s_waitcnt lgkmcnt(0)" ::: "memory"); \
      _Pragma("unroll") for (int d_ = 0; d_ < 2; ++d_) _Pragma("unroll") for (int r = 0; r < 16; ++r) o[d_][r] *= wsf[crow(r, hi)]; } } while (0)
    f32x16 pA0, pA1, pB0, pB1;
    int sl_prev = 0, sl_cur = 0, sl_next = SLOTB;
#define ROT() do { sl_prev = sl_cur; sl_cur = sl_next; sl_next = (sl_next == (NSLOT - 1) * SLOTB) ? 0 : sl_next + SLOTB; } while (0)
    DMA_K(2, 2 * SLOTB);
    WAIT_BAR(3);
    if (MOBA && qb >= 4) {
        float gate[8];
#pragma unroll
        for (int n = 0; n < 8; ++n) gate[n] = 0.f;
#pragma unroll
        for (int d0 = 0; d0 < 4; ++d0) {
            const h16x8 qv = __builtin_bit_cast(h16x8, qr[d0]);
#pragma unroll
            for (int n = 0; n < 7; ++n) {
                const f32x4 k0 = *(lds_cf32x4*)(shm3 + LDS_KM + n * 256 + d0 * 64 + hi * 32), k1 = *(lds_cf32x4*)(shm3 + LDS_KM + n * 256 + d0 * 64 + hi * 32 + 16);
                gate[n] += (float)qv[0] * k0[0] + (float)qv[1] * k0[1] + (float)qv[2] * k0[2] + (float)qv[3] * k0[3] + (float)qv[4] * k1[0] + (float)qv[5] * k1[1] + (float)qv[6] * k1[2] + (float)qv[7] * k1[3];
            }
        }
#pragma unroll
        for (int n = 0; n < 7; ++n) { gate[n] += __shfl_xor(gate[n], 32); if (n >= qb) gate[n] = -INFINITY; }
        unsigned sb = 0u;
#pragma unroll
        for (int r = 0; r < 3; ++r) {
            float best = -INFINITY; int bi = 0;
#pragma unroll
            for (int n = 0; n < 7; ++n) { const bool fr_ = !((sb >> n) & 1u); if (fr_ && gate[n] > best) { best = gate[n]; bi = n; } }
            sb |= 1u << bi;
        }
        selbits = sb;
    }
    qkt(pA0, pA1, Kbase, qr, negm, r32, hi); asm volatile("s_nop 15\n\ts_nop 7" : "+v"(pA0), "+v"(pA1)); ADDB(pA0, pA1, 0); CMASK(pA0, pA1, 0);
    START(pA0, pA1);
    _Pragma("unroll") for (int r = 0; r < 16; ++r) pA1[r] = __builtin_amdgcn_exp2f(pA1[r]);
    WAIT_BAR(0);
    DMA_K(3, 0); DMA_V(1, SLOTB);
    ROT();
    kload8(kf, kp0 + sl_cur);
    WAIT_BAR(2);
    s16x4 vlo[8], vhi[8]; u32x4 pw0, pw1, pw2, pw3;
#define PKW(P, B) cvtpk_s(P[B], P[B + 1])
#define PAF(k) __builtin_bit_cast(s16x8, pw##k)
#define VFR(i) (s16x8){vlo[i][0], vlo[i][1], vlo[i][2], vlo[i][3], vhi[i][0], vhi[i][1], vhi[i][2], vhi[i][3]}
#define PIN(x) asm volatile("" : "+v"(x))
#define MX3(a, b, c) __builtin_fmaxf(__builtin_fmaxf((a), (b)), (c))
#define GAPA(MF, A0, A1, A2, A3, W0, W1, PW_) do { MF; sacc += A0; sacc += A1; sacc += A2; sacc += A3; PIN(sacc); W0; W1; PIN(PW_); SBAR(); } while (0)
#define EX(v) __builtin_amdgcn_exp2f(v)
#define GAPB(MF, X, B) do { MF; X[B] = EX(X[B]); X[B + 1] = EX(X[B + 1]); X[B + 2] = EX(X[B + 2]); X[B + 3] = EX(X[B + 3]); PIN(X); SBAR(); } while (0)
#define VRD(i) do { vlo[i] = vtr(vp_ + (((i) >> 2) * 4096 + ((i) & 3) * 1024)); vhi[i] = vtr(vp_ + (((i) >> 2) * 4096 + ((i) & 3) * 1024 + 512)); } while (0)
#define KRD(G, j) do { if (G) { kload2(kf, kp0 + sl_next, j); SBAR(); } } while (0)
#define STEP(C0, C1, P0, P1, t, GK, GV, GL) do { SBAR(); \
    const lds_cptr vp_ = vp0 + sl_prev; \
    VRD(0); SBAR(); float sacc = (P0[0] + P0[1]); \
    GAPA(C0 = MFMA32(kf[0], qr[0], negm), P0[2], P0[3], P0[4], P0[5],     pw0[0] = PKW(P0, 0), pw0[1] = PKW(P0, 2), pw0); \
    VRD(4); SBAR(); GAPA(C1 = MFMA32(kf[1], qr[0], negm), P0[6], P0[7], P0[8], P0[9],     pw0[2] = PKW(P0, 4), pw0[3] = PKW(P0, 6), pw0); \
    VRD(1); SBAR(); GAPA(C0 = MFMA32(kf[2], qr[1], C0),   P0[10], P0[11], P0[12], P0[13], pw1[0] = PKW(P0, 8), pw1[1] = PKW(P0, 10), pw1); \
    VRD(5); SBAR(); GAPA(C1 = MFMA32(kf[3], qr[1], C1),   P0[14], P0[15], P1[0], P1[1],   pw1[2] = PKW(P0, 12), pw1[3] = PKW(P0, 14), pw1); \
    VRD(2); SBAR(); GAPA(C0 = MFMA32(kf[4], qr[2], C0),   P1[2], P1[3], P1[4], P1[5],     pw2[0] = PKW(P1, 0), pw2[1] = PKW(P1, 2), pw2); \
    VRD(6); SBAR(); GAPA(C1 = MFMA32(kf[5], qr[2], C1),   P1[6], P1[7], P1[8], P1[9],     pw2[2] = PKW(P1, 4), pw2[3] = PKW(P1, 6), pw2); \
    VRD(3); SBAR(); GAPA(C0 = MFMA32(kf[6], qr[3], C0),   P1[10], P1[11], P1[12], P1[13], pw3[0] = PKW(P1, 8), pw3[1] = PKW(P1, 10), pw3); \
    VRD(7); SBAR(); GAPA(C1 = MFMA32(kf[7], qr[3], C1),   P1[14], P1[15], 0.f, 0.f,       pw3[2] = PKW(P1, 12), pw3[3] = PKW(P1, 14), pw3); \
    l_reg += sacc; \
    if (GK) { DMA_K((t) + 3, sl_cur); } if (GV) { DMA_V((t) + 1, sl_next); } \
    ADDB(C0, C1, t); CMASK(C0, C1, t); \
    { float a = MX3(C0[0], C0[1], C1[0]), b = MX3(C0[2], C0[3], C1[1]); a = MX3(a, C1[2], C1[3]); \
      _Pragma("unroll") for (int r = 4; r < 16; r += 4) { a = MX3(a, C0[r], C0[r + 1]); b = MX3(b, C0[r + 2], C0[r + 3]); a = MX3(a, C1[r], C1[r + 1]); b = MX3(b, C1[r + 2], C1[r + 3]); } \
      float rm = __builtin_fmaxf(a, b); { auto rr = __builtin_amdgcn_permlane32_swap(__float_as_uint(rm), __float_as_uint(rm), false, false); rm = __builtin_fmaxf(__uint_as_float(rr[0]), __uint_as_float(rr[1])); } \
      resc = false; \
      if (__builtin_expect(__any(rm > (float)THRL), 0)) { const float dl = __builtin_fmaxf(rm, 0.f); mhat += dl; \
        _Pragma("unroll") for (int r = 0; r < 16; ++r) { C0[r] -= dl; C1[r] -= dl; } \
        _Pragma("unroll") for (int r = 0; r < 16; ++r) negm[r] = -mhat; asm volatile("" : "+v"(negm)); \
        const float f = __builtin_amdgcn_exp2f(-dl); l_reg *= f; if (hi == 0) wsf[r32] = f; resc = true; } } \
    SBAR(); \
    GAPB(o[0] = MFMA32(PAF(0), VFR(0), o[0]), C0, 0); \
    GAPB(o[1] = MFMA32(PAF(0), VFR(4), o[1]), C0, 4); \
    KRD(GL, 0); GAPB(o[0] = MFMA32(PAF(1), VFR(1), o[0]), C0, 8); \
    KRD(GL, 1); GAPB(o[1] = MFMA32(PAF(1), VFR(5), o[1]), C0, 12); \
    KRD(GL, 2); GAPB(o[0] = MFMA32(PAF(2), VFR(2), o[0]), C1, 0); \
    KRD(GL, 3); GAPB(o[1] = MFMA32(PAF(2), VFR(6), o[1]), C1, 4); \
    GAPB(o[0] = MFMA32(PAF(3), VFR(3), o[0]), C1, 8); \
    GAPB(o[1] = MFMA32(PAF(3), VFR(7), o[1]), C1, 12); \
    } while (0)
    int t = 1;
#define ENDW(tt) do { if ((tt) + 3 < NT) { WAIT_BAR(2); } else if ((tt) + 2 < NT) { WAIT_BAR(1); } else { WAIT_BAR(0); } } while (0)
    for (; t + 1 < NT; t += 2) {
        STEP(pB0, pB1, pA0, pA1, t, (t + 3 < NT), (t + 1 < NT), (t + 1 < NT));       ENDW(t);     RESC(); ROT();
        STEP(pA0, pA1, pB0, pB1, t + 1, (t + 4 < NT), (t + 2 < NT), (t + 2 < NT));   ENDW(t + 1); RESC(); ROT();
    }
    STEP(pB0, pB1, pA0, pA1, NT - 1, false, false, false); RESC();
    { float sacc = pB0[0] + pB0[1]; _Pragma("unroll") for (int r = 2; r < 16; ++r) sacc += pB0[r]; _Pragma("unroll") for (int r = 0; r < 16; ++r) sacc += pB1[r]; l_reg += sacc;
      pw0 = (u32x4){PKW(pB0, 0), PKW(pB0, 2), PKW(pB0, 4), PKW(pB0, 6)}; pw1 = (u32x4){PKW(pB0, 8), PKW(pB0, 10), PKW(pB0, 12), PKW(pB0, 14)}; pw2 = (u32x4){PKW(pB1, 0), PKW(pB1, 2), PKW(pB1, 4), PKW(pB1, 6)}; pw3 = (u32x4){PKW(pB1, 8), PKW(pB1, 10), PKW(pB1, 12), PKW(pB1, 14)};
      int ln_ = threadIdx.x & 63; asm volatile("" : "+v"(ln_));
      const int vb0 = (int)(lds0 + LDS_V) + ((ln_ >> 4) & 1) * 32 + (ln_ & 3) * 8 + (4 * (ln_ >> 5) + ((ln_ & 15) >> 2)) * 64;
      SBAR(); pv(o, vb0 + sl_cur, PAF(0), PAF(1), PAF(2), PAF(3)); }
#undef PKW
#undef PAF
#undef VFR
#undef PIN
#undef MX3
#undef GAPA
#undef GAPB
#undef EX
#undef VRD
#undef KRD
#undef STEP
#undef ENDW
    { auto rr = __builtin_amdgcn_permlane32_swap(__float_as_uint(l_reg), __float_as_uint(l_reg), false, false); l_reg = __uint_as_float(rr[0]) + __uint_as_float(rr[1]); }
    if (hi == 0) wsf[32 + r32] = l_reg; asm volatile("s_waitcnt lgkmcnt(0)" ::: "memory");
    float rli[16];
#pragma unroll
    for (int r = 0; r < 16; ++r) rli[r] = __builtin_amdgcn_rcpf(wsf[32 + crow(r, hi)]);
    {
        int le = threadIdx.x & 63; asm volatile("" : "+v"(le));
        float* stg = (float*)(shm + LDS_OST) + wid * 1024;
        const h16* Zw = Z + (rowbase + q0 + wid * QBLK) * PQ + h * D;
        h16* Yw = Y + (rowbase + q0 + wid * QBLK) * 1536 + h * D;
#pragma unroll
        for (int d0 = 0; d0 < 2; ++d0) {
#pragma unroll
            for (int r = 0; r < 16; ++r) stg[crow(r, le >> 5) * 32 + (le & 31)] = o[d0][r] * rli[r];
            asm volatile("s_waitcnt lgkmcnt(0)" ::: "memory");
#pragma unroll
            for (int i = 0; i < 2; ++i) { const int row = i * 16 + (le >> 2), ch = le & 3;
                const f32x4 a0 = *(const f32x4*)(stg + row * 32 + ch * 8), a1 = *(const f32x4*)(stg + row * 32 + ch * 8 + 4);
                const h16x8 zv = *(const h16x8*)(Zw + (long)row * PQ + d0 * 32 + ch * 8);
                float ov[8] = {a0[0], a0[1], a0[2], a0[3], a1[0], a1[1], a1[2], a1[3]};
#pragma unroll
                for (int e = 0; e < 8; ++e) { const float zz = (float)zv[e]; ov[e] *= zz * __builtin_amdgcn_rcpf(1.f + __expf(-zz)); }
                u32x4 w; w.x = cvtpk_s(ov[0], ov[1]); w.y = cvtpk_s(ov[2], ov[3]); w.z = cvtpk_s(ov[4], ov[5]); w.w = cvtpk_s(ov[6], ov[7]);
                *(u32x4*)(Yw + (long)row * 1536 + d0 * 32 + ch * 8) = w; }
            asm volatile("s_waitcnt lgkmcnt(0)" ::: "memory");
        }
    }
    asm volatile("s_waitcnt vmcnt(0) lgkmcnt(0)\n\ts_barrier" ::: "memory");
#undef DMA_K
#undef DMA_V
#undef AMAP
#undef ADDB
#undef CMASK
#undef START
#undef RESC
#undef ROT
}
#undef SBAR
#undef WAIT_BAR
#undef MFMA32
#undef LDS8
}

constexpr int NWAVES = 8, NTHREADS = 512;
constexpr int MK_LDS_BYTES = 147456;
enum { PH_NORM = 0, PH_PROJ = 1, PH_PRE = 2, PH_SCAN = 3, PH_MIX = 4, PH_BR = 5, PH_OUT = 6, NPH = 7 };
constexpr int N_STEPS = 1 + NPH * 4 + 1;
struct MArgs { const float* in[11]; float* out; unsigned char* ws; int s_lo, s_hi; };

__device__ __forceinline__ void barrier_lds() { asm volatile("s_waitcnt vmcnt(0) lgkmcnt(0)" ::: "memory"); __syncthreads(); }
__device__ __forceinline__ void fox_cumsum_item(int item, int b0, const float* __restrict__ small, float* __restrict__ cb, char* shm) {
    int tid_ = threadIdx.x; asm volatile("" : "+v"(tid_));
    const int tid = tid_, lane = tid & 63, wid = tid >> 6, bl = item >> 3, h = item & 7;
    const float* sp = small + ((size_t)(b0 + bl) * SEQ + 4 * tid) * 16 + h;
    float v0 = sp[0], v1 = sp[16], v2 = sp[32], v3 = sp[48];
    v1 += v0; v2 += v1; v3 += v2;
    float tot = v3;
#pragma unroll
    for (int o = 1; o < 64; o <<= 1) { const float u = __shfl_up(tot, o); if (lane >= o) tot += u; }
    float* wt = (float*)shm;
    if (lane == 63) wt[wid] = tot;
    __syncthreads();
    float base = tot - v3;
    for (int w = 0; w < wid; ++w) base += wt[w];
    float* o4 = cb + (size_t)((b0 + bl) * 8 + h) * SEQ + 4 * tid;
    *(f32x4*)o4 = (f32x4){-(base + v0) * LOG2E, -(base + v1) * LOG2E, -(base + v2) * LOG2E, -(base + v3) * LOG2E};
    __syncthreads();
}
__device__ __forceinline__ void moba_kmean_item(int item, int b0, const h16* __restrict__ proj, float* __restrict__ kmean, char* shm) {
    int tid_ = threadIdx.x; asm volatile("" : "+v"(tid_));
    const int tid = tid_, h = item & 7, blk = (item >> 3) & 7, bl = item >> 6, r8 = tid >> 3, c8 = tid & 7;
    const h16* kp = proj + ((size_t)bl * SEQ + blk * 256 + r8) * PW + PC_BK + h * 64 + c8 * 8;
    float acc[8];
#pragma unroll
    for (int e = 0; e < 8; ++e) acc[e] = 0.f;
#pragma unroll
    for (int j = 0; j < 4; ++j) { const h16x8 v = *(const h16x8*)(kp + (size_t)(64 * j) * PW);
#pragma unroll
        for (int e = 0; e < 8; ++e) acc[e] += (float)v[e]; }
    float* red = (float*)shm;
#pragma unroll
    for (int e = 0; e < 8; ++e) red[r8 * 65 + c8 * 8 + e] = acc[e];
    __syncthreads();
    if (tid < 64) { float sum = 0.f;
#pragma unroll 8
        for (int r = 0; r < 64; ++r) sum += red[r * 65 + tid];
        kmean[(((size_t)(b0 + bl) * 8 + h) * 8 + blk) * 64 + tid] = sum * (1.f / 256.f); }
    __syncthreads();
}

namespace mlstm {
typedef __attribute__((address_space(3))) char* lds_ptr;
typedef __attribute__((address_space(3))) const char* lds_cptr;
typedef short s16x8 __attribute__((ext_vector_type(8)));
typedef float f32x16 __attribute__((ext_vector_type(16)));
constexpr int PT = 144;
__device__ __forceinline__ int crow(int r, int hi) { return (r & 3) + 8 * (r >> 2) + 4 * hi; }
__device__ __forceinline__ f32x16 mma_nt64(f32x16 acc, lds_cptr A, lds_cptr Bt, int r32, int hi) {
#pragma unroll
    for (int ks = 0; ks < 4; ++ks) {
        const s16x8 a = *(const __attribute__((address_space(3))) s16x8*)(A + r32 * PT + ks * 32 + hi * 16);
        const s16x8 b = *(const __attribute__((address_space(3))) s16x8*)(Bt + r32 * PT + ks * 32 + hi * 16);
        acc = __builtin_amdgcn_mfma_f32_32x32x16_f16(__builtin_bit_cast(h16x8, a), __builtin_bit_cast(h16x8, b), acc, 0, 0, 0);
    }
    return acc;
}
#define LF(off) ((__attribute__((address_space(3))) float*)(L + (off)))
constexpr int X1_KW = 2048, X1_VT = X1_KW + 64 * PT, X1_END = X1_VT + 128 * PT;
__device__ __forceinline__ void x1_item(int item, int b0, const h16* __restrict__ proj, const float* __restrict__ small, const float* __restrict__ convw,
                                        h16* __restrict__ qkc, float* __restrict__ U, float* __restrict__ un, float* __restrict__ amax, float* __restrict__ blast, lds_ptr L) {
    int tid_ = threadIdx.x; asm volatile("" : "+v"(tid_));
    const int tid = tid_, lane = tid & 63, wid = tid >> 6, r32 = lane & 31, hi = lane >> 5;
    const int c = item & 31, hh = (item >> 5) & 3, bl = item >> 7;
    const size_t row0 = (size_t)bl * SEQ + c * 64;
    const int gbh = (b0 + bl) * 4 + hh, lbh = bl * 4 + hh;
    if (wid == 0) {
        const float* sp = small + ((size_t)b0 * SEQ + row0 + lane) * 16;
        const float li = sp[8 + hh], lf = sp[12 + hh];
        float bc = lf;
#pragma unroll
        for (int o = 1; o < 64; o <<= 1) { const float u = __shfl_up(bc, o); if (lane >= o) bc += u; }
        const float as = li - bc;
        float mx = as;
#pragma unroll
        for (int o = 1; o < 64; o <<= 1) mx = fmaxf(mx, __shfl_xor(mx, o));
        LF(0)[lane] = __expf(as - mx);
        if (lane == 63) { amax[gbh * 32 + c] = mx; blast[gbh * 32 + c] = bc; }
    }
    __syncthreads();
    {
        const int r = tid >> 3, ch0 = (tid & 7) * 16, isk = ch0 >= 64;
        const int pcol = isk ? 256 + hh * 64 + (ch0 - 64) : hh * 64 + ch0;
        const int t = c * 64 + r;
        float acc[16];
#pragma unroll
        for (int e = 0; e < 16; ++e) acc[e] = 0.f;
#pragma unroll
        for (int j = 0; j < 4; ++j) {
            const int tt = t - 3 + j;
            if (tt >= 0) {
                const h16* xp = proj + ((size_t)bl * SEQ + tt) * PW + PC_CQK + pcol;
                const h16x8 x0 = *(const h16x8*)xp, x1 = *(const h16x8*)(xp + 8);
                const float* wp = convw + j * 512 + pcol;
#pragma unroll
                for (int e = 0; e < 8; ++e) { acc[e] += wp[e] * (float)x0[e]; acc[8 + e] += wp[8 + e] * (float)x1[e]; }
            }
        }
        const float ws = LF(0)[r];
        h16x8 o0, o1;
#pragma unroll
        for (int e = 0; e < 16; ++e) { float v = acc[e] * __builtin_amdgcn_rcpf(1.f + __expf(-acc[e])); if (isk) v *= 0.125f; acc[e] = v; if (e < 8) o0[e] = (h16)v; else o1[e - 8] = (h16)v; }
        h16* qp = qkc + (row0 + r) * 512 + pcol;
        *(h16x8*)qp = o0; *(h16x8*)(qp + 8) = o1;
        if (isk) {
            const int d0 = ch0 - 64;
#pragma unroll
            for (int e = 0; e < 16; ++e) *(__attribute__((address_space(3))) h16*)(L + X1_KW + (d0 + e) * PT + r * 2) = (h16)(acc[e] * ws);
        }
    }
    {
        const int sidx = tid >> 3, v0 = (tid & 7) * 16;
        const h16* vp = proj + (row0 + sidx) * PW + PC_CV + hh * 128 + v0;
        const h16x8 a0 = *(const h16x8*)vp, a1 = *(const h16x8*)(vp + 8);
#pragma unroll
        for (int e = 0; e < 8; ++e) { *(__attribute__((address_space(3))) h16*)(L + X1_VT + (v0 + e) * PT + sidx * 2) = a0[e]; *(__attribute__((address_space(3))) h16*)(L + X1_VT + (v0 + 8 + e) * PT + sidx * 2) = a1[e]; }
    }
    __syncthreads();
    {
        const int vb = wid >> 1, db = wid & 1;
        f32x16 acc = f32x16{};
        acc = mma_nt64(acc, (lds_cptr)(L + X1_VT + vb * 32 * PT), (lds_cptr)(L + X1_KW + db * 32 * PT), r32, hi);
        float* up = U + ((size_t)lbh * 32 + c) * 8192;
#pragma unroll
        for (int r = 0; r < 16; ++r) up[(vb * 32 + crow(r, hi)) * 64 + db * 32 + r32] = acc[r];
        if (tid < 64) { float sum = 0.f;
#pragma unroll 8
            for (int q = 0; q < 64; ++q) sum += (float)*(__attribute__((address_space(3))) const h16*)(L + X1_KW + tid * PT + q * 2);
            un[((size_t)gbh * 32 + c) * 64 + tid] = sum; }
    }
    __syncthreads();
}
__device__ __forceinline__ void x2_scan(int b0, const float* __restrict__ U, const float* __restrict__ un, const float* __restrict__ amax, const float* __restrict__ blast,
                                        h16* __restrict__ CS, float* __restrict__ ns, float* __restrict__ Ms) {
    int tid_ = threadIdx.x; asm volatile("" : "+v"(tid_));
    const int gt = blockIdx.x * NTHREADS + tid_, GT = gridDim.x * NTHREADS;
    for (int i = gt; i < 32 * 4096; i += GT) {
        const int lbh = i >> 12, e2 = (i & 4095) * 2, gbh = (b0 + (lbh >> 2)) * 4 + (lbh & 3);
        const float* up = U + (size_t)lbh * 32 * 8192 + e2; h16* cp = CS + (size_t)lbh * 32 * 8192 + e2;
        float c0 = 0.f, c1 = 0.f, M = 0.f;
        *(pg8::h16x2*)cp = (pg8::h16x2){(h16)0.f, (h16)0.f};
#pragma unroll 4
        for (int c = 0; c < 31; ++c) {
            const float am = amax[gbh * 32 + c], bls = blast[gbh * 32 + c];
            const float Mn = bls + fmaxf(M, am), fdec = __expf(bls + M - Mn), fin = __expf(bls + am - Mn);
            const pg8::f32x2 u = *(const pg8::f32x2*)(up + (size_t)c * 8192);
            c0 = fdec * c0 + fin * u.x; c1 = fdec * c1 + fin * u.y; M = Mn;
            *(pg8::h16x2*)(cp + (size_t)(c + 1) * 8192) = (pg8::h16x2){(h16)c0, (h16)c1};
        }
    }
    for (int i = gt; i < 32 * 64; i += GT) {
        const int lbh = i >> 6, d = i & 63, gbh = (b0 + (lbh >> 2)) * 4 + (lbh & 3);
        float n = 0.f, M = 0.f;
        ns[((size_t)gbh * 32) * 64 + d] = 0.f; if (d == 0) Ms[gbh * 32] = 0.f;
        for (int c = 0; c < 31; ++c) {
            const float am = amax[gbh * 32 + c], bls = blast[gbh * 32 + c];
            const float Mn = bls + fmaxf(M, am), fdec = __expf(bls + M - Mn), fin = __expf(bls + am - Mn);
            n = fdec * n + fin * un[((size_t)gbh * 32 + c) * 64 + d]; M = Mn;
            ns[((size_t)gbh * 32 + c + 1) * 64 + d] = n; if (d == 0) Ms[gbh * 32 + c + 1] = M;
        }
    }
}
constexpr int X3_Q = 4096, X3_K = X3_Q + 64 * PT, X3_W = X3_K + 64 * PT, X3_C = X3_W + 64 * PT, X3_VT = X3_C + 128 * PT, X3_END = X3_VT + 128 * PT;
constexpr int X3_HS = X3_Q, HSP = 132;
__device__ __forceinline__ void x3_item(int item, int b0, const h16* __restrict__ proj, const float* __restrict__ small, const h16* __restrict__ qkc, const h16* __restrict__ CS,
                                        const float* __restrict__ ns, const float* __restrict__ Ms, const float* __restrict__ headg, h16* __restrict__ y, lds_ptr L) {
    int tid_ = threadIdx.x; asm volatile("" : "+v"(tid_));
    const int tid = tid_, lane = tid & 63, wid = tid >> 6, r32 = lane & 31, hi = lane >> 5;
    const int c = item & 31, hh = (item >> 5) & 3, bl = item >> 7;
    const size_t row0 = (size_t)bl * SEQ + c * 64;
    const int gbh = (b0 + bl) * 4 + hh, lbh = bl * 4 + hh;
    if (wid == 0) {
        const float* sp = small + ((size_t)b0 * SEQ + row0 + lane) * 16;
        const float li = sp[8 + hh], lf = sp[12 + hh], Mc = Ms[gbh * 32 + c];
        float bc = lf;
#pragma unroll
        for (int o = 1; o < 64; o <<= 1) { const float u = __shfl_up(bc, o); if (lane >= o) bc += u; }
        const float as = li - bc;
        float pm = as;
#pragma unroll
        for (int o = 1; o < 64; o <<= 1) { const float u = __shfl_up(pm, o); if (lane >= o) pm = fmaxf(pm, u); }
        const float mx = fmaxf(Mc, pm);
        LF(0)[lane] = as; LF(256)[lane] = mx; LF(512)[lane] = __expf(Mc - mx); LF(768)[lane] = __expf(-(bc + mx));
        LF(1792)[lane] = ns[((size_t)gbh * 32 + c) * 64 + lane];
    }
    {
        const int r = tid >> 3, c8 = (tid & 7) * 8;
        const h16* qp = qkc + (row0 + r) * 512 + hh * 64 + c8;
        *(__attribute__((address_space(3))) h16x8*)(L + X3_Q + r * PT + c8 * 2) = *(const h16x8*)qp;
        *(__attribute__((address_space(3))) h16x8*)(L + X3_K + r * PT + c8 * 2) = *(const h16x8*)(qp + 256);
        const h16* cp = CS + ((size_t)lbh * 32 + c) * 8192;
#pragma unroll
        for (int j = 0; j < 2; ++j) { const int v = r + 64 * j;
            *(__attribute__((address_space(3))) h16x8*)(L + X3_C + v * PT + c8 * 2) = *(const h16x8*)(cp + v * 64 + c8); }
        const int v0 = (tid & 7) * 16;
        const h16* vp = proj + (row0 + r) * PW + PC_CV + hh * 128 + v0;
        const h16x8 a0 = *(const h16x8*)vp, a1 = *(const h16x8*)(vp + 8);
#pragma unroll
        for (int e = 0; e < 8; ++e) { *(__attribute__((address_space(3))) h16*)(L + X3_VT + (v0 + e) * PT + r * 2) = a0[e]; *(__attribute__((address_space(3))) h16*)(L + X3_VT + (v0 + 8 + e) * PT + r * 2) = a1[e]; }
    }
    __syncthreads();
    if (tid < 64) { float sum = 0.f;
#pragma unroll 8
        for (int d = 0; d < 64; ++d) sum += LF(1792)[d] * (float)*(__attribute__((address_space(3))) const h16*)(L + X3_Q + tid * PT + d * 2);
        LF(1536)[tid] = sum; }
    const int tb = wid >> 2, vb = wid & 3;
    f32x16 acc2 = f32x16{};
    acc2 = mma_nt64(acc2, (lds_cptr)(L + X3_Q + tb * 32 * PT), (lds_cptr)(L + X3_C + vb * 32 * PT), r32, hi);
    if (wid < 4) {
        const int sb = wid >> 1, tbs = wid & 1;
        f32x16 st = f32x16{};
        st = mma_nt64(st, (lds_cptr)(L + X3_K + sb * 32 * PT), (lds_cptr)(L + X3_Q + tbs * 32 * PT), r32, hi);
        const int t = tbs * 32 + r32; const float mxt = LF(256)[t];
        float dsum = 0.f;
#pragma unroll
        for (int g = 0; g < 4; ++g) {
            float w4[4];
#pragma unroll
            for (int i = 0; i < 4; ++i) { const int sidx = sb * 32 + 8 * g + 4 * hi + i; const float wv = sidx <= t ? st[4 * g + i] * __expf(LF(0)[sidx] - mxt) : 0.f; w4[i] = wv; dsum += wv; }
            typedef unsigned u32x2 __attribute__((ext_vector_type(2)));
            u32x2 pk; pk.x = pg8::cvt_pk_f16(w4[0], w4[1]); pk.y = pg8::cvt_pk_f16(w4[2], w4[3]);
            *(__attribute__((address_space(3))) u32x2*)(L + X3_W + t * PT + (sb * 32 + 8 * g + 4 * hi) * 2) = pk;
        }
        dsum += __shfl_xor(dsum, 32);
        if (hi == 0) LF(1024)[sb * 64 + t] = dsum;
    }
    __syncthreads();
    f32x16 acc1 = f32x16{};
    acc1 = mma_nt64(acc1, (lds_cptr)(L + X3_W + tb * 32 * PT), (lds_cptr)(L + X3_VT + vb * 32 * PT), r32, hi);
    __syncthreads();
#pragma unroll
    for (int r = 0; r < 16; ++r) {
        const int t = tb * 32 + crow(r, hi);
        const float wi = LF(512)[t], den = LF(1024)[t] + LF(1024)[64 + t] + wi * LF(1536)[t];
        const float hv = (acc1[r] + wi * acc2[r]) / fmaxf(fabsf(den), LF(768)[t]);
        *(__attribute__((address_space(3))) float*)(L + X3_HS + (t * HSP + vb * 32 + r32) * 4) = hv;
    }
    __syncthreads();
    {
        const int t = tid >> 3, v0 = (tid & 7) * 16;
        const h16* op = proj + (row0 + t) * PW + PC_CO + hh * 128 + v0;
        const h16* zp = proj + (row0 + t) * PW + PC_CZ + hh * 128 + v0;
        const h16x8 o0 = *(const h16x8*)op, o1 = *(const h16x8*)(op + 8), z0 = *(const h16x8*)zp, z1 = *(const h16x8*)(zp + 8);
        float hvv[16]; float ss = 0.f;
#pragma unroll
        for (int e = 0; e < 16; ++e) { const float og = (float)(e < 8 ? o0[e] : o1[e - 8]);
            const float hv = *(__attribute__((address_space(3))) const float*)(L + X3_HS + (t * HSP + v0 + e) * 4) * __builtin_amdgcn_rcpf(1.f + __expf(-og)); hvv[e] = hv; ss += hv * hv; }
        ss += __shfl_xor(ss, 1); ss += __shfl_xor(ss, 2); ss += __shfl_xor(ss, 4);
        const float rn = rsqrtf(ss * (1.f / 128.f) + RMS_EPS);
        pg8::u32x4 w0, w1; float ov[16];
#pragma unroll
        for (int e = 0; e < 16; ++e) { const float zz = (float)(e < 8 ? z0[e] : z1[e - 8]); ov[e] = hvv[e] * rn * headg[hh * 128 + v0 + e] * zz * __builtin_amdgcn_rcpf(1.f + __expf(-zz)); }
        w0.x = pg8::cvt_pk_f16(ov[0], ov[1]); w0.y = pg8::cvt_pk_f16(ov[2], ov[3]); w0.z = pg8::cvt_pk_f16(ov[4], ov[5]); w0.w = pg8::cvt_pk_f16(ov[6], ov[7]);
        w1.x = pg8::cvt_pk_f16(ov[8], ov[9]); w1.y = pg8::cvt_pk_f16(ov[10], ov[11]); w1.z = pg8::cvt_pk_f16(ov[12], ov[13]); w1.w = pg8::cvt_pk_f16(ov[14], ov[15]);
        h16* yp = y + (row0 + t) * 1536 + 1024 + hh * 128 + v0;
        *(pg8::u32x4*)yp = w0; *(pg8::u32x4*)(yp + 8) = w1;
    }
    __syncthreads();
}
#undef LF
}

__device__ __forceinline__ void transpose_item(const float* __restrict__ W, int ldsrc, int K, h16* __restrict__ WT, int k0, int n0, int src_col0, float scale, PG8_LAS float* scr, int lane) {
#pragma unroll 8
    for (int i = 0; i < 32; ++i) { const int kk = 2 * i + (lane >> 5); scr[kk * 33 + (lane & 31)] = W[(size_t)(k0 + kk) * ldsrc + src_col0 + (lane & 31)]; }
    asm volatile("s_waitcnt lgkmcnt(0)" ::: "memory");
    const int c = lane & 7;
#pragma unroll
    for (int j = 0; j < 4; ++j) { const int n = (lane >> 3) + 8 * j; const PG8_LAS float* sp = scr + (8 * c) * 33 + n;
        pg8::u32x4 o; o.x = pg8::cvt_pk_f16(sp[0 * 33] * scale, sp[1 * 33] * scale); o.y = pg8::cvt_pk_f16(sp[2 * 33] * scale, sp[3 * 33] * scale);
        o.z = pg8::cvt_pk_f16(sp[4 * 33] * scale, sp[5 * 33] * scale); o.w = pg8::cvt_pk_f16(sp[6 * 33] * scale, sp[7 * 33] * scale);
        *(pg8::u32x4*)(WT + (size_t)(n0 + n) * K + k0 + 8 * c) = o; }
    asm volatile("s_waitcnt lgkmcnt(0)" ::: "memory");
}
__device__ __forceinline__ void prologue_phase(const MArgs& a, PG8_LAS unsigned char* L) {
    int tid_ = threadIdx.x; asm volatile("" : "+v"(tid_));
    const int lane = tid_ & 63, wave = tid_ >> 6;
    PG8_LAS float* scr = (PG8_LAS float*)(L + wave * 16384);
    const int gw = blockIdx.x * NWAVES + wave, NGW = gridDim.x * NWAVES;
    constexpr int I_IN = (DM / 64) * (PW / 32), I_BR = (512 / 64) * (1024 / 32), I_OUT = (DM / 64) * (DM / 32), I_L = I_IN + 3 * I_BR + I_OUT;
    unsigned char* ws = a.ws;
    for (int it = gw; it < DEPTH * I_L; it += NGW) {
        const int l = it / I_L; int r = it - l * I_L;
        if (r < I_IN) { const int nblk = PW / 32, kb = r / nblk, nb = r % nblk, n0 = nb * 32;
            const float sc = ((n0 >= PC_AQ && n0 < PC_AQ + 512) || (n0 >= PC_BQ && n0 < PC_BQ + 512)) ? C2 : 1.f;
            transpose_item(a.in[2] + (size_t)l * DM * INW, INW, DM, (h16*)(ws + WS_WIN) + (size_t)l * PW * DM, kb * 64, n0, orig_col(n0), sc, scr, lane); continue; }
        r -= I_IN;
        if (r < 3 * I_BR) { const int n3 = r / I_BR, q = r % I_BR, nblk = 1024 / 32, kb = q / nblk, nb = q % nblk;
            transpose_item(a.in[8] + ((size_t)l * 3 + n3) * 512 * 1024, 1024, 512, (h16*)(ws + WS_WBR) + ((size_t)l * 3 + n3) * 1024 * 512, kb * 64, nb * 32, nb * 32, 1.f, scr, lane); continue; }
        r -= 3 * I_BR;
        { const int nblk = DM / 32, kb = r / nblk, nb = r % nblk;
          transpose_item(a.in[9] + (size_t)l * DM * DM, DM, DM, (h16*)(ws + WS_WOUT) + (size_t)l * DM * DM, kb * 64, nb * 32, nb * 32, 1.f, scr, lane); }
    }
    float* wsmall = (float*)(ws + WS_WSMALL);
    for (int i = blockIdx.x * NTHREADS + tid_; i < DEPTH * 16 * DM; i += gridDim.x * NTHREADS) {
        const int l = i / (16 * DM), c = (i >> 10) & 15, k = i & 1023;
        wsmall[i] = a.in[2][(size_t)l * DM * INW + (size_t)k * INW + small_col(c)];
    }
}
__device__ __forceinline__ void norm_phase(const float* __restrict__ x, const float* __restrict__ g, const float* __restrict__ wsmall, const float* __restrict__ fox_bf,
                                           const float* __restrict__ ml_bi, const float* __restrict__ ml_bf, h16* __restrict__ hn, float* __restrict__ small, int row0) {
    int tid_ = threadIdx.x; asm volatile("" : "+v"(tid_));
    const int lane = tid_ & 63, gw = blockIdx.x * NWAVES + (tid_ >> 6), NGW = gridDim.x * NWAVES;
    for (int r4 = gw; r4 < TH / 4; r4 += NGW) {
        f32x4 v[4][4];
#pragma unroll
        for (int q = 0; q < 4; ++q) {
            const f32x4* xr = (const f32x4*)(x + (size_t)(row0 + 4 * r4 + q) * DM) + lane;
            float ssq = 0.f;
#pragma unroll
            for (int j = 0; j < 4; ++j) { v[q][j] = xr[64 * j]; ssq += v[q][j].x * v[q][j].x + v[q][j].y * v[q][j].y + v[q][j].z * v[q][j].z + v[q][j].w * v[q][j].w; }
            const float rstd = rsqrtf(wave_sum(ssq) * (1.f / DM) + RMS_EPS);
#pragma unroll
            for (int j = 0; j < 4; ++j) {
                const f32x4 gg = ((const f32x4*)g)[lane + 64 * j];
                v[q][j].x *= rstd * gg.x; v[q][j].y *= rstd * gg.y; v[q][j].z *= rstd * gg.z; v[q][j].w *= rstd * gg.w;
                pg8::u32x4 dummy; (void)dummy;
                typedef unsigned u32x2 __attribute__((ext_vector_type(2)));
                u32x2 o; o.x = pg8::cvt_pk_f16(v[q][j].x, v[q][j].y); o.y = pg8::cvt_pk_f16(v[q][j].z, v[q][j].w);
                *((u32x2*)(hn + (size_t)(4 * r4 + q) * DM) + lane + 64 * j) = o;
            }
        }
        float mine[4] = {0.f, 0.f, 0.f, 0.f};
#pragma unroll 1
        for (int c = 0; c < 16; ++c) {
            const f32x4* wr = (const f32x4*)(wsmall + c * DM) + lane;
            float acc[4] = {0.f, 0.f, 0.f, 0.f};
#pragma unroll
            for (int j = 0; j < 4; ++j) { const f32x4 w = wr[64 * j];
#pragma unroll
                for (int q = 0; q < 4; ++q) acc[q] += v[q][j].x * w.x + v[q][j].y * w.y + v[q][j].z * w.z + v[q][j].w * w.w; }
#pragma unroll
            for (int q = 0; q < 4; ++q) { const float t = wave_sum(acc[q]); if (lane == c) mine[q] = t; }
        }
        if (lane < 16) {
            const float bias = lane < 8 ? fox_bf[lane] : lane < 12 ? ml_bi[lane - 8] : ml_bf[lane - 12];
#pragma unroll
            for (int q = 0; q < 4; ++q) { const float pre = mine[q] + bias; small[(size_t)(row0 + 4 * r4 + q) * 16 + lane] = (lane >= 8 && lane < 12) ? pre : log_sigmoidf_(pre); }
        }
    }
}
__device__ __forceinline__ void final_norm_phase(float* __restrict__ x, const float* __restrict__ g) {
    int tid_ = threadIdx.x; asm volatile("" : "+v"(tid_));
    const int lane = tid_ & 63, gw = blockIdx.x * NWAVES + (tid_ >> 6), NGW = gridDim.x * NWAVES;
    for (int row = gw; row < TT; row += NGW) {
        f32x4* xr = (f32x4*)(x + (size_t)row * DM) + lane;
        f32x4 v[4]; float ssq = 0.f;
#pragma unroll
        for (int j = 0; j < 4; ++j) { v[j] = xr[64 * j]; ssq += v[j].x * v[j].x + v[j].y * v[j].y + v[j].z * v[j].z + v[j].w * v[j].w; }
        const float rstd = rsqrtf(wave_sum(ssq) * (1.f / DM) + RMS_EPS);
#pragma unroll
        for (int j = 0; j < 4; ++j) { const f32x4 gg = ((const f32x4*)g)[lane + 64 * j];
            xr[64 * j] = (f32x4){v[j].x * rstd * gg.x, v[j].y * rstd * gg.y, v[j].z * rstd * gg.z, v[j].w * rstd * gg.w}; }
    }
}

__global__ void __launch_bounds__(NTHREADS, 2) mega(MArgs a) {
    extern __shared__ __attribute__((aligned(16))) unsigned char lds[];
    PG8_LAS unsigned char* L = (PG8_LAS unsigned char*)lds;
    unsigned char* ws = a.ws;
    for (int s = a.s_lo; s < a.s_hi; ++s) {
        if (s > a.s_lo) { __builtin_amdgcn_fence(__ATOMIC_RELEASE, "agent"); cg::this_grid().sync(); __builtin_amdgcn_fence(__ATOMIC_ACQUIRE, "agent"); }
        if (s == 0) { prologue_phase(a, L); barrier_lds(); continue; }
        if (s == N_STEPS - 1) { final_norm_phase(a.out, a.in[10]); continue; }
        const int li = (s - 1) / NPH, ph = (s - 1) % NPH, layer = li >> 1, hf = li & 1;
        const int row0 = hf * TH;
        if (ph == PH_NORM) {
            norm_phase(layer == 0 ? a.in[0] : a.out, a.in[1] + layer * DM, (const float*)(ws + WS_WSMALL) + layer * 16 * DM, a.in[3] + layer * 8, a.in[5] + layer * 4, a.in[6] + layer * 4,
                       (h16*)(ws + WS_HN), (float*)(ws + WS_SMALL), row0);
        } else if (ph == PH_PRE) {
            const int b0 = hf * HB;
            for (int it = blockIdx.x; it < HB * 8; it += gridDim.x) fox_cumsum_item(it, b0, (const float*)(ws + WS_SMALL), (float*)(ws + WS_CB), (char*)lds);
            for (int it = blockIdx.x; it < HB * 64; it += gridDim.x) moba_kmean_item(it, b0, (const h16*)(ws + WS_PROJ), (float*)(ws + WS_KMEAN), (char*)lds);
            for (int it = blockIdx.x; it < HB * 128; it += gridDim.x)
                mlstm::x1_item(it, b0, (const h16*)(ws + WS_PROJ), (const float*)(ws + WS_SMALL), a.in[4] + (size_t)layer * 4 * 512, (h16*)(ws + WS_QKC), (float*)(ws + WS_U),
                               (float*)(ws + WS_MUN), (float*)(ws + WS_MAMAX), (float*)(ws + WS_MBLAST), (mlstm::lds_ptr)L);
        } else if (ph == PH_SCAN) {
            mlstm::x2_scan(hf * HB, (const float*)(ws + WS_U), (const float*)(ws + WS_MUN), (const float*)(ws + WS_MAMAX), (const float*)(ws + WS_MBLAST),
                           (h16*)(ws + WS_CS), (float*)(ws + WS_MNS), (float*)(ws + WS_MMS));
        } else if (ph == PH_MIX) {
            const int b0 = hf * HB, G = gridDim.x, bx = blockIdx.x;
            const int vcu = (G % 8 == 0) ? (bx % 8) * (G / 8) + bx / 8 : bx;
            const h16* proj = (const h16*)(ws + WS_PROJ); h16* y = (h16*)(ws + WS_Y);
            for (int v = vcu; v < 256; v += G) {
                const int bh = v >> 2, sidx = v & 3, bl = bh >> 3, h = bh & 7;
                const float* cbp = (const float*)(ws + WS_CB) + (size_t)((b0 + bl) * 8 + h) * SEQ;
                const float* kmp = (const float*)(ws + WS_KMEAN) + (size_t)((b0 + bl) * 8 + h) * 512;
                const float slope2 = exp2f(-(float)(h + 1)) * LOG2E;
#pragma unroll 1
                for (int i = 0; i < 4; ++i) {
                    const int qb = (i < 2) ? 7 - sidx : sidx;
                    if ((i & 1) == 0) attn_body::attn_unit<false, 8>(bl, h, qb, proj + PC_AQ, proj + PC_AK, proj + PC_AV, proj + PC_AZ, y, cbp, 0.f, kmp, (char*)lds);
                    else attn_body::attn_unit<true, 8>(bl, h, qb, proj + PC_BQ, proj + PC_BK, proj + PC_BV, proj + PC_BZ, y + 512, cbp, slope2, kmp, (char*)lds);
                }
            }
            for (int it = blockIdx.x; it < HB * 128; it += gridDim.x)
                mlstm::x3_item(it, b0, proj, (const float*)(ws + WS_SMALL), (const h16*)(ws + WS_QKC), (const h16*)(ws + WS_CS), (const float*)(ws + WS_MNS), (const float*)(ws + WS_MMS),
                               a.in[7] + (size_t)layer * 512, y, (mlstm::lds_ptr)L);
        } else if (ph == PH_PROJ) {
            pg8::Gemm g{(const h16*)(ws + WS_HN), (const h16*)(ws + WS_WIN) + (size_t)layer * PW * DM, DM, DM, DM, 0, 0};
            pg8::StaticOrder S; S.init(TH, PW, gridDim.x, blockIdx.x);
            pg8::EpiF16 E{(h16*)(ws + WS_PROJ), PW};
            pg8::gemm_phase(L, g, S, E);
        } else if (ph == PH_BR) {
            pg8::Gemm g{(const h16*)(ws + WS_Y), (const h16*)(ws + WS_WBR) + (size_t)layer * 3 * 1024 * 512, 1536, 512, 512, 512, 1024 * 512};
            pg8::BranchOrder S; S.init(TH, DM, gridDim.x, blockIdx.x, 3);
            pg8::EpiGate E{(h16*)(ws + WS_MRG), (const h16*)(ws + WS_PROJ) + PC_G, PW};
            pg8::gemm_phase(L, g, S, E);
        } else if (ph == PH_OUT) {
            pg8::Gemm g{(const h16*)(ws + WS_MRG), (const h16*)(ws + WS_WOUT) + (size_t)layer * DM * DM, DM, DM, DM, 0, 0};
            pg8::StaticOrder S; S.init(TH, DM, gridDim.x, blockIdx.x);
            const float* xsrc = layer == 0 ? a.in[0] : a.out;
            pg8::EpiRes E{xsrc + (size_t)row0 * DM, a.out + (size_t)row0 * DM, DM};
            pg8::gemm_phase(L, g, S, E);
        }
    }
}

extern "C" void kernel_launch(void* const* d_in, const int* in_sizes, int n_in, void* d_out, int out_size, void* d_ws, size_t ws_size, hipStream_t stream) {
    if (n_in != 11 || in_sizes[0] != TT * DM || out_size != TT * DM || ws_size < WS_END) {
        fprintf(stderr, "kernel_launch: unexpected shapes / workspace (n_in %d, in0 %d, out %d, ws %zu < %zu)\n", n_in, n_in > 0 ? in_sizes[0] : -1, out_size, ws_size, (size_t)WS_END);
        return;
    }
    static int grid = 0;
    if (grid == 0) {
        int dev = 0, cus = 0, per_cu = 0;
        hipGetDevice(&dev);
        hipDeviceGetAttribute(&cus, hipDeviceAttributeMultiprocessorCount, dev);
        if (hipFuncSetAttribute((const void*)mega, hipFuncAttributeMaxDynamicSharedMemorySize, MK_LDS_BYTES) != hipSuccess) fprintf(stderr, "kernel_launch: hipFuncSetAttribute failed\n");
        if (hipOccupancyMaxActiveBlocksPerMultiprocessor(&per_cu, (const void*)mega, NTHREADS, MK_LDS_BYTES) != hipSuccess || per_cu < 1) { fprintf(stderr, "kernel_launch: occupancy query says %d blocks per CU\n", per_cu); per_cu = 1; }
        (void)hipGetLastError();
        grid = cus;
        if (grid != 256) fprintf(stderr, "kernel_launch: note: %d CUs (tuned for 256)\n", grid);
    }
    MArgs ma{};
    for (int i = 0; i < 11; ++i) ma.in[i] = (const float*)d_in[i];
    ma.out = (float*)d_out; ma.ws = (unsigned char*)d_ws; ma.s_lo = 0; ma.s_hi = N_STEPS;
    void* args[] = {&ma};
    hipError_t e = hipLaunchCooperativeKernel((const void*)mega, dim3(grid), dim3(NTHREADS), args, MK_LDS_BYTES, stream);
    if (e != hipSuccess) fprintf(stderr, "kernel_launch: cooperative launch failed: %s (grid %d)\n", hipGetErrorString(e), grid);
}
```

```cpp
#include <hip/hip_runtime.h>
#include <hip/hip_cooperative_groups.h>
#include <cstdio>
#include <cstdint>

namespace cg = cooperative_groups;
typedef _Float16 h16;
typedef _Float16 h16x4 __attribute__((ext_vector_type(4)));
typedef _Float16 h16x8 __attribute__((ext_vector_type(8)));
typedef float f32x4 __attribute__((ext_vector_type(4)));

constexpr int DM = 1024, BATCH = 16, SEQ = 2048, DEPTH = 2;
constexpr int TT = BATCH * SEQ;
constexpr int HB = 8;
constexpr int TH = HB * SEQ;
constexpr int INW = 9232;
constexpr int PW = 9216;
constexpr float RMS_EPS = 1e-6f;
constexpr float LOG2E = 1.4426950408889634f;
constexpr float C2 = 0.125f * LOG2E;
constexpr int PC_AQ = 0, PC_AK = 512, PC_AV = 1024, PC_AZ = 1536, PC_BQ = 2048, PC_BK = 2560, PC_BV = 3072, PC_BZ = 3584,
              PC_CQK = 4096, PC_CV = 4608, PC_CO = 5120, PC_CZ = 5632, PC_G = 6144;
__host__ __device__ inline int orig_col(int j) { return j < 2048 ? j : (j < 6144 ? j + 8 : j + 16); }
__host__ __device__ inline int small_col(int c) { return c < 8 ? 2048 + c : 6152 + (c - 8); }

constexpr size_t MiB = 1u << 20;
constexpr size_t WS_CTL = 0;
constexpr size_t WS_WSMALL = 512 * 1024;
constexpr size_t WS_SMALL = 1 * MiB;
constexpr size_t WS_CB = 3 * MiB;
constexpr size_t WS_KMEAN = 4 * MiB;
constexpr size_t WS_MSC = 5 * MiB;
constexpr size_t WS_MUN = WS_MSC, WS_MNS = WS_MSC + 512 * 1024;
constexpr size_t WS_MAMAX = 4 * MiB + 512 * 1024, WS_MBLAST = WS_MAMAX + 8192, WS_MMS = WS_MAMAX + 16384;
constexpr size_t WS_WBR = 6 * MiB;
constexpr size_t WS_WOUT = 12 * MiB;
constexpr size_t WS_WIN = 16 * MiB;
constexpr size_t WS_HN = 52 * MiB;
constexpr size_t WS_Y = 84 * MiB;
constexpr size_t WS_MRG = WS_HN;
constexpr size_t WS_U = 132 * MiB;
constexpr size_t WS_CS = 164 * MiB;
constexpr size_t WS_QKC = 180 * MiB;
constexpr size_t WS_PROJ = 196 * MiB;
constexpr size_t WS_END = 484 * MiB;

__device__ __forceinline__ float sigmoidf_(float x) { return 1.f / (1.f + __expf(-x)); }
__device__ __forceinline__ float siluf_(float x) { return x / (1.f + __expf(-x)); }
__device__ __forceinline__ float log_sigmoidf_(float x) {
    const float e = __expf(-fabsf(x)); const float l = e < 0.01f ? e * (1.f - 0.5f * e + 0.33333334f * e * e) : __logf(1.f + e); return fminf(x, 0.f) - l; }
__device__ __forceinline__ float wave_sum(float v) {
#pragma unroll
    for (int o = 1; o < 64; o <<= 1) v += __shfl_xor(v, o);
    return v;
}

__global__ void nv_convert_t(const float* __restrict__ src, int ldsrc, int K, h16* __restrict__ dst, int Nd, int mode) {
    __shared__ float tile[32][33];
    const int tx = threadIdx.x & 31, ty = threadIdx.x >> 5;
    const int j0 = blockIdx.x * 32, k0 = blockIdx.y * 32;
#pragma unroll
    for (int i = 0; i < 4; ++i) {
        const int k = k0 + ty + 8 * i, j = j0 + tx;
        const int sc = mode == 1 ? orig_col(j) : j;
        tile[ty + 8 * i][tx] = src[(size_t)k * ldsrc + sc];
    }
    __syncthreads();
#pragma unroll
    for (int i = 0; i < 4; ++i) {
        const int j = j0 + ty + 8 * i, k = k0 + tx;
        float v = tile[tx][ty + 8 * i];
        if (mode == 1 && ((j >= PC_AQ && j < PC_AQ + 512) || (j >= PC_BQ && j < PC_BQ + 512))) v *= C2;
        dst[(size_t)j * K + k] = (h16)v;
    }
}

__global__ void nv_small_w(const float* __restrict__ w_in, float* __restrict__ wsmall) {
    const int i = blockIdx.x * blockDim.x + threadIdx.x;
    if (i >= 16 * DM) return;
    const int c = i >> 10, k = i & 1023;
    wsmall[i] = w_in[(size_t)k * INW + small_col(c)];
}
__global__ void __launch_bounds__(256) nv_rmsnorm_small(const float* __restrict__ x, const float* __restrict__ g, const float* __restrict__ wsmall  ,
                                 const float* __restrict__ fox_bf, const float* __restrict__ ml_bi, const float* __restrict__ ml_bf,
                                 h16* __restrict__ hn, float* __restrict__ small, int row0, int nrows) {
    const int lane = threadIdx.x & 63, wv = (blockIdx.x * blockDim.x + threadIdx.x) >> 6, nw = (gridDim.x * blockDim.x) >> 6;
    for (int r = wv; r < nrows; r += nw) {
        const int row = row0 + r;
        const f32x4* xr = (const f32x4*)(x + (size_t)row * DM) + lane;
        f32x4 v[4]; float s = 0.f;
#pragma unroll
        for (int j = 0; j < 4; ++j) { v[j] = xr[64 * j]; s += v[j].x * v[j].x + v[j].y * v[j].y + v[j].z * v[j].z + v[j].w * v[j].w; }
        const float rstd = rsqrtf(wave_sum(s) * (1.f / DM) + RMS_EPS);
#pragma unroll
        for (int j = 0; j < 4; ++j) {
            const f32x4 gg = ((const f32x4*)g)[lane + 64 * j];
            v[j].x *= rstd * gg.x; v[j].y *= rstd * gg.y; v[j].z *= rstd * gg.z; v[j].w *= rstd * gg.w;
            h16x4 o = {(h16)v[j].x, (h16)v[j].y, (h16)v[j].z, (h16)v[j].w};
            *((h16x4*)(hn + (size_t)r * DM) + lane + 64 * j) = o;
        }
        float mine = 0.f;
#pragma unroll 1
        for (int c = 0; c < 16; ++c) {
            const f32x4* wr = (const f32x4*)(wsmall + c * DM) + lane;
            float a = 0.f;
#pragma unroll
            for (int j = 0; j < 4; ++j) { const f32x4 w = wr[64 * j]; a += v[j].x * w.x + v[j].y * w.y + v[j].z * w.z + v[j].w * w.w; }
            a = wave_sum(a);
            if (lane == c) mine = a;
        }
        if (lane < 16) {
            float o;
            if (lane < 8) o = log_sigmoidf_(mine + fox_bf[lane]);
            else if (lane < 12) o = mine + ml_bi[lane - 8];
            else o = log_sigmoidf_(mine + ml_bf[lane - 12]);
            small[(size_t)row * 16 + lane] = o;
        }
    }
}

struct GemmArgs {
    const h16* A; int lda; const h16* Bt; int ldb; int K;
    h16* C; int ldc;
    const h16* gates; int ldg;
    const float* xin; float* xout;
};
template <int EPI>
__global__ void __launch_bounds__(256) nv_gemm(GemmArgs g) {
    __shared__ float As[16][68], Bs[16][68];
    const int tid = threadIdx.x, tx = tid & 15, ty = tid >> 4;
    const int m0 = blockIdx.y * 64, n0 = blockIdx.x * 64;
    float res[4][4];
#pragma unroll
    for (int i = 0; i < 4; ++i)
#pragma unroll
        for (int j = 0; j < 4; ++j) res[i][j] = 0.f;
    const int NB = EPI == 1 ? 3 : 1;
    for (int nb = 0; nb < NB; ++nb) {
        float acc[4][4];
#pragma unroll
        for (int i = 0; i < 4; ++i)
#pragma unroll
            for (int j = 0; j < 4; ++j) acc[i][j] = 0.f;
        const h16* A = g.A + (EPI == 1 ? nb * 512 : 0);
        const h16* Bt = g.Bt + (EPI == 1 ? (size_t)nb * 1024 * 512 : 0);
        const int lr = tid >> 2, lk = (tid & 3) * 4;
        for (int k0 = 0; k0 < g.K; k0 += 16) {
            const h16x4 av = *(const h16x4*)(A + (size_t)(m0 + lr) * g.lda + k0 + lk);
            const h16x4 bv = *(const h16x4*)(Bt + (size_t)(n0 + lr) * g.ldb + k0 + lk);
            __syncthreads();
#pragma unroll
            for (int e = 0; e < 4; ++e) { As[lk + e][lr] = (float)av[e]; Bs[lk + e][lr] = (float)bv[e]; }
            __syncthreads();
#pragma unroll
            for (int kk = 0; kk < 16; ++kk) {
                float a[4], b[4];
#pragma unroll
                for (int i = 0; i < 4; ++i) { a[i] = As[kk][ty * 4 + i]; b[i] = Bs[kk][tx * 4 + i]; }
#pragma unroll
                for (int i = 0; i < 4; ++i)
#pragma unroll
                    for (int j = 0; j < 4; ++j) acc[i][j] += a[i] * b[j];
            }
        }
#pragma unroll
        for (int i = 0; i < 4; ++i)
#pragma unroll
            for (int j = 0; j < 4; ++j) {
                if (EPI == 1) {
                    const int m = m0 + ty * 4 + i, n = n0 + tx * 4 + j;
                    const float gt = (float)g.gates[(size_t)m * g.ldg + nb * 1024 + n];
                    res[i][j] += sigmoidf_(gt) * acc[i][j];
                } else res[i][j] = acc[i][j];
            }
    }
#pragma unroll
    for (int i = 0; i < 4; ++i)
#pragma unroll
        for (int j = 0; j < 4; ++j) {
            const int m = m0 + ty * 4 + i, n = n0 + tx * 4 + j;
            if (EPI == 2) g.xout[(size_t)m * DM + n] = g.xin[(size_t)m * DM + n] + res[i][j];
            else g.C[(size_t)m * g.ldc + n] = (h16)res[i][j];
        }
}

__global__ void nv_fox_cumsum(const float* __restrict__ small, float* __restrict__ cb, int b0) {
    const int i = blockIdx.x * blockDim.x + threadIdx.x;
    if (i >= HB * 8) return;
    const int bl = i >> 3, h = i & 7;
    const float* s = small + (size_t)(b0 + bl) * SEQ * 16 + h;
    float* o = cb + (size_t)((b0 + bl) * 8 + h) * SEQ;
    float c = 0.f;
    for (int t = 0; t < SEQ; ++t) { c += s[(size_t)t * 16]; o[t] = -c * LOG2E; }
}
__global__ void nv_moba_kmean(const h16* __restrict__ proj, float* __restrict__ kmean, int b0) {
    const int i = blockIdx.x * blockDim.x + threadIdx.x;
    if (i >= HB * 8 * 512) return;
    const int col = i & 511, blk = (i >> 9) & 7, bl = i >> 12;
    const h16* p = proj + (size_t)(bl * SEQ + blk * 256) * PW + PC_BK + col;
    float s = 0.f;
    for (int t = 0; t < 256; ++t) s += (float)p[(size_t)t * PW];
    const int h = col >> 6, d = col & 63;
    kmean[(((size_t)(b0 + bl) * 8 + h) * 8 + blk) * 64 + d] = s * (1.f / 256.f);
}

__global__ void __launch_bounds__(256) nv_fox_attn(const h16* __restrict__ proj, const float* __restrict__ cb, h16* __restrict__ y, int b0) {
    const int bh = blockIdx.y, bl = bh >> 3, h = bh & 7;
    const int t = blockIdx.x * 256 + threadIdx.x;
    const size_t rowb = (size_t)bl * SEQ;
    float q[64], o[64];
    {
        const h16* qp = proj + (rowb + t) * PW + PC_AQ + h * 64;
#pragma unroll
        for (int d = 0; d < 64; ++d) { q[d] = (float)qp[d]; o[d] = 0.f; }
    }
    const float* cbh = cb + (size_t)((b0 + bl) * 8 + h) * SEQ;
    float m = -INFINITY, l = 0.f;
    const int send = blockIdx.x * 256 + 255;
    for (int s = 0; s <= send; ++s) {
        const h16* kp = proj + (rowb + s) * PW + PC_AK + h * 64;
        const h16* vp = proj + (rowb + s) * PW + PC_AV + h * 64;
        float sd = 0.f;
#pragma unroll
        for (int d = 0; d < 64; ++d) sd += q[d] * (float)kp[d];
        sd += cbh[s];
        if (s <= t) {
            const float mn = fmaxf(m, sd), al = exp2f(m - mn), p = exp2f(sd - mn);
            l = l * al + p;
#pragma unroll
            for (int d = 0; d < 64; ++d) o[d] = o[d] * al + p * (float)vp[d];
            m = mn;
        }
    }
    const float il = 1.f / l;
    const h16* zp = proj + (rowb + t) * PW + PC_AZ + h * 64;
    h16* yp = y + (rowb + t) * 1536 + h * 64;
#pragma unroll
    for (int d = 0; d < 64; ++d) yp[d] = (h16)(o[d] * il * siluf_((float)zp[d]));
}

__global__ void __launch_bounds__(256) nv_moba_attn(const h16* __restrict__ proj, const float* __restrict__ kmean, h16* __restrict__ y, int b0) {
    const int bh = blockIdx.y, bl = bh >> 3, h = bh & 7;
    const int own = blockIdx.x;
    const int t = own * 256 + threadIdx.x;
    const size_t rowb = (size_t)bl * SEQ;
    float q[64], o[64];
    {
        const h16* qp = proj + (rowb + t) * PW + PC_BQ + h * 64;
#pragma unroll
        for (int d = 0; d < 64; ++d) { q[d] = (float)qp[d]; o[d] = 0.f; }
    }
    unsigned selmask = 0;
    if (own <= 3) selmask = (1u << own) - 1u;
    else {
        float gate[8];
        const float* km = kmean + ((size_t)(b0 + bl) * 8 + h) * 8 * 64;
#pragma unroll
        for (int n = 0; n < 8; ++n) {
            float sd = 0.f;
#pragma unroll
            for (int d = 0; d < 64; ++d) sd += q[d] * km[n * 64 + d];
            gate[n] = n < own ? sd : -INFINITY;
        }
        for (int r = 0; r < 3; ++r) {
            float best = -INFINITY; int bi = -1;
#pragma unroll
            for (int n = 0; n < 8; ++n) { const bool free_ = !((selmask >> n) & 1u); if (free_ && n < own && gate[n] > best) { best = gate[n]; bi = n; } }
            if (bi >= 0) selmask |= 1u << bi;
        }
    }
    const float slope2 = exp2f(-(float)(h + 1)) * LOG2E;
    float m = -INFINITY, l = 0.f;
    for (int n = 0; n <= own; ++n) {
        const bool isown = n == own;
        const bool sel = isown || ((selmask >> n) & 1u);
        for (int ss = 0; ss < 256; ++ss) {
            const int s = n * 256 + ss;
            const h16* kp = proj + (rowb + s) * PW + PC_BK + h * 64;
            const h16* vp = proj + (rowb + s) * PW + PC_BV + h * 64;
            if (sel && s <= t) {
                float sd = 0.f;
#pragma unroll
                for (int d = 0; d < 64; ++d) sd += q[d] * (float)kp[d];
                sd -= slope2 * (float)(t - s);
                const float mn = fmaxf(m, sd), al = exp2f(m - mn), p = exp2f(sd - mn);
                l = l * al + p;
#pragma unroll
                for (int d = 0; d < 64; ++d) o[d] = o[d] * al + p * (float)vp[d];
                m = mn;
            }
        }
    }
    const float il = 1.f / l;
    const h16* zp = proj + (rowb + t) * PW + PC_BZ + h * 64;
    h16* yp = y + (rowb + t) * 1536 + 512 + h * 64;
#pragma unroll
    for (int d = 0; d < 64; ++d) yp[d] = (h16)(o[d] * il * siluf_((float)zp[d]));
}

__global__ void __launch_bounds__(256) nv_mlstm(const h16* __restrict__ proj, const float* __restrict__ small, const float* __restrict__ convw  ,
                                                const float* __restrict__ headg  , h16* __restrict__ y, int b0) {
    __shared__ float qk[128];
    __shared__ float red[4];
    const int bl = blockIdx.x >> 2, hh = blockIdx.x & 3, tid = threadIdx.x, v = tid >> 1, kh = tid & 1;
    const size_t rowb = (size_t)bl * SEQ;
    float C[32], nn[32];
#pragma unroll
    for (int j = 0; j < 32; ++j) { C[j] = 0.f; nn[j] = 0.f; }
    float m = 0.f;
    const int ccol = tid < 64 ? hh * 64 + tid : 256 + hh * 64 + (tid - 64);
    float cw[4] = {0.f, 0.f, 0.f, 0.f};
    if (tid < 128) {
#pragma unroll
        for (int j = 0; j < 4; ++j) cw[j] = convw[j * 512 + ccol];
    }
    const float hg = headg[hh * 128 + v];
    for (int t = 0; t < SEQ; ++t) {
        if (tid < 128) {
            float a = 0.f;
#pragma unroll
            for (int j = 0; j < 4; ++j) { const int tt = t - 3 + j; if (tt >= 0) a += cw[j] * (float)proj[(rowb + tt) * PW + PC_CQK + ccol]; }
            a = siluf_(a);
            if (tid >= 64) a *= 0.125f;
            qk[tid] = a;
        }
        __syncthreads();
        const size_t row = rowb + t;
        const float li = small[((size_t)b0 * SEQ + row) * 16 + 8 + hh], lf = small[((size_t)b0 * SEQ + row) * 16 + 12 + hh];
        const float vt = (float)proj[row * PW + PC_CV + hh * 128 + v];
        const float mn = fmaxf(lf + m, li), fw = __expf(lf + m - mn), iw = __expf(li - mn);
        float nump = 0.f, denp = 0.f;
#pragma unroll
        for (int j = 0; j < 32; ++j) {
            const float kj = qk[64 + kh * 32 + j], qj = qk[kh * 32 + j];
            C[j] = fw * C[j] + iw * vt * kj; nn[j] = fw * nn[j] + iw * kj;
            nump += C[j] * qj; denp += nn[j] * qj;
        }
        nump += __shfl_xor(nump, 1); denp += __shfl_xor(denp, 1);
        m = mn;
        const float hval = nump / fmaxf(fabsf(denp), __expf(-mn));
        const float hgt = hval * sigmoidf_((float)proj[row * PW + PC_CO + hh * 128 + v]);
        float ss = kh == 0 ? hgt * hgt : 0.f;
        ss = wave_sum(ss);
        if ((tid & 63) == 0) red[tid >> 6] = ss;
        __syncthreads();
        const float tot = red[0] + red[1] + red[2] + red[3];
        if (kh == 0) {
            const float o = hgt * rsqrtf(tot * (1.f / 128.f) + RMS_EPS) * hg * siluf_((float)proj[row * PW + PC_CZ + hh * 128 + v]);
            y[row * 1536 + 1024 + hh * 128 + v] = (h16)o;
        }
    }
}

__global__ void nv_final_norm(float* __restrict__ x, const float* __restrict__ g) {
    const int lane = threadIdx.x & 63, wv = (blockIdx.x * blockDim.x + threadIdx.x) >> 6, nw = (gridDim.x * blockDim.x) >> 6;
    for (int row = wv; row < TT; row += nw) {
        f32x4* xr = (f32x4*)(x + (size_t)row * DM) + lane;
        f32x4 v[4]; float s = 0.f;
#pragma unroll
        for (int j = 0; j < 4; ++j) { v[j] = xr[64 * j]; s += v[j].x * v[j].x + v[j].y * v[j].y + v[j].z * v[j].z + v[j].w * v[j].w; }
        const float rstd = rsqrtf(wave_sum(s) * (1.f / DM) + RMS_EPS);
#pragma unroll
        for (int j = 0; j < 4; ++j) {
            const f32x4 gg = ((const f32x4*)g)[lane + 64 * j];
            f32x4 o = {v[j].x * rstd * gg.x, v[j].y * rstd * gg.y, v[j].z * rstd * gg.z, v[j].w * rstd * gg.w};
            xr[64 * j] = o;
        }
    }
}


namespace pg8 {
#define PG8_LAS __attribute__((address_space(3)))
typedef short s16x8 __attribute__((ext_vector_type(8)));
typedef unsigned u32x4 __attribute__((ext_vector_type(4)));
typedef float f32x2 __attribute__((ext_vector_type(2)));
typedef _Float16 h16x2 __attribute__((ext_vector_type(2)));
constexpr int BM = 256, BK = 64, HALF = 128, HTB = HALF * BK * 2  , STAGE_BYTES = 8 * HTB, NXCD = 8, WGM = 8;
__host__ __device__ __forceinline__ int lds_byte(int r, int c) { const int st = (r >> 4) * 2 + (c >> 5), rr = r & 15, cc = c & 31, ob = rr * 64 + cc * 2; return st * 1024 + (ob ^ (((ob >> 9) & 1) << 5)); }
__host__ __device__ __forceinline__ void stage_rc(int b, int& R, int& C) { const int st = b / 1024, sb = b % 1024, swz = sb ^ (((sb >> 9) & 1) << 5); R = (st >> 1) * 16 + swz / 64; C = (st & 1) * 32 + (swz % 64) / 2; }
__host__ __device__ __forceinline__ int perm32(int rho) { const int n = rho >> 4, i = rho & 15; return 8 * (i >> 2) + 4 * n + (i & 3); }
__device__ __forceinline__ unsigned cvt_pk_f16(float lo, float hi) { f32x2 v = {lo, hi}; h16x2 b = __builtin_convertvector(v, h16x2); return __builtin_bit_cast(unsigned, b); }

struct Unit { int pm, pn, z; };
struct Gemm { const h16* A; const h16* Bt; int lda, ldb, K; long zA, zB; };

__device__ __forceinline__ void tile_of(int L, int nM, int nN, int& pm, int& pn) {
    const int nwg = nM * nN; int wgid = L;
    { const int q = nwg / NXCD, r = nwg % NXCD, xcd = wgid % NXCD, off = wgid / NXCD; wgid = (xcd < r ? xcd * (q + 1) : r * (q + 1) + (xcd - r) * q) + off; }
    const int nig = WGM * nN, gid = wgid / nig, fm = gid * WGM, gsz = (nM - fm) < WGM ? (nM - fm) : WGM;
    pm = fm + ((wgid % nig) % gsz); pn = (wgid % nig) / gsz;
}
struct StaticOrder {
    int nM, nN, nwg, G, c;
    __device__ void init(int M, int N, int G_, int c_) { nM = M / BM; nN = N / BM; nwg = nM * nN; G = G_; c = c_; }
    __device__ bool next(int i, Unit& u) const { const long L = (long)i * G + c; if (L >= nwg) return false; tile_of((int)L, nM, nN, u.pm, u.pn); u.z = 0; return true; }
};
struct BranchOrder {
    int nM, nN, nwg, G, c, NZ;
    __device__ void init(int M, int N, int G_, int c_, int nz) { nM = M / BM; nN = N / BM; nwg = nM * nN; G = G_; c = c_; NZ = nz; }
    __device__ bool next(int i, Unit& u) const { const int j = i / NZ; const long L = (long)j * G + c; if (L >= nwg) return false; tile_of((int)L, nM, nN, u.pm, u.pn); u.z = i - j * NZ; return true; }
};

struct EpiF16 {
    static constexpr bool PERM = true;
    h16* C; int ldc;
    __device__ __forceinline__ void operator()(const f32x4 (&acc)[2][2][4][2], const Unit& u, int wr, int wc, int fr, int fq) const {
        const int row0 = u.pm * BM + wr * 64 + fr, col0 = u.pn * BM + wc * 32 + 8 * fq;
#pragma unroll
        for (int ai = 0; ai < 2; ++ai)
#pragma unroll
            for (int m = 0; m < 4; ++m) { h16* rowp = C + (size_t)(row0 + ai * HALF + m * 16) * ldc + col0;
#pragma unroll
                for (int bj = 0; bj < 2; ++bj) { const f32x4 v0 = acc[ai][bj][m][0], v1 = acc[ai][bj][m][1];
                    u32x4 w; w.x = cvt_pk_f16(v0[0], v0[1]); w.y = cvt_pk_f16(v0[2], v0[3]); w.z = cvt_pk_f16(v1[0], v1[1]); w.w = cvt_pk_f16(v1[2], v1[3]);
                    *(u32x4*)(rowp + bj * HALF) = w; } }
    }
};
struct EpiGate {
    static constexpr bool PERM = true;
    h16* Mg; const h16* G; int ldg;
    __device__ __forceinline__ void operator()(const f32x4 (&acc)[2][2][4][2], const Unit& u, int wr, int wc, int fr, int fq) const {
        const int row0 = u.pm * BM + wr * 64 + fr, col0 = u.pn * BM + wc * 32 + 8 * fq;
#pragma unroll
        for (int ai = 0; ai < 2; ++ai)
#pragma unroll
            for (int mp = 0; mp < 2; ++mp) {
                h16x8 gv[2][2], pv[2][2];
#pragma unroll
                for (int mm = 0; mm < 2; ++mm)
#pragma unroll
                    for (int bj = 0; bj < 2; ++bj) { const size_t row = (size_t)(row0 + ai * HALF + (2 * mp + mm) * 16);
                        gv[mm][bj] = *(const h16x8*)(G + row * ldg + u.z * 1024 + col0 + bj * HALF);
                        if (u.z > 0) pv[mm][bj] = *(const h16x8*)(Mg + row * 1024 + col0 + bj * HALF); }
#pragma unroll
                for (int mm = 0; mm < 2; ++mm)
#pragma unroll
                    for (int bj = 0; bj < 2; ++bj) { const int m = 2 * mp + mm; const size_t row = (size_t)(row0 + ai * HALF + m * 16);
                        float o[8];
#pragma unroll
                        for (int e = 0; e < 8; ++e) { const float a = e < 4 ? acc[ai][bj][m][0][e] : acc[ai][bj][m][1][e - 4]; o[e] = a * __builtin_amdgcn_rcpf(1.f + __expf(-(float)gv[mm][bj][e])); }
                        if (u.z > 0) {
#pragma unroll
                            for (int e = 0; e < 8; ++e) o[e] += (float)pv[mm][bj][e]; }
                        u32x4 w; w.x = cvt_pk_f16(o[0], o[1]); w.y = cvt_pk_f16(o[2], o[3]); w.z = cvt_pk_f16(o[4], o[5]); w.w = cvt_pk_f16(o[6], o[7]);
                        *(u32x4*)(Mg + row * 1024 + col0 + bj * HALF) = w; }
            }
    }
};
struct EpiRes {
    static constexpr bool PERM = false;
    const float* xin; float* out; int ldc;
    __device__ __forceinline__ void operator()(const f32x4 (&acc)[2][2][4][2], const Unit& u, int wr, int wc, int fr, int fq) const {
        const int row0 = u.pm * BM + wr * 64 + fr, col0 = u.pn * BM + wc * 32 + 4 * fq;
#pragma unroll
        for (int ai = 0; ai < 2; ++ai)
#pragma unroll
            for (int mp = 0; mp < 2; ++mp) {
                f32x4 xv[2][2][2];
#pragma unroll
                for (int mm = 0; mm < 2; ++mm) { const size_t off = (size_t)(row0 + ai * HALF + (2 * mp + mm) * 16) * ldc + col0;
#pragma unroll
                    for (int bj = 0; bj < 2; ++bj)
#pragma unroll
                        for (int n = 0; n < 2; ++n) xv[mm][bj][n] = *(const f32x4*)(xin + off + bj * HALF + n * 16); }
#pragma unroll
                for (int mm = 0; mm < 2; ++mm) { const int m = 2 * mp + mm; const size_t off = (size_t)(row0 + ai * HALF + m * 16) * ldc + col0;
#pragma unroll
                    for (int bj = 0; bj < 2; ++bj)
#pragma unroll
                        for (int n = 0; n < 2; ++n) *(f32x4*)(out + off + bj * HALF + n * 16) = xv[mm][bj][n] + acc[ai][bj][m][n]; }
            }
    }
};

template <class Epi, class Sched>
__device__ __forceinline__ void gemm_phase(PG8_LAS unsigned char* lds, const Gemm g, const Sched& S, const Epi& E) {
    int tid_ = threadIdx.x; asm volatile("" : "+v"(tid_));
    const int tid = tid_, wid = __builtin_amdgcn_readfirstlane(tid >> 6), lane = tid & 63, wr = wid >> 2, wc = wid & 3, fr = lane & 15, fq = lane >> 4;
    const int nt = g.K / BK;
    unsigned voffA[2], voffB[2];
#pragma unroll
    for (int i = 0; i < 2; ++i) { int R, C; stage_rc(tid * 16 + i * 8192, R, C); const int Rb = Epi::PERM ? ((R & ~31) + perm32(R & 31)) : R;
        voffA[i] = (unsigned)(R * g.lda + C) * 2u; voffB[i] = (unsigned)(Rb * g.ldb + C) * 2u; }
    const size_t kstep = (size_t)(BK * 2);
    const size_t hA = (size_t)HALF * g.lda * 2, hB = (size_t)HALF * g.ldb * 2;
    const size_t tA = 2 * hA, tB = 2 * hB;
    const unsigned ldsw = (unsigned)wid * 1024u;
    const int aoff = lds_byte(wr * 64 + fr, fq * 8), boff = lds_byte(wc * 32 + fr, fq * 8);
#define PG8_SA(b, h) (((b) * 2 + (h)) * HTB)
#define PG8_SB(b, h) ((4 + (b) * 2 + (h)) * HTB)
#define PG8_STAGE(bufoff, gbase, voff) do { _Pragma("unroll") for (int _i = 0; _i < 2; ++_i) \
        __builtin_amdgcn_global_load_lds((const unsigned*)((const char*)(gbase) + (voff)[_i]), (PG8_LAS unsigned*)(lds + (bufoff) + ldsw + _i * 8192), 16, 0, 0); } while (0)
#define PG8_LDA(dst, b, h) do { _Pragma("unroll") for (int m = 0; m < 4; ++m) _Pragma("unroll") for (int k = 0; k < 2; ++k) dst[m][k] = *(const PG8_LAS s16x8*)(lds + PG8_SA(b, h) + aoff + m * 2048 + k * 1024); } while (0)
#define PG8_LDB(dst, b, h) do { _Pragma("unroll") for (int n = 0; n < 2; ++n) _Pragma("unroll") for (int k = 0; k < 2; ++k) dst[n][k] = *(const PG8_LAS s16x8*)(lds + PG8_SB(b, h) + boff + n * 2048 + k * 1024); } while (0)
#define PG8_MMA(ai, bj, At, Bt) do { __builtin_amdgcn_s_setprio(1); _Pragma("unroll") for (int m = 0; m < 4; ++m) _Pragma("unroll") for (int n = 0; n < 2; ++n) _Pragma("unroll") for (int k = 0; k < 2; ++k) \
        acc[ai][bj][m][n] = __builtin_amdgcn_mfma_f32_16x16x32_f16(__builtin_bit_cast(h16x8, Bt[n][k]), __builtin_bit_cast(h16x8, At[m][k]), acc[ai][bj][m][n], 0, 0, 0); __builtin_amdgcn_s_setprio(0); } while (0)
#define PG8_WAIT_V(n) asm volatile("s_waitcnt vmcnt(" #n ")" ::: "memory")
#define PG8_WAIT_L(n) asm volatile("s_waitcnt lgkmcnt(" #n ")" ::: "memory")
#define PG8_BAR __builtin_amdgcn_s_barrier()
#define PG8_SCHED __builtin_amdgcn_sched_barrier(0)
    Unit cur, nxt; int ui = 0;
    if (!S.next(0, cur)) return;
    f32x4 acc[2][2][4][2];
#pragma unroll
    for (int a = 0; a < 2; ++a)
#pragma unroll
        for (int b = 0; b < 2; ++b)
#pragma unroll
            for (int m = 0; m < 4; ++m)
#pragma unroll
                for (int n = 0; n < 2; ++n) acc[a][b][m][n] = (f32x4){0.f, 0.f, 0.f, 0.f};
    s16x8 At[4][2], B0[2][2], B1[2][2];
    const char* cA = (const char*)(g.A + (long)cur.z * g.zA) + (size_t)cur.pm * tA; const char* cB = (const char*)(g.Bt + (long)cur.z * g.zB) + (size_t)cur.pn * tB;
    PG8_STAGE(PG8_SB(0, 0), cB, voffB); PG8_STAGE(PG8_SB(0, 1), cB + hB, voffB); PG8_STAGE(PG8_SA(0, 0), cA, voffA); PG8_STAGE(PG8_SA(0, 1), cA + hA, voffA);
    if (wr == 1) PG8_BAR;
    PG8_WAIT_V(2); PG8_BAR;
    PG8_STAGE(PG8_SB(1, 0), cB + kstep, voffB); PG8_STAGE(PG8_SA(1, 0), cA + kstep, voffA); PG8_STAGE(PG8_SB(1, 1), cB + hB + kstep, voffB);
    PG8_WAIT_V(6); PG8_BAR;
    for (;;) {
        const bool has_next = S.next(ui + 1, nxt);
        const char* nA = has_next ? (const char*)(g.A + (long)nxt.z * g.zA) + (size_t)nxt.pm * tA : cA; const char* nB = has_next ? (const char*)(g.Bt + (long)nxt.z * g.zB) + (size_t)nxt.pn * tB : cB;
        for (int t = 0; t < nt; t += 2) {
            const bool last = (t == nt - 2);
            const char* a1 = cA + (size_t)(t + 1) * kstep;
            const char* a2 = last ? nA : cA + (size_t)(t + 2) * kstep; const char* b2 = last ? nB : cB + (size_t)(t + 2) * kstep;
            const char* a3 = a2 + kstep; const char* b3 = b2 + kstep;
            PG8_LDB(B0, 0, 0); PG8_LDB(B1, 0, 1); PG8_SCHED; PG8_LDA(At, 0, 0); PG8_STAGE(PG8_SA(1, 1), a1 + hA, voffA);
            PG8_WAIT_V(8); PG8_WAIT_L(0); PG8_BAR; PG8_MMA(0, 0, At, B0); PG8_MMA(0, 1, At, B1); PG8_BAR; PG8_SCHED;
            PG8_LDA(At, 0, 1); PG8_STAGE(PG8_SB(0, 0), b2, voffB); PG8_STAGE(PG8_SB(0, 1), b2 + hB, voffB); PG8_STAGE(PG8_SA(0, 0), a2, voffA);
            PG8_WAIT_V(8); PG8_WAIT_L(0); PG8_BAR; PG8_MMA(1, 0, At, B0); PG8_MMA(1, 1, At, B1); PG8_BAR; PG8_SCHED;
            PG8_LDB(B0, 1, 0); PG8_LDB(B1, 1, 1); PG8_SCHED; PG8_LDA(At, 1, 0); PG8_STAGE(PG8_SA(0, 1), a2 + hA, voffA);
            PG8_WAIT_V(8); PG8_WAIT_L(0); PG8_BAR; PG8_MMA(0, 0, At, B0); PG8_MMA(0, 1, At, B1); PG8_BAR; PG8_SCHED;
            PG8_LDA(At, 1, 1); PG8_STAGE(PG8_SB(1, 0), b3, voffB); PG8_STAGE(PG8_SB(1, 1), b3 + hB, voffB); PG8_STAGE(PG8_SA(1, 0), a3, voffA);
            PG8_WAIT_V(8); PG8_WAIT_L(0); PG8_BAR; PG8_MMA(1, 0, At, B0); PG8_MMA(1, 1, At, B1); PG8_BAR; PG8_SCHED;
        }
        if (wr == 0) PG8_BAR;
        E(acc, cur, wr, wc, fr, fq);
        if (!has_next) break;
#pragma unroll
        for (int a = 0; a < 2; ++a)
#pragma unroll
            for (int b = 0; b < 2; ++b)
#pragma unroll
                for (int m = 0; m < 4; ++m)
#pragma unroll
                    for (int n = 0; n < 2; ++n) acc[a][b][m][n] = (f32x4){0.f, 0.f, 0.f, 0.f};
        cur = nxt; cA = nA; cB = nB; ++ui;
        if (wr == 1) PG8_BAR;
    }
    PG8_WAIT_V(0);
    PG8_BAR;
#undef PG8_SA
#undef PG8_SB
#undef PG8_STAGE
#undef PG8_LDA
#undef PG8_LDB
#undef PG8_MMA
#undef PG8_WAIT_V
#undef PG8_WAIT_L
#undef PG8_BAR
#undef PG8_SCHED
}
}

namespace attn_body {
using s16x8 = __attribute__((ext_vector_type(8))) short;
using s16x4 = __attribute__((ext_vector_type(4))) short;
using f32x16 = __attribute__((ext_vector_type(16))) float;
using u32x4 = __attribute__((ext_vector_type(4))) unsigned;
constexpr int D = 64, NW = 8, QBLK = 32, QB = QBLK * NW, KVBLK = 64;
constexpr int PQ = PW;
__device__ __forceinline__ int crow(int r, int hi) { return (r & 3) + 8 * (r >> 2) + 4 * hi; }
#define SBAR() __builtin_amdgcn_sched_barrier(0)
__device__ __forceinline__ void cmask(f32x16& p0, f32x16& p1, int jb, int qrel, int hi) {
    const float NEG = -INFINITY; int kb = 64 * jb + 4 * hi;
#pragma unroll
    for (int r = 0; r < 16; ++r) { int kv = kb + (r & 3) + 8 * (r >> 2); if (kv > qrel) p0[r] = NEG; if (kv + 32 > qrel) p1[r] = NEG; }
}
constexpr int NSLOT = 3, SLOTB = 8192;
constexpr int LDS_K = 0, LDS_V = NSLOT * SLOTB, LDS_WS = 2 * NSLOT * SLOTB, LDS_OST = LDS_WS + NW * 64 * 4, LDS_BT = LDS_OST + NW * 4096, LDS_INF = LDS_BT + 2048 * 4, LDS_KM = LDS_INF + 256, LDS_BYTES = LDS_KM + 2048;
__device__ __forceinline__ void glds16(const void* gsrc, unsigned lds_dst) { unsigned keep;
    asm volatile("s_mov_b32 %0, m0\n\ts_mov_b32 m0, %2\n\ts_nop 0\n\tglobal_load_lds_dwordx4 %1, off\n\ts_mov_b32 m0, %0" : "=&s"(keep) : "v"(gsrc), "s"(lds_dst) : "memory"); }
__device__ __forceinline__ float max3f(float a, float b, float c) { float r; asm("v_max3_f32 %0, %1, %2, %3" : "=v"(r) : "v"(a), "v"(b), "v"(c)); return r; }
__device__ __forceinline__ float max2f(float a, float b) { float r; asm("v_max_f32_e32 %0, %1, %2" : "=v"(r) : "v"(a), "v"(b)); return r; }
__device__ __forceinline__ float fadd_s(float a, float b) { float r; asm("v_add_f32_e32 %0, %1, %2" : "=v"(r) : "v"(a), "v"(b)); return r; }
__device__ __forceinline__ float fsub_s(float a, float b) { float r; asm("v_sub_f32_e32 %0, %1, %2" : "=v"(r) : "v"(a), "v"(b)); return r; }
__device__ __forceinline__ unsigned cvtpk_s(float lo, float hi) { return pg8::cvt_pk_f16(lo, hi); }
#define MFMA32(a, b, c) __builtin_amdgcn_mfma_f32_32x32x16_f16(__builtin_bit_cast(h16x8, (a)), __builtin_bit_cast(h16x8, (b)), (c), 0, 0, 0)
#define WAIT_BAR(N) asm volatile("s_waitcnt vmcnt(" #N ") lgkmcnt(0)\n\ts_barrier" ::: "memory")
__device__ __forceinline__ void qkt(f32x16& p0, f32x16& p1, const char* Kslot, const s16x8* qr, const f32x16& negm, int r32, int hi) {
    const char* kb = Kslot + hi * 1024 + r32 * 16;
#pragma unroll
    for (int d0 = 0; d0 < 4; ++d0) {
        const s16x8 b0 = *reinterpret_cast<const s16x8*>(kb + d0 * 2048);
        const s16x8 b1 = *reinterpret_cast<const s16x8*>(kb + d0 * 2048 + 512);
        if (d0 == 0) { p0 = MFMA32(b0, qr[0], negm); p1 = MFMA32(b1, qr[0], negm); }
        else { p0 = MFMA32(b0, qr[d0], p0); p1 = MFMA32(b1, qr[d0], p1); } }
}
typedef __attribute__((address_space(3))) const char* lds_cptr;
typedef short v4i16_t __attribute__((ext_vector_type(4)));
#define LDS8(p) (*(const __attribute__((address_space(3))) s16x8*)(p))
__device__ __forceinline__ void kload8(s16x8* kf, lds_cptr kp) {
    kf[0] = LDS8(kp); kf[1] = LDS8(kp + 512); kf[2] = LDS8(kp + 2048); kf[3] = LDS8(kp + 2560);
    kf[4] = LDS8(kp + 4096); kf[5] = LDS8(kp + 4608); kf[6] = LDS8(kp + 6144); kf[7] = LDS8(kp + 6656);
}
__device__ __forceinline__ void kload2(s16x8* kf, lds_cptr kp, int j) { kf[2 * j] = LDS8(kp + j * 2048); kf[2 * j + 1] = LDS8(kp + j * 2048 + 512); }
__device__ __forceinline__ s16x4 vtr(lds_cptr p) { return __builtin_bit_cast(s16x4, __builtin_amdgcn_ds_read_tr16_b64_v4i16((__attribute__((address_space(3))) v4i16_t*)p)); }
__device__ __forceinline__ float rowmax(const f32x16& p0, const f32x16& p1) {
    float a = max3f(p0[0], p0[1], p1[0]), b = max3f(p0[2], p0[3], p1[1]); a = max3f(a, p1[2], p1[3]);
#pragma unroll
    for (int r = 4; r < 16; r += 4) { a = max3f(a, p0[r], p0[r + 1]); b = max3f(b, p0[r + 2], p0[r + 3]); a = max3f(a, p1[r], p1[r + 1]); b = max3f(b, p1[r + 2], p1[r + 3]); }
    const float m = max2f(a, b);
    auto rr = __builtin_amdgcn_permlane32_swap(__float_as_uint(m), __float_as_uint(m), false, false);
    return max2f(__uint_as_float(rr[0]), __uint_as_float(rr[1]));
}
__device__ __forceinline__ void pv(f32x16* o, int vb, s16x8 pa0, s16x8 pa1, s16x8 pa2, s16x8 pa3) {
#pragma unroll
    for (int d0 = 0; d0 < 2; ++d0) { s16x4 lo[4], hi[4];
#pragma unroll
        for (int ks = 0; ks < 4; ++ks) {
            asm volatile("ds_read_b64_tr_b16 %0,%1 offset:%c2" : "=&v"(lo[ks]) : "v"(vb), "i"(d0 * 4096 + ks * 1024) : "memory");
            asm volatile("ds_read_b64_tr_b16 %0,%1 offset:%c2" : "=&v"(hi[ks]) : "v"(vb), "i"(d0 * 4096 + ks * 1024 + 512) : "memory"); }
        asm volatile("s_waitcnt lgkmcnt(0)" ::: "memory"); SBAR();
#define PK(k) (s16x8){lo[k][0], lo[k][1], lo[k][2], lo[k][3], hi[k][0], hi[k][1], hi[k][2], hi[k][3]}
        o[d0] = MFMA32(pa0, PK(0), o[d0]);
        o[d0] = MFMA32(pa1, PK(1), o[d0]);
        o[d0] = MFMA32(pa2, PK(2), o[d0]);
        o[d0] = MFMA32(pa3, PK(3), o[d0]);
#undef PK
    }
}

template <bool MOBA, int THRL>
__device__ __forceinline__ void attn_unit(int bl, int h, int qb, const h16* Q, const h16* __restrict__ K, const h16* __restrict__ V, const h16* __restrict__ Z, h16* Y,
                                          const float* __restrict__ bsrc, float slope2, const float* __restrict__ kmean, char* shm) {
    int tid_ = threadIdx.x; asm volatile("" : "+v"(tid_));
    const int tid = tid_, lane = tid & 63, r32 = lane & 31, hi = lane >> 5; const int wid = __builtin_amdgcn_readfirstlane(tid >> 6);
    const long rowbase = (long)bl * SEQ; const int q0 = qb * QB;
    const h16* Qw = Q + (rowbase + q0 + wid * QBLK) * PQ + h * D;
    const h16* Kh = K + rowbase * PQ + h * D, *Vh = V + rowbase * PQ + h * D;
    const unsigned lds0 = (unsigned)(uintptr_t)shm;
    float* wsf = (float*)(shm + LDS_WS) + wid * 64;
    typedef __attribute__((address_space(3))) float lds_f32;
    typedef __attribute__((address_space(3))) const f32x4 lds_cf32x4;
    const lds_cptr shm3 = (lds_cptr)shm;
    {
        lds_f32* bt = (lds_f32*)(shm3 + LDS_BT);
        const int nkeys = q0 + QB;
        if (MOBA) { for (int i = tid; i < nkeys; i += NW * 64) bt[i] = slope2 * (float)(i - q0); }
        else { for (int i = tid; i < nkeys; i += NW * 64) bt[i] = bsrc[i]; }
        if (tid < 64) ((lds_f32*)(shm3 + LDS_INF))[tid] = -INFINITY;
        if (MOBA) { if (tid < 512) ((lds_f32*)(shm3 + LDS_KM))[tid] = kmean[tid]; }
    }
    const h16* ksrc = Kh + (long)lane * PQ + wid * 8;
    const h16* vsrc = Vh + (long)(16 * (wid & 3) + (lane >> 2)) * PQ + (wid >> 2) * 32 + (lane & 3) * 8;
    const unsigned kdst = lds0 + LDS_K + wid * 1024, vdst = lds0 + LDS_V + wid * 1024;
    const int NT = (q0 + QB) / KVBLK;
#define AMAP(t) (MOBA ? ((t) < 4 ? 4 * qb + (t) : (t) - 4) : (t))
#define DMA_K(t, slot) glds16(ksrc + (long)AMAP(t) * KVBLK * PQ, (unsigned)__builtin_amdgcn_readfirstlane(kdst + (slot)))
#define DMA_V(t, slot) glds16(vsrc + (long)AMAP(t) * KVBLK * PQ, (unsigned)__builtin_amdgcn_readfirstlane(vdst + (slot)))
    const char* Kbase = shm + LDS_K; s16x8 kf[8];
    const lds_cptr kp0 = shm3 + LDS_K + hi * 1024 + r32 * 16; const lds_cptr vp0 = shm3 + LDS_V + ((lane >> 4) & 1) * 32 + (lane & 3) * 8 + (4 * hi + ((lane & 15) >> 2)) * 64;
    DMA_K(0, 0); DMA_V(0, 0); DMA_K(1, SLOTB);
    s16x8 qr[4];
#pragma unroll
    for (int d0 = 0; d0 < 4; ++d0) qr[d0] = *reinterpret_cast<const s16x8*>(&Qw[(long)r32 * PQ + d0 * 16 + hi * 8]);
    float mhat = 0.f, l_reg = 0.f; f32x16 o[2]; o[0] = f32x16{}; o[1] = f32x16{}; f32x16 negm = f32x16{}; asm volatile("" : "+v"(negm));
    const int qrel = wid * QBLK + r32;
    unsigned selbits = 0xffu;
#define ADDB(P0, P1, t) do { const int kt_ = AMAP(t); lds_cptr tb_ = shm3 + LDS_BT + kt_ * 256; \
        if (MOBA) { const bool s_ = ((t) < 4) || ((selbits >> (kt_ >> 2)) & 1u); tb_ = s_ ? tb_ : (shm3 + LDS_INF); } \
        _Pragma("unroll") for (int g_ = 0; g_ < 4; ++g_) { const f32x4 b0_ = *(lds_cf32x4*)(tb_ + 16 * hi + 32 * g_), b1_ = *(lds_cf32x4*)(tb_ + 128 + 16 * hi + 32 * g_); \
            _Pragma("unroll") for (int i_ = 0; i_ < 4; ++i_) { P0[4 * g_ + i_] += b0_[i_]; P1[4 * g_ + i_] += b1_[i_]; } } } while (0)
#define CMASK(P0, P1, t) do { const int jb_ = MOBA ? (t) : (t) - (NT - 4); if (MOBA ? (jb_ < 4) : (jb_ >= 0)) cmask(P0, P1, jb_, qrel, hi); } while (0)
    bool resc = false;
#define START(P0, P1) do { const float rm = rowmax(P0, P1); resc = false; \
    { const float dl = rm; mhat = fadd_s(mhat, dl); \
      _Pragma("unroll") for (int r = 0; r < 16; ++r) { P0[r] = fsub_s(P0[r], dl); P1[r] = fsub_s(P1[r], dl); } \
      _Pragma("unroll") for (int r = 0; r < 16; ++r) negm[r] = -mhat; asm volatile("" : "+v"(negm)); } \
    _Pragma("unroll") for (int r = 0; r < 16; ++r) P0[r] = __builtin_amdgcn_exp2f(P0[r]); } while (0)
#define RESC() do { if (resc) { asm volatile("s_waitcnt lgkmcnt(0)" ::: "memory"); \
      _Pragma("unroll") for (int d_ = 0; d_ < 2; ++d_) _Pragma("unroll") for (int r = 0; r < 16; ++r) o[d_][r] *= wsf[crow(r, hi)]; } } while (0)
    f32x16 pA0, pA1, pB0, pB1;
    int sl_prev = 0, sl_cur = 0, sl_next = SLOTB;
#define ROT() do { sl_prev = sl_cur; sl_cur = sl_next; sl_next = (sl_next == (NSLOT - 1) * SLOTB) ? 0 : sl_next + SLOTB; } while (0)
    DMA_K(2, 2 * SLOTB);
    WAIT_BAR(3);
    if (MOBA && qb >= 4) {
        float gate[8];
#pragma unroll
        for (int n = 0; n < 8; ++n) gate[n] = 0.f;
#pragma unroll
        for (int d0 = 0; d0 < 4; ++d0) {
            const h16x8 qv = __builtin_bit_cast(h16x8, qr[d0]);
#pragma unroll
            for (int n = 0; n < 7; ++n) {
                const f32x4 k0 = *(lds_cf32x4*)(shm3 + LDS_KM + n * 256 + d0 * 64 + hi * 32), k1 = *(lds_cf32x4*)(shm3 + LDS_KM + n * 256 + d0 * 64 + hi * 32 + 16);
                gate[n] += (float)qv[0] * k0[0] + (float)qv[1] * k0[1] + (float)qv[2] * k0[2] + (float)qv[3] * k0[3] + (float)qv[4] * k1[0] + (float)qv[5] * k1[1] + (float)qv[6] * k1[2] + (float)qv[7] * k1[3];
            }
        }
#pragma unroll
        for (int n = 0; n < 7; ++n) { gate[n] += __shfl_xor(gate[n], 32); if (n >= qb) gate[n] = -INFINITY; }
        unsigned sb = 0u;
#pragma unroll
        for (int r = 0; r < 3; ++r) {
            float best = -INFINITY; int bi = 0;
#pragma unroll
            for (int n = 0; n < 7; ++n) { const bool fr_ = !((sb >> n) & 1u); if (fr_ && gate[n] > best) { best = gate[n]; bi = n; } }
            sb |= 1u << bi;
        }
        selbits = sb;
    }
    qkt(pA0, pA1, Kbase, qr, negm, r32, hi); asm volatile("s_nop 15\n\ts_nop 7" : "+v"(pA0), "+v"(pA1)); ADDB(pA0, pA1, 0); CMASK(pA0, pA1, 0);
    START(pA0, pA1);
    _Pragma("unroll") for (int r = 0; r < 16; ++r) pA1[r] = __builtin_amdgcn_exp2f(pA1[r]);
    WAIT_BAR(0);
    DMA_K(3, 0); DMA_V(1, SLOTB);
    ROT();
    kload8(kf, kp0 + sl_cur);
    WAIT_BAR(2);
    s16x4 vlo[8], vhi[8]; u32x4 pw0, pw1, pw2, pw3;
#define PKW(P, B) cvtpk_s(P[B], P[B + 1])
#define PAF(k) __builtin_bit_cast(s16x8, pw##k)
#define VFR(i) (s16x8){vlo[i][0], vlo[i][1], vlo[i][2], vlo[i][3], vhi[i][0], vhi[i][1], vhi[i][2], vhi[i][3]}
#define PIN(x) asm volatile("" : "+v"(x))
#define MX3(a, b, c) __builtin_fmaxf(__builtin_fmaxf((a), (b)), (c))
#define GAPA(MF, A0, A1, A2, A3, W0, W1, PW_) do { MF; sacc += A0; sacc += A1; sacc += A2; sacc += A3; PIN(sacc); W0; W1; PIN(PW_); SBAR(); } while (0)
#define EX(v) __builtin_amdgcn_exp2f(v)
#define GAPB(MF, X, B) do { MF; X[B] = EX(X[B]); X[B + 1] = EX(X[B + 1]); X[B + 2] = EX(X[B + 2]); X[B + 3] = EX(X[B + 3]); PIN(X); SBAR(); } while (0)
#define VRD(i) do { vlo[i] = vtr(vp_ + (((i) >> 2) * 4096 + ((i) & 3) * 1024)); vhi[i] = vtr(vp_ + (((i) >> 2) * 4096 + ((i) & 3) * 1024 + 512)); } while (0)
#define KRD(G, j) do { if (G) { kload2(kf, kp0 + sl_next, j); SBAR(); } } while (0)
#define STEP(C0, C1, P0, P1, t, GK, GV, GL) do { SBAR(); \
    const lds_cptr vp_ = vp0 + sl_prev; \
    VRD(0); SBAR(); float sacc = (P0[0] + P0[1]); \
    GAPA(C0 = MFMA32(kf[0], qr[0], negm), P0[2], P0[3], P0[4], P0[5],     pw0[0] = PKW(P0, 0), pw0[1] = PKW(P0, 2), pw0); \
    VRD(4); SBAR(); GAPA(C1 = MFMA32(kf[1], qr[0], negm), P0[6], P0[7], P0[8], P0[9],     pw0[2] = PKW(P0, 4), pw0[3] = PKW(P0, 6), pw0); \
    VRD(1); SBAR(); GAPA(C0 = MFMA32(kf[2], qr[1], C0),   P0[10], P0[11], P0[12], P0[13], pw1[0] = PKW(P0, 8), pw1[1] = PKW(P0, 10), pw1); \
    VRD(5); SBAR(); GAPA(C1 = MFMA32(kf[3], qr[1], C1),   P0[14], P0[15], P1[0], P1[1],   pw1[2] = PKW(P0, 12), pw1[3] = PKW(P0, 14), pw1); \
    VRD(2); SBAR(); GAPA(C0 = MFMA32(kf[4], qr[2], C0),   P1[2], P1[3], P1[4], P1[5],     pw2[0] = PKW(P1, 0), pw2[1] = PKW(P1, 2), pw2); \
    VRD(6); SBAR(); GAPA(C1 = MFMA32(kf[5], qr[2], C1),   P1[6], P1[7], P1[8], P1[9],     pw2[2] = PKW(P1, 4), pw2[3] = PKW(P1, 6), pw2); \
    VRD(3); SBAR(); GAPA(C0 = MFMA32(kf[6], qr[3], C0),   P1[10], P1[11], P1[12], P1[13], pw3[0] = PKW(P1, 8), pw3[1] = PKW(P1, 10), pw3); \
    VRD(7); SBAR(); GAPA(C1 = MFMA32(kf[7], qr[3], C1),   P1[14], P1[15], 0.f, 0.f,       pw3[2] = PKW(P1, 12), pw3[3] = PKW(P1, 14), pw3); \
    l_reg += sacc; \
    if (GK) { DMA_K((t) + 3, sl_cur); } if (GV) { DMA_V((t) + 1, sl_next); } \
    ADDB(C0, C1, t); CMASK(C0, C1, t); \
    { float a = MX3(C0[0], C0[1], C1[0]), b = MX3(C0[2], C0[3], C1[1]); a = MX3(a, C1[2], C1[3]); \
      _Pragma("unroll") for (int r = 4; r < 16; r += 4) { a = MX3(a, C0[r], C0[r + 1]); b = MX3(b, C0[r + 2], C0[r + 3]); a = MX3(a, C1[r], C1[r + 1]); b = MX3(b, C1[r + 2], C1[r + 3]); } \
      float rm = __builtin_fmaxf(a, b); { auto rr = __builtin_amdgcn_permlane32_swap(__float_as_uint(rm), __float_as_uint(rm), false, false); rm = __builtin_fmaxf(__uint_as_float(rr[0]), __uint_as_float(rr[1])); } \
      resc = false; \
      if (__builtin_expect(__any(rm > (float)THRL), 0)) { const float dl = __builtin_fmaxf(rm, 0.f); mhat += dl; \
        _Pragma("unroll") for (int r = 0; r < 16; ++r) { C0[r] -= dl; C1[r] -= dl; } \
        _Pragma("unroll") for (int r = 0; r < 16; ++r) negm[r] = -mhat; asm volatile("" : "+v"(negm)); \
        const float f = __builtin_amdgcn_exp2f(-dl); l_reg *= f; if (hi == 0) wsf[r32] = f; resc = true; } } \
    SBAR(); \
    GAPB(o[0] = MFMA32(PAF(0), VFR(0), o[0]), C0, 0); \
    GAPB(o[1] = MFMA32(PAF(0), VFR(4), o[1]), C0, 4); \
    KRD(GL, 0); GAPB(o[0] = MFMA32(PAF(1), VFR(1), o[0]), C0, 8); \
    KRD(GL, 1); GAPB(o[1] = MFMA32(PAF(1), VFR(5), o[1]), C0, 12); \
    KRD(GL, 2); GAPB(o[0] = MFMA32(PAF(2), VFR(2), o[0]), C1, 0); \
    KRD(GL, 3); GAPB(o[1] = MFMA32(PAF(2), VFR(6), o[1]), C1, 4); \
    GAPB(o[0] = MFMA32(PAF(3), VFR(3), o[0]), C1, 8); \
    GAPB(o[1] = MFMA32(PAF(3), VFR(7), o[1]), C1, 12); \
    } while (0)
    int t = 1;
#define ENDW(tt) do { if ((tt) + 3 < NT) { WAIT_BAR(2); } else if ((tt) + 2 < NT) { WAIT_BAR(1); } else { WAIT_BAR(0); } } while (0)
    for (; t + 1 < NT; t += 2) {
        STEP(pB0, pB1, pA0, pA1, t, (t + 3 < NT), (t + 1 < NT), (t + 1 < NT));       ENDW(t);     RESC(); ROT();
        STEP(pA0, pA1, pB0, pB1, t + 1, (t + 4 < NT), (t + 2 < NT), (t + 2 < NT));   ENDW(t + 1); RESC(); ROT();
    }
    STEP(pB0, pB1, pA0, pA1, NT - 1, false, false, false); RESC();
    { float sacc = pB0[0] + pB0[1]; _Pragma("unroll") for (int r = 2; r < 16; ++r) sacc += pB0[r]; _Pragma("unroll") for (int r = 0; r < 16; ++r) sacc += pB1[r]; l_reg += sacc;
      pw0 = (u32x4){PKW(pB0, 0), PKW(pB0, 2), PKW(pB0, 4), PKW(pB0, 6)}; pw1 = (u32x4){PKW(pB0, 8), PKW(pB0, 10), PKW(pB0, 12), PKW(pB0, 14)}; pw2 = (u32x4){PKW(pB1, 0), PKW(pB1, 2), PKW(pB1, 4), PKW(pB1, 6)}; pw3 = (u32x4){PKW(pB1, 8), PKW(pB1, 10), PKW(pB1, 12), PKW(pB1, 14)};
      int ln_ = threadIdx.x & 63; asm volatile("" : "+v"(ln_));
      const int vb0 = (int)(lds0 + LDS_V) + ((ln_ >> 4) & 1) * 32 + (ln_ & 3) * 8 + (4 * (ln_ >> 5) + ((ln_ & 15) >> 2)) * 64;
      SBAR(); pv(o, vb0 + sl_cur, PAF(0), PAF(1), PAF(2), PAF(3)); }
#undef PKW
#undef PAF
#undef VFR
#undef PIN
#undef MX3
#undef GAPA
#undef GAPB
#undef EX
#undef VRD
#undef KRD
#undef STEP
#undef ENDW
    { auto rr = __builtin_amdgcn_permlane32_swap(__float_as_uint(l_reg), __float_as_uint(l_reg), false, false); l_reg = __uint_as_float(rr[0]) + __uint_as_float(rr[1]); }
    if (hi == 0) wsf[32 + r32] = l_reg; asm volatile("s_waitcnt lgkmcnt(0)" ::: "memory");
    float rli[16];
#pragma unroll
    for (int r = 0; r < 16; ++r) rli[r] = __builtin_amdgcn_rcpf(wsf[32 + crow(r, hi)]);
    {
        int le = threadIdx.x & 63; asm volatile("" : "+v"(le));
        float* stg = (float*)(shm + LDS_OST) + wid * 1024;
        const h16* Zw = Z + (rowbase + q0 + wid * QBLK) * PQ + h * D;
        h16* Yw = Y + (rowbase + q0 + wid * QBLK) * 1536 + h * D;
#pragma unroll
        for (int d0 = 0; d0 < 2; ++d0) {
#pragma unroll
            for (int r = 0; r < 16; ++r) stg[crow(r, le >> 5) * 32 + (le & 31)] = o[d0][r] * rli[r];
            asm volatile("s_waitcnt lgkmcnt(0)" ::: "memory");
#pragma unroll
            for (int i = 0; i < 2; ++i) { const int row = i * 16 + (le >> 2), ch = le & 3;
                const f32x4 a0 = *(const f32x4*)(stg + row * 32 + ch * 8), a1 = *(const f32x4*)(stg + row * 32 + ch * 8 + 4);
                const h16x8 zv = *(const h16x8*)(Zw + (long)row * PQ + d0 * 32 + ch * 8);
                float ov[8] = {a0[0], a0[1], a0[2], a0[3], a1[0], a1[1], a1[2], a1[3]};
#pragma unroll
                for (int e = 0; e < 8; ++e) { const float zz = (float)zv[e]; ov[e] *= zz * __builtin_amdgcn_rcpf(1.f + __expf(-zz)); }
                u32x4 w; w.x = cvtpk_s(ov[0], ov[1]); w.y = cvtpk_s(ov[2], ov[3]); w.z = cvtpk_s(ov[4], ov[5]); w.w = cvtpk_s(ov[6], ov[7]);
                *(u32x4*)(Yw + (long)row * 1536 + d0 * 32 + ch * 8) = w; }
            asm volatile("s_waitcnt lgkmcnt(0)" ::: "memory");
        }
    }
    asm volatile("s_waitcnt vmcnt(0) lgkmcnt(0)\n\ts_barrier" ::: "memory");
#undef DMA_K
#undef DMA_V
#undef AMAP
#undef ADDB
#undef CMASK
#undef START
#undef RESC
#undef ROT
}
#undef SBAR
#undef WAIT_BAR
#undef MFMA32
#undef LDS8
}

constexpr int NWAVES = 8, NTHREADS = 512;
constexpr int MK_LDS_BYTES = 147456;
enum { PH_NORM = 0, PH_PROJ = 1, PH_PRE = 2, PH_SCAN = 3, PH_MIX = 4, PH_BR = 5, PH_OUT = 6, NPH = 7 };
constexpr int N_STEPS = 1 + NPH * 4 + 1;
struct MArgs { const float* in[11]; float* out; unsigned char* ws; int s_lo, s_hi; };

__device__ __forceinline__ void barrier_lds() { asm volatile("s_waitcnt vmcnt(0) lgkmcnt(0)" ::: "memory"); __syncthreads(); }
__device__ __forceinline__ void fox_cumsum_item(int item, int b0, const float* __restrict__ small, float* __restrict__ cb, char* shm) {
    int tid_ = threadIdx.x; asm volatile("" : "+v"(tid_));
    const int tid = tid_, lane = tid & 63, wid = tid >> 6, bl = item >> 3, h = item & 7;
    const float* sp = small + ((size_t)(b0 + bl) * SEQ + 4 * tid) * 16 + h;
    float v0 = sp[0], v1 = sp[16], v2 = sp[32], v3 = sp[48];
    v1 += v0; v2 += v1; v3 += v2;
    float tot = v3;
#pragma unroll
    for (int o = 1; o < 64; o <<= 1) { const float u = __shfl_up(tot, o); if (lane >= o) tot += u; }
    float* wt = (float*)shm;
    if (lane == 63) wt[wid] = tot;
    __syncthreads();
    float base = tot - v3;
    for (int w = 0; w < wid; ++w) base += wt[w];
    float* o4 = cb + (size_t)((b0 + bl) * 8 + h) * SEQ + 4 * tid;
    *(f32x4*)o4 = (f32x4){-(base + v0) * LOG2E, -(base + v1) * LOG2E, -(base + v2) * LOG2E, -(base + v3) * LOG2E};
    __syncthreads();
}
__device__ __forceinline__ void moba_kmean_item(int item, int b0, const h16* __restrict__ proj, float* __restrict__ kmean, char* shm) {
    int tid_ = threadIdx.x; asm volatile("" : "+v"(tid_));
    const int tid = tid_, h = item & 7, blk = (item >> 3) & 7, bl = item >> 6, r8 = tid >> 3, c8 = tid & 7;
    const h16* kp = proj + ((size_t)bl * SEQ + blk * 256 + r8) * PW + PC_BK + h * 64 + c8 * 8;
    float acc[8];
#pragma unroll
    for (int e = 0; e < 8; ++e) acc[e] = 0.f;
#pragma unroll
    for (int j = 0; j < 4; ++j) { const h16x8 v = *(const h16x8*)(kp + (size_t)(64 * j) * PW);
#pragma unroll
        for (int e = 0; e < 8; ++e) acc[e] += (float)v[e]; }
    float* red = (float*)shm;
#pragma unroll
    for (int e = 0; e < 8; ++e) red[r8 * 65 + c8 * 8 + e] = acc[e];
    __syncthreads();
    if (tid < 64) { float sum = 0.f;
#pragma unroll 8
        for (int r = 0; r < 64; ++r) sum += red[r * 65 + tid];
        kmean[(((size_t)(b0 + bl) * 8 + h) * 8 + blk) * 64 + tid] = sum * (1.f / 256.f); }
    __syncthreads();
}

namespace mlstm {
typedef __attribute__((address_space(3))) char* lds_ptr;
typedef __attribute__((address_space(3))) const char* lds_cptr;
typedef short s16x8 __attribute__((ext_vector_type(8)));
typedef float f32x16 __attribute__((ext_vector_type(16)));
constexpr int PT = 144;
__device__ __forceinline__ int crow(int r, int hi) { return (r & 3) + 8 * (r >> 2) + 4 * hi; }
__device__ __forceinline__ f32x16 mma_nt64(f32x16 acc, lds_cptr A, lds_cptr Bt, int r32, int hi) {
#pragma unroll
    for (int ks = 0; ks < 4; ++ks) {
        const s16x8 a = *(const __attribute__((address_space(3))) s16x8*)(A + r32 * PT + ks * 32 + hi * 16);
        const s16x8 b = *(const __attribute__((address_space(3))) s16x8*)(Bt + r32 * PT + ks * 32 + hi * 16);
        acc = __builtin_amdgcn_mfma_f32_32x32x16_f16(__builtin_bit_cast(h16x8, a), __builtin_bit_cast(h16x8, b), acc, 0, 0, 0);
    }
    return acc;
}
#define LF(off) ((__attribute__((address_space(3))) float*)(L + (off)))
constexpr int X1_KW = 2048, X1_VT = X1_KW + 64 * PT, X1_END = X1_VT + 128 * PT;
__device__ __forceinline__ void x1_item(int item, int b0, const h16* __restrict__ proj, const float* __restrict__ small, const float* __restrict__ convw,
                                        h16* __restrict__ qkc, float* __restrict__ U, float* __restrict__ un, float* __restrict__ amax, float* __restrict__ blast, lds_ptr L) {
    int tid_ = threadIdx.x; asm volatile("" : "+v"(tid_));
    const int tid = tid_, lane = tid & 63, wid = tid >> 6, r32 = lane & 31, hi = lane >> 5;
    const int c = item & 31, hh = (item >> 5) & 3, bl = item >> 7;
    const size_t row0 = (size_t)bl * SEQ + c * 64;
    const int gbh = (b0 + bl) * 4 + hh, lbh = bl * 4 + hh;
    if (wid == 0) {
        const float* sp = small + ((size_t)b0 * SEQ + row0 + lane) * 16;
        const float li = sp[8 + hh], lf = sp[12 + hh];
        float bc = lf;
#pragma unroll
        for (int o = 1; o < 64; o <<= 1) { const float u = __shfl_up(bc, o); if (lane >= o) bc += u; }
        const float as = li - bc;
        float mx = as;
#pragma unroll
        for (int o = 1; o < 64; o <<= 1) mx = fmaxf(mx, __shfl_xor(mx, o));
        LF(0)[lane] = __expf(as - mx);
        if (lane == 63) { amax[gbh * 32 + c] = mx; blast[gbh * 32 + c] = bc; }
    }
    __syncthreads();
    {
        const int r = tid >> 3, ch0 = (tid & 7) * 16, isk = ch0 >= 64;
        const int pcol = isk ? 256 + hh * 64 + (ch0 - 64) : hh * 64 + ch0;
        const int t = c * 64 + r;
        float acc[16];
#pragma unroll
        for (int e = 0; e < 16; ++e) acc[e] = 0.f;
#pragma unroll
        for (int j = 0; j < 4; ++j) {
            const int tt = t - 3 + j;
            if (tt >= 0) {
                const h16* xp = proj + ((size_t)bl * SEQ + tt) * PW + PC_CQK + pcol;
                const h16x8 x0 = *(const h16x8*)xp, x1 = *(const h16x8*)(xp + 8);
                const float* wp = convw + j * 512 + pcol;
#pragma unroll
                for (int e = 0; e < 8; ++e) { acc[e] += wp[e] * (float)x0[e]; acc[8 + e] += wp[8 + e] * (float)x1[e]; }
            }
        }
        const float ws = LF(0)[r];
        h16x8 o0, o1;
#pragma unroll
        for (int e = 0; e < 16; ++e) { float v = acc[e] * __builtin_amdgcn_rcpf(1.f + __expf(-acc[e])); if (isk) v *= 0.125f; acc[e] = v; if (e < 8) o0[e] = (h16)v; else o1[e - 8] = (h16)v; }
        h16* qp = qkc + (row0 + r) * 512 + pcol;
        *(h16x8*)qp = o0; *(h16x8*)(qp + 8) = o1;
        if (isk) {
            const int d0 = ch0 - 64;
#pragma unroll
            for (int e = 0; e < 16; ++e) *(__attribute__((address_space(3))) h16*)(L + X1_KW + (d0 + e) * PT + r * 2) = (h16)(acc[e] * ws);
        }
    }
    {
        const int sidx = tid >> 3, v0 = (tid & 7) * 16;
        const h16* vp = proj + (row0 + sidx) * PW + PC_CV + hh * 128 + v0;
        const h16x8 a0 = *(const h16x8*)vp, a1 = *(const h16x8*)(vp + 8);
#pragma unroll
        for (int e = 0; e < 8; ++e) { *(__attribute__((address_space(3))) h16*)(L + X1_VT + (v0 + e) * PT + sidx * 2) = a0[e]; *(__attribute__((address_space(3))) h16*)(L + X1_VT + (v0 + 8 + e) * PT + sidx * 2) = a1[e]; }
    }
    __syncthreads();
    {
        const int vb = wid >> 1, db = wid & 1;
        f32x16 acc = f32x16{};
        acc = mma_nt64(acc, (lds_cptr)(L + X1_VT + vb * 32 * PT), (lds_cptr)(L + X1_KW + db * 32 * PT), r32, hi);
        float* up = U + ((size_t)lbh * 32 + c) * 8192;
#pragma unroll
        for (int r = 0; r < 16; ++r) up[(vb * 32 + crow(r, hi)) * 64 + db * 32 + r32] = acc[r];
        if (tid < 64) { float sum = 0.f;
#pragma unroll 8
            for (int q = 0; q < 64; ++q) sum += (float)*(__attribute__((address_space(3))) const h16*)(L + X1_KW + tid * PT + q * 2);
            un[((size_t)gbh * 32 + c) * 64 + tid] = sum; }
    }
    __syncthreads();
}
__device__ __forceinline__ void x2_scan(int b0, const float* __restrict__ U, const float* __restrict__ un, const float* __restrict__ amax, const float* __restrict__ blast,
                                        h16* __restrict__ CS, float* __restrict__ ns, float* __restrict__ Ms) {
    int tid_ = threadIdx.x; asm volatile("" : "+v"(tid_));
    const int gt = blockIdx.x * NTHREADS + tid_, GT = gridDim.x * NTHREADS;
    for (int i = gt; i < 32 * 4096; i += GT) {
        const int lbh = i >> 12, e2 = (i & 4095) * 2, gbh = (b0 + (lbh >> 2)) * 4 + (lbh & 3);
        const float* up = U + (size_t)lbh * 32 * 8192 + e2; h16* cp = CS + (size_t)lbh * 32 * 8192 + e2;
        float c0 = 0.f, c1 = 0.f, M = 0.f;
        *(pg8::h16x2*)cp = (pg8::h16x2){(h16)0.f, (h16)0.f};
#pragma unroll 4
        for (int c = 0; c < 31; ++c) {
            const float am = amax[gbh * 32 + c], bls = blast[gbh * 32 + c];
            const float Mn = bls + fmaxf(M, am), fdec = __expf(bls + M - Mn), fin = __expf(bls + am - Mn);
            const pg8::f32x2 u = *(const pg8::f32x2*)(up + (size_t)c * 8192);
            c0 = fdec * c0 + fin * u.x; c1 = fdec * c1 + fin * u.y; M = Mn;
            *(pg8::h16x2*)(cp + (size_t)(c + 1) * 8192) = (pg8::h16x2){(h16)c0, (h16)c1};
        }
    }
    for (int i = gt; i < 32 * 64; i += GT) {
        const int lbh = i >> 6, d = i & 63, gbh = (b0 + (lbh >> 2)) * 4 + (lbh & 3);
        float n = 0.f, M = 0.f;
        ns[((size_t)gbh * 32) * 64 + d] = 0.f; if (d == 0) Ms[gbh * 32] = 0.f;
        for (int c = 0; c < 31; ++c) {
            const float am = amax[gbh * 32 + c], bls = blast[gbh * 32 + c];
            const float Mn = bls + fmaxf(M, am), fdec = __expf(bls + M - Mn), fin = __expf(bls + am - Mn);
            n = fdec * n + fin * un[((size_t)gbh * 32 + c) * 64 + d]; M = Mn;
            ns[((size_t)gbh * 32 + c + 1) * 64 + d] = n; if (d == 0) Ms[gbh * 32 + c + 1] = M;
        }
    }
}
constexpr int X3_Q = 4096, X3_K = X3_Q + 64 * PT, X3_W = X3_K + 64 * PT, X3_C = X3_W + 64 * PT, X3_VT = X3_C + 128 * PT, X3_END = X3_VT + 128 * PT;
constexpr int X3_HS = X3_Q, HSP = 132;
__device__ __forceinline__ void x3_item(int item, int b0, const h16* __restrict__ proj, const float* __restrict__ small, const h16* __restrict__ qkc, const h16* __restrict__ CS,
                                        const float* __restrict__ ns, const float* __restrict__ Ms, const float* __restrict__ headg, h16* __restrict__ y, lds_ptr L) {
    int tid_ = threadIdx.x; asm volatile("" : "+v"(tid_));
    const int tid = tid_, lane = tid & 63, wid = tid >> 6, r32 = lane & 31, hi = lane >> 5;
    const int c = item & 31, hh = (item >> 5) & 3, bl = item >> 7;
    const size_t row0 = (size_t)bl * SEQ + c * 64;
    const int gbh = (b0 + bl) * 4 + hh, lbh = bl * 4 + hh;
    if (wid == 0) {
        const float* sp = small + ((size_t)b0 * SEQ + row0 + lane) * 16;
        const float li = sp[8 + hh], lf = sp[12 + hh], Mc = Ms[gbh * 32 + c];
        float bc = lf;
#pragma unroll
        for (int o = 1; o < 64; o <<= 1) { const float u = __shfl_up(bc, o); if (lane >= o) bc += u; }
        const float as = li - bc;
        float pm = as;
#pragma unroll
        for (int o = 1; o < 64; o <<= 1) { const float u = __shfl_up(pm, o); if (lane >= o) pm = fmaxf(pm, u); }
        const float mx = fmaxf(Mc, pm);
        LF(0)[lane] = as; LF(256)[lane] = mx; LF(512)[lane] = __expf(Mc - mx); LF(768)[lane] = __expf(-(bc + mx));
        LF(1792)[lane] = ns[((size_t)gbh * 32 + c) * 64 + lane];
    }
    {
        const int r = tid >> 3, c8 = (tid & 7) * 8;
        const h16* qp = qkc + (row0 + r) * 512 + hh * 64 + c8;
        *(__attribute__((address_space(3))) h16x8*)(L + X3_Q + r * PT + c8 * 2) = *(const h16x8*)qp;
        *(__attribute__((address_space(3))) h16x8*)(L + X3_K + r * PT + c8 * 2) = *(const h16x8*)(qp + 256);
        const h16* cp = CS + ((size_t)lbh * 32 + c) * 8192;
#pragma unroll
        for (int j = 0; j < 2; ++j) { const int v = r + 64 * j;
            *(__attribute__((address_space(3))) h16x8*)(L + X3_C + v * PT + c8 * 2) = *(const h16x8*)(cp + v * 64 + c8); }
        const int v0 = (tid & 7) * 16;
        const h16* vp = proj + (row0 + r) * PW + PC_CV + hh * 128 + v0;
        const h16x8 a0 = *(const h16x8*)vp, a1 = *(const h16x8*)(vp + 8);
#pragma unroll
        for (int e = 0; e < 8; ++e) { *(__attribute__((address_space(3))) h16*)(L + X3_VT + (v0 + e) * PT + r * 2) = a0[e]; *(__attribute__((address_space(3))) h16*)(L + X3_VT + (v0 + 8 + e) * PT + r * 2) = a1[e]; }
    }
    __syncthreads();
    if (tid < 64) { float sum = 0.f;
#pragma unroll 8
        for (int d = 0; d < 64; ++d) sum += LF(1792)[d] * (float)*(__attribute__((address_space(3))) const h16*)(L + X3_Q + tid * PT + d * 2);
        LF(1536)[tid] = sum; }
    const int tb = wid >> 2, vb = wid & 3;
    f32x16 acc2 = f32x16{};
    acc2 = mma_nt64(acc2, (lds_cptr)(L + X3_Q + tb * 32 * PT), (lds_cptr)(L + X3_C + vb * 32 * PT), r32, hi);
    if (wid < 4) {
        const int sb = wid >> 1, tbs = wid & 1;
        f32x16 st = f32x16{};
        st = mma_nt64(st, (lds_cptr)(L + X3_K + sb * 32 * PT), (lds_cptr)(L + X3_Q + tbs * 32 * PT), r32, hi);
        const int t = tbs * 32 + r32; const float mxt = LF(256)[t];
        float dsum = 0.f;
#pragma unroll
        for (int g = 0; g < 4; ++g) {
            float w4[4];
#pragma unroll
            for (int i = 0; i < 4; ++i) { const int sidx = sb * 32 + 8 * g + 4 * hi + i; const float wv = sidx <= t ? st[4 * g + i] * __expf(LF(0)[sidx] - mxt) : 0.f; w4[i] = wv; dsum += wv; }
            typedef unsigned u32x2 __attribute__((ext_vector_type(2)));
            u32x2 pk; pk.x = pg8::cvt_pk_f16(w4[0], w4[1]); pk.y = pg8::cvt_pk_f16(w4[2], w4[3]);
            *(__attribute__((address_space(3))) u32x2*)(L + X3_W + t * PT + (sb * 32 + 8 * g + 4 * hi) * 2) = pk;
        }
        dsum += __shfl_xor(dsum, 32);
        if (hi == 0) LF(1024)[sb * 64 + t] = dsum;
    }
    __syncthreads();
    f32x16 acc1 = f32x16{};
    acc1 = mma_nt64(acc1, (lds_cptr)(L + X3_W + tb * 32 * PT), (lds_cptr)(L + X3_VT + vb * 32 * PT), r32, hi);
    __syncthreads();
#pragma unroll
    for (int r = 0; r < 16; ++r) {
        const int t = tb * 32 + crow(r, hi);
        const float wi = LF(512)[t], den = LF(1024)[t] + LF(1024)[64 + t] + wi * LF(1536)[t];
        const float hv = (acc1[r] + wi * acc2[r]) / fmaxf(fabsf(den), LF(768)[t]);
        *(__attribute__((address_space(3))) float*)(L + X3_HS + (t * HSP + vb * 32 + r32) * 4) = hv;
    }
    __syncthreads();
    {
        const int t = tid >> 3, v0 = (tid & 7) * 16;
        const h16* op = proj + (row0 + t) * PW + PC_CO + hh * 128 + v0;
        const h16* zp = proj + (row0 + t) * PW + PC_CZ + hh * 128 + v0;
        const h16x8 o0 = *(const h16x8*)op, o1 = *(const h16x8*)(op + 8), z0 = *(const h16x8*)zp, z1 = *(const h16x8*)(zp + 8);
        float hvv[16]; float ss = 0.f;
#pragma unroll
        for (int e = 0; e < 16; ++e) { const float og = (float)(e < 8 ? o0[e] : o1[e - 8]);
            const float hv = *(__attribute__((address_space(3))) const float*)(L + X3_HS + (t * HSP + v0 + e) * 4) * __builtin_amdgcn_rcpf(1.f + __expf(-og)); hvv[e] = hv; ss += hv * hv; }
        ss += __shfl_xor(ss, 1); ss += __shfl_xor(ss, 2); ss += __shfl_xor(ss, 4);
        const float rn = rsqrtf(ss * (1.f / 128.f) + RMS_EPS);
        pg8::u32x4 w0, w1; float ov[16];
#pragma unroll
        for (int e = 0; e < 16; ++e) { const float zz = (float)(e < 8 ? z0[e] : z1[e - 8]); ov[e] = hvv[e] * rn * headg[hh * 128 + v0 + e] * zz * __builtin_amdgcn_rcpf(1.f + __expf(-zz)); }
        w0.x = pg8::cvt_pk_f16(ov[0], ov[1]); w0.y = pg8::cvt_pk_f16(ov[2], ov[3]); w0.z = pg8::cvt_pk_f16(ov[4], ov[5]); w0.w = pg8::cvt_pk_f16(ov[6], ov[7]);
        w1.x = pg8::cvt_pk_f16(ov[8], ov[9]); w1.y = pg8::cvt_pk_f16(ov[10], ov[11]); w1.z = pg8::cvt_pk_f16(ov[12], ov[13]); w1.w = pg8::cvt_pk_f16(ov[14], ov[15]);
        h16* yp = y + (row0 + t) * 1536 + 1024 + hh * 128 + v0;
        *(pg8::u32x4*)yp = w0; *(pg8::u32x4*)(yp + 8) = w1;
    }
    __syncthreads();
}
#undef LF
}

#define LAS __attribute__((address_space(3)))
#define XB_TMO      128
#define XB_XCNT(j)  (256  + 64 * (j))
#define XB_XSUB(j)  (1280 + 64 * (j))
#define XB_XGEN(j)  (2304 + 64 * (j))
#define XB_TOP      3328
#define XB_TOPGEN   3392
#define XCD_BAR_WORDS 3456
#define XB_SPIN_CAP (1u << 18)
__device__ __forceinline__ unsigned xb_ld(unsigned* p)              { return __hip_atomic_load(p, __ATOMIC_RELAXED, __HIP_MEMORY_SCOPE_AGENT); }
__device__ __forceinline__ unsigned xb_add(unsigned* p, unsigned v) { return __hip_atomic_fetch_add(p, v, __ATOMIC_RELAXED, __HIP_MEMORY_SCOPE_AGENT); }
__device__ __forceinline__ unsigned xb_xcc_id() { return (unsigned)__builtin_amdgcn_s_getreg((3 << 11) | 20) & 0xFu; }
#define XB_SPIN(cond, bar) do { unsigned _sp = 0; while (cond) { __builtin_amdgcn_s_sleep(1); \
    if ((++_sp & 255u) == 0u) { if (xb_ld(&(bar)[XB_TMO])) break; if (_sp > XB_SPIN_CAP) { atomicAdd(&(bar)[XB_TMO], 1u); break; } } } } while (0)
struct XcdBarrier { unsigned* bar; unsigned x; volatile LAS unsigned* st; };
__device__ __forceinline__ XcdBarrier xcd_barrier_post(unsigned* bar, volatile LAS unsigned* st) {
    XcdBarrier b; b.bar = bar; b.x = xb_xcc_id(); b.st = st;
    if (threadIdx.x == 0) (void)xb_add(&bar[XB_XCNT(b.x)], 1u);
    return b;
}
__device__ __forceinline__ void xcd_barrier_complete(unsigned* bar, unsigned x, unsigned& nloc, unsigned& nx) {
    const unsigned G = gridDim.x * gridDim.y * gridDim.z;
    unsigned sum, cnt, mine, sp = 0u;
    for (;;) {
        sum = 0u; cnt = 0u; mine = 0u;
#pragma unroll
        for (unsigned j = 0; j < 16; ++j) { const unsigned c = xb_ld(&bar[XB_XCNT(j)]); sum += c; cnt += (c > 0u) ? 1u : 0u; mine = (j == x) ? c : mine; }
        if (sum == G) break;
        __builtin_amdgcn_s_sleep(1);
        if ((++sp & 255u) == 0u) { if (xb_ld(&bar[XB_TMO])) break; if (sp > XB_SPIN_CAP) { atomicAdd(&bar[XB_TMO], 1u); break; } }
    }
    nloc = mine > 0u ? mine : 1u; nx = cnt > 0u ? cnt : 1u;
}
__device__ __forceinline__ void xcd_barrier(const XcdBarrier& b) {
    asm volatile("s_waitcnt vmcnt(0)" ::: "memory");
    __syncthreads();
    if (threadIdx.x == 0) {
        unsigned* bar = b.bar;
        __builtin_amdgcn_s_waitcnt(0);
        unsigned nloc = b.st[0], nx = b.st[1];
        if (nloc == 0u) { xcd_barrier_complete(bar, b.x, nloc, nx); b.st[0] = nloc; b.st[1] = nx; }
        const unsigned old = xb_add(&bar[XB_XSUB(b.x)], 1u);
        const unsigned gen = old / nloc;
        if (old + 1u == (gen + 1u) * nloc) {
            __builtin_amdgcn_fence(__ATOMIC_RELEASE, "agent");
            asm volatile("s_waitcnt vmcnt(0)" ::: "memory");
            const unsigned og = xb_add(&bar[XB_TOP], 1u);
            const unsigned tg = og / nx;
            if (og + 1u == (tg + 1u) * nx) xb_add(&bar[XB_TOPGEN], 1u);
            else XB_SPIN(xb_ld(&bar[XB_TOPGEN]) == tg, bar);
            __builtin_amdgcn_fence(__ATOMIC_ACQUIRE, "agent");
            xb_add(&bar[XB_XGEN(b.x)], 1u);
            asm volatile("s_waitcnt vmcnt(0)" ::: "memory");
        } else {
            XB_SPIN(xb_ld(&bar[XB_XGEN(b.x)]) == gen, bar);
            __builtin_amdgcn_fence(__ATOMIC_ACQUIRE, "agent");
            asm volatile("s_waitcnt vmcnt(0)" ::: "memory");
        }
    }
    __syncthreads();
}
constexpr int LDSCTL_OFF = 131072, MISC_OFF = LDSCTL_OFF + 320;
constexpr int CW_BAR = 4096;
constexpr size_t CTL_ZERO_BYTES = 65536;

__device__ __forceinline__ void transpose_item(const float* __restrict__ W, int ldsrc, int K, h16* __restrict__ WT, int k0, int n0, int src_col0, float scale, PG8_LAS float* scr, int lane) {
#pragma unroll 8
    for (int i = 0; i < 32; ++i) { const int kk = 2 * i + (lane >> 5); scr[kk * 33 + (lane & 31)] = W[(size_t)(k0 + kk) * ldsrc + src_col0 + (lane & 31)]; }
    asm volatile("s_waitcnt lgkmcnt(0)" ::: "memory");
    const int c = lane & 7;
#pragma unroll
    for (int j = 0; j < 4; ++j) { const int n = (lane >> 3) + 8 * j; const PG8_LAS float* sp = scr + (8 * c) * 33 + n;
        pg8::u32x4 o; o.x = pg8::cvt_pk_f16(sp[0 * 33] * scale, sp[1 * 33] * scale); o.y = pg8::cvt_pk_f16(sp[2 * 33] * scale, sp[3 * 33] * scale);
        o.z = pg8::cvt_pk_f16(sp[4 * 33] * scale, sp[5 * 33] * scale); o.w = pg8::cvt_pk_f16(sp[6 * 33] * scale, sp[7 * 33] * scale);
        *(pg8::u32x4*)(WT + (size_t)(n0 + n) * K + k0 + 8 * c) = o; }
    asm volatile("s_waitcnt lgkmcnt(0)" ::: "memory");
}
__device__ __forceinline__ void prologue_phase(const MArgs& a, PG8_LAS unsigned char* L) {
    int tid_ = threadIdx.x; asm volatile("" : "+v"(tid_));
    const int lane = tid_ & 63, wave = tid_ >> 6;
    PG8_LAS float* scr = (PG8_LAS float*)(L + wave * 16384);
    const int gw = blockIdx.x * NWAVES + wave, NGW = gridDim.x * NWAVES;
    constexpr int I_IN = (DM / 64) * (PW / 32), I_BR = (512 / 64) * (1024 / 32), I_OUT = (DM / 64) * (DM / 32), I_L = I_IN + 3 * I_BR + I_OUT;
    unsigned char* ws = a.ws;
    for (int it = gw; it < DEPTH * I_L; it += NGW) {
        const int l = it / I_L; int r = it - l * I_L;
        if (r < I_IN) { const int nblk = PW / 32, kb = r / nblk, nb = r % nblk, n0 = nb * 32;
            const float sc = ((n0 >= PC_AQ && n0 < PC_AQ + 512) || (n0 >= PC_BQ && n0 < PC_BQ + 512)) ? C2 : 1.f;
            transpose_item(a.in[2] + (size_t)l * DM * INW, INW, DM, (h16*)(ws + WS_WIN) + (size_t)l * PW * DM, kb * 64, n0, orig_col(n0), sc, scr, lane); continue; }
        r -= I_IN;
        if (r < 3 * I_BR) { const int n3 = r / I_BR, q = r % I_BR, nblk = 1024 / 32, kb = q / nblk, nb = q % nblk;
            transpose_item(a.in[8] + ((size_t)l * 3 + n3) * 512 * 1024, 1024, 512, (h16*)(ws + WS_WBR) + ((size_t)l * 3 + n3) * 1024 * 512, kb * 64, nb * 32, nb * 32, 1.f, scr, lane); continue; }
        r -= 3 * I_BR;
        { const int nblk = DM / 32, kb = r / nblk, nb = r % nblk;
          transpose_item(a.in[9] + (size_t)l * DM * DM, DM, DM, (h16*)(ws + WS_WOUT) + (size_t)l * DM * DM, kb * 64, nb * 32, nb * 32, 1.f, scr, lane); }
    }
    float* wsmall = (float*)(ws + WS_WSMALL);
    for (int i = blockIdx.x * NTHREADS + tid_; i < DEPTH * 16 * DM; i += gridDim.x * NTHREADS) {
        const int l = i / (16 * DM), c = (i >> 10) & 15, k = i & 1023;
        wsmall[i] = a.in[2][(size_t)l * DM * INW + (size_t)k * INW + small_col(c)];
    }
}
__device__ __forceinline__ void norm_phase(const float* __restrict__ x, const float* __restrict__ g, const float* __restrict__ wsmall, const float* __restrict__ fox_bf,
                                           const float* __restrict__ ml_bi, const float* __restrict__ ml_bf, h16* __restrict__ hn, float* __restrict__ small, int row0) {
    int tid_ = threadIdx.x; asm volatile("" : "+v"(tid_));
    const int lane = tid_ & 63, gw = blockIdx.x * NWAVES + (tid_ >> 6), NGW = gridDim.x * NWAVES;
    for (int r4 = gw; r4 < TH / 4; r4 += NGW) {
        f32x4 v[4][4];
#pragma unroll
        for (int q = 0; q < 4; ++q) {
            const f32x4* xr = (const f32x4*)(x + (size_t)(row0 + 4 * r4 + q) * DM) + lane;
            float ssq = 0.f;
#pragma unroll
            for (int j = 0; j < 4; ++j) { v[q][j] = xr[64 * j]; ssq += v[q][j].x * v[q][j].x + v[q][j].y * v[q][j].y + v[q][j].z * v[q][j].z + v[q][j].w * v[q][j].w; }
            const float rstd = rsqrtf(wave_sum(ssq) * (1.f / DM) + RMS_EPS);
#pragma unroll
            for (int j = 0; j < 4; ++j) {
                const f32x4 gg = ((const f32x4*)g)[lane + 64 * j];
                v[q][j].x *= rstd * gg.x; v[q][j].y *= rstd * gg.y; v[q][j].z *= rstd * gg.z; v[q][j].w *= rstd * gg.w;
                pg8::u32x4 dummy; (void)dummy;
                typedef unsigned u32x2 __attribute__((ext_vector_type(2)));
                u32x2 o; o.x = pg8::cvt_pk_f16(v[q][j].x, v[q][j].y); o.y = pg8::cvt_pk_f16(v[q][j].z, v[q][j].w);
                *((u32x2*)(hn + (size_t)(4 * r4 + q) * DM) + lane + 64 * j) = o;
            }
        }
        float mine[4] = {0.f, 0.f, 0.f, 0.f};
#pragma unroll 1
        for (int c = 0; c < 16; ++c) {
            const f32x4* wr = (const f32x4*)(wsmall + c * DM) + lane;
            float acc[4] = {0.f, 0.f, 0.f, 0.f};
#pragma unroll
            for (int j = 0; j < 4; ++j) { const f32x4 w = wr[64 * j];
#pragma unroll
                for (int q = 0; q < 4; ++q) acc[q] += v[q][j].x * w.x + v[q][j].y * w.y + v[q][j].z * w.z + v[q][j].w * w.w; }
#pragma unroll
            for (int q = 0; q < 4; ++q) { const float t = wave_sum(acc[q]); if (lane == c) mine[q] = t; }
        }
        if (lane < 16) {
            const float bias = lane < 8 ? fox_bf[lane] : lane < 12 ? ml_bi[lane - 8] : ml_bf[lane - 12];
#pragma unroll
            for (int q = 0; q < 4; ++q) { const float pre = mine[q] + bias; small[(size_t)(row0 + 4 * r4 + q) * 16 + lane] = (lane >= 8 && lane < 12) ? pre : log_sigmoidf_(pre); }
        }
    }
}
__device__ __forceinline__ void final_norm_phase(float* __restrict__ x, const float* __restrict__ g) {
    int tid_ = threadIdx.x; asm volatile("" : "+v"(tid_));
    const int lane = tid_ & 63, gw = blockIdx.x * NWAVES + (tid_ >> 6), NGW = gridDim.x * NWAVES;
    for (int row = gw; row < TT; row += NGW) {
        f32x4* xr = (f32x4*)(x + (size_t)row * DM) + lane;
        f32x4 v[4]; float ssq = 0.f;
#pragma unroll
        for (int j = 0; j < 4; ++j) { v[j] = xr[64 * j]; ssq += v[j].x * v[j].x + v[j].y * v[j].y + v[j].z * v[j].z + v[j].w * v[j].w; }
        const float rstd = rsqrtf(wave_sum(ssq) * (1.f / DM) + RMS_EPS);
#pragma unroll
        for (int j = 0; j < 4; ++j) { const f32x4 gg = ((const f32x4*)g)[lane + 64 * j];
            xr[64 * j] = (f32x4){v[j].x * rstd * gg.x, v[j].y * rstd * gg.y, v[j].z * rstd * gg.z, v[j].w * rstd * gg.w}; }
    }
}

__global__ void __launch_bounds__(NTHREADS, 2) mega(MArgs a) {
    extern __shared__ __attribute__((aligned(16))) unsigned char lds[];
    PG8_LAS unsigned char* L = (PG8_LAS unsigned char*)lds;
    unsigned char* ws = a.ws;
    for (int u = threadIdx.x; u < (MK_LDS_BYTES - LDSCTL_OFF) / 4; u += NTHREADS) ((LAS unsigned*)(L + LDSCTL_OFF))[u] = 0u;
    __syncthreads();
    XcdBarrier bar = xcd_barrier_post((unsigned*)(ws + WS_CTL) + CW_BAR, (volatile LAS unsigned*)(L + MISC_OFF) + 8);
    for (int s = a.s_lo; s < a.s_hi; ++s) {
        if (s == a.s_lo + 1) { __builtin_amdgcn_fence(__ATOMIC_RELEASE, "agent"); cg::this_grid().sync(); __builtin_amdgcn_fence(__ATOMIC_ACQUIRE, "agent"); }
        else if (s > a.s_lo) xcd_barrier(bar);
        if (s == 0) { prologue_phase(a, L); barrier_lds(); continue; }
        if (s == N_STEPS - 1) { final_norm_phase(a.out, a.in[10]); continue; }
        const int li = (s - 1) / NPH, ph = (s - 1) % NPH, layer = li >> 1, hf = li & 1;
        const int row0 = hf * TH;
        if (ph == PH_NORM) {
            norm_phase(layer == 0 ? a.in[0] : a.out, a.in[1] + layer * DM, (const float*)(ws + WS_WSMALL) + layer * 16 * DM, a.in[3] + layer * 8, a.in[5] + layer * 4, a.in[6] + layer * 4,
                       (h16*)(ws + WS_HN), (float*)(ws + WS_SMALL), row0);
        } else if (ph == PH_PRE) {
            const int b0 = hf * HB;
            for (int it = blockIdx.x; it < HB * 8; it += gridDim.x) fox_cumsum_item(it, b0, (const float*)(ws + WS_SMALL), (float*)(ws + WS_CB), (char*)lds);
            for (int it = blockIdx.x; it < HB * 64; it += gridDim.x) moba_kmean_item(it, b0, (const h16*)(ws + WS_PROJ), (float*)(ws + WS_KMEAN), (char*)lds);
            for (int it = blockIdx.x; it < HB * 128; it += gridDim.x)
                mlstm::x1_item(it, b0, (const h16*)(ws + WS_PROJ), (const float*)(ws + WS_SMALL), a.in[4] + (size_t)layer * 4 * 512, (h16*)(ws + WS_QKC), (float*)(ws + WS_U),
                               (float*)(ws + WS_MUN), (float*)(ws + WS_MAMAX), (float*)(ws + WS_MBLAST), (mlstm::lds_ptr)L);
        } else if (ph == PH_SCAN) {
            mlstm::x2_scan(hf * HB, (const float*)(ws + WS_U), (const float*)(ws + WS_MUN), (const float*)(ws + WS_MAMAX), (const float*)(ws + WS_MBLAST),
                           (h16*)(ws + WS_CS), (float*)(ws + WS_MNS), (float*)(ws + WS_MMS));
        } else if (ph == PH_MIX) {
            const int b0 = hf * HB, G = gridDim.x, bx = blockIdx.x;
            const int vcu = (G % 8 == 0) ? (bx % 8) * (G / 8) + bx / 8 : bx;
            const h16* proj = (const h16*)(ws + WS_PROJ); h16* y = (h16*)(ws + WS_Y);
            for (int v = vcu; v < 256; v += G) {
                const int bh = v >> 2, sidx = v & 3, bl = bh >> 3, h = bh & 7;
                const float* cbp = (const float*)(ws + WS_CB) + (size_t)((b0 + bl) * 8 + h) * SEQ;
                const float* kmp = (const float*)(ws + WS_KMEAN) + (size_t)((b0 + bl) * 8 + h) * 512;
                const float slope2 = exp2f(-(float)(h + 1)) * LOG2E;
#pragma unroll 1
                for (int i = 0; i < 4; ++i) {
                    const int qb = (i < 2) ? 7 - sidx : sidx;
                    if ((i & 1) == 0) attn_body::attn_unit<false, 8>(bl, h, qb, proj + PC_AQ, proj + PC_AK, proj + PC_AV, proj + PC_AZ, y, cbp, 0.f, kmp, (char*)lds);
                    else attn_body::attn_unit<true, 8>(bl, h, qb, proj + PC_BQ, proj + PC_BK, proj + PC_BV, proj + PC_BZ, y + 512, cbp, slope2, kmp, (char*)lds);
                }
            }
            for (int it = blockIdx.x; it < HB * 128; it += gridDim.x)
                mlstm::x3_item(it, b0, proj, (const float*)(ws + WS_SMALL), (const h16*)(ws + WS_QKC), (const h16*)(ws + WS_CS), (const float*)(ws + WS_MNS), (const float*)(ws + WS_MMS),
                               a.in[7] + (size_t)layer * 512, y, (mlstm::lds_ptr)L);
        } else if (ph == PH_PROJ) {
            pg8::Gemm g{(const h16*)(ws + WS_HN), (const h16*)(ws + WS_WIN) + (size_t)layer * PW * DM, DM, DM, DM, 0, 0};
            pg8::StaticOrder S; S.init(TH, PW, gridDim.x, blockIdx.x);
            pg8::EpiF16 E{(h16*)(ws + WS_PROJ), PW};
            pg8::gemm_phase(L, g, S, E);
        } else if (ph == PH_BR) {
            pg8::Gemm g{(const h16*)(ws + WS_Y), (const h16*)(ws + WS_WBR) + (size_t)layer * 3 * 1024 * 512, 1536, 512, 512, 512, 1024 * 512};
            pg8::BranchOrder S; S.init(TH, DM, gridDim.x, blockIdx.x, 3);
            pg8::EpiGate E{(h16*)(ws + WS_MRG), (const h16*)(ws + WS_PROJ) + PC_G, PW};
            pg8::gemm_phase(L, g, S, E);
        } else if (ph == PH_OUT) {
            pg8::Gemm g{(const h16*)(ws + WS_MRG), (const h16*)(ws + WS_WOUT) + (size_t)layer * DM * DM, DM, DM, DM, 0, 0};
            pg8::StaticOrder S; S.init(TH, DM, gridDim.x, blockIdx.x);
            const float* xsrc = layer == 0 ? a.in[0] : a.out;
            pg8::EpiRes E{xsrc + (size_t)row0 * DM, a.out + (size_t)row0 * DM, DM};
            pg8::gemm_phase(L, g, S, E);
        }
    }
}

extern "C" void kernel_launch(void* const* d_in, const int* in_sizes, int n_in, void* d_out, int out_size, void* d_ws, size_t ws_size, hipStream_t stream) {
    if (n_in != 11 || in_sizes[0] != TT * DM || out_size != TT * DM || ws_size < WS_END) {
        fprintf(stderr, "kernel_launch: unexpected shapes / workspace (n_in %d, in0 %d, out %d, ws %zu < %zu)\n", n_in, n_in > 0 ? in_sizes[0] : -1, out_size, ws_size, (size_t)WS_END);
        return;
    }
    static int grid = 0;
    if (grid == 0) {
        int dev = 0, cus = 0, per_cu = 0;
        hipGetDevice(&dev);
        hipDeviceGetAttribute(&cus, hipDeviceAttributeMultiprocessorCount, dev);
        if (hipFuncSetAttribute((const void*)mega, hipFuncAttributeMaxDynamicSharedMemorySize, MK_LDS_BYTES) != hipSuccess) fprintf(stderr, "kernel_launch: hipFuncSetAttribute failed\n");
        if (hipOccupancyMaxActiveBlocksPerMultiprocessor(&per_cu, (const void*)mega, NTHREADS, MK_LDS_BYTES) != hipSuccess || per_cu < 1) { fprintf(stderr, "kernel_launch: occupancy query says %d blocks per CU\n", per_cu); per_cu = 1; }
        (void)hipGetLastError();
        grid = cus;
        if (grid != 256) fprintf(stderr, "kernel_launch: note: %d CUs (tuned for 256)\n", grid);
    }
    MArgs ma{};
    for (int i = 0; i < 11; ++i) ma.in[i] = (const float*)d_in[i];
    ma.out = (float*)d_out; ma.ws = (unsigned char*)d_ws; ma.s_lo = 0; ma.s_hi = N_STEPS;
    if (hipMemsetAsync((char*)d_ws + WS_CTL, 0, CTL_ZERO_BYTES, stream) != hipSuccess) { fprintf(stderr, "kernel_launch: hipMemsetAsync of the control words failed\n"); return; }
    void* args[] = {&ma};
    hipError_t e = hipLaunchCooperativeKernel((const void*)mega, dim3(grid), dim3(NTHREADS), args, MK_LDS_BYTES, stream);
    if (e != hipSuccess) fprintf(stderr, "kernel_launch: cooperative launch failed: %s (grid %d)\n", hipGetErrorString(e), grid);
}
```

```cpp
#include <hip/hip_runtime.h>
#include <hip/hip_cooperative_groups.h>
#include <cstdio>
#include <cstdint>

namespace cg = cooperative_groups;
typedef _Float16 h16;
typedef _Float16 h16x4 __attribute__((ext_vector_type(4)));
typedef _Float16 h16x8 __attribute__((ext_vector_type(8)));
typedef float f32x4 __attribute__((ext_vector_type(4)));

constexpr int DM = 1024, BATCH = 16, SEQ = 2048, DEPTH = 2;
constexpr int TT = BATCH * SEQ;
constexpr int HB = 8;
constexpr int TH = HB * SEQ;
constexpr int INW = 9232;
constexpr int PW = 9216;
constexpr float RMS_EPS = 1e-6f;
constexpr float LOG2E = 1.4426950408889634f;
constexpr float C2 = 0.125f * LOG2E;
constexpr int PC_AQ = 0, PC_AK = 512, PC_AV = 1024, PC_AZ = 1536, PC_BQ = 2048, PC_BK = 2560, PC_BV = 3072, PC_BZ = 3584,
              PC_CQK = 4096, PC_CV = 4608, PC_CO = 5120, PC_CZ = 5632, PC_G = 6144;
__host__ __device__ inline int orig_col(int j) { return j < 2048 ? j : (j < 6144 ? j + 8 : j + 16); }
__host__ __device__ inline int small_col(int c) { return c < 8 ? 2048 + c : 6152 + (c - 8); }

constexpr size_t MiB = 1u << 20;
constexpr size_t WS_CTL = 0;
constexpr size_t WS_WSMALL = 512 * 1024;
constexpr size_t WS_SMALL = 1 * MiB;
constexpr size_t WS_CB = 3 * MiB;
constexpr size_t WS_KMEAN = 4 * MiB;
constexpr size_t WS_MSC = 5 * MiB;
constexpr size_t WS_MUN = WS_MSC, WS_MNS = WS_MSC + 512 * 1024;
constexpr size_t WS_MAMAX = 4 * MiB + 512 * 1024, WS_MBLAST = WS_MAMAX + 8192, WS_MMS = WS_MAMAX + 16384;
constexpr size_t WS_WBR = 6 * MiB;
constexpr size_t WS_WOUT = 12 * MiB;
constexpr size_t WS_WIN = 16 * MiB;
constexpr size_t WS_HN = 52 * MiB;
constexpr size_t WS_Y = 84 * MiB;
constexpr size_t WS_MRG = WS_HN;
constexpr size_t WS_U = 132 * MiB;
constexpr size_t WS_CS = 164 * MiB;
constexpr size_t WS_QKC = 180 * MiB;
constexpr size_t WS_PROJ = 196 * MiB;
constexpr size_t WS_END = 484 * MiB;

__device__ __forceinline__ float sigmoidf_(float x) { return 1.f / (1.f + __expf(-x)); }
__device__ __forceinline__ float siluf_(float x) { return x / (1.f + __expf(-x)); }
__device__ __forceinline__ float log_sigmoidf_(float x) {
    const float e = __expf(-fabsf(x)); const float l = e < 0.01f ? e * (1.f - 0.5f * e + 0.33333334f * e * e) : __logf(1.f + e); return fminf(x, 0.f) - l; }
template <int M> __device__ __forceinline__ float swz_xor(float v) { return __int_as_float(__builtin_amdgcn_ds_swizzle(__float_as_int(v), (M << 10) | 0x1f)); }
__device__ __forceinline__ float half_sum(float v) { auto rr = __builtin_amdgcn_permlane32_swap(__float_as_uint(v), __float_as_uint(v), false, false); return __uint_as_float(rr[0]) + __uint_as_float(rr[1]); }
__device__ __forceinline__ float shfl_idx(float x, int srclane) { return __int_as_float(__builtin_amdgcn_ds_bpermute(srclane << 2, __float_as_int(x))); }
__device__ __forceinline__ float wave_sum(float v) {
    v += swz_xor<1>(v); v += swz_xor<2>(v); v += swz_xor<4>(v); v += swz_xor<8>(v); v += swz_xor<16>(v);
    return half_sum(v);
}

__global__ void nv_convert_t(const float* __restrict__ src, int ldsrc, int K, h16* __restrict__ dst, int Nd, int mode) {
    __shared__ float tile[32][33];
    const int tx = threadIdx.x & 31, ty = threadIdx.x >> 5;
    const int j0 = blockIdx.x * 32, k0 = blockIdx.y * 32;
#pragma unroll
    for (int i = 0; i < 4; ++i) {
        const int k = k0 + ty + 8 * i, j = j0 + tx;
        const int sc = mode == 1 ? orig_col(j) : j;
        tile[ty + 8 * i][tx] = src[(size_t)k * ldsrc + sc];
    }
    __syncthreads();
#pragma unroll
    for (int i = 0; i < 4; ++i) {
        const int j = j0 + ty + 8 * i, k = k0 + tx;
        float v = tile[tx][ty + 8 * i];
        if (mode == 1 && ((j >= PC_AQ && j < PC_AQ + 512) || (j >= PC_BQ && j < PC_BQ + 512))) v *= C2;
        dst[(size_t)j * K + k] = (h16)v;
    }
}

__global__ void nv_small_w(const float* __restrict__ w_in, float* __restrict__ wsmall) {
    const int i = blockIdx.x * blockDim.x + threadIdx.x;
    if (i >= 16 * DM) return;
    const int c = i >> 10, k = i & 1023;
    wsmall[i] = w_in[(size_t)k * INW + small_col(c)];
}
__global__ void __launch_bounds__(256) nv_rmsnorm_small(const float* __restrict__ x, const float* __restrict__ g, const float* __restrict__ wsmall  ,
                                 const float* __restrict__ fox_bf, const float* __restrict__ ml_bi, const float* __restrict__ ml_bf,
                                 h16* __restrict__ hn, float* __restrict__ small, int row0, int nrows) {
    const int lane = threadIdx.x & 63, wv = (blockIdx.x * blockDim.x + threadIdx.x) >> 6, nw = (gridDim.x * blockDim.x) >> 6;
    for (int r = wv; r < nrows; r += nw) {
        const int row = row0 + r;
        const f32x4* xr = (const f32x4*)(x + (size_t)row * DM) + lane;
        f32x4 v[4]; float s = 0.f;
#pragma unroll
        for (int j = 0; j < 4; ++j) { v[j] = xr[64 * j]; s += v[j].x * v[j].x + v[j].y * v[j].y + v[j].z * v[j].z + v[j].w * v[j].w; }
        const float rstd = rsqrtf(wave_sum(s) * (1.f / DM) + RMS_EPS);
#pragma unroll
        for (int j = 0; j < 4; ++j) {
            const f32x4 gg = ((const f32x4*)g)[lane + 64 * j];
            v[j].x *= rstd * gg.x; v[j].y *= rstd * gg.y; v[j].z *= rstd * gg.z; v[j].w *= rstd * gg.w;
            h16x4 o = {(h16)v[j].x, (h16)v[j].y, (h16)v[j].z, (h16)v[j].w};
            *((h16x4*)(hn + (size_t)r * DM) + lane + 64 * j) = o;
        }
        float mine = 0.f;
#pragma unroll 1
        for (int c = 0; c < 16; ++c) {
            const f32x4* wr = (const f32x4*)(wsmall + c * DM) + lane;
            float a = 0.f;
#pragma unroll
            for (int j = 0; j < 4; ++j) { const f32x4 w = wr[64 * j]; a += v[j].x * w.x + v[j].y * w.y + v[j].z * w.z + v[j].w * w.w; }
            a = wave_sum(a);
            if (lane == c) mine = a;
        }
        if (lane < 16) {
            float o;
            if (lane < 8) o = log_sigmoidf_(mine + fox_bf[lane]);
            else if (lane < 12) o = mine + ml_bi[lane - 8];
            else o = log_sigmoidf_(mine + ml_bf[lane - 12]);
            small[(size_t)row * 16 + lane] = o;
        }
    }
}

struct GemmArgs {
    const h16* A; int lda; const h16* Bt; int ldb; int K;
    h16* C; int ldc;
    const h16* gates; int ldg;
    const float* xin; float* xout;
};
template <int EPI>
__global__ void __launch_bounds__(256) nv_gemm(GemmArgs g) {
    __shared__ float As[16][68], Bs[16][68];
    const int tid = threadIdx.x, tx = tid & 15, ty = tid >> 4;
    const int m0 = blockIdx.y * 64, n0 = blockIdx.x * 64;
    float res[4][4];
#pragma unroll
    for (int i = 0; i < 4; ++i)
#pragma unroll
        for (int j = 0; j < 4; ++j) res[i][j] = 0.f;
    const int NB = EPI == 1 ? 3 : 1;
    for (int nb = 0; nb < NB; ++nb) {
        float acc[4][4];
#pragma unroll
        for (int i = 0; i < 4; ++i)
#pragma unroll
            for (int j = 0; j < 4; ++j) acc[i][j] = 0.f;
        const h16* A = g.A + (EPI == 1 ? nb * 512 : 0);
        const h16* Bt = g.Bt + (EPI == 1 ? (size_t)nb * 1024 * 512 : 0);
        const int lr = tid >> 2, lk = (tid & 3) * 4;
        for (int k0 = 0; k0 < g.K; k0 += 16) {
            const h16x4 av = *(const h16x4*)(A + (size_t)(m0 + lr) * g.lda + k0 + lk);
            const h16x4 bv = *(const h16x4*)(Bt + (size_t)(n0 + lr) * g.ldb + k0 + lk);
            __syncthreads();
#pragma unroll
            for (int e = 0; e < 4; ++e) { As[lk + e][lr] = (float)av[e]; Bs[lk + e][lr] = (float)bv[e]; }
            __syncthreads();
#pragma unroll
            for (int kk = 0; kk < 16; ++kk) {
                float a[4], b[4];
#pragma unroll
                for (int i = 0; i < 4; ++i) { a[i] = As[kk][ty * 4 + i]; b[i] = Bs[kk][tx * 4 + i]; }
#pragma unroll
                for (int i = 0; i < 4; ++i)
#pragma unroll
                    for (int j = 0; j < 4; ++j) acc[i][j] += a[i] * b[j];
            }
        }
#pragma unroll
        for (int i = 0; i < 4; ++i)
#pragma unroll
            for (int j = 0; j < 4; ++j) {
                if (EPI == 1) {
                    const int m = m0 + ty * 4 + i, n = n0 + tx * 4 + j;
                    const float gt = (float)g.gates[(size_t)m * g.ldg + nb * 1024 + n];
                    res[i][j] += sigmoidf_(gt) * acc[i][j];
                } else res[i][j] = acc[i][j];
            }
    }
#pragma unroll
    for (int i = 0; i < 4; ++i)
#pragma unroll
        for (int j = 0; j < 4; ++j) {
            const int m = m0 + ty * 4 + i, n = n0 + tx * 4 + j;
            if (EPI == 2) g.xout[(size_t)m * DM + n] = g.xin[(size_t)m * DM + n] + res[i][j];
            else g.C[(size_t)m * g.ldc + n] = (h16)res[i][j];
        }
}

__global__ void nv_fox_cumsum(const float* __restrict__ small, float* __restrict__ cb, int b0) {
    const int i = blockIdx.x * blockDim.x + threadIdx.x;
    if (i >= HB * 8) return;
    const int bl = i >> 3, h = i & 7;
    const float* s = small + (size_t)(b0 + bl) * SEQ * 16 + h;
    float* o = cb + (size_t)((b0 + bl) * 8 + h) * SEQ;
    float c = 0.f;
    for (int t = 0; t < SEQ; ++t) { c += s[(size_t)t * 16]; o[t] = -c * LOG2E; }
}
__global__ void nv_moba_kmean(const h16* __restrict__ proj, float* __restrict__ kmean, int b0) {
    const int i = blockIdx.x * blockDim.x + threadIdx.x;
    if (i >= HB * 8 * 512) return;
    const int col = i & 511, blk = (i >> 9) & 7, bl = i >> 12;
    const h16* p = proj + (size_t)(bl * SEQ + blk * 256) * PW + PC_BK + col;
    float s = 0.f;
    for (int t = 0; t < 256; ++t) s += (float)p[(size_t)t * PW];
    const int h = col >> 6, d = col & 63;
    kmean[(((size_t)(b0 + bl) * 8 + h) * 8 + blk) * 64 + d] = s * (1.f / 256.f);
}

__global__ void __launch_bounds__(256) nv_fox_attn(const h16* __restrict__ proj, const float* __restrict__ cb, h16* __restrict__ y, int b0) {
    const int bh = blockIdx.y, bl = bh >> 3, h = bh & 7;
    const int t = blockIdx.x * 256 + threadIdx.x;
    const size_t rowb = (size_t)bl * SEQ;
    float q[64], o[64];
    {
        const h16* qp = proj + (rowb + t) * PW + PC_AQ + h * 64;
#pragma unroll
        for (int d = 0; d < 64; ++d) { q[d] = (float)qp[d]; o[d] = 0.f; }
    }
    const float* cbh = cb + (size_t)((b0 + bl) * 8 + h) * SEQ;
    float m = -INFINITY, l = 0.f;
    const int send = blockIdx.x * 256 + 255;
    for (int s = 0; s <= send; ++s) {
        const h16* kp = proj + (rowb + s) * PW + PC_AK + h * 64;
        const h16* vp = proj + (rowb + s) * PW + PC_AV + h * 64;
        float sd = 0.f;
#pragma unroll
        for (int d = 0; d < 64; ++d) sd += q[d] * (float)kp[d];
        sd += cbh[s];
        if (s <= t) {
            const float mn = fmaxf(m, sd), al = exp2f(m - mn), p = exp2f(sd - mn);
            l = l * al + p;
#pragma unroll
            for (int d = 0; d < 64; ++d) o[d] = o[d] * al + p * (float)vp[d];
            m = mn;
        }
    }
    const float il = 1.f / l;
    const h16* zp = proj + (rowb + t) * PW + PC_AZ + h * 64;
    h16* yp = y + (rowb + t) * 1536 + h * 64;
#pragma unroll
    for (int d = 0; d < 64; ++d) yp[d] = (h16)(o[d] * il * siluf_((float)zp[d]));
}

__global__ void __launch_bounds__(256) nv_moba_attn(const h16* __restrict__ proj, const float* __restrict__ kmean, h16* __restrict__ y, int b0) {
    const int bh = blockIdx.y, bl = bh >> 3, h = bh & 7;
    const int own = blockIdx.x;
    const int t = own * 256 + threadIdx.x;
    const size_t rowb = (size_t)bl * SEQ;
    float q[64], o[64];
    {
        const h16* qp = proj + (rowb + t) * PW + PC_BQ + h * 64;
#pragma unroll
        for (int d = 0; d < 64; ++d) { q[d] = (float)qp[d]; o[d] = 0.f; }
    }
    unsigned selmask = 0;
    if (own <= 3) selmask = (1u << own) - 1u;
    else {
        float gate[8];
        const float* km = kmean + ((size_t)(b0 + bl) * 8 + h) * 8 * 64;
#pragma unroll
        for (int n = 0; n < 8; ++n) {
            float sd = 0.f;
#pragma unroll
            for (int d = 0; d < 64; ++d) sd += q[d] * km[n * 64 + d];
            gate[n] = n < own ? sd : -INFINITY;
        }
        for (int r = 0; r < 3; ++r) {
            float best = -INFINITY; int bi = -1;
#pragma unroll
            for (int n = 0; n < 8; ++n) { const bool free_ = !((selmask >> n) & 1u); if (free_ && n < own && gate[n] > best) { best = gate[n]; bi = n; } }
            if (bi >= 0) selmask |= 1u << bi;
        }
    }
    const float slope2 = exp2f(-(float)(h + 1)) * LOG2E;
    float m = -INFINITY, l = 0.f;
    for (int n = 0; n <= own; ++n) {
        const bool isown = n == own;
        const bool sel = isown || ((selmask >> n) & 1u);
        for (int ss = 0; ss < 256; ++ss) {
            const int s = n * 256 + ss;
            const h16* kp = proj + (rowb + s) * PW + PC_BK + h * 64;
            const h16* vp = proj + (rowb + s) * PW + PC_BV + h * 64;
            if (sel && s <= t) {
                float sd = 0.f;
#pragma unroll
                for (int d = 0; d < 64; ++d) sd += q[d] * (float)kp[d];
                sd -= slope2 * (float)(t - s);
                const float mn = fmaxf(m, sd), al = exp2f(m - mn), p = exp2f(sd - mn);
                l = l * al + p;
#pragma unroll
                for (int d = 0; d < 64; ++d) o[d] = o[d] * al + p * (float)vp[d];
                m = mn;
            }
        }
    }
    const float il = 1.f / l;
    const h16* zp = proj + (rowb + t) * PW + PC_BZ + h * 64;
    h16* yp = y + (rowb + t) * 1536 + 512 + h * 64;
#pragma unroll
    for (int d = 0; d < 64; ++d) yp[d] = (h16)(o[d] * il * siluf_((float)zp[d]));
}

__global__ void __launch_bounds__(256) nv_mlstm(const h16* __restrict__ proj, const float* __restrict__ small, const float* __restrict__ convw  ,
                                                const float* __restrict__ headg  , h16* __restrict__ y, int b0) {
    __shared__ float qk[128];
    __shared__ float red[4];
    const int bl = blockIdx.x >> 2, hh = blockIdx.x & 3, tid = threadIdx.x, v = tid >> 1, kh = tid & 1;
    const size_t rowb = (size_t)bl * SEQ;
    float C[32], nn[32];
#pragma unroll
    for (int j = 0; j < 32; ++j) { C[j] = 0.f; nn[j] = 0.f; }
    float m = 0.f;
    const int ccol = tid < 64 ? hh * 64 + tid : 256 + hh * 64 + (tid - 64);
    float cw[4] = {0.f, 0.f, 0.f, 0.f};
    if (tid < 128) {
#pragma unroll
        for (int j = 0; j < 4; ++j) cw[j] = convw[j * 512 + ccol];
    }
    const float hg = headg[hh * 128 + v];
    for (int t = 0; t < SEQ; ++t) {
        if (tid < 128) {
            float a = 0.f;
#pragma unroll
            for (int j = 0; j < 4; ++j) { const int tt = t - 3 + j; if (tt >= 0) a += cw[j] * (float)proj[(rowb + tt) * PW + PC_CQK + ccol]; }
            a = siluf_(a);
            if (tid >= 64) a *= 0.125f;
            qk[tid] = a;
        }
        __syncthreads();
        const size_t row = rowb + t;
        const float li = small[((size_t)b0 * SEQ + row) * 16 + 8 + hh], lf = small[((size_t)b0 * SEQ + row) * 16 + 12 + hh];
        const float vt = (float)proj[row * PW + PC_CV + hh * 128 + v];
        const float mn = fmaxf(lf + m, li), fw = __expf(lf + m - mn), iw = __expf(li - mn);
        float nump = 0.f, denp = 0.f;
#pragma unroll
        for (int j = 0; j < 32; ++j) {
            const float kj = qk[64 + kh * 32 + j], qj = qk[kh * 32 + j];
            C[j] = fw * C[j] + iw * vt * kj; nn[j] = fw * nn[j] + iw * kj;
            nump += C[j] * qj; denp += nn[j] * qj;
        }
        nump += __shfl_xor(nump, 1); denp += __shfl_xor(denp, 1);
        m = mn;
        const float hval = nump / fmaxf(fabsf(denp), __expf(-mn));
        const float hgt = hval * sigmoidf_((float)proj[row * PW + PC_CO + hh * 128 + v]);
        float ss = kh == 0 ? hgt * hgt : 0.f;
        ss = wave_sum(ss);
        if ((tid & 63) == 0) red[tid >> 6] = ss;
        __syncthreads();
        const float tot = red[0] + red[1] + red[2] + red[3];
        if (kh == 0) {
            const float o = hgt * rsqrtf(tot * (1.f / 128.f) + RMS_EPS) * hg * siluf_((float)proj[row * PW + PC_CZ + hh * 128 + v]);
            y[row * 1536 + 1024 + hh * 128 + v] = (h16)o;
        }
    }
}

__global__ void nv_final_norm(float* __restrict__ x, const float* __restrict__ g) {
    const int lane = threadIdx.x & 63, wv = (blockIdx.x * blockDim.x + threadIdx.x) >> 6, nw = (gridDim.x * blockDim.x) >> 6;
    for (int row = wv; row < TT; row += nw) {
        f32x4* xr = (f32x4*)(x + (size_t)row * DM) + lane;
        f32x4 v[4]; float s = 0.f;
#pragma unroll
        for (int j = 0; j < 4; ++j) { v[j] = xr[64 * j]; s += v[j].x * v[j].x + v[j].y * v[j].y + v[j].z * v[j].z + v[j].w * v[j].w; }
        const float rstd = rsqrtf(wave_sum(s) * (1.f / DM) + RMS_EPS);
#pragma unroll
        for (int j = 0; j < 4; ++j) {
            const f32x4 gg = ((const f32x4*)g)[lane + 64 * j];
            f32x4 o = {v[j].x * rstd * gg.x, v[j].y * rstd * gg.y, v[j].z * rstd * gg.z, v[j].w * rstd * gg.w};
            xr[64 * j] = o;
        }
    }
}


namespace pg8 {
#define PG8_LAS __attribute__((address_space(3)))
typedef short s16x8 __attribute__((ext_vector_type(8)));
typedef unsigned u32x4 __attribute__((ext_vector_type(4)));
typedef float f32x2 __attribute__((ext_vector_type(2)));
typedef _Float16 h16x2 __attribute__((ext_vector_type(2)));
constexpr int BM = 256, BK = 64, HALF = 128, HTB = HALF * BK * 2  , STAGE_BYTES = 8 * HTB, NXCD = 8, WGM = 8;
__host__ __device__ __forceinline__ int lds_byte(int r, int c) { const int st = (r >> 4) * 2 + (c >> 5), rr = r & 15, cc = c & 31, ob = rr * 64 + cc * 2; return st * 1024 + (ob ^ (((ob >> 9) & 1) << 5)); }
__host__ __device__ __forceinline__ void stage_rc(int b, int& R, int& C) { const int st = b / 1024, sb = b % 1024, swz = sb ^ (((sb >> 9) & 1) << 5); R = (st >> 1) * 16 + swz / 64; C = (st & 1) * 32 + (swz % 64) / 2; }
__host__ __device__ __forceinline__ int perm32(int rho) { const int n = rho >> 4, i = rho & 15; return 8 * (i >> 2) + 4 * n + (i & 3); }
__device__ __forceinline__ unsigned cvt_pk_f16(float lo, float hi) { f32x2 v = {lo, hi}; h16x2 b = __builtin_convertvector(v, h16x2); return __builtin_bit_cast(unsigned, b); }

struct Unit { int pm, pn, z; };
struct Gemm { const h16* A; const h16* Bt; int lda, ldb, K; long zA, zB; };

__device__ __forceinline__ void tile_of(int L, int nM, int nN, int& pm, int& pn) {
    const int nwg = nM * nN; int wgid = L;
    { const int q = nwg / NXCD, r = nwg % NXCD, xcd = wgid % NXCD, off = wgid / NXCD; wgid = (xcd < r ? xcd * (q + 1) : r * (q + 1) + (xcd - r) * q) + off; }
    const int nig = WGM * nN, gid = wgid / nig, fm = gid * WGM, gsz = (nM - fm) < WGM ? (nM - fm) : WGM;
    pm = fm + ((wgid % nig) % gsz); pn = (wgid % nig) / gsz;
}
struct StaticOrder {
    int nM, nN, nwg, G, c;
    __device__ void init(int M, int N, int G_, int c_) { nM = M / BM; nN = N / BM; nwg = nM * nN; G = G_; c = c_; }
    __device__ bool next(int i, Unit& u) const { const long L = (long)i * G + c; if (L >= nwg) return false; tile_of((int)L, nM, nN, u.pm, u.pn); u.z = 0; return true; }
};
struct BranchOrder {
    int nM, nN, nwg, G, c, NZ;
    __device__ void init(int M, int N, int G_, int c_, int nz) { nM = M / BM; nN = N / BM; nwg = nM * nN; G = G_; c = c_; NZ = nz; }
    __device__ bool next(int i, Unit& u) const { const int j = i / NZ; const long L = (long)j * G + c; if (L >= nwg) return false; tile_of((int)L, nM, nN, u.pm, u.pn); u.z = i - j * NZ; return true; }
};

struct EpiF16 {
    static constexpr bool PERM = true;
    h16* C; int ldc;
    __device__ __forceinline__ void operator()(const f32x4 (&acc)[2][2][4][2], const Unit& u, int wr, int wc, int fr, int fq) const {
        const int row0 = u.pm * BM + wr * 64 + fr, col0 = u.pn * BM + wc * 32 + 8 * fq;
#pragma unroll
        for (int ai = 0; ai < 2; ++ai)
#pragma unroll
            for (int m = 0; m < 4; ++m) { h16* rowp = C + (size_t)(row0 + ai * HALF + m * 16) * ldc + col0;
#pragma unroll
                for (int bj = 0; bj < 2; ++bj) { const f32x4 v0 = acc[ai][bj][m][0], v1 = acc[ai][bj][m][1];
                    u32x4 w; w.x = cvt_pk_f16(v0[0], v0[1]); w.y = cvt_pk_f16(v0[2], v0[3]); w.z = cvt_pk_f16(v1[0], v1[1]); w.w = cvt_pk_f16(v1[2], v1[3]);
                    *(u32x4*)(rowp + bj * HALF) = w; } }
    }
};
struct EpiGate {
    static constexpr bool PERM = true;
    h16* Mg; const h16* G; int ldg;
    __device__ __forceinline__ void operator()(const f32x4 (&acc)[2][2][4][2], const Unit& u, int wr, int wc, int fr, int fq) const {
        const int row0 = u.pm * BM + wr * 64 + fr, col0 = u.pn * BM + wc * 32 + 8 * fq;
#pragma unroll
        for (int ai = 0; ai < 2; ++ai)
#pragma unroll
            for (int mp = 0; mp < 2; ++mp) {
                h16x8 gv[2][2], pv[2][2];
#pragma unroll
                for (int mm = 0; mm < 2; ++mm)
#pragma unroll
                    for (int bj = 0; bj < 2; ++bj) { const size_t row = (size_t)(row0 + ai * HALF + (2 * mp + mm) * 16);
                        gv[mm][bj] = *(const h16x8*)(G + row * ldg + u.z * 1024 + col0 + bj * HALF);
                        if (u.z > 0) pv[mm][bj] = *(const h16x8*)(Mg + row * 1024 + col0 + bj * HALF); }
#pragma unroll
                for (int mm = 0; mm < 2; ++mm)
#pragma unroll
                    for (int bj = 0; bj < 2; ++bj) { const int m = 2 * mp + mm; const size_t row = (size_t)(row0 + ai * HALF + m * 16);
                        float o[8];
#pragma unroll
                        for (int e = 0; e < 8; ++e) { const float a = e < 4 ? acc[ai][bj][m][0][e] : acc[ai][bj][m][1][e - 4]; o[e] = a * __builtin_amdgcn_rcpf(1.f + __expf(-(float)gv[mm][bj][e])); }
                        if (u.z > 0) {
#pragma unroll
                            for (int e = 0; e < 8; ++e) o[e] += (float)pv[mm][bj][e]; }
                        u32x4 w; w.x = cvt_pk_f16(o[0], o[1]); w.y = cvt_pk_f16(o[2], o[3]); w.z = cvt_pk_f16(o[4], o[5]); w.w = cvt_pk_f16(o[6], o[7]);
                        *(u32x4*)(Mg + row * 1024 + col0 + bj * HALF) = w; }
            }
    }
};
struct EpiRes {
    static constexpr bool PERM = false;
    const float* xin; float* out; int ldc;
    __device__ __forceinline__ void operator()(const f32x4 (&acc)[2][2][4][2], const Unit& u, int wr, int wc, int fr, int fq) const {
        const int row0 = u.pm * BM + wr * 64 + fr, col0 = u.pn * BM + wc * 32 + 4 * fq;
#pragma unroll
        for (int ai = 0; ai < 2; ++ai)
#pragma unroll
            for (int mp = 0; mp < 2; ++mp) {
                f32x4 xv[2][2][2];
#pragma unroll
                for (int mm = 0; mm < 2; ++mm) { const size_t off = (size_t)(row0 + ai * HALF + (2 * mp + mm) * 16) * ldc + col0;
#pragma unroll
                    for (int bj = 0; bj < 2; ++bj)
#pragma unroll
                        for (int n = 0; n < 2; ++n) xv[mm][bj][n] = *(const f32x4*)(xin + off + bj * HALF + n * 16); }
#pragma unroll
                for (int mm = 0; mm < 2; ++mm) { const int m = 2 * mp + mm; const size_t off = (size_t)(row0 + ai * HALF + m * 16) * ldc + col0;
#pragma unroll
                    for (int bj = 0; bj < 2; ++bj)
#pragma unroll
                        for (int n = 0; n < 2; ++n) *(f32x4*)(out + off + bj * HALF + n * 16) = xv[mm][bj][n] + acc[ai][bj][m][n]; }
            }
    }
};

template <class Epi, class Sched>
__device__ __forceinline__ void gemm_phase(PG8_LAS unsigned char* lds, const Gemm g, const Sched& S, const Epi& E) {
    int tid_ = threadIdx.x; asm volatile("" : "+v"(tid_));
    const int tid = tid_, wid = __builtin_amdgcn_readfirstlane(tid >> 6), lane = tid & 63, wr = wid >> 2, wc = wid & 3, fr = lane & 15, fq = lane >> 4;
    const int nt = g.K / BK;
    unsigned voffA[2], voffB[2];
#pragma unroll
    for (int i = 0; i < 2; ++i) { int R, C; stage_rc(tid * 16 + i * 8192, R, C); const int Rb = Epi::PERM ? ((R & ~31) + perm32(R & 31)) : R;
        voffA[i] = (unsigned)(R * g.lda + C) * 2u; voffB[i] = (unsigned)(Rb * g.ldb + C) * 2u; }
    const size_t kstep = (size_t)(BK * 2);
    const size_t hA = (size_t)HALF * g.lda * 2, hB = (size_t)HALF * g.ldb * 2;
    const size_t tA = 2 * hA, tB = 2 * hB;
    const unsigned ldsw = (unsigned)wid * 1024u;
    const int aoff = lds_byte(wr * 64 + fr, fq * 8), boff = lds_byte(wc * 32 + fr, fq * 8);
#define PG8_SA(b, h) (((b) * 2 + (h)) * HTB)
#define PG8_SB(b, h) ((4 + (b) * 2 + (h)) * HTB)
#define PG8_STAGE(bufoff, gbase, voff) do { _Pragma("unroll") for (int _i = 0; _i < 2; ++_i) \
        __builtin_amdgcn_global_load_lds((const unsigned*)((const char*)(gbase) + (voff)[_i]), (PG8_LAS unsigned*)(lds + (bufoff) + ldsw + _i * 8192), 16, 0, 0); } while (0)
#define PG8_LDA(dst, b, h) do { _Pragma("unroll") for (int m = 0; m < 4; ++m) _Pragma("unroll") for (int k = 0; k < 2; ++k) dst[m][k] = *(const PG8_LAS s16x8*)(lds + PG8_SA(b, h) + aoff + m * 2048 + k * 1024); } while (0)
#define PG8_LDB(dst, b, h) do { _Pragma("unroll") for (int n = 0; n < 2; ++n) _Pragma("unroll") for (int k = 0; k < 2; ++k) dst[n][k] = *(const PG8_LAS s16x8*)(lds + PG8_SB(b, h) + boff + n * 2048 + k * 1024); } while (0)
#define PG8_MMA(ai, bj, At, Bt) do { __builtin_amdgcn_s_setprio(1); _Pragma("unroll") for (int m = 0; m < 4; ++m) _Pragma("unroll") for (int n = 0; n < 2; ++n) _Pragma("unroll") for (int k = 0; k < 2; ++k) \
        acc[ai][bj][m][n] = __builtin_amdgcn_mfma_f32_16x16x32_f16(__builtin_bit_cast(h16x8, Bt[n][k]), __builtin_bit_cast(h16x8, At[m][k]), acc[ai][bj][m][n], 0, 0, 0); __builtin_amdgcn_s_setprio(0); } while (0)
#define PG8_WAIT_V(n) asm volatile("s_waitcnt vmcnt(" #n ")" ::: "memory")
#define PG8_WAIT_L(n) asm volatile("s_waitcnt lgkmcnt(" #n ")" ::: "memory")
#define PG8_BAR __builtin_amdgcn_s_barrier()
#define PG8_SCHED __builtin_amdgcn_sched_barrier(0)
    Unit cur, nxt; int ui = 0;
    if (!S.next(0, cur)) return;
    f32x4 acc[2][2][4][2];
#pragma unroll
    for (int a = 0; a < 2; ++a)
#pragma unroll
        for (int b = 0; b < 2; ++b)
#pragma unroll
            for (int m = 0; m < 4; ++m)
#pragma unroll
                for (int n = 0; n < 2; ++n) acc[a][b][m][n] = (f32x4){0.f, 0.f, 0.f, 0.f};
    s16x8 At[4][2], B0[2][2], B1[2][2];
    const char* cA = (const char*)(g.A + (long)cur.z * g.zA) + (size_t)cur.pm * tA; const char* cB = (const char*)(g.Bt + (long)cur.z * g.zB) + (size_t)cur.pn * tB;
    PG8_STAGE(PG8_SB(0, 0), cB, voffB); PG8_STAGE(PG8_SB(0, 1), cB + hB, voffB); PG8_STAGE(PG8_SA(0, 0), cA, voffA); PG8_STAGE(PG8_SA(0, 1), cA + hA, voffA);
    if (wr == 1) PG8_BAR;
    PG8_WAIT_V(2); PG8_BAR;
    PG8_STAGE(PG8_SB(1, 0), cB + kstep, voffB); PG8_STAGE(PG8_SA(1, 0), cA + kstep, voffA); PG8_STAGE(PG8_SB(1, 1), cB + hB + kstep, voffB);
    PG8_WAIT_V(6); PG8_BAR;
    for (;;) {
        const bool has_next = S.next(ui + 1, nxt);
        const char* nA = has_next ? (const char*)(g.A + (long)nxt.z * g.zA) + (size_t)nxt.pm * tA : cA; const char* nB = has_next ? (const char*)(g.Bt + (long)nxt.z * g.zB) + (size_t)nxt.pn * tB : cB;
        for (int t = 0; t < nt; t += 2) {
            const bool last = (t == nt - 2);
            const char* a1 = cA + (size_t)(t + 1) * kstep;
            const char* a2 = last ? nA : cA + (size_t)(t + 2) * kstep; const char* b2 = last ? nB : cB + (size_t)(t + 2) * kstep;
            const char* a3 = a2 + kstep; const char* b3 = b2 + kstep;
            PG8_LDB(B0, 0, 0); PG8_LDB(B1, 0, 1); PG8_SCHED; PG8_LDA(At, 0, 0); PG8_STAGE(PG8_SA(1, 1), a1 + hA, voffA);
            PG8_WAIT_V(8); PG8_WAIT_L(0); PG8_BAR; PG8_MMA(0, 0, At, B0); PG8_MMA(0, 1, At, B1); PG8_BAR; PG8_SCHED;
            PG8_LDA(At, 0, 1); PG8_STAGE(PG8_SB(0, 0), b2, voffB); PG8_STAGE(PG8_SB(0, 1), b2 + hB, voffB); PG8_STAGE(PG8_SA(0, 0), a2, voffA);
            PG8_WAIT_V(8); PG8_WAIT_L(0); PG8_BAR; PG8_MMA(1, 0, At, B0); PG8_MMA(1, 1, At, B1); PG8_BAR; PG8_SCHED;
            PG8_LDB(B0, 1, 0); PG8_LDB(B1, 1, 1); PG8_SCHED; PG8_LDA(At, 1, 0); PG8_STAGE(PG8_SA(0, 1), a2 + hA, voffA);
            PG8_WAIT_V(8); PG8_WAIT_L(0); PG8_BAR; PG8_MMA(0, 0, At, B0); PG8_MMA(0, 1, At, B1); PG8_BAR; PG8_SCHED;
            PG8_LDA(At, 1, 1); PG8_STAGE(PG8_SB(1, 0), b3, voffB); PG8_STAGE(PG8_SB(1, 1), b3 + hB, voffB); PG8_STAGE(PG8_SA(1, 0), a3, voffA);
            PG8_WAIT_V(8); PG8_WAIT_L(0); PG8_BAR; PG8_MMA(1, 0, At, B0); PG8_MMA(1, 1, At, B1); PG8_BAR; PG8_SCHED;
        }
        if (wr == 0) PG8_BAR;
        E(acc, cur, wr, wc, fr, fq);
        if (!has_next) break;
#pragma unroll
        for (int a = 0; a < 2; ++a)
#pragma unroll
            for (int b = 0; b < 2; ++b)
#pragma unroll
                for (int m = 0; m < 4; ++m)
#pragma unroll
                    for (int n = 0; n < 2; ++n) acc[a][b][m][n] = (f32x4){0.f, 0.f, 0.f, 0.f};
        cur = nxt; cA = nA; cB = nB; ++ui;
        if (wr == 1) PG8_BAR;
    }
    PG8_WAIT_V(0);
    PG8_BAR;
#undef PG8_SA
#undef PG8_SB
#undef PG8_STAGE
#undef PG8_LDA
#undef PG8_LDB
#undef PG8_MMA
#undef PG8_WAIT_V
#undef PG8_WAIT_L
#undef PG8_BAR
#undef PG8_SCHED
}
}

namespace attn_body {
using s16x8 = __attribute__((ext_vector_type(8))) short;
using s16x4 = __attribute__((ext_vector_type(4))) short;
using f32x16 = __attribute__((ext_vector_type(16))) float;
using u32x4 = __attribute__((ext_vector_type(4))) unsigned;
constexpr int D = 64, NW = 8, QBLK = 32, QB = QBLK * NW, KVBLK = 64;
constexpr int PQ = PW;
__device__ __forceinline__ int crow(int r, int hi) { return (r & 3) + 8 * (r >> 2) + 4 * hi; }
#define SBAR() __builtin_amdgcn_sched_barrier(0)
__device__ __forceinline__ void cmask(f32x16& p0, f32x16& p1, int jb, int qrel, int hi) {
    const float NEG = -INFINITY; int kb = 64 * jb + 4 * hi;
#pragma unroll
    for (int r = 0; r < 16; ++r) { int kv = kb + (r & 3) + 8 * (r >> 2); if (kv > qrel) p0[r] = NEG; if (kv + 32 > qrel) p1[r] = NEG; }
}
constexpr int NSLOT = 3, SLOTB = 8192;
constexpr int LDS_K = 0, LDS_V = NSLOT * SLOTB, LDS_WS = 2 * NSLOT * SLOTB, LDS_OST = LDS_WS + NW * 64 * 4, LDS_BT = LDS_OST + NW * 4096, LDS_INF = LDS_BT + 2048 * 4, LDS_KM = LDS_INF + 256, LDS_BYTES = LDS_KM + 2048;
__device__ __forceinline__ void glds16(const void* gsrc, unsigned lds_dst) { unsigned keep;
    asm volatile("s_mov_b32 %0, m0\n\ts_mov_b32 m0, %2\n\ts_nop 0\n\tglobal_load_lds_dwordx4 %1, off\n\ts_mov_b32 m0, %0" : "=&s"(keep) : "v"(gsrc), "s"(lds_dst) : "memory"); }
__device__ __forceinline__ float max3f(float a, float b, float c) { float r; asm("v_max3_f32 %0, %1, %2, %3" : "=v"(r) : "v"(a), "v"(b), "v"(c)); return r; }
__device__ __forceinline__ float max2f(float a, float b) { float r; asm("v_max_f32_e32 %0, %1, %2" : "=v"(r) : "v"(a), "v"(b)); return r; }
__device__ __forceinline__ float fadd_s(float a, float b) { float r; asm("v_add_f32_e32 %0, %1, %2" : "=v"(r) : "v"(a), "v"(b)); return r; }
__device__ __forceinline__ float fsub_s(float a, float b) { float r; asm("v_sub_f32_e32 %0, %1, %2" : "=v"(r) : "v"(a), "v"(b)); return r; }
__device__ __forceinline__ unsigned cvtpk_s(float lo, float hi) { return pg8::cvt_pk_f16(lo, hi); }
#define MFMA32(a, b, c) __builtin_amdgcn_mfma_f32_32x32x16_f16(__builtin_bit_cast(h16x8, (a)), __builtin_bit_cast(h16x8, (b)), (c), 0, 0, 0)
#define WAIT_BAR(N) asm volatile("s_waitcnt vmcnt(" #N ") lgkmcnt(0)\n\ts_barrier" ::: "memory")
__device__ __forceinline__ void qkt(f32x16& p0, f32x16& p1, const char* Kslot, const s16x8* qr, const f32x16& negm, int r32, int hi) {
    const char* kb = Kslot + hi * 1024 + r32 * 16;
#pragma unroll
    for (int d0 = 0; d0 < 4; ++d0) {
        const s16x8 b0 = *reinterpret_cast<const s16x8*>(kb + d0 * 2048);
        const s16x8 b1 = *reinterpret_cast<const s16x8*>(kb + d0 * 2048 + 512);
        if (d0 == 0) { p0 = MFMA32(b0, qr[0], negm); p1 = MFMA32(b1, qr[0], negm); }
        else { p0 = MFMA32(b0, qr[d0], p0); p1 = MFMA32(b1, qr[d0], p1); } }
}
typedef __attribute__((address_space(3))) const char* lds_cptr;
typedef short v4i16_t __attribute__((ext_vector_type(4)));
#define LDS8(p) (*(const __attribute__((address_space(3))) s16x8*)(p))
__device__ __forceinline__ void kload8(s16x8* kf, lds_cptr kp) {
    kf[0] = LDS8(kp); kf[1] = LDS8(kp + 512); kf[2] = LDS8(kp + 2048); kf[3] = LDS8(kp + 2560);
    kf[4] = LDS8(kp + 4096); kf[5] = LDS8(kp + 4608); kf[6] = LDS8(kp + 6144); kf[7] = LDS8(kp + 6656);
}
__device__ __forceinline__ void kload2(s16x8* kf, lds_cptr kp, int j) { kf[2 * j] = LDS8(kp + j * 2048); kf[2 * j + 1] = LDS8(kp + j * 2048 + 512); }
__device__ __forceinline__ s16x4 vtr(lds_cptr p) { return __builtin_bit_cast(s16x4, __builtin_amdgcn_ds_read_tr16_b64_v4i16((__attribute__((address_space(3))) v4i16_t*)p)); }
__device__ __forceinline__ float rowmax(const f32x16& p0, const f32x16& p1) {
    float a = max3f(p0[0], p0[1], p1[0]), b = max3f(p0[2], p0[3], p1[1]); a = max3f(a, p1[2], p1[3]);
#pragma unroll
    for (int r = 4; r < 16; r += 4) { a = max3f(a, p0[r], p0[r + 1]); b = max3f(b, p0[r + 2], p0[r + 3]); a = max3f(a, p1[r], p1[r + 1]); b = max3f(b, p1[r + 2], p1[r + 3]); }
    const float m = max2f(a, b);
    auto rr = __builtin_amdgcn_permlane32_swap(__float_as_uint(m), __float_as_uint(m), false, false);
    return max2f(__uint_as_float(rr[0]), __uint_as_float(rr[1]));
}
__device__ __forceinline__ void pv(f32x16* o, int vb, s16x8 pa0, s16x8 pa1, s16x8 pa2, s16x8 pa3) {
#pragma unroll
    for (int d0 = 0; d0 < 2; ++d0) { s16x4 lo[4], hi[4];
#pragma unroll
        for (int ks = 0; ks < 4; ++ks) {
            asm volatile("ds_read_b64_tr_b16 %0,%1 offset:%c2" : "=&v"(lo[ks]) : "v"(vb), "i"(d0 * 4096 + ks * 1024) : "memory");
            asm volatile("ds_read_b64_tr_b16 %0,%1 offset:%c2" : "=&v"(hi[ks]) : "v"(vb), "i"(d0 * 4096 + ks * 1024 + 512) : "memory"); }
        asm volatile("s_waitcnt lgkmcnt(0)" ::: "memory"); SBAR();
#define PK(k) (s16x8){lo[k][0], lo[k][1], lo[k][2], lo[k][3], hi[k][0], hi[k][1], hi[k][2], hi[k][3]}
        o[d0] = MFMA32(pa0, PK(0), o[d0]);
        o[d0] = MFMA32(pa1, PK(1), o[d0]);
        o[d0] = MFMA32(pa2, PK(2), o[d0]);
        o[d0] = MFMA32(pa3, PK(3), o[d0]);
#undef PK
    }
}

template <bool MOBA, int THRL>
__device__ __forceinline__ void attn_unit(int bl, int h, int qb, const h16* Q, const h16* __restrict__ K, const h16* __restrict__ V, const h16* __restrict__ Z, h16* Y,
                                          const float* __restrict__ bsrc, float slope2, const float* __restrict__ kmean, char* shm) {
    int tid_ = threadIdx.x; asm volatile("" : "+v"(tid_));
    const int tid = tid_, lane = tid & 63, r32 = lane & 31, hi = lane >> 5; const int wid = __builtin_amdgcn_readfirstlane(tid >> 6);
    const long rowbase = (long)bl * SEQ; const int q0 = qb * QB;
    const h16* Qw = Q + (rowbase + q0 + wid * QBLK) * PQ + h * D;
    const h16* Kh = K + rowbase * PQ + h * D, *Vh = V + rowbase * PQ + h * D;
    const unsigned lds0 = (unsigned)(uintptr_t)shm;
    float* wsf = (float*)(shm + LDS_WS) + wid * 64;
    typedef __attribute__((address_space(3))) float lds_f32;
    typedef __attribute__((address_space(3))) const f32x4 lds_cf32x4;
    const lds_cptr shm3 = (lds_cptr)shm;
    {
        lds_f32* bt = (lds_f32*)(shm3 + LDS_BT);
        const int nkeys = q0 + QB;
        if (MOBA) { for (int i = tid; i < nkeys; i += NW * 64) bt[i] = slope2 * (float)(i - q0); }
        else { for (int i = tid; i < nkeys; i += NW * 64) bt[i] = bsrc[i]; }
        if (tid < 64) ((lds_f32*)(shm3 + LDS_INF))[tid] = -INFINITY;
        if (MOBA) { if (tid < 512) ((lds_f32*)(shm3 + LDS_KM))[tid] = kmean[tid]; }
    }
    const h16* ksrc = Kh + (long)lane * PQ + wid * 8;
    const h16* vsrc = Vh + (long)(16 * (wid & 3) + (lane >> 2)) * PQ + (wid >> 2) * 32 + (lane & 3) * 8;
    const unsigned kdst = lds0 + LDS_K + wid * 1024, vdst = lds0 + LDS_V + wid * 1024;
    const int NT = (q0 + QB) / KVBLK;
#define AMAP(t) (MOBA ? ((t) < 4 ? 4 * qb + (t) : (t) - 4) : (t))
#define DMA_K(t, slot) glds16(ksrc + (long)AMAP(t) * KVBLK * PQ, (unsigned)__builtin_amdgcn_readfirstlane(kdst + (slot)))
#define DMA_V(t, slot) glds16(vsrc + (long)AMAP(t) * KVBLK * PQ, (unsigned)__builtin_amdgcn_readfirstlane(vdst + (slot)))
    const char* Kbase = shm + LDS_K; s16x8 kf[8];
    const lds_cptr kp0 = shm3 + LDS_K + hi * 1024 + r32 * 16; const lds_cptr vp0 = shm3 + LDS_V + ((lane >> 4) & 1) * 32 + (lane & 3) * 8 + (4 * hi + ((lane & 15) >> 2)) * 64;
    DMA_K(0, 0); DMA_V(0, 0); DMA_K(1, SLOTB);
    s16x8 qr[4];
#pragma unroll
    for (int d0 = 0; d0 < 4; ++d0) qr[d0] = *reinterpret_cast<const s16x8*>(&Qw[(long)r32 * PQ + d0 * 16 + hi * 8]);
    float mhat = 0.f, l_reg = 0.f; f32x16 o[2]; o[0] = f32x16{}; o[1] = f32x16{}; f32x16 negm = f32x16{}; asm volatile("" : "+v"(negm));
    const int qrel = wid * QBLK + r32;
    unsigned selbits = 0xffu;
#define ADDB(P0, P1, t) do { const int kt_ = AMAP(t); lds_cptr tb_ = shm3 + LDS_BT + kt_ * 256; \
        if (MOBA) { const bool s_ = ((t) < 4) || ((selbits >> (kt_ >> 2)) & 1u); tb_ = s_ ? tb_ : (shm3 + LDS_INF); } \
        _Pragma("unroll") for (int g_ = 0; g_ < 4; ++g_) { const f32x4 b0_ = *(lds_cf32x4*)(tb_ + 16 * hi + 32 * g_), b1_ = *(lds_cf32x4*)(tb_ + 128 + 16 * hi + 32 * g_); \
            _Pragma("unroll") for (int i_ = 0; i_ < 4; ++i_) { P0[4 * g_ + i_] += b0_[i_]; P1[4 * g_ + i_] += b1_[i_]; } } } while (0)
#define CMASK(P0, P1, t) do { const int jb_ = MOBA ? (t) : (t) - (NT - 4); if (MOBA ? (jb_ < 4) : (jb_ >= 0)) cmask(P0, P1, jb_, qrel, hi); } while (0)
    bool resc = false;
#define START(P0, P1) do { const float rm = rowmax(P0, P1); resc = false; \
    { const float dl = rm; mhat = fadd_s(mhat, dl); \
      _Pragma("unroll") for (int r = 0; r < 16; ++r) { P0[r] = fsub_s(P0[r], dl); P1[r] = fsub_s(P1[r], dl); } \
      _Pragma("unroll") for (int r = 0; r < 16; ++r) negm[r] = -mhat; asm volatile("" : "+v"(negm)); } \
    _Pragma("unroll") for (int r = 0; r < 16; ++r) P0[r] = __builtin_amdgcn_exp2f(P0[r]); } while (0)
#define RESC() do { if (resc) { asm volatile("s_waitcnt lgkmcnt(0)" ::: "memory"); \
      _Pragma("unroll") for (int d_ = 0; d_ < 2; ++d_) _Pragma("unroll") for (int r = 0; r < 16; ++r) o[d_][r] *= wsf[crow(r, hi)]; } } while (0)
    f32x16 pA0, pA1, pB0, pB1;
    int sl_prev = 0, sl_cur = 0, sl_next = SLOTB;
#define ROT() do { sl_prev = sl_cur; sl_cur = sl_next; sl_next = (sl_next == (NSLOT - 1) * SLOTB) ? 0 : sl_next + SLOTB; } while (0)
    DMA_K(2, 2 * SLOTB);
    WAIT_BAR(3);
    if (MOBA && qb >= 4) {
        float gate[8];
#pragma unroll
        for (int n = 0; n < 8; ++n) gate[n] = 0.f;
#pragma unroll
        for (int d0 = 0; d0 < 4; ++d0) {
            const h16x8 qv = __builtin_bit_cast(h16x8, qr[d0]);
#pragma unroll
            for (int n = 0; n < 7; ++n) {
                const f32x4 k0 = *(lds_cf32x4*)(shm3 + LDS_KM + n * 256 + d0 * 64 + hi * 32), k1 = *(lds_cf32x4*)(shm3 + LDS_KM + n * 256 + d0 * 64 + hi * 32 + 16);
                gate[n] += (float)qv[0] * k0[0] + (float)qv[1] * k0[1] + (float)qv[2] * k0[2] + (float)qv[3] * k0[3] + (float)qv[4] * k1[0] + (float)qv[5] * k1[1] + (float)qv[6] * k1[2] + (float)qv[7] * k1[3];
            }
        }
#pragma unroll
        for (int n = 0; n < 7; ++n) { gate[n] = half_sum(gate[n]); if (n >= qb) gate[n] = -INFINITY; }
        unsigned sb = 0u;
#pragma unroll
        for (int r = 0; r < 3; ++r) {
            float best = -INFINITY; int bi = 0;
#pragma unroll
            for (int n = 0; n < 7; ++n) { const bool fr_ = !((sb >> n) & 1u); if (fr_ && gate[n] > best) { best = gate[n]; bi = n; } }
            sb |= 1u << bi;
        }
        selbits = sb;
    }
    qkt(pA0, pA1, Kbase, qr, negm, r32, hi); asm volatile("s_nop 15\n\ts_nop 7" : "+v"(pA0), "+v"(pA1)); ADDB(pA0, pA1, 0); CMASK(pA0, pA1, 0);
    START(pA0, pA1);
    _Pragma("unroll") for (int r = 0; r < 16; ++r) pA1[r] = __builtin_amdgcn_exp2f(pA1[r]);
    WAIT_BAR(0);
    DMA_K(3, 0); DMA_V(1, SLOTB);
    ROT();
    kload8(kf, kp0 + sl_cur);
    WAIT_BAR(2);
    s16x4 vlo[8], vhi[8]; u32x4 pw0, pw1, pw2, pw3;
#define PKW(P, B) cvtpk_s(P[B], P[B + 1])
#define PAF(k) __builtin_bit_cast(s16x8, pw##k)
#define VFR(i) (s16x8){vlo[i][0], vlo[i][1], vlo[i][2], vlo[i][3], vhi[i][0], vhi[i][1], vhi[i][2], vhi[i][3]}
#define PIN(x) asm volatile("" : "+v"(x))
#define MX3(a, b, c) __builtin_fmaxf(__builtin_fmaxf((a), (b)), (c))
#define GAPA(MF, A0, A1, A2, A3, W0, W1, PW_) do { MF; sacc += A0; sacc += A1; sacc += A2; sacc += A3; PIN(sacc); W0; W1; PIN(PW_); SBAR(); } while (0)
#define EX(v) __builtin_amdgcn_exp2f(v)
#define GAPB(MF, X, B) do { MF; X[B] = EX(X[B]); X[B + 1] = EX(X[B + 1]); X[B + 2] = EX(X[B + 2]); X[B + 3] = EX(X[B + 3]); PIN(X); SBAR(); } while (0)
#define VRD(i) do { vlo[i] = vtr(vp_ + (((i) >> 2) * 4096 + ((i) & 3) * 1024)); vhi[i] = vtr(vp_ + (((i) >> 2) * 4096 + ((i) & 3) * 1024 + 512)); } while (0)
#define KRD(G, j) do { if (G) { kload2(kf, kp0 + sl_next, j); SBAR(); } } while (0)
#define STEP(C0, C1, P0, P1, t, GK, GV, GL) do { SBAR(); \
    const lds_cptr vp_ = vp0 + sl_prev; \
    VRD(0); SBAR(); float sacc = (P0[0] + P0[1]); \
    GAPA(C0 = MFMA32(kf[0], qr[0], negm), P0[2], P0[3], P0[4], P0[5],     pw0[0] = PKW(P0, 0), pw0[1] = PKW(P0, 2), pw0); \
    VRD(4); SBAR(); GAPA(C1 = MFMA32(kf[1], qr[0], negm), P0[6], P0[7], P0[8], P0[9],     pw0[2] = PKW(P0, 4), pw0[3] = PKW(P0, 6), pw0); \
    VRD(1); SBAR(); GAPA(C0 = MFMA32(kf[2], qr[1], C0),   P0[10], P0[11], P0[12], P0[13], pw1[0] = PKW(P0, 8), pw1[1] = PKW(P0, 10), pw1); \
    VRD(5); SBAR(); GAPA(C1 = MFMA32(kf[3], qr[1], C1),   P0[14], P0[15], P1[0], P1[1],   pw1[2] = PKW(P0, 12), pw1[3] = PKW(P0, 14), pw1); \
    VRD(2); SBAR(); GAPA(C0 = MFMA32(kf[4], qr[2], C0),   P1[2], P1[3], P1[4], P1[5],     pw2[0] = PKW(P1, 0), pw2[1] = PKW(P1, 2), pw2); \
    VRD(6); SBAR(); GAPA(C1 = MFMA32(kf[5], qr[2], C1),   P1[6], P1[7], P1[8], P1[9],     pw2[2] = PKW(P1, 4), pw2[3] = PKW(P1, 6), pw2); \
    VRD(3); SBAR(); GAPA(C0 = MFMA32(kf[6], qr[3], C0),   P1[10], P1[11], P1[12], P1[13], pw3[0] = PKW(P1, 8), pw3[1] = PKW(P1, 10), pw3); \
    VRD(7); SBAR(); GAPA(C1 = MFMA32(kf[7], qr[3], C1),   P1[14], P1[15], 0.f, 0.f,       pw3[2] = PKW(P1, 12), pw3[3] = PKW(P1, 14), pw3); \
    l_reg += sacc; \
    if (GK) { DMA_K((t) + 3, sl_cur); } if (GV) { DMA_V((t) + 1, sl_next); } \
    ADDB(C0, C1, t); CMASK(C0, C1, t); \
    { float a = MX3(C0[0], C0[1], C1[0]), b = MX3(C0[2], C0[3], C1[1]); a = MX3(a, C1[2], C1[3]); \
      _Pragma("unroll") for (int r = 4; r < 16; r += 4) { a = MX3(a, C0[r], C0[r + 1]); b = MX3(b, C0[r + 2], C0[r + 3]); a = MX3(a, C1[r], C1[r + 1]); b = MX3(b, C1[r + 2], C1[r + 3]); } \
      float rm = __builtin_fmaxf(a, b); { auto rr = __builtin_amdgcn_permlane32_swap(__float_as_uint(rm), __float_as_uint(rm), false, false); rm = __builtin_fmaxf(__uint_as_float(rr[0]), __uint_as_float(rr[1])); } \
      resc = false; \
      if (__builtin_expect(__any(rm > (float)THRL), 0)) { const float dl = __builtin_fmaxf(rm, 0.f); mhat += dl; \
        _Pragma("unroll") for (int r = 0; r < 16; ++r) { C0[r] -= dl; C1[r] -= dl; } \
        _Pragma("unroll") for (int r = 0; r < 16; ++r) negm[r] = -mhat; asm volatile("" : "+v"(negm)); \
        const float f = __builtin_amdgcn_exp2f(-dl); l_reg *= f; if (hi == 0) wsf[r32] = f; resc = true; } } \
    SBAR(); \
    GAPB(o[0] = MFMA32(PAF(0), VFR(0), o[0]), C0, 0); \
    GAPB(o[1] = MFMA32(PAF(0), VFR(4), o[1]), C0, 4); \
    KRD(GL, 0); GAPB(o[0] = MFMA32(PAF(1), VFR(1), o[0]), C0, 8); \
    KRD(GL, 1); GAPB(o[1] = MFMA32(PAF(1), VFR(5), o[1]), C0, 12); \
    KRD(GL, 2); GAPB(o[0] = MFMA32(PAF(2), VFR(2), o[0]), C1, 0); \
    KRD(GL, 3); GAPB(o[1] = MFMA32(PAF(2), VFR(6), o[1]), C1, 4); \
    GAPB(o[0] = MFMA32(PAF(3), VFR(3), o[0]), C1, 8); \
    GAPB(o[1] = MFMA32(PAF(3), VFR(7), o[1]), C1, 12); \
    } while (0)
    int t = 1;
#define ENDW(tt) do { if ((tt) + 3 < NT) { WAIT_BAR(2); } else if ((tt) + 2 < NT) { WAIT_BAR(1); } else { WAIT_BAR(0); } } while (0)
    for (; t + 1 < NT; t += 2) {
        STEP(pB0, pB1, pA0, pA1, t, (t + 3 < NT), (t + 1 < NT), (t + 1 < NT));       ENDW(t);     RESC(); ROT();
        STEP(pA0, pA1, pB0, pB1, t + 1, (t + 4 < NT), (t + 2 < NT), (t + 2 < NT));   ENDW(t + 1); RESC(); ROT();
    }
    STEP(pB0, pB1, pA0, pA1, NT - 1, false, false, false); RESC();
    { float sacc = pB0[0] + pB0[1]; _Pragma("unroll") for (int r = 2; r < 16; ++r) sacc += pB0[r]; _Pragma("unroll") for (int r = 0; r < 16; ++r) sacc += pB1[r]; l_reg += sacc;
      pw0 = (u32x4){PKW(pB0, 0), PKW(pB0, 2), PKW(pB0, 4), PKW(pB0, 6)}; pw1 = (u32x4){PKW(pB0, 8), PKW(pB0, 10), PKW(pB0, 12), PKW(pB0, 14)}; pw2 = (u32x4){PKW(pB1, 0), PKW(pB1, 2), PKW(pB1, 4), PKW(pB1, 6)}; pw3 = (u32x4){PKW(pB1, 8), PKW(pB1, 10), PKW(pB1, 12), PKW(pB1, 14)};
      int ln_ = threadIdx.x & 63; asm volatile("" : "+v"(ln_));
      const int vb0 = (int)(lds0 + LDS_V) + ((ln_ >> 4) & 1) * 32 + (ln_ & 3) * 8 + (4 * (ln_ >> 5) + ((ln_ & 15) >> 2)) * 64;
      SBAR(); pv(o, vb0 + sl_cur, PAF(0), PAF(1), PAF(2), PAF(3)); }
#undef PKW
#undef PAF
#undef VFR
#undef PIN
#undef MX3
#undef GAPA
#undef GAPB
#undef EX
#undef VRD
#undef KRD
#undef STEP
#undef ENDW
    { auto rr = __builtin_amdgcn_permlane32_swap(__float_as_uint(l_reg), __float_as_uint(l_reg), false, false); l_reg = __uint_as_float(rr[0]) + __uint_as_float(rr[1]); }
    if (hi == 0) wsf[32 + r32] = l_reg; asm volatile("s_waitcnt lgkmcnt(0)" ::: "memory");
    float rli[16];
#pragma unroll
    for (int r = 0; r < 16; ++r) rli[r] = __builtin_amdgcn_rcpf(wsf[32 + crow(r, hi)]);
    {
        int le = threadIdx.x & 63; asm volatile("" : "+v"(le));
        float* stg = (float*)(shm + LDS_OST) + wid * 1024;
        const h16* Zw = Z + (rowbase + q0 + wid * QBLK) * PQ + h * D;
        h16* Yw = Y + (rowbase + q0 + wid * QBLK) * 1536 + h * D;
#pragma unroll
        for (int d0 = 0; d0 < 2; ++d0) {
#pragma unroll
            for (int r = 0; r < 16; ++r) stg[crow(r, le >> 5) * 32 + (le & 31)] = o[d0][r] * rli[r];
            asm volatile("s_waitcnt lgkmcnt(0)" ::: "memory");
#pragma unroll
            for (int i = 0; i < 2; ++i) { const int row = i * 16 + (le >> 2), ch = le & 3;
                const f32x4 a0 = *(const f32x4*)(stg + row * 32 + ch * 8), a1 = *(const f32x4*)(stg + row * 32 + ch * 8 + 4);
                const h16x8 zv = *(const h16x8*)(Zw + (long)row * PQ + d0 * 32 + ch * 8);
                float ov[8] = {a0[0], a0[1], a0[2], a0[3], a1[0], a1[1], a1[2], a1[3]};
#pragma unroll
                for (int e = 0; e < 8; ++e) { const float zz = (float)zv[e]; ov[e] *= zz * __builtin_amdgcn_rcpf(1.f + __expf(-zz)); }
                u32x4 w; w.x = cvtpk_s(ov[0], ov[1]); w.y = cvtpk_s(ov[2], ov[3]); w.z = cvtpk_s(ov[4], ov[5]); w.w = cvtpk_s(ov[6], ov[7]);
                *(u32x4*)(Yw + (long)row * 1536 + d0 * 32 + ch * 8) = w; }
            asm volatile("s_waitcnt lgkmcnt(0)" ::: "memory");
        }
    }
    asm volatile("s_waitcnt vmcnt(0) lgkmcnt(0)\n\ts_barrier" ::: "memory");
#undef DMA_K
#undef DMA_V
#undef AMAP
#undef ADDB
#undef CMASK
#undef START
#undef RESC
#undef ROT
}
#undef SBAR
#undef WAIT_BAR
#undef MFMA32
#undef LDS8
}

constexpr int NWAVES = 8, NTHREADS = 512;
constexpr int MK_LDS_BYTES = 147456;
enum { PH_NORM = 0, PH_PROJ = 1, PH_PRE = 2, PH_SCAN = 3, PH_MIX = 4, PH_BR = 5, PH_OUT = 6, NPH = 7 };
constexpr int N_STEPS = 1 + NPH * 4 + 1;
struct MArgs { const float* in[11]; float* out; unsigned char* ws; int s_lo, s_hi; };

__device__ __forceinline__ void barrier_lds() { asm volatile("s_waitcnt vmcnt(0) lgkmcnt(0)" ::: "memory"); __syncthreads(); }
__device__ __forceinline__ void fox_cumsum_item(int item, int b0, const float* __restrict__ small, float* __restrict__ cb, char* shm) {
    int tid_ = threadIdx.x; asm volatile("" : "+v"(tid_));
    const int tid = tid_, lane = tid & 63, wid = tid >> 6, bl = item >> 3, h = item & 7;
    const float* sp = small + ((size_t)(b0 + bl) * SEQ + 4 * tid) * 16 + h;
    float v0 = sp[0], v1 = sp[16], v2 = sp[32], v3 = sp[48];
    v1 += v0; v2 += v1; v3 += v2;
    float tot = v3;
#pragma unroll
    for (int o = 1; o < 64; o <<= 1) { const float u = shfl_idx(tot, lane - o); if (lane >= o) tot += u; }
    float* wt = (float*)shm;
    if (lane == 63) wt[wid] = tot;
    __syncthreads();
    float base = tot - v3;
    for (int w = 0; w < wid; ++w) base += wt[w];
    float* o4 = cb + (size_t)((b0 + bl) * 8 + h) * SEQ + 4 * tid;
    *(f32x4*)o4 = (f32x4){-(base + v0) * LOG2E, -(base + v1) * LOG2E, -(base + v2) * LOG2E, -(base + v3) * LOG2E};
    __syncthreads();
}
__device__ __forceinline__ void moba_kmean_item(int item, int b0, const h16* __restrict__ proj, float* __restrict__ kmean, char* shm) {
    int tid_ = threadIdx.x; asm volatile("" : "+v"(tid_));
    const int tid = tid_, h = item & 7, blk = (item >> 3) & 7, bl = item >> 6, r8 = tid >> 3, c8 = tid & 7;
    const h16* kp = proj + ((size_t)bl * SEQ + blk * 256 + r8) * PW + PC_BK + h * 64 + c8 * 8;
    float acc[8];
#pragma unroll
    for (int e = 0; e < 8; ++e) acc[e] = 0.f;
#pragma unroll
    for (int j = 0; j < 4; ++j) { const h16x8 v = *(const h16x8*)(kp + (size_t)(64 * j) * PW);
#pragma unroll
        for (int e = 0; e < 8; ++e) acc[e] += (float)v[e]; }
    float* red = (float*)shm;
#pragma unroll
    for (int e = 0; e < 8; ++e) red[r8 * 65 + c8 * 8 + e] = acc[e];
    __syncthreads();
    if (tid < 64) { float sum = 0.f;
#pragma unroll 8
        for (int r = 0; r < 64; ++r) sum += red[r * 65 + tid];
        kmean[(((size_t)(b0 + bl) * 8 + h) * 8 + blk) * 64 + tid] = sum * (1.f / 256.f); }
    __syncthreads();
}

namespace mlstm {
typedef __attribute__((address_space(3))) char* lds_ptr;
typedef __attribute__((address_space(3))) const char* lds_cptr;
typedef short s16x8 __attribute__((ext_vector_type(8)));
typedef short s16x4 __attribute__((ext_vector_type(4)));
typedef short v4i16_t __attribute__((ext_vector_type(4)));
typedef float f32x16 __attribute__((ext_vector_type(16)));
typedef unsigned u32x4 __attribute__((ext_vector_type(4)));
constexpr int W_V = 0, W_K = 16384, W_SC = W_K + 8704, WREG = W_SC + 2048;
constexpr int NACT = 4;
__device__ __forceinline__ int crow(int r, int hi) { return (r & 3) + 8 * (r >> 2) + 4 * hi; }
#define MF32(a, b, c) __builtin_amdgcn_mfma_f32_32x32x16_f16(__builtin_bit_cast(h16x8, (a)), __builtin_bit_cast(h16x8, (b)), (c), 0, 0, 0)
#define LFW(off) ((__attribute__((address_space(3))) float*)(R + W_SC + (off)))
__device__ __forceinline__ s16x4 vtr(lds_cptr p) { return __builtin_bit_cast(s16x4, __builtin_amdgcn_ds_read_tr16_b64_v4i16((__attribute__((address_space(3))) v4i16_t*)p)); }
__device__ __forceinline__ s16x8 trfrag(lds_cptr img, int blk, int ks, int lb) {
    const s16x4 lo = vtr(img + blk * 4096 + ks * 1024 + lb), hi = vtr(img + blk * 4096 + ks * 1024 + 512 + lb);
    return (s16x8){lo[0], lo[1], lo[2], lo[3], hi[0], hi[1], hi[2], hi[3]};
}
__device__ __forceinline__ void stage_v(lds_ptr R, const h16* __restrict__ vsrc  , int lane) {
    int ln = lane; asm volatile("" : "+v"(ln));
    const h16* vp = vsrc + (size_t)(ln >> 2) * PW + (ln & 3) * 8;
#pragma unroll 1
    for (int sg = 0; sg < 4; ++sg) {
        h16x8 x[4];
#pragma unroll
        for (int vb = 0; vb < 4; ++vb) x[vb] = *(const h16x8*)(vp + 32 * vb);
#pragma unroll
        for (int vb = 0; vb < 4; ++vb) *(__attribute__((address_space(3))) h16x8*)(R + W_V + vb * 4096 + sg * 1024 + ln * 16) = x[vb];
        vp += (size_t)16 * PW; }
}
__device__ __forceinline__ void x1_wave(int item, int b0, const h16* __restrict__ proj, const float* __restrict__ small, const float* __restrict__ convw,
                                        h16* __restrict__ qkc, float* __restrict__ U, float* __restrict__ un, float* __restrict__ amax, float* __restrict__ blast, lds_ptr R, int lane_in) {
    int lane = threadIdx.x & 63; (void)lane_in; asm volatile("" : "+v"(lane));
    const int r32 = lane & 31, hi = lane >> 5;
    const int c = item & 31, hh = (item >> 5) & 3, bl = item >> 7;
    const size_t row0 = (size_t)bl * SEQ + c * 64;
    const int gbh = (b0 + bl) * 4 + hh, lbh = bl * 4 + hh;
    float ws;
    {   const float* sp = small + ((size_t)b0 * SEQ + row0 + lane) * 16;
        const float li = sp[8 + hh], lf = sp[12 + hh];
        float bc = lf;
#pragma unroll
        for (int o = 1; o < 64; o <<= 1) { const float u = shfl_idx(bc, lane - o); if (lane >= o) bc += u; }
        const float as = li - bc; float mx = as;
#pragma unroll
        for (int o = 1; o < 64; o <<= 1) mx = fmaxf(mx, shfl_idx(mx, lane ^ o));
        ws = __expf(as - mx);
        if (lane == 63) { amax[gbh * 32 + c] = mx; blast[gbh * 32 + c] = bc; } }
    stage_v(R, proj + row0 * PW + PC_CV + hh * 128, lane);
    const int t = c * 64 + lane;
#pragma unroll 1
    for (int dg = 0; dg < 16; ++dg) {
        const int isk = dg >> 3, pcol = isk ? 256 + hh * 64 + (dg - 8) * 8 : hh * 64 + dg * 8;
        float acc[8];
#pragma unroll
        for (int e = 0; e < 8; ++e) acc[e] = 0.f;
#pragma unroll
        for (int j = 0; j < 4; ++j) {
            const int tt = t - 3 + j, tc = tt < 0 ? 0 : tt;
            const h16x8 x = *(const h16x8*)(proj + ((size_t)bl * SEQ + tc) * PW + PC_CQK + pcol);
            const float m = tt < 0 ? 0.f : 1.f;
            const float* wp = convw + j * 512 + pcol;
#pragma unroll
            for (int e = 0; e < 8; ++e) acc[e] += wp[e] * m * (float)x[e];
        }
        h16x8 o, ow;
#pragma unroll
        for (int e = 0; e < 8; ++e) { float v = acc[e] * __builtin_amdgcn_rcpf(1.f + __expf(-acc[e])); if (isk) v *= 0.125f; o[e] = (h16)v; ow[e] = (h16)(v * ws); }
        *(h16x8*)(qkc + (row0 + lane) * 512 + pcol) = o;
        if (isk) { const int dgk = dg - 8; *(__attribute__((address_space(3))) h16x8*)(R + W_K + (dgk >> 2) * 4096 + lane * 64 + (dgk & 3) * 16) = ow; }
    }
    asm volatile("s_waitcnt lgkmcnt(0)" ::: "memory");
    const int lb = ((lane >> 4) & 1) * 32 + (lane & 3) * 8 + (4 * hi + ((lane & 15) >> 2)) * 64;
    float* up = U + ((size_t)lbh * 32 + c) * 8192;
#pragma unroll 1
    for (int vb = 0; vb < 4; ++vb) {
        f32x16 a0 = f32x16{}, a1 = f32x16{};
#pragma unroll
        for (int ks = 0; ks < 4; ++ks) { const s16x8 vf = trfrag((lds_cptr)(R + W_V), vb, ks, lb);
            a0 = MF32(vf, trfrag((lds_cptr)(R + W_K), 0, ks, lb), a0); a1 = MF32(vf, trfrag((lds_cptr)(R + W_K), 1, ks, lb), a1); }
#pragma unroll
        for (int r = 0; r < 16; ++r) { up[(vb * 32 + crow(r, hi)) * 64 + r32] = a0[r]; up[(vb * 32 + crow(r, hi)) * 64 + 32 + r32] = a1[r]; }
    }
    {   float sum = 0.f;
        lds_cptr kp = (lds_cptr)(R + W_K) + (lane >> 5) * 4096 + (lane & 31) * 2;
#pragma unroll 16
        for (int q = 0; q < 64; ++q) sum += (float)*(const __attribute__((address_space(3))) h16*)(kp + q * 64);
        un[((size_t)gbh * 32 + c) * 64 + lane] = sum; }
    asm volatile("s_waitcnt lgkmcnt(0)" ::: "memory");
}
__device__ __forceinline__ void x2_item(int item, int b0, const float* __restrict__ U, const float* __restrict__ un, const float* __restrict__ amax, const float* __restrict__ blast,
                                        h16* __restrict__ CS, float* __restrict__ ns, float* __restrict__ Ms, char* shm) {
    int tid_ = threadIdx.x; asm volatile("" : "+v"(tid_));
    const int tid = tid_, lbh = item >> 3, sl = item & 7, gbh = (b0 + (lbh >> 2)) * 4 + (lbh & 3);
    float* coef = (float*)shm;
    if (tid == 0) { float M = 0.f; if (sl == 0) Ms[gbh * 32] = 0.f;
        for (int c = 0; c < 31; ++c) { const float am = amax[gbh * 32 + c], bls = blast[gbh * 32 + c], Mn = bls + fmaxf(M, am);
            coef[2 * c] = __expf(bls + M - Mn); coef[2 * c + 1] = __expf(bls + am - Mn); M = Mn; if (sl == 0) Ms[gbh * 32 + c + 1] = M; } }
    __syncthreads();
    {   const int e2 = sl * 1024 + tid * 2;
        const float* up = U + (size_t)lbh * 32 * 8192 + e2; h16* cp = CS + (size_t)lbh * 32 * 8192 + e2;
        float c0 = 0.f, c1 = 0.f;
        *(pg8::h16x2*)cp = (pg8::h16x2){(h16)0.f, (h16)0.f};
#pragma unroll 1
        for (int cb = 0; cb < 31; cb += 8) {
            pg8::f32x2 u[8];
#pragma unroll
            for (int j = 0; j < 8; ++j) if (cb + j < 31) u[j] = *(const pg8::f32x2*)(up + (size_t)(cb + j) * 8192);
#pragma unroll
            for (int j = 0; j < 8; ++j) if (cb + j < 31) { const float fd = coef[2 * (cb + j)], fi = coef[2 * (cb + j) + 1];
                c0 = fd * c0 + fi * u[j].x; c1 = fd * c1 + fi * u[j].y;
                *(pg8::h16x2*)(cp + (size_t)(cb + j + 1) * 8192) = (pg8::h16x2){(h16)c0, (h16)c1}; }
        }
    }
    if (sl == 0 && tid < 64) { float n = 0.f; ns[((size_t)gbh * 32) * 64 + tid] = 0.f;
        for (int c = 0; c < 31; ++c) { n = coef[2 * c] * n + coef[2 * c + 1] * un[((size_t)gbh * 32 + c) * 64 + tid]; ns[((size_t)gbh * 32 + c + 1) * 64 + tid] = n; } }
    __syncthreads();
}
__device__ __forceinline__ void x3_wave(int item, int b0, const h16* __restrict__ proj, const float* __restrict__ small, const h16* __restrict__ qkc, const h16* __restrict__ CS,
                                        const float* __restrict__ ns, const float* __restrict__ Ms, const float* __restrict__ headg, h16* __restrict__ y, lds_ptr R, int lane_in) {
    int lane = threadIdx.x & 63; (void)lane_in; asm volatile("" : "+v"(lane));
    const int c = item & 31, hh = (item >> 5) & 3, bl = item >> 7;
    const size_t row0 = (size_t)bl * SEQ + c * 64;
    const int gbh = (b0 + bl) * 4 + hh, lbh = bl * 4 + hh;
    {   const float* sp = small + ((size_t)b0 * SEQ + row0 + lane) * 16;
        const float li = sp[8 + hh], lf = sp[12 + hh], Mc = Ms[gbh * 32 + c];
        float bc = lf;
#pragma unroll
        for (int o = 1; o < 64; o <<= 1) { const float u = shfl_idx(bc, lane - o); if (lane >= o) bc += u; }
        const float as = li - bc; float pm = as;
#pragma unroll
        for (int o = 1; o < 64; o <<= 1) { const float u = shfl_idx(pm, lane - o); if (lane >= o) pm = fmaxf(pm, u); }
        const float mx = fmaxf(Mc, pm);
        LFW(0)[lane] = as; LFW(256)[lane] = mx; LFW(512)[lane] = __expf(Mc - mx); LFW(768)[lane] = __expf(-(bc + mx));
        LFW(1280)[lane] = ns[((size_t)gbh * 32 + c) * 64 + lane]; }
    stage_v(R, proj + row0 * PW + PC_CV + hh * 128, lane);
    asm volatile("s_waitcnt lgkmcnt(0)" ::: "memory");
    const h16* cprev = CS + ((size_t)lbh * 32 + c) * 8192;
    typedef __attribute__((address_space(3))) const f32x4 lds_cf32x4;
#pragma unroll 1
    for (int tb = 0; tb < 2; ++tb) {
        int l2 = lane; asm volatile("" : "+v"(l2));
        const int r32 = l2 & 31, hi = l2 >> 5;
        const int lb = ((l2 >> 4) & 1) * 32 + (l2 & 3) * 8 + (4 * hi + ((l2 & 15) >> 2)) * 64;
        const int t = 32 * tb + r32;
        s16x8 qr[4];
#pragma unroll
        for (int ks = 0; ks < 4; ++ks) qr[ks] = *(const s16x8*)(qkc + (row0 + t) * 512 + hh * 64 + 16 * ks + 8 * hi);
        const float mxt = LFW(256)[t], wit = LFW(512)[t];
        float nq = 0.f;
#pragma unroll
        for (int ks = 0; ks < 4; ++ks) { const h16x8 qv = __builtin_bit_cast(h16x8, qr[ks]);
            const f32x4 n0 = *(lds_cf32x4*)(R + W_SC + 1280 + (16 * ks + 8 * hi) * 4), n1 = *(lds_cf32x4*)(R + W_SC + 1280 + (16 * ks + 8 * hi + 4) * 4);
            nq += (float)qv[0] * n0[0] + (float)qv[1] * n0[1] + (float)qv[2] * n0[2] + (float)qv[3] * n0[3] + (float)qv[4] * n1[0] + (float)qv[5] * n1[1] + (float)qv[6] * n1[2] + (float)qv[7] * n1[3]; }
        nq = half_sum(nq);
        f32x16 p0 = f32x16{}, p1 = f32x16{};
#pragma unroll
        for (int ks = 0; ks < 4; ++ks) { const s16x8 k0 = *(const s16x8*)(qkc + (row0 + r32) * 512 + 256 + hh * 64 + 16 * ks + 8 * hi); p0 = MF32(k0, qr[ks], p0); }
        if (tb == 1) {
#pragma unroll
            for (int ks = 0; ks < 4; ++ks) { const s16x8 k1 = *(const s16x8*)(qkc + (row0 + 32 + r32) * 512 + 256 + hh * 64 + 16 * ks + 8 * hi); p1 = MF32(k1, qr[ks], p1); } }
        float dsum = 0.f;
#pragma unroll
        for (int g = 0; g < 4; ++g) { const f32x4 a0 = *(lds_cf32x4*)(R + W_SC + (8 * g + 4 * hi) * 4), a1 = *(lds_cf32x4*)(R + W_SC + (32 + 8 * g + 4 * hi) * 4);
#pragma unroll
            for (int i = 0; i < 4; ++i) { const int s0 = 8 * g + 4 * hi + i;
                const float w0 = s0 <= t ? p0[4 * g + i] * __expf(a0[i] - mxt) : 0.f; p0[4 * g + i] = w0; dsum += w0;
                const float w1 = (tb == 1 && s0 + 32 <= t) ? p1[4 * g + i] * __expf(a1[i] - mxt) : 0.f; p1[4 * g + i] = w1; dsum += w1; } }
        dsum = half_sum(dsum);
        if (hi == 0) LFW(1024)[t] = dsum + wit * nq;
        u32x4 pw0, pw1, pw2, pw3;
#define PKW(P, B) pg8::cvt_pk_f16(P[B], P[B + 1])
        pw0 = (u32x4){PKW(p0, 0), PKW(p0, 2), PKW(p0, 4), PKW(p0, 6)}; pw1 = (u32x4){PKW(p0, 8), PKW(p0, 10), PKW(p0, 12), PKW(p0, 14)};
        pw2 = (u32x4){PKW(p1, 0), PKW(p1, 2), PKW(p1, 4), PKW(p1, 6)}; pw3 = (u32x4){PKW(p1, 8), PKW(p1, 10), PKW(p1, 12), PKW(p1, 14)};
#undef PKW
        s16x8 qs[4];
        { const h16 wh = (h16)wit;
#pragma unroll
          for (int ks = 0; ks < 4; ++ks) { h16x8 qv = __builtin_bit_cast(h16x8, qr[ks]);
#pragma unroll
              for (int e = 0; e < 8; ++e) qv[e] = qv[e] * wh;
              qs[ks] = __builtin_bit_cast(s16x8, qv); } }
        f32x16 acc[4];
#pragma unroll
        for (int vb = 0; vb < 4; ++vb) { acc[vb] = f32x16{};
#pragma unroll
            for (int ks = 0; ks < 4; ++ks) { const s16x8 cf = *(const s16x8*)(cprev + (32 * vb + r32) * 64 + 16 * ks + 8 * hi); acc[vb] = MF32(qs[ks], cf, acc[vb]); }
            acc[vb] = MF32(__builtin_bit_cast(s16x8, pw0), trfrag((lds_cptr)(R + W_V), vb, 0, lb), acc[vb]);
            acc[vb] = MF32(__builtin_bit_cast(s16x8, pw1), trfrag((lds_cptr)(R + W_V), vb, 1, lb), acc[vb]);
            if (tb == 1) { acc[vb] = MF32(__builtin_bit_cast(s16x8, pw2), trfrag((lds_cptr)(R + W_V), vb, 2, lb), acc[vb]);
                           acc[vb] = MF32(__builtin_bit_cast(s16x8, pw3), trfrag((lds_cptr)(R + W_V), vb, 3, lb), acc[vb]); } }
        asm volatile("s_waitcnt lgkmcnt(0)" ::: "memory");
#pragma unroll
        for (int g = 0; g < 4; ++g) { const f32x4 dn = *(lds_cf32x4*)(R + W_SC + 1024 + (32 * tb + 8 * g + 4 * hi) * 4), em = *(lds_cf32x4*)(R + W_SC + 768 + (32 * tb + 8 * g + 4 * hi) * 4);
#pragma unroll
            for (int i = 0; i < 4; ++i) { const float inv = __builtin_amdgcn_rcpf(fmaxf(fabsf(dn[i]), em[i])); const int rl = 8 * g + 4 * hi + i;
#pragma unroll
                for (int vb = 0; vb < 4; ++vb) *(__attribute__((address_space(3))) h16*)(R + W_K + rl * 272 + (32 * vb + r32) * 2) = (h16)(acc[vb][4 * g + i] * inv); } }
        asm volatile("s_waitcnt lgkmcnt(0)" ::: "memory");
#pragma unroll 1
        for (int ps = 0; ps < 2; ++ps) {
            int l3 = threadIdx.x & 63; asm volatile("" : "+v"(l3));
            const int rl = 16 * ps + (l3 >> 2), v0 = (l3 & 3) * 32;
            const size_t row = row0 + 32 * tb + rl;
            float hg[32]; float ss = 0.f;
#pragma unroll
            for (int q = 0; q < 4; ++q) { const h16x8 hv = *(const __attribute__((address_space(3))) h16x8*)(R + W_K + rl * 272 + (v0 + 8 * q) * 2);
                const h16x8 og = *(const h16x8*)(proj + row * PW + PC_CO + hh * 128 + v0 + 8 * q);
#pragma unroll
                for (int e = 0; e < 8; ++e) { const float x = (float)hv[e] * __builtin_amdgcn_rcpf(1.f + __expf(-(float)og[e])); hg[8 * q + e] = x; ss += x * x; } }
            ss += swz_xor<1>(ss); ss += swz_xor<2>(ss);
            const float rn = rsqrtf(ss * (1.f / 128.f) + RMS_EPS);
#pragma unroll
            for (int q = 0; q < 4; ++q) { const h16x8 zv = *(const h16x8*)(proj + row * PW + PC_CZ + hh * 128 + v0 + 8 * q);
                const f32x4 g0 = *(const f32x4*)(headg + hh * 128 + v0 + 8 * q), g1 = *(const f32x4*)(headg + hh * 128 + v0 + 8 * q + 4);
                float ov[8];
#pragma unroll
                for (int e = 0; e < 8; ++e) { const float zz = (float)zv[e]; ov[e] = hg[8 * q + e] * rn * (e < 4 ? g0[e] : g1[e - 4]) * zz * __builtin_amdgcn_rcpf(1.f + __expf(-zz)); }
                u32x4 w; w.x = pg8::cvt_pk_f16(ov[0], ov[1]); w.y = pg8::cvt_pk_f16(ov[2], ov[3]); w.z = pg8::cvt_pk_f16(ov[4], ov[5]); w.w = pg8::cvt_pk_f16(ov[6], ov[7]);
                *(u32x4*)(y + row * 1536 + 1024 + hh * 128 + v0 + 8 * q) = w; }
        }
        asm volatile("s_waitcnt lgkmcnt(0)" ::: "memory");
    }
}
#undef LFW
#undef MF32
}

#define LAS __attribute__((address_space(3)))
#define XB_TMO      128
#define XB_XCNT(j)  (256  + 64 * (j))
#define XB_XSUB(j)  (1280 + 64 * (j))
#define XB_XGEN(j)  (2304 + 64 * (j))
#define XB_TOP      3328
#define XB_TOPGEN   3392
#define XCD_BAR_WORDS 3456
#define XB_SPIN_CAP (1u << 18)
__device__ __forceinline__ unsigned xb_ld(unsigned* p)              { return __hip_atomic_load(p, __ATOMIC_RELAXED, __HIP_MEMORY_SCOPE_AGENT); }
__device__ __forceinline__ unsigned xb_add(unsigned* p, unsigned v) { return __hip_atomic_fetch_add(p, v, __ATOMIC_RELAXED, __HIP_MEMORY_SCOPE_AGENT); }
__device__ __forceinline__ unsigned xb_xcc_id() { return (unsigned)__builtin_amdgcn_s_getreg((3 << 11) | 20) & 0xFu; }
#define XB_SPIN(cond, bar) do { unsigned _sp = 0; while (cond) { __builtin_amdgcn_s_sleep(1); \
    if ((++_sp & 255u) == 0u) { if (xb_ld(&(bar)[XB_TMO])) break; if (_sp > XB_SPIN_CAP) { atomicAdd(&(bar)[XB_TMO], 1u); break; } } } } while (0)
struct XcdBarrier { unsigned* bar; unsigned x; volatile LAS unsigned* st; };
__device__ __forceinline__ XcdBarrier xcd_barrier_post(unsigned* bar, volatile LAS unsigned* st) {
    XcdBarrier b; b.bar = bar; b.x = xb_xcc_id(); b.st = st;
    if (threadIdx.x == 0) (void)xb_add(&bar[XB_XCNT(b.x)], 1u);
    return b;
}
__device__ __forceinline__ void xcd_barrier_complete(unsigned* bar, unsigned x, unsigned& nloc, unsigned& nx) {
    const unsigned G = gridDim.x * gridDim.y * gridDim.z;
    unsigned sum, cnt, mine, sp = 0u;
    for (;;) {
        sum = 0u; cnt = 0u; mine = 0u;
#pragma unroll
        for (unsigned j = 0; j < 16; ++j) { const unsigned c = xb_ld(&bar[XB_XCNT(j)]); sum += c; cnt += (c > 0u) ? 1u : 0u; mine = (j == x) ? c : mine; }
        if (sum == G) break;
        __builtin_amdgcn_s_sleep(1);
        if ((++sp & 255u) == 0u) { if (xb_ld(&bar[XB_TMO])) break; if (sp > XB_SPIN_CAP) { atomicAdd(&bar[XB_TMO], 1u); break; } }
    }
    nloc = mine > 0u ? mine : 1u; nx = cnt > 0u ? cnt : 1u;
}
__device__ __forceinline__ void xcd_barrier(const XcdBarrier& b) {
    asm volatile("s_waitcnt vmcnt(0)" ::: "memory");
    __syncthreads();
    if (threadIdx.x == 0) {
        unsigned* bar = b.bar;
        __builtin_amdgcn_s_waitcnt(0);
        unsigned nloc = b.st[0], nx = b.st[1];
        if (nloc == 0u) { xcd_barrier_complete(bar, b.x, nloc, nx); b.st[0] = nloc; b.st[1] = nx; }
        const unsigned old = xb_add(&bar[XB_XSUB(b.x)], 1u);
        const unsigned gen = old / nloc;
        if (old + 1u == (gen + 1u) * nloc) {
            __builtin_amdgcn_fence(__ATOMIC_RELEASE, "agent");
            asm volatile("s_waitcnt vmcnt(0)" ::: "memory");
            const unsigned og = xb_add(&bar[XB_TOP], 1u);
            const unsigned tg = og / nx;
            if (og + 1u == (tg + 1u) * nx) xb_add(&bar[XB_TOPGEN], 1u);
            else XB_SPIN(xb_ld(&bar[XB_TOPGEN]) == tg, bar);
            __builtin_amdgcn_fence(__ATOMIC_ACQUIRE, "agent");
            xb_add(&bar[XB_XGEN(b.x)], 1u);
            asm volatile("s_waitcnt vmcnt(0)" ::: "memory");
        } else {
            XB_SPIN(xb_ld(&bar[XB_XGEN(b.x)]) == gen, bar);
            __builtin_amdgcn_fence(__ATOMIC_ACQUIRE, "agent");
            asm volatile("s_waitcnt vmcnt(0)" ::: "memory");
        }
    }
    __syncthreads();
}
constexpr int LDSCTL_OFF = 131072, MISC_OFF = LDSCTL_OFF + 320;
constexpr int CW_BAR = 4096;
constexpr size_t CTL_ZERO_BYTES = 65536;

__device__ __forceinline__ void transpose_item(const float* __restrict__ W, int ldsrc, int K, h16* __restrict__ WT, int k0, int n0, int src_col0, float scale, PG8_LAS float* scr, int lane) {
#pragma unroll 8
    for (int i = 0; i < 32; ++i) { const int kk = 2 * i + (lane >> 5); scr[kk * 33 + (lane & 31)] = W[(size_t)(k0 + kk) * ldsrc + src_col0 + (lane & 31)]; }
    asm volatile("s_waitcnt lgkmcnt(0)" ::: "memory");
    const int c = lane & 7;
#pragma unroll
    for (int j = 0; j < 4; ++j) { const int n = (lane >> 3) + 8 * j; const PG8_LAS float* sp = scr + (8 * c) * 33 + n;
        pg8::u32x4 o; o.x = pg8::cvt_pk_f16(sp[0 * 33] * scale, sp[1 * 33] * scale); o.y = pg8::cvt_pk_f16(sp[2 * 33] * scale, sp[3 * 33] * scale);
        o.z = pg8::cvt_pk_f16(sp[4 * 33] * scale, sp[5 * 33] * scale); o.w = pg8::cvt_pk_f16(sp[6 * 33] * scale, sp[7 * 33] * scale);
        *(pg8::u32x4*)(WT + (size_t)(n0 + n) * K + k0 + 8 * c) = o; }
    asm volatile("s_waitcnt lgkmcnt(0)" ::: "memory");
}
__device__ __forceinline__ void prologue_phase(const MArgs& a, PG8_LAS unsigned char* L) {
    int tid_ = threadIdx.x; asm volatile("" : "+v"(tid_));
    const int lane = tid_ & 63, wave = tid_ >> 6;
    PG8_LAS float* scr = (PG8_LAS float*)(L + wave * 16384);
    const int gw = blockIdx.x * NWAVES + wave, NGW = gridDim.x * NWAVES;
    constexpr int I_IN = (DM / 64) * (PW / 32), I_BR = (512 / 64) * (1024 / 32), I_OUT = (DM / 64) * (DM / 32), I_L = I_IN + 3 * I_BR + I_OUT;
    unsigned char* ws = a.ws;
    for (int it = gw; it < DEPTH * I_L; it += NGW) {
        const int l = it / I_L; int r = it - l * I_L;
        if (r < I_IN) { const int nblk = PW / 32, kb = r / nblk, nb = r % nblk, n0 = nb * 32;
            const float sc = ((n0 >= PC_AQ && n0 < PC_AQ + 512) || (n0 >= PC_BQ && n0 < PC_BQ + 512)) ? C2 : 1.f;
            transpose_item(a.in[2] + (size_t)l * DM * INW, INW, DM, (h16*)(ws + WS_WIN) + (size_t)l * PW * DM, kb * 64, n0, orig_col(n0), sc, scr, lane); continue; }
        r -= I_IN;
        if (r < 3 * I_BR) { const int n3 = r / I_BR, q = r % I_BR, nblk = 1024 / 32, kb = q / nblk, nb = q % nblk;
            transpose_item(a.in[8] + ((size_t)l * 3 + n3) * 512 * 1024, 1024, 512, (h16*)(ws + WS_WBR) + ((size_t)l * 3 + n3) * 1024 * 512, kb * 64, nb * 32, nb * 32, 1.f, scr, lane); continue; }
        r -= 3 * I_BR;
        { const int nblk = DM / 32, kb = r / nblk, nb = r % nblk;
          transpose_item(a.in[9] + (size_t)l * DM * DM, DM, DM, (h16*)(ws + WS_WOUT) + (size_t)l * DM * DM, kb * 64, nb * 32, nb * 32, 1.f, scr, lane); }
    }
    float* wsmall = (float*)(ws + WS_WSMALL);
    for (int i = blockIdx.x * NTHREADS + tid_; i < DEPTH * 16 * DM; i += gridDim.x * NTHREADS) {
        const int l = i / (16 * DM), c = (i >> 10) & 15, k = i & 1023;
        wsmall[i] = a.in[2][(size_t)l * DM * INW + (size_t)k * INW + small_col(c)];
    }
}
__device__ __forceinline__ void norm_phase(const float* __restrict__ x, const float* __restrict__ g, const float* __restrict__ wsmall, const float* __restrict__ fox_bf,
                                           const float* __restrict__ ml_bi, const float* __restrict__ ml_bf, h16* __restrict__ hn, float* __restrict__ small, int row0) {
    int tid_ = threadIdx.x; asm volatile("" : "+v"(tid_));
    const int lane = tid_ & 63, gw = blockIdx.x * NWAVES + (tid_ >> 6), NGW = gridDim.x * NWAVES;
    for (int r4 = gw; r4 < TH / 4; r4 += NGW) {
        f32x4 v[4][4];
#pragma unroll
        for (int q = 0; q < 4; ++q) {
            const f32x4* xr = (const f32x4*)(x + (size_t)(row0 + 4 * r4 + q) * DM) + lane;
            float ssq = 0.f;
#pragma unroll
            for (int j = 0; j < 4; ++j) { v[q][j] = xr[64 * j]; ssq += v[q][j].x * v[q][j].x + v[q][j].y * v[q][j].y + v[q][j].z * v[q][j].z + v[q][j].w * v[q][j].w; }
            const float rstd = rsqrtf(wave_sum(ssq) * (1.f / DM) + RMS_EPS);
#pragma unroll
            for (int j = 0; j < 4; ++j) {
                const f32x4 gg = ((const f32x4*)g)[lane + 64 * j];
                v[q][j].x *= rstd * gg.x; v[q][j].y *= rstd * gg.y; v[q][j].z *= rstd * gg.z; v[q][j].w *= rstd * gg.w;
                pg8::u32x4 dummy; (void)dummy;
                typedef unsigned u32x2 __attribute__((ext_vector_type(2)));
                u32x2 o; o.x = pg8::cvt_pk_f16(v[q][j].x, v[q][j].y); o.y = pg8::cvt_pk_f16(v[q][j].z, v[q][j].w);
                *((u32x2*)(hn + (size_t)(4 * r4 + q) * DM) + lane + 64 * j) = o;
            }
        }
        float mine[4] = {0.f, 0.f, 0.f, 0.f};
#pragma unroll 1
        for (int c = 0; c < 16; ++c) {
            const f32x4* wr = (const f32x4*)(wsmall + c * DM) + lane;
            float acc[4] = {0.f, 0.f, 0.f, 0.f};
#pragma unroll
            for (int j = 0; j < 4; ++j) { const f32x4 w = wr[64 * j];
#pragma unroll
                for (int q = 0; q < 4; ++q) acc[q] += v[q][j].x * w.x + v[q][j].y * w.y + v[q][j].z * w.z + v[q][j].w * w.w; }
#pragma unroll
            for (int q = 0; q < 4; ++q) { const float t = wave_sum(acc[q]); if (lane == c) mine[q] = t; }
        }
        if (lane < 16) {
            const float bias = lane < 8 ? fox_bf[lane] : lane < 12 ? ml_bi[lane - 8] : ml_bf[lane - 12];
#pragma unroll
            for (int q = 0; q < 4; ++q) { const float pre = mine[q] + bias; small[(size_t)(row0 + 4 * r4 + q) * 16 + lane] = (lane >= 8 && lane < 12) ? pre : log_sigmoidf_(pre); }
        }
    }
}
__device__ __forceinline__ void final_norm_phase(float* __restrict__ x, const float* __restrict__ g) {
    int tid_ = threadIdx.x; asm volatile("" : "+v"(tid_));
    const int lane = tid_ & 63, gw = blockIdx.x * NWAVES + (tid_ >> 6), NGW = gridDim.x * NWAVES;
    for (int row = gw; row < TT; row += NGW) {
        f32x4* xr = (f32x4*)(x + (size_t)row * DM) + lane;
        f32x4 v[4]; float ssq = 0.f;
#pragma unroll
        for (int j = 0; j < 4; ++j) { v[j] = xr[64 * j]; ssq += v[j].x * v[j].x + v[j].y * v[j].y + v[j].z * v[j].z + v[j].w * v[j].w; }
        const float rstd = rsqrtf(wave_sum(ssq) * (1.f / DM) + RMS_EPS);
#pragma unroll
        for (int j = 0; j < 4; ++j) { const f32x4 gg = ((const f32x4*)g)[lane + 64 * j];
            xr[64 * j] = (f32x4){v[j].x * rstd * gg.x, v[j].y * rstd * gg.y, v[j].z * rstd * gg.z, v[j].w * rstd * gg.w}; }
    }
}

__global__ void __launch_bounds__(NTHREADS, 2) mega(MArgs a) {
    extern __shared__ __attribute__((aligned(16))) unsigned char lds[];
    PG8_LAS unsigned char* L = (PG8_LAS unsigned char*)lds;
    unsigned char* ws = a.ws;
    for (int u = threadIdx.x; u < (MK_LDS_BYTES - LDSCTL_OFF) / 4; u += NTHREADS) ((LAS unsigned*)(L + LDSCTL_OFF))[u] = 0u;
    __syncthreads();
    XcdBarrier bar = xcd_barrier_post((unsigned*)(ws + WS_CTL) + CW_BAR, (volatile LAS unsigned*)(L + MISC_OFF) + 8);
    for (int s = a.s_lo; s < a.s_hi; ++s) {
        if (s == a.s_lo + 1) { __builtin_amdgcn_fence(__ATOMIC_RELEASE, "agent"); cg::this_grid().sync(); __builtin_amdgcn_fence(__ATOMIC_ACQUIRE, "agent"); }
        else if (s > a.s_lo) xcd_barrier(bar);
        if (s == 0) { prologue_phase(a, L); barrier_lds(); continue; }
        if (s == N_STEPS - 1) { final_norm_phase(a.out, a.in[10]); continue; }
        const int li = (s - 1) / NPH, ph = (s - 1) % NPH, layer = li >> 1, hf = li & 1;
        const int row0 = hf * TH;
        if (ph == PH_NORM) {
            norm_phase(layer == 0 ? a.in[0] : a.out, a.in[1] + layer * DM, (const float*)(ws + WS_WSMALL) + layer * 16 * DM, a.in[3] + layer * 8, a.in[5] + layer * 4, a.in[6] + layer * 4,
                       (h16*)(ws + WS_HN), (float*)(ws + WS_SMALL), row0);
        } else if (ph == PH_PRE) {
            const int b0 = hf * HB;
            for (int it = blockIdx.x; it < HB * 8; it += gridDim.x) fox_cumsum_item(it, b0, (const float*)(ws + WS_SMALL), (float*)(ws + WS_CB), (char*)lds);
            for (int it = blockIdx.x; it < HB * 64; it += gridDim.x) moba_kmean_item(it, b0, (const h16*)(ws + WS_PROJ), (float*)(ws + WS_KMEAN), (char*)lds);
            {   int tid_ = threadIdx.x; asm volatile("" : "+v"(tid_));
                const int wv = __builtin_amdgcn_readfirstlane(tid_ >> 6), ln = tid_ & 63;
                if (wv < mlstm::NACT) for (int it = blockIdx.x * mlstm::NACT + wv; it < HB * 128; it += gridDim.x * mlstm::NACT)
                    mlstm::x1_wave(it, b0, (const h16*)(ws + WS_PROJ), (const float*)(ws + WS_SMALL), a.in[4] + (size_t)layer * 4 * 512, (h16*)(ws + WS_QKC), (float*)(ws + WS_U),
                                   (float*)(ws + WS_MUN), (float*)(ws + WS_MAMAX), (float*)(ws + WS_MBLAST), (mlstm::lds_ptr)L + wv * mlstm::WREG, ln);
                barrier_lds(); }
        } else if (ph == PH_SCAN) {
            for (int it = blockIdx.x; it < 32 * 8; it += gridDim.x)
                mlstm::x2_item(it, hf * HB, (const float*)(ws + WS_U), (const float*)(ws + WS_MUN), (const float*)(ws + WS_MAMAX), (const float*)(ws + WS_MBLAST),
                               (h16*)(ws + WS_CS), (float*)(ws + WS_MNS), (float*)(ws + WS_MMS), (char*)lds);
        } else if (ph == PH_MIX) {
            const int b0 = hf * HB, G = gridDim.x, bx = blockIdx.x;
            const int vcu = (G % 8 == 0) ? (bx % 8) * (G / 8) + bx / 8 : bx;
            const h16* proj = (const h16*)(ws + WS_PROJ); h16* y = (h16*)(ws + WS_Y);
            for (int v = vcu; v < 256; v += G) {
                const int bh = v >> 2, sidx = v & 3, bl = bh >> 3, h = bh & 7;
                const float* cbp = (const float*)(ws + WS_CB) + (size_t)((b0 + bl) * 8 + h) * SEQ;
                const float* kmp = (const float*)(ws + WS_KMEAN) + (size_t)((b0 + bl) * 8 + h) * 512;
                const float slope2 = exp2f(-(float)(h + 1)) * LOG2E;
#pragma unroll 1
                for (int i = 0; i < 4; ++i) {
                    const int qb = (i < 2) ? 7 - sidx : sidx;
                    if ((i & 1) == 0) attn_body::attn_unit<false, 8>(bl, h, qb, proj + PC_AQ, proj + PC_AK, proj + PC_AV, proj + PC_AZ, y, cbp, 0.f, kmp, (char*)lds);
                    else attn_body::attn_unit<true, 8>(bl, h, qb, proj + PC_BQ, proj + PC_BK, proj + PC_BV, proj + PC_BZ, y + 512, cbp, slope2, kmp, (char*)lds);
                }
            }
            {   int tid_ = threadIdx.x; asm volatile("" : "+v"(tid_));
                const int wv = __builtin_amdgcn_readfirstlane(tid_ >> 6), ln = tid_ & 63;
                if (wv < mlstm::NACT) for (int it = blockIdx.x * mlstm::NACT + wv; it < HB * 128; it += gridDim.x * mlstm::NACT)
                    mlstm::x3_wave(it, b0, proj, (const float*)(ws + WS_SMALL), (const h16*)(ws + WS_QKC), (const h16*)(ws + WS_CS), (const float*)(ws + WS_MNS), (const float*)(ws + WS_MMS),
                                   a.in[7] + (size_t)layer * 512, y, (mlstm::lds_ptr)L + wv * mlstm::WREG, ln);
                barrier_lds(); }
        } else if (ph == PH_PROJ) {
            pg8::Gemm g{(const h16*)(ws + WS_HN), (const h16*)(ws + WS_WIN) + (size_t)layer * PW * DM, DM, DM, DM, 0, 0};
            pg8::StaticOrder S; S.init(TH, PW, gridDim.x, blockIdx.x);
            pg8::EpiF16 E{(h16*)(ws + WS_PROJ), PW};
            pg8::gemm_phase(L, g, S, E);
        } else if (ph == PH_BR) {
            pg8::Gemm g{(const h16*)(ws + WS_Y), (const h16*)(ws + WS_WBR) + (size_t)layer * 3 * 1024 * 512, 1536, 512, 512, 512, 1024 * 512};
            pg8::BranchOrder S; S.init(TH, DM, gridDim.x, blockIdx.x, 3);
            pg8::EpiGate E{(h16*)(ws + WS_MRG), (const h16*)(ws + WS_PROJ) + PC_G, PW};
            pg8::gemm_phase(L, g, S, E);
        } else if (ph == PH_OUT) {
            pg8::Gemm g{(const h16*)(ws + WS_MRG), (const h16*)(ws + WS_WOUT) + (size_t)layer * DM * DM, DM, DM, DM, 0, 0};
            pg8::StaticOrder S; S.init(TH, DM, gridDim.x, blockIdx.x);
            const float* xsrc = layer == 0 ? a.in[0] : a.out;
            pg8::EpiRes E{xsrc + (size_t)row0 * DM, a.out + (size_t)row0 * DM, DM};
            pg8::gemm_phase(L, g, S, E);
        }
    }
}

extern "C" void kernel_launch(void* const* d_in, const int* in_sizes, int n_in, void* d_out, int out_size, void* d_ws, size_t ws_size, hipStream_t stream) {
    if (n_in != 11 || in_sizes[0] != TT * DM || out_size != TT * DM || ws_size < WS_END) {
        fprintf(stderr, "kernel_launch: unexpected shapes / workspace (n_in %d, in0 %d, out %d, ws %zu < %zu)\n", n_in, n_in > 0 ? in_sizes[0] : -1, out_size, ws_size, (size_t)WS_END);
        return;
    }
    static int grid = 0;
    if (grid == 0) {
        int dev = 0, cus = 0, per_cu = 0;
        hipGetDevice(&dev);
        hipDeviceGetAttribute(&cus, hipDeviceAttributeMultiprocessorCount, dev);
        if (hipFuncSetAttribute((const void*)mega, hipFuncAttributeMaxDynamicSharedMemorySize, MK_LDS_BYTES) != hipSuccess) fprintf(stderr, "kernel_launch: hipFuncSetAttribute failed\n");
        if (hipOccupancyMaxActiveBlocksPerMultiprocessor(&per_cu, (const void*)mega, NTHREADS, MK_LDS_BYTES) != hipSuccess || per_cu < 1) { fprintf(stderr, "kernel_launch: occupancy query says %d blocks per CU\n", per_cu); per_cu = 1; }
        (void)hipGetLastError();
        grid = cus;
        if (grid != 256) fprintf(stderr, "kernel_launch: note: %d CUs (tuned for 256)\n", grid);
    }
    MArgs ma{};
    for (int i = 0; i < 11; ++i) ma.in[i] = (const float*)d_in[i];
    ma.out = (float*)d_out; ma.ws = (unsigned char*)d_ws; ma.s_lo = 0; ma.s_hi = N_STEPS;
    if (hipMemsetAsync((char*)d_ws + WS_CTL, 0, CTL_ZERO_BYTES, stream) != hipSuccess) { fprintf(stderr, "kernel_launch: hipMemsetAsync of the control words failed\n"); return; }
    void* args[] = {&ma};
    hipError_t e = hipLaunchCooperativeKernel((const void*)mega, dim3(grid), dim3(NTHREADS), args, MK_LDS_BYTES, stream);
    if (e != hipSuccess) fprintf(stderr, "kernel_launch: cooperative launch failed: %s (grid %d)\n", hipGetErrorString(e), grid);
}
```

```cpp
#include <hip/hip_runtime.h>
#include <hip/hip_cooperative_groups.h>
#include <cstdio>
#include <cstdint>

namespace cg = cooperative_groups;
typedef _Float16 h16;
typedef _Float16 h16x4 __attribute__((ext_vector_type(4)));
typedef _Float16 h16x8 __attribute__((ext_vector_type(8)));
typedef float f32x4 __attribute__((ext_vector_type(4)));

constexpr int DM = 1024, BATCH = 16, SEQ = 2048, DEPTH = 2;
constexpr int TT = BATCH * SEQ;
constexpr int HB = 8;
constexpr int TH = HB * SEQ;
constexpr int INW = 9232;
constexpr int PW = 9216;
constexpr float RMS_EPS = 1e-6f;
constexpr float LOG2E = 1.4426950408889634f;
constexpr float C2 = 0.125f * LOG2E;
constexpr int PC_AQ = 0, PC_AK = 512, PC_AV = 1024, PC_AZ = 1536, PC_BQ = 2048, PC_BK = 2560, PC_BV = 3072, PC_BZ = 3584,
              PC_CQK = 4096, PC_CV = 4608, PC_CO = 5120, PC_CZ = 5632, PC_G = 6144;
__host__ __device__ inline int orig_col(int j) { return j < 2048 ? j : (j < 6144 ? j + 8 : j + 16); }
__host__ __device__ inline int small_col(int c) { return c < 8 ? 2048 + c : 6152 + (c - 8); }

constexpr size_t MiB = 1u << 20;
constexpr size_t WS_CTL = 0;
constexpr size_t WS_WSMALL = 512 * 1024;
constexpr size_t WS_SMALL = 1 * MiB;
constexpr size_t WS_CB = 3 * MiB;
constexpr size_t WS_KMEAN = 4 * MiB;
constexpr size_t WS_MSC = 5 * MiB;
constexpr size_t WS_MUN = WS_MSC, WS_MNS = WS_MSC + 512 * 1024;
constexpr size_t WS_MAMAX = 4 * MiB + 512 * 1024, WS_MBLAST = WS_MAMAX + 8192, WS_MMS = WS_MAMAX + 16384;
constexpr size_t WS_WBR = 6 * MiB;
constexpr size_t WS_WOUT = 12 * MiB;
constexpr size_t WS_WIN = 16 * MiB;
constexpr size_t WS_HN = 52 * MiB;
constexpr size_t WS_Y = 84 * MiB;
constexpr size_t WS_MRG = WS_HN;
constexpr size_t WS_U = 132 * MiB;
constexpr size_t WS_CS = 164 * MiB;
constexpr size_t WS_QKC = 180 * MiB;
constexpr size_t WS_PROJ = 196 * MiB;
constexpr size_t WS_END = 484 * MiB;

__device__ __forceinline__ float sigmoidf_(float x) { return 1.f / (1.f + __expf(-x)); }
__device__ __forceinline__ float siluf_(float x) { return x / (1.f + __expf(-x)); }
__device__ __forceinline__ float log_sigmoidf_(float x) {
    const float e = __expf(-fabsf(x)); const float l = e < 0.01f ? e * (1.f - 0.5f * e + 0.33333334f * e * e) : __logf(1.f + e); return fminf(x, 0.f) - l; }
template <int M> __device__ __forceinline__ float swz_xor(float v) { return __int_as_float(__builtin_amdgcn_ds_swizzle(__float_as_int(v), (M << 10) | 0x1f)); }
__device__ __forceinline__ float half_sum(float v) { auto rr = __builtin_amdgcn_permlane32_swap(__float_as_uint(v), __float_as_uint(v), false, false); return __uint_as_float(rr[0]) + __uint_as_float(rr[1]); }
__device__ __forceinline__ float shfl_idx(float x, int srclane) { return __int_as_float(__builtin_amdgcn_ds_bpermute(srclane << 2, __float_as_int(x))); }
__device__ __forceinline__ float wave_sum(float v) {
    v += swz_xor<1>(v); v += swz_xor<2>(v); v += swz_xor<4>(v); v += swz_xor<8>(v); v += swz_xor<16>(v);
    return half_sum(v);
}

__global__ void nv_convert_t(const float* __restrict__ src, int ldsrc, int K, h16* __restrict__ dst, int Nd, int mode) {
    __shared__ float tile[32][33];
    const int tx = threadIdx.x & 31, ty = threadIdx.x >> 5;
    const int j0 = blockIdx.x * 32, k0 = blockIdx.y * 32;
#pragma unroll
    for (int i = 0; i < 4; ++i) {
        const int k = k0 + ty + 8 * i, j = j0 + tx;
        const int sc = mode == 1 ? orig_col(j) : j;
        tile[ty + 8 * i][tx] = src[(size_t)k * ldsrc + sc];
    }
    __syncthreads();
#pragma unroll
    for (int i = 0; i < 4; ++i) {
        const int j = j0 + ty + 8 * i, k = k0 + tx;
        float v = tile[tx][ty + 8 * i];
        if (mode == 1 && ((j >= PC_AQ && j < PC_AQ + 512) || (j >= PC_BQ && j < PC_BQ + 512))) v *= C2;
        dst[(size_t)j * K + k] = (h16)v;
    }
}

__global__ void nv_small_w(const float* __restrict__ w_in, float* __restrict__ wsmall) {
    const int i = blockIdx.x * blockDim.x + threadIdx.x;
    if (i >= 16 * DM) return;
    const int c = i >> 10, k = i & 1023;
    wsmall[i] = w_in[(size_t)k * INW + small_col(c)];
}
__global__ void __launch_bounds__(256) nv_rmsnorm_small(const float* __restrict__ x, const float* __restrict__ g, const float* __restrict__ wsmall  ,
                                 const float* __restrict__ fox_bf, const float* __restrict__ ml_bi, const float* __restrict__ ml_bf,
                                 h16* __restrict__ hn, float* __restrict__ small, int row0, int nrows) {
    const int lane = threadIdx.x & 63, wv = (blockIdx.x * blockDim.x + threadIdx.x) >> 6, nw = (gridDim.x * blockDim.x) >> 6;
    for (int r = wv; r < nrows; r += nw) {
        const int row = row0 + r;
        const f32x4* xr = (const f32x4*)(x + (size_t)row * DM) + lane;
        f32x4 v[4]; float s = 0.f;
#pragma unroll
        for (int j = 0; j < 4; ++j) { v[j] = xr[64 * j]; s += v[j].x * v[j].x + v[j].y * v[j].y + v[j].z * v[j].z + v[j].w * v[j].w; }
        const float rstd = rsqrtf(wave_sum(s) * (1.f / DM) + RMS_EPS);
#pragma unroll
        for (int j = 0; j < 4; ++j) {
            const f32x4 gg = ((const f32x4*)g)[lane + 64 * j];
            v[j].x *= rstd * gg.x; v[j].y *= rstd * gg.y; v[j].z *= rstd * gg.z; v[j].w *= rstd * gg.w;
            h16x4 o = {(h16)v[j].x, (h16)v[j].y, (h16)v[j].z, (h16)v[j].w};
            *((h16x4*)(hn + (size_t)r * DM) + lane + 64 * j) = o;
        }
        float mine = 0.f;
#pragma unroll 1
        for (int c = 0; c < 16; ++c) {
            const f32x4* wr = (const f32x4*)(wsmall + c * DM) + lane;
            float a = 0.f;
#pragma unroll
            for (int j = 0; j < 4; ++j) { const f32x4 w = wr[64 * j]; a += v[j].x * w.x + v[j].y * w.y + v[j].z * w.z + v[j].w * w.w; }
            a = wave_sum(a);
            if (lane == c) mine = a;
        }
        if (lane < 16) {
            float o;
            if (lane < 8) o = log_sigmoidf_(mine + fox_bf[lane]);
            else if (lane < 12) o = mine + ml_bi[lane - 8];
            else o = log_sigmoidf_(mine + ml_bf[lane - 12]);
            small[(size_t)row * 16 + lane] = o;
        }
    }
}

struct GemmArgs {
    const h16* A; int lda; const h16* Bt; int ldb; int K;
    h16* C; int ldc;
    const h16* gates; int ldg;
    const float* xin; float* xout;
};
template <int EPI>
__global__ void __launch_bounds__(256) nv_gemm(GemmArgs g) {
    __shared__ float As[16][68], Bs[16][68];
    const int tid = threadIdx.x, tx = tid & 15, ty = tid >> 4;
    const int m0 = blockIdx.y * 64, n0 = blockIdx.x * 64;
    float res[4][4];
#pragma unroll
    for (int i = 0; i < 4; ++i)
#pragma unroll
        for (int j = 0; j < 4; ++j) res[i][j] = 0.f;
    const int NB = EPI == 1 ? 3 : 1;
    for (int nb = 0; nb < NB; ++nb) {
        float acc[4][4];
#pragma unroll
        for (int i = 0; i < 4; ++i)
#pragma unroll
            for (int j = 0; j < 4; ++j) acc[i][j] = 0.f;
        const h16* A = g.A + (EPI == 1 ? nb * 512 : 0);
        const h16* Bt = g.Bt + (EPI == 1 ? (size_t)nb * 1024 * 512 : 0);
        const int lr = tid >> 2, lk = (tid & 3) * 4;
        for (int k0 = 0; k0 < g.K; k0 += 16) {
            const h16x4 av = *(const h16x4*)(A + (size_t)(m0 + lr) * g.lda + k0 + lk);
            const h16x4 bv = *(const h16x4*)(Bt + (size_t)(n0 + lr) * g.ldb + k0 + lk);
            __syncthreads();
#pragma unroll
            for (int e = 0; e < 4; ++e) { As[lk + e][lr] = (float)av[e]; Bs[lk + e][lr] = (float)bv[e]; }
            __syncthreads();
#pragma unroll
            for (int kk = 0; kk < 16; ++kk) {
                float a[4], b[4];
#pragma unroll
                for (int i = 0; i < 4; ++i) { a[i] = As[kk][ty * 4 + i]; b[i] = Bs[kk][tx * 4 + i]; }
#pragma unroll
                for (int i = 0; i < 4; ++i)
#pragma unroll
                    for (int j = 0; j < 4; ++j) acc[i][j] += a[i] * b[j];
            }
        }
#pragma unroll
        for (int i = 0; i < 4; ++i)
#pragma unroll
            for (int j = 0; j < 4; ++j) {
                if (EPI == 1) {
                    const int m = m0 + ty * 4 + i, n = n0 + tx * 4 + j;
                    const float gt = (float)g.gates[(size_t)m * g.ldg + nb * 1024 + n];
                    res[i][j] += sigmoidf_(gt) * acc[i][j];
                } else res[i][j] = acc[i][j];
            }
    }
#pragma unroll
    for (int i = 0; i < 4; ++i)
#pragma unroll
        for (int j = 0; j < 4; ++j) {
            const int m = m0 + ty * 4 + i, n = n0 + tx * 4 + j;
            if (EPI == 2) g.xout[(size_t)m * DM + n] = g.xin[(size_t)m * DM + n] + res[i][j];
            else g.C[(size_t)m * g.ldc + n] = (h16)res[i][j];
        }
}

__global__ void nv_fox_cumsum(const float* __restrict__ small, float* __restrict__ cb, int b0) {
    const int i = blockIdx.x * blockDim.x + threadIdx.x;
    if (i >= HB * 8) return;
    const int bl = i >> 3, h = i & 7;
    const float* s = small + (size_t)(b0 + bl) * SEQ * 16 + h;
    float* o = cb + (size_t)((b0 + bl) * 8 + h) * SEQ;
    float c = 0.f;
    for (int t = 0; t < SEQ; ++t) { c += s[(size_t)t * 16]; o[t] = -c * LOG2E; }
}
__global__ void nv_moba_kmean(const h16* __restrict__ proj, float* __restrict__ kmean, int b0) {
    const int i = blockIdx.x * blockDim.x + threadIdx.x;
    if (i >= HB * 8 * 512) return;
    const int col = i & 511, blk = (i >> 9) & 7, bl = i >> 12;
    const h16* p = proj + (size_t)(bl * SEQ + blk * 256) * PW + PC_BK + col;
    float s = 0.f;
    for (int t = 0; t < 256; ++t) s += (float)p[(size_t)t * PW];
    const int h = col >> 6, d = col & 63;
    kmean[(((size_t)(b0 + bl) * 8 + h) * 8 + blk) * 64 + d] = s * (1.f / 256.f);
}

__global__ void __launch_bounds__(256) nv_fox_attn(const h16* __restrict__ proj, const float* __restrict__ cb, h16* __restrict__ y, int b0) {
    const int bh = blockIdx.y, bl = bh >> 3, h = bh & 7;
    const int t = blockIdx.x * 256 + threadIdx.x;
    const size_t rowb = (size_t)bl * SEQ;
    float q[64], o[64];
    {
        const h16* qp = proj + (rowb + t) * PW + PC_AQ + h * 64;
#pragma unroll
        for (int d = 0; d < 64; ++d) { q[d] = (float)qp[d]; o[d] = 0.f; }
    }
    const float* cbh = cb + (size_t)((b0 + bl) * 8 + h) * SEQ;
    float m = -INFINITY, l = 0.f;
    const int send = blockIdx.x * 256 + 255;
    for (int s = 0; s <= send; ++s) {
        const h16* kp = proj + (rowb + s) * PW + PC_AK + h * 64;
        const h16* vp = proj + (rowb + s) * PW + PC_AV + h * 64;
        float sd = 0.f;
#pragma unroll
        for (int d = 0; d < 64; ++d) sd += q[d] * (float)kp[d];
        sd += cbh[s];
        if (s <= t) {
            const float mn = fmaxf(m, sd), al = exp2f(m - mn), p = exp2f(sd - mn);
            l = l * al + p;
#pragma unroll
            for (int d = 0; d < 64; ++d) o[d] = o[d] * al + p * (float)vp[d];
            m = mn;
        }
    }
    const float il = 1.f / l;
    const h16* zp = proj + (rowb + t) * PW + PC_AZ + h * 64;
    h16* yp = y + (rowb + t) * 1536 + h * 64;
#pragma unroll
    for (int d = 0; d < 64; ++d) yp[d] = (h16)(o[d] * il * siluf_((float)zp[d]));
}

__global__ void __launch_bounds__(256) nv_moba_attn(const h16* __restrict__ proj, const float* __restrict__ kmean, h16* __restrict__ y, int b0) {
    const int bh = blockIdx.y, bl = bh >> 3, h = bh & 7;
    const int own = blockIdx.x;
    const int t = own * 256 + threadIdx.x;
    const size_t rowb = (size_t)bl * SEQ;
    float q[64], o[64];
    {
        const h16* qp = proj + (rowb + t) * PW + PC_BQ + h * 64;
#pragma unroll
        for (int d = 0; d < 64; ++d) { q[d] = (float)qp[d]; o[d] = 0.f; }
    }
    unsigned selmask = 0;
    if (own <= 3) selmask = (1u << own) - 1u;
    else {
        float gate[8];
        const float* km = kmean + ((size_t)(b0 + bl) * 8 + h) * 8 * 64;
#pragma unroll
        for (int n = 0; n < 8; ++n) {
            float sd = 0.f;
#pragma unroll
            for (int d = 0; d < 64; ++d) sd += q[d] * km[n * 64 + d];
            gate[n] = n < own ? sd : -INFINITY;
        }
        for (int r = 0; r < 3; ++r) {
            float best = -INFINITY; int bi = -1;
#pragma unroll
            for (int n = 0; n < 8; ++n) { const bool free_ = !((selmask >> n) & 1u); if (free_ && n < own && gate[n] > best) { best = gate[n]; bi = n; } }
            if (bi >= 0) selmask |= 1u << bi;
        }
    }
    const float slope2 = exp2f(-(float)(h + 1)) * LOG2E;
    float m = -INFINITY, l = 0.f;
    for (int n = 0; n <= own; ++n) {
        const bool isown = n == own;
        const bool sel = isown || ((selmask >> n) & 1u);
        for (int ss = 0; ss < 256; ++ss) {
            const int s = n * 256 + ss;
            const h16* kp = proj + (rowb + s) * PW + PC_BK + h * 64;
            const h16* vp = proj + (rowb + s) * PW + PC_BV + h * 64;
            if (sel && s <= t) {
                float sd = 0.f;
#pragma unroll
                for (int d = 0; d < 64; ++d) sd += q[d] * (float)kp[d];
                sd -= slope2 * (float)(t - s);
                const float mn = fmaxf(m, sd), al = exp2f(m - mn), p = exp2f(sd - mn);
                l = l * al + p;
#pragma unroll
                for (int d = 0; d < 64; ++d) o[d] = o[d] * al + p * (float)vp[d];
                m = mn;
            }
        }
    }
    const float il = 1.f / l;
    const h16* zp = proj + (rowb + t) * PW + PC_BZ + h * 64;
    h16* yp = y + (rowb + t) * 1536 + 512 + h * 64;
#pragma unroll
    for (int d = 0; d < 64; ++d) yp[d] = (h16)(o[d] * il * siluf_((float)zp[d]));
}

__global__ void __launch_bounds__(256) nv_mlstm(const h16* __restrict__ proj, const float* __restrict__ small, const float* __restrict__ convw  ,
                                                const float* __restrict__ headg  , h16* __restrict__ y, int b0) {
    __shared__ float qk[128];
    __shared__ float red[4];
    const int bl = blockIdx.x >> 2, hh = blockIdx.x & 3, tid = threadIdx.x, v = tid >> 1, kh = tid & 1;
    const size_t rowb = (size_t)bl * SEQ;
    float C[32], nn[32];
#pragma unroll
    for (int j = 0; j < 32; ++j) { C[j] = 0.f; nn[j] = 0.f; }
    float m = 0.f;
    const int ccol = tid < 64 ? hh * 64 + tid : 256 + hh * 64 + (tid - 64);
    float cw[4] = {0.f, 0.f, 0.f, 0.f};
    if (tid < 128) {
#pragma unroll
        for (int j = 0; j < 4; ++j) cw[j] = convw[j * 512 + ccol];
    }
    const float hg = headg[hh * 128 + v];
    for (int t = 0; t < SEQ; ++t) {
        if (tid < 128) {
            float a = 0.f;
#pragma unroll
            for (int j = 0; j < 4; ++j) { const int tt = t - 3 + j; if (tt >= 0) a += cw[j] * (float)proj[(rowb + tt) * PW + PC_CQK + ccol]; }
            a = siluf_(a);
            if (tid >= 64) a *= 0.125f;
            qk[tid] = a;
        }
        __syncthreads();
        const size_t row = rowb + t;
        const float li = small[((size_t)b0 * SEQ + row) * 16 + 8 + hh], lf = small[((size_t)b0 * SEQ + row) * 16 + 12 + hh];
        const float vt = (float)proj[row * PW + PC_CV + hh * 128 + v];
        const float mn = fmaxf(lf + m, li), fw = __expf(lf + m - mn), iw = __expf(li - mn);
        float nump = 0.f, denp = 0.f;
#pragma unroll
        for (int j = 0; j < 32; ++j) {
            const float kj = qk[64 + kh * 32 + j], qj = qk[kh * 32 + j];
            C[j] = fw * C[j] + iw * vt * kj; nn[j] = fw * nn[j] + iw * kj;
            nump += C[j] * qj; denp += nn[j] * qj;
        }
        nump += __shfl_xor(nump, 1); denp += __shfl_xor(denp, 1);
        m = mn;
        const float hval = nump / fmaxf(fabsf(denp), __expf(-mn));
        const float hgt = hval * sigmoidf_((float)proj[row * PW + PC_CO + hh * 128 + v]);
        float ss = kh == 0 ? hgt * hgt : 0.f;
        ss = wave_sum(ss);
        if ((tid & 63) == 0) red[tid >> 6] = ss;
        __syncthreads();
        const float tot = red[0] + red[1] + red[2] + red[3];
        if (kh == 0) {
            const float o = hgt * rsqrtf(tot * (1.f / 128.f) + RMS_EPS) * hg * siluf_((float)proj[row * PW + PC_CZ + hh * 128 + v]);
            y[row * 1536 + 1024 + hh * 128 + v] = (h16)o;
        }
    }
}

__global__ void nv_final_norm(float* __restrict__ x, const float* __restrict__ g) {
    const int lane = threadIdx.x & 63, wv = (blockIdx.x * blockDim.x + threadIdx.x) >> 6, nw = (gridDim.x * blockDim.x) >> 6;
    for (int row = wv; row < TT; row += nw) {
        f32x4* xr = (f32x4*)(x + (size_t)row * DM) + lane;
        f32x4 v[4]; float s = 0.f;
#pragma unroll
        for (int j = 0; j < 4; ++j) { v[j] = xr[64 * j]; s += v[j].x * v[j].x + v[j].y * v[j].y + v[j].z * v[j].z + v[j].w * v[j].w; }
        const float rstd = rsqrtf(wave_sum(s) * (1.f / DM) + RMS_EPS);
#pragma unroll
        for (int j = 0; j < 4; ++j) {
            const f32x4 gg = ((const f32x4*)g)[lane + 64 * j];
            f32x4 o = {v[j].x * rstd * gg.x, v[j].y * rstd * gg.y, v[j].z * rstd * gg.z, v[j].w * rstd * gg.w};
            xr[64 * j] = o;
        }
    }
}


namespace pg8 {
#define PG8_LAS __attribute__((address_space(3)))
typedef short s16x8 __attribute__((ext_vector_type(8)));
typedef unsigned u32x4 __attribute__((ext_vector_type(4)));
typedef float f32x2 __attribute__((ext_vector_type(2)));
typedef _Float16 h16x2 __attribute__((ext_vector_type(2)));
constexpr int BM = 256, BK = 64, HALF = 128, HTB = HALF * BK * 2  , STAGE_BYTES = 8 * HTB, NXCD = 8, WGM = 8;
__host__ __device__ __forceinline__ int lds_byte(int r, int c) { const int st = (r >> 4) * 2 + (c >> 5), rr = r & 15, cc = c & 31, ob = rr * 64 + cc * 2; return st * 1024 + (ob ^ (((ob >> 9) & 1) << 5)); }
__host__ __device__ __forceinline__ void stage_rc(int b, int& R, int& C) { const int st = b / 1024, sb = b % 1024, swz = sb ^ (((sb >> 9) & 1) << 5); R = (st >> 1) * 16 + swz / 64; C = (st & 1) * 32 + (swz % 64) / 2; }
__host__ __device__ __forceinline__ int perm32(int rho) { const int n = rho >> 4, i = rho & 15; return 8 * (i >> 2) + 4 * n + (i & 3); }
__device__ __forceinline__ unsigned cvt_pk_f16(float lo, float hi) { f32x2 v = {lo, hi}; h16x2 b = __builtin_convertvector(v, h16x2); return __builtin_bit_cast(unsigned, b); }

struct Unit { int pm, pn, z; };
struct Gemm { const h16* A; const h16* Bt; int lda, ldb, K; long zA, zB; };

__device__ __forceinline__ void tile_of(int L, int nM, int nN, int& pm, int& pn) {
    const int nwg = nM * nN; int wgid = L;
    { const int q = nwg / NXCD, r = nwg % NXCD, xcd = wgid % NXCD, off = wgid / NXCD; wgid = (xcd < r ? xcd * (q + 1) : r * (q + 1) + (xcd - r) * q) + off; }
    const int nig = WGM * nN, gid = wgid / nig, fm = gid * WGM, gsz = (nM - fm) < WGM ? (nM - fm) : WGM;
    pm = fm + ((wgid % nig) % gsz); pn = (wgid % nig) / gsz;
}
struct StaticOrder {
    int nM, nN, nwg, G, c;
    __device__ void init(int M, int N, int G_, int c_) { nM = M / BM; nN = N / BM; nwg = nM * nN; G = G_; c = c_; }
    __device__ bool next(int i, Unit& u) const { const long L = (long)i * G + c; if (L >= nwg) return false; tile_of((int)L, nM, nN, u.pm, u.pn); u.z = 0; return true; }
};
struct BranchOrder {
    int nM, nN, nwg, G, c, NZ;
    __device__ void init(int M, int N, int G_, int c_, int nz) { nM = M / BM; nN = N / BM; nwg = nM * nN; G = G_; c = c_; NZ = nz; }
    __device__ bool next(int i, Unit& u) const { const int j = i / NZ; const long L = (long)j * G + c; if (L >= nwg) return false; tile_of((int)L, nM, nN, u.pm, u.pn); u.z = i - j * NZ; return true; }
};

struct EpiF16 {
    static constexpr bool PERM = true;
    h16* C; int ldc;
    __device__ __forceinline__ void operator()(const f32x4 (&acc)[2][2][4][2], const Unit& u, int wr, int wc, int fr, int fq) const {
        const int row0 = u.pm * BM + wr * 64 + fr, col0 = u.pn * BM + wc * 32 + 8 * fq;
#pragma unroll
        for (int ai = 0; ai < 2; ++ai)
#pragma unroll
            for (int m = 0; m < 4; ++m) { h16* rowp = C + (size_t)(row0 + ai * HALF + m * 16) * ldc + col0;
#pragma unroll
                for (int bj = 0; bj < 2; ++bj) { const f32x4 v0 = acc[ai][bj][m][0], v1 = acc[ai][bj][m][1];
                    u32x4 w; w.x = cvt_pk_f16(v0[0], v0[1]); w.y = cvt_pk_f16(v0[2], v0[3]); w.z = cvt_pk_f16(v1[0], v1[1]); w.w = cvt_pk_f16(v1[2], v1[3]);
                    *(u32x4*)(rowp + bj * HALF) = w; } }
    }
};
struct EpiGate {
    static constexpr bool PERM = true;
    h16* Mg; const h16* G; int ldg;
    __device__ __forceinline__ void operator()(const f32x4 (&acc)[2][2][4][2], const Unit& u, int wr, int wc, int fr, int fq) const {
        const int row0 = u.pm * BM + wr * 64 + fr, col0 = u.pn * BM + wc * 32 + 8 * fq;
#pragma unroll
        for (int ai = 0; ai < 2; ++ai)
#pragma unroll
            for (int mp = 0; mp < 2; ++mp) {
                h16x8 gv[2][2], pv[2][2];
#pragma unroll
                for (int mm = 0; mm < 2; ++mm)
#pragma unroll
                    for (int bj = 0; bj < 2; ++bj) { const size_t row = (size_t)(row0 + ai * HALF + (2 * mp + mm) * 16);
                        gv[mm][bj] = *(const h16x8*)(G + row * ldg + u.z * 1024 + col0 + bj * HALF);
                        if (u.z > 0) pv[mm][bj] = *(const h16x8*)(Mg + row * 1024 + col0 + bj * HALF); }
#pragma unroll
                for (int mm = 0; mm < 2; ++mm)
#pragma unroll
                    for (int bj = 0; bj < 2; ++bj) { const int m = 2 * mp + mm; const size_t row = (size_t)(row0 + ai * HALF + m * 16);
                        float o[8];
#pragma unroll
                        for (int e = 0; e < 8; ++e) { const float a = e < 4 ? acc[ai][bj][m][0][e] : acc[ai][bj][m][1][e - 4]; o[e] = a * __builtin_amdgcn_rcpf(1.f + __expf(-(float)gv[mm][bj][e])); }
                        if (u.z > 0) {
#pragma unroll
                            for (int e = 0; e < 8; ++e) o[e] += (float)pv[mm][bj][e]; }
                        u32x4 w; w.x = cvt_pk_f16(o[0], o[1]); w.y = cvt_pk_f16(o[2], o[3]); w.z = cvt_pk_f16(o[4], o[5]); w.w = cvt_pk_f16(o[6], o[7]);
                        *(u32x4*)(Mg + row * 1024 + col0 + bj * HALF) = w; }
            }
    }
};
struct EpiRes {
    static constexpr bool PERM = false;
    const float* xin; float* out; int ldc;
    __device__ __forceinline__ void operator()(const f32x4 (&acc)[2][2][4][2], const Unit& u, int wr, int wc, int fr, int fq) const {
        const int row0 = u.pm * BM + wr * 64 + fr, col0 = u.pn * BM + wc * 32 + 4 * fq;
#pragma unroll
        for (int ai = 0; ai < 2; ++ai)
#pragma unroll
            for (int mp = 0; mp < 2; ++mp) {
                f32x4 xv[2][2][2];
#pragma unroll
                for (int mm = 0; mm < 2; ++mm) { const size_t off = (size_t)(row0 + ai * HALF + (2 * mp + mm) * 16) * ldc + col0;
#pragma unroll
                    for (int bj = 0; bj < 2; ++bj)
#pragma unroll
                        for (int n = 0; n < 2; ++n) xv[mm][bj][n] = *(const f32x4*)(xin + off + bj * HALF + n * 16); }
#pragma unroll
                for (int mm = 0; mm < 2; ++mm) { const int m = 2 * mp + mm; const size_t off = (size_t)(row0 + ai * HALF + m * 16) * ldc + col0;
#pragma unroll
                    for (int bj = 0; bj < 2; ++bj)
#pragma unroll
                        for (int n = 0; n < 2; ++n) *(f32x4*)(out + off + bj * HALF + n * 16) = xv[mm][bj][n] + acc[ai][bj][m][n]; }
            }
    }
};

template <class Epi, class Sched>
__device__ __forceinline__ void gemm_phase(PG8_LAS unsigned char* lds, const Gemm g, const Sched& S, const Epi& E) {
    int tid_ = threadIdx.x; asm volatile("" : "+v"(tid_));
    const int tid = tid_, wid = __builtin_amdgcn_readfirstlane(tid >> 6), lane = tid & 63, wr = wid >> 2, wc = wid & 3, fr = lane & 15, fq = lane >> 4;
    const int nt = g.K / BK;
    unsigned voffA[2], voffB[2];
#pragma unroll
    for (int i = 0; i < 2; ++i) { int R, C; stage_rc(tid * 16 + i * 8192, R, C); const int Rb = Epi::PERM ? ((R & ~31) + perm32(R & 31)) : R;
        voffA[i] = (unsigned)(R * g.lda + C) * 2u; voffB[i] = (unsigned)(Rb * g.ldb + C) * 2u; }
    const size_t kstep = (size_t)(BK * 2);
    const size_t hA = (size_t)HALF * g.lda * 2, hB = (size_t)HALF * g.ldb * 2;
    const size_t tA = 2 * hA, tB = 2 * hB;
    const unsigned ldsw = (unsigned)wid * 1024u;
    const int aoff = lds_byte(wr * 64 + fr, fq * 8), boff = lds_byte(wc * 32 + fr, fq * 8);
#define PG8_SA(b, h) (((b) * 2 + (h)) * HTB)
#define PG8_SB(b, h) ((4 + (b) * 2 + (h)) * HTB)
#define PG8_STAGE(bufoff, gbase, voff) do { _Pragma("unroll") for (int _i = 0; _i < 2; ++_i) \
        __builtin_amdgcn_global_load_lds((const unsigned*)((const char*)(gbase) + (voff)[_i]), (PG8_LAS unsigned*)(lds + (bufoff) + ldsw + _i * 8192), 16, 0, 0); } while (0)
#define PG8_LDA(dst, b, h) do { _Pragma("unroll") for (int m = 0; m < 4; ++m) _Pragma("unroll") for (int k = 0; k < 2; ++k) dst[m][k] = *(const PG8_LAS s16x8*)(lds + PG8_SA(b, h) + aoff + m * 2048 + k * 1024); } while (0)
#define PG8_LDB(dst, b, h) do { _Pragma("unroll") for (int n = 0; n < 2; ++n) _Pragma("unroll") for (int k = 0; k < 2; ++k) dst[n][k] = *(const PG8_LAS s16x8*)(lds + PG8_SB(b, h) + boff + n * 2048 + k * 1024); } while (0)
#define PG8_MMA(ai, bj, At, Bt) do { __builtin_amdgcn_s_setprio(1); _Pragma("unroll") for (int m = 0; m < 4; ++m) _Pragma("unroll") for (int n = 0; n < 2; ++n) _Pragma("unroll") for (int k = 0; k < 2; ++k) \
        acc[ai][bj][m][n] = __builtin_amdgcn_mfma_f32_16x16x32_f16(__builtin_bit_cast(h16x8, Bt[n][k]), __builtin_bit_cast(h16x8, At[m][k]), acc[ai][bj][m][n], 0, 0, 0); __builtin_amdgcn_s_setprio(0); } while (0)
#define PG8_WAIT_V(n) asm volatile("s_waitcnt vmcnt(" #n ")" ::: "memory")
#define PG8_WAIT_L(n) asm volatile("s_waitcnt lgkmcnt(" #n ")" ::: "memory")
#define PG8_BAR __builtin_amdgcn_s_barrier()
#define PG8_SCHED __builtin_amdgcn_sched_barrier(0)
    Unit cur, nxt; int ui = 0;
    if (!S.next(0, cur)) return;
    f32x4 acc[2][2][4][2];
#pragma unroll
    for (int a = 0; a < 2; ++a)
#pragma unroll
        for (int b = 0; b < 2; ++b)
#pragma unroll
            for (int m = 0; m < 4; ++m)
#pragma unroll
                for (int n = 0; n < 2; ++n) acc[a][b][m][n] = (f32x4){0.f, 0.f, 0.f, 0.f};
    s16x8 At[4][2], B0[2][2], B1[2][2];
    const char* cA = (const char*)(g.A + (long)cur.z * g.zA) + (size_t)cur.pm * tA; const char* cB = (const char*)(g.Bt + (long)cur.z * g.zB) + (size_t)cur.pn * tB;
    PG8_STAGE(PG8_SB(0, 0), cB, voffB); PG8_STAGE(PG8_SB(0, 1), cB + hB, voffB); PG8_STAGE(PG8_SA(0, 0), cA, voffA); PG8_STAGE(PG8_SA(0, 1), cA + hA, voffA);
    if (wr == 1) PG8_BAR;
    PG8_WAIT_V(2); PG8_BAR;
    PG8_STAGE(PG8_SB(1, 0), cB + kstep, voffB); PG8_STAGE(PG8_SA(1, 0), cA + kstep, voffA); PG8_STAGE(PG8_SB(1, 1), cB + hB + kstep, voffB);
    PG8_WAIT_V(6); PG8_BAR;
    for (;;) {
        const bool has_next = S.next(ui + 1, nxt);
        const char* nA = has_next ? (const char*)(g.A + (long)nxt.z * g.zA) + (size_t)nxt.pm * tA : cA; const char* nB = has_next ? (const char*)(g.Bt + (long)nxt.z * g.zB) + (size_t)nxt.pn * tB : cB;
        for (int t = 0; t < nt; t += 2) {
            const bool last = (t == nt - 2);
            const char* a1 = cA + (size_t)(t + 1) * kstep;
            const char* a2 = last ? nA : cA + (size_t)(t + 2) * kstep; const char* b2 = last ? nB : cB + (size_t)(t + 2) * kstep;
            const char* a3 = a2 + kstep; const char* b3 = b2 + kstep;
            PG8_LDB(B0, 0, 0); PG8_LDB(B1, 0, 1); PG8_SCHED; PG8_LDA(At, 0, 0); PG8_STAGE(PG8_SA(1, 1), a1 + hA, voffA);
            PG8_WAIT_V(8); PG8_WAIT_L(0); PG8_BAR; PG8_MMA(0, 0, At, B0); PG8_MMA(0, 1, At, B1); PG8_BAR; PG8_SCHED;
            PG8_LDA(At, 0, 1); PG8_STAGE(PG8_SB(0, 0), b2, voffB); PG8_STAGE(PG8_SB(0, 1), b2 + hB, voffB); PG8_STAGE(PG8_SA(0, 0), a2, voffA);
            PG8_WAIT_V(8); PG8_WAIT_L(0); PG8_BAR; PG8_MMA(1, 0, At, B0); PG8_MMA(1, 1, At, B1); PG8_BAR; PG8_SCHED;
            PG8_LDB(B0, 1, 0); PG8_LDB(B1, 1, 1); PG8_SCHED; PG8_LDA(At, 1, 0); PG8_STAGE(PG8_SA(0, 1), a2 + hA, voffA);
            PG8_WAIT_V(8); PG8_WAIT_L(0); PG8_BAR; PG8_MMA(0, 0, At, B0); PG8_MMA(0, 1, At, B1); PG8_BAR; PG8_SCHED;
            PG8_LDA(At, 1, 1); PG8_STAGE(PG8_SB(1, 0), b3, voffB); PG8_STAGE(PG8_SB(1, 1), b3 + hB, voffB); PG8_STAGE(PG8_SA(1, 0), a3, voffA);
            PG8_WAIT_V(8); PG8_WAIT_L(0); PG8_BAR; PG8_MMA(1, 0, At, B0); PG8_MMA(1, 1, At, B1); PG8_BAR; PG8_SCHED;
        }
        if (wr == 0) PG8_BAR;
        E(acc, cur, wr, wc, fr, fq);
        if (!has_next) break;
#pragma unroll
        for (int a = 0; a < 2; ++a)
#pragma unroll
            for (int b = 0; b < 2; ++b)
#pragma unroll
                for (int m = 0; m < 4; ++m)
#pragma unroll
                    for (int n = 0; n < 2; ++n) acc[a][b][m][n] = (f32x4){0.f, 0.f, 0.f, 0.f};
        cur = nxt; cA = nA; cB = nB; ++ui;
        if (wr == 1) PG8_BAR;
    }
    PG8_WAIT_V(0);
    PG8_BAR;
#undef PG8_SA
#undef PG8_SB
#undef PG8_STAGE
#undef PG8_LDA
#undef PG8_LDB
#undef PG8_MMA
#undef PG8_WAIT_V
#undef PG8_WAIT_L
#undef PG8_BAR
#undef PG8_SCHED
}
}

namespace attn_body {
using s16x8 = __attribute__((ext_vector_type(8))) short;
using s16x4 = __attribute__((ext_vector_type(4))) short;
using f32x16 = __attribute__((ext_vector_type(16))) float;
using u32x4 = __attribute__((ext_vector_type(4))) unsigned;
constexpr int D = 64, NW = 8, QBLK = 32, QB = QBLK * NW, KVBLK = 64;
constexpr int PQ = PW;
__device__ __forceinline__ int crow(int r, int hi) { return (r & 3) + 8 * (r >> 2) + 4 * hi; }
#define SBAR() __builtin_amdgcn_sched_barrier(0)
__device__ __forceinline__ void cmask(f32x16& p0, f32x16& p1, int jb, int qrel, int hi) {
    const float NEG = -INFINITY; int kb = 64 * jb + 4 * hi;
#pragma unroll
    for (int r = 0; r < 16; ++r) { int kv = kb + (r & 3) + 8 * (r >> 2); if (kv > qrel) p0[r] = NEG; if (kv + 32 > qrel) p1[r] = NEG; }
}
constexpr int NSLOT = 3, SLOTB = 8192;
constexpr int LDS_K = 0, LDS_V = NSLOT * SLOTB, LDS_WS = 2 * NSLOT * SLOTB, LDS_OST = LDS_WS + NW * 64 * 4, LDS_BT = LDS_OST + NW * 4096, LDS_INF = LDS_BT + 2048 * 4, LDS_KM = LDS_INF + 256, LDS_BYTES = LDS_KM + 2048;
__device__ __forceinline__ void glds16(const void* gsrc, unsigned lds_dst) { unsigned keep;
    asm volatile("s_mov_b32 %0, m0\n\ts_mov_b32 m0, %2\n\ts_nop 0\n\tglobal_load_lds_dwordx4 %1, off\n\ts_mov_b32 m0, %0" : "=&s"(keep) : "v"(gsrc), "s"(lds_dst) : "memory"); }
__device__ __forceinline__ float max3f(float a, float b, float c) { float r; asm("v_max3_f32 %0, %1, %2, %3" : "=v"(r) : "v"(a), "v"(b), "v"(c)); return r; }
__device__ __forceinline__ float max2f(float a, float b) { float r; asm("v_max_f32_e32 %0, %1, %2" : "=v"(r) : "v"(a), "v"(b)); return r; }
__device__ __forceinline__ float fadd_s(float a, float b) { float r; asm("v_add_f32_e32 %0, %1, %2" : "=v"(r) : "v"(a), "v"(b)); return r; }
__device__ __forceinline__ float fsub_s(float a, float b) { float r; asm("v_sub_f32_e32 %0, %1, %2" : "=v"(r) : "v"(a), "v"(b)); return r; }
__device__ __forceinline__ unsigned cvtpk_s(float lo, float hi) { return pg8::cvt_pk_f16(lo, hi); }
#define MFMA32(a, b, c) __builtin_amdgcn_mfma_f32_32x32x16_f16(__builtin_bit_cast(h16x8, (a)), __builtin_bit_cast(h16x8, (b)), (c), 0, 0, 0)
#define WAIT_BAR(N) asm volatile("s_waitcnt vmcnt(" #N ") lgkmcnt(0)\n\ts_barrier" ::: "memory")
__device__ __forceinline__ void qkt(f32x16& p0, f32x16& p1, const char* Kslot, const s16x8* qr, const f32x16& negm, int r32, int hi) {
    const char* kb = Kslot + hi * 1024 + r32 * 16;
#pragma unroll
    for (int d0 = 0; d0 < 4; ++d0) {
        const s16x8 b0 = *reinterpret_cast<const s16x8*>(kb + d0 * 2048);
        const s16x8 b1 = *reinterpret_cast<const s16x8*>(kb + d0 * 2048 + 512);
        if (d0 == 0) { p0 = MFMA32(b0, qr[0], negm); p1 = MFMA32(b1, qr[0], negm); }
        else { p0 = MFMA32(b0, qr[d0], p0); p1 = MFMA32(b1, qr[d0], p1); } }
}
typedef __attribute__((address_space(3))) const char* lds_cptr;
typedef short v4i16_t __attribute__((ext_vector_type(4)));
#define LDS8(p) (*(const __attribute__((address_space(3))) s16x8*)(p))
__device__ __forceinline__ void kload8(s16x8* kf, lds_cptr kp) {
    kf[0] = LDS8(kp); kf[1] = LDS8(kp + 512); kf[2] = LDS8(kp + 2048); kf[3] = LDS8(kp + 2560);
    kf[4] = LDS8(kp + 4096); kf[5] = LDS8(kp + 4608); kf[6] = LDS8(kp + 6144); kf[7] = LDS8(kp + 6656);
}
__device__ __forceinline__ void kload2(s16x8* kf, lds_cptr kp, int j) { kf[2 * j] = LDS8(kp + j * 2048); kf[2 * j + 1] = LDS8(kp + j * 2048 + 512); }
__device__ __forceinline__ s16x4 vtr(lds_cptr p) { return __builtin_bit_cast(s16x4, __builtin_amdgcn_ds_read_tr16_b64_v4i16((__attribute__((address_space(3))) v4i16_t*)p)); }
__device__ __forceinline__ float rowmax(const f32x16& p0, const f32x16& p1) {
    float a = max3f(p0[0], p0[1], p1[0]), b = max3f(p0[2], p0[3], p1[1]); a = max3f(a, p1[2], p1[3]);
#pragma unroll
    for (int r = 4; r < 16; r += 4) { a = max3f(a, p0[r], p0[r + 1]); b = max3f(b, p0[r + 2], p0[r + 3]); a = max3f(a, p1[r], p1[r + 1]); b = max3f(b, p1[r + 2], p1[r + 3]); }
    const float m = max2f(a, b);
    auto rr = __builtin_amdgcn_permlane32_swap(__float_as_uint(m), __float_as_uint(m), false, false);
    return max2f(__uint_as_float(rr[0]), __uint_as_float(rr[1]));
}
__device__ __forceinline__ void pv(f32x16* o, int vb, s16x8 pa0, s16x8 pa1, s16x8 pa2, s16x8 pa3) {
#pragma unroll
    for (int d0 = 0; d0 < 2; ++d0) { s16x4 lo[4], hi[4];
#pragma unroll
        for (int ks = 0; ks < 4; ++ks) {
            asm volatile("ds_read_b64_tr_b16 %0,%1 offset:%c2" : "=&v"(lo[ks]) : "v"(vb), "i"(d0 * 4096 + ks * 1024) : "memory");
            asm volatile("ds_read_b64_tr_b16 %0,%1 offset:%c2" : "=&v"(hi[ks]) : "v"(vb), "i"(d0 * 4096 + ks * 1024 + 512) : "memory"); }
        asm volatile("s_waitcnt lgkmcnt(0)" ::: "memory"); SBAR();
#define PK(k) (s16x8){lo[k][0], lo[k][1], lo[k][2], lo[k][3], hi[k][0], hi[k][1], hi[k][2], hi[k][3]}
        o[d0] = MFMA32(pa0, PK(0), o[d0]);
        o[d0] = MFMA32(pa1, PK(1), o[d0]);
        o[d0] = MFMA32(pa2, PK(2), o[d0]);
        o[d0] = MFMA32(pa3, PK(3), o[d0]);
#undef PK
    }
}

template <bool MOBA, int THRL>
__device__ __forceinline__ void attn_unit(int bl, int h, int qb, const h16* Q, const h16* __restrict__ K, const h16* __restrict__ V, const h16* __restrict__ Z, h16* Y,
                                          const float* __restrict__ bsrc, float slope2, const float* __restrict__ kmean, char* shm) {
    int tid_ = threadIdx.x; asm volatile("" : "+v"(tid_));
    const int tid = tid_, lane = tid & 63, r32 = lane & 31, hi = lane >> 5; const int wid = __builtin_amdgcn_readfirstlane(tid >> 6);
    const long rowbase = (long)bl * SEQ; const int q0 = qb * QB;
    const h16* Qw = Q + (rowbase + q0 + wid * QBLK) * PQ + h * D;
    const h16* Kh = K + rowbase * PQ + h * D, *Vh = V + rowbase * PQ + h * D;
    const unsigned lds0 = (unsigned)(uintptr_t)shm;
    float* wsf = (float*)(shm + LDS_WS) + wid * 64;
    typedef __attribute__((address_space(3))) float lds_f32;
    typedef __attribute__((address_space(3))) const f32x4 lds_cf32x4;
    const lds_cptr shm3 = (lds_cptr)shm;
    {
        lds_f32* bt = (lds_f32*)(shm3 + LDS_BT);
        const int nkeys = q0 + QB;
        if (MOBA) { for (int i = tid; i < nkeys; i += NW * 64) bt[i] = slope2 * (float)(i - q0); }
        else { for (int i = tid; i < nkeys; i += NW * 64) bt[i] = bsrc[i]; }
        if (tid < 64) ((lds_f32*)(shm3 + LDS_INF))[tid] = -INFINITY;
        if (MOBA) { if (tid < 512) ((lds_f32*)(shm3 + LDS_KM))[tid] = kmean[tid]; }
    }
    const h16* ksrc = Kh + (long)lane * PQ + wid * 8;
    const h16* vsrc = Vh + (long)(16 * (wid & 3) + (lane >> 2)) * PQ + (wid >> 2) * 32 + (lane & 3) * 8;
    const unsigned kdst = lds0 + LDS_K + wid * 1024, vdst = lds0 + LDS_V + wid * 1024;
    const int NT = (q0 + QB) / KVBLK;
#define AMAP(t) ((t) < 4 ? 4 * qb + (t) : (MOBA ? (t) - 4 : 4 * qb + 3 - (t)))
#define DMA_K(t, slot) glds16(ksrc + (long)AMAP(t) * KVBLK * PQ, (unsigned)__builtin_amdgcn_readfirstlane(kdst + (slot)))
#define DMA_V(t, slot) glds16(vsrc + (long)AMAP(t) * KVBLK * PQ, (unsigned)__builtin_amdgcn_readfirstlane(vdst + (slot)))
    const char* Kbase = shm + LDS_K; s16x8 kf[8];
    const lds_cptr kp0 = shm3 + LDS_K + hi * 1024 + r32 * 16; const lds_cptr vp0 = shm3 + LDS_V + ((lane >> 4) & 1) * 32 + (lane & 3) * 8 + (4 * hi + ((lane & 15) >> 2)) * 64;
    DMA_K(0, 0); DMA_V(0, 0); DMA_K(1, SLOTB);
    s16x8 qr[4];
#pragma unroll
    for (int d0 = 0; d0 < 4; ++d0) qr[d0] = *reinterpret_cast<const s16x8*>(&Qw[(long)r32 * PQ + d0 * 16 + hi * 8]);
    float mhat = 0.f, l_reg = 0.f; f32x16 o[2]; o[0] = f32x16{}; o[1] = f32x16{}; f32x16 negm = f32x16{}; asm volatile("" : "+v"(negm));
    const int qrel = wid * QBLK + r32;
    unsigned selbits = 0xffu;
#define ADDB(P0, P1, t) do { const int kt_ = AMAP(t); lds_cptr tb_ = shm3 + LDS_BT + kt_ * 256; \
        if (MOBA) { const bool s_ = ((t) < 4) || ((selbits >> (kt_ >> 2)) & 1u); tb_ = s_ ? tb_ : (shm3 + LDS_INF); } \
        _Pragma("unroll") for (int g_ = 0; g_ < 4; ++g_) { const f32x4 b0_ = *(lds_cf32x4*)(tb_ + 16 * hi + 32 * g_), b1_ = *(lds_cf32x4*)(tb_ + 128 + 16 * hi + 32 * g_); \
            _Pragma("unroll") for (int i_ = 0; i_ < 4; ++i_) { P0[4 * g_ + i_] += b0_[i_]; P1[4 * g_ + i_] += b1_[i_]; } } } while (0)
#define CMASK(P0, P1, t) do { if ((t) < 4) cmask(P0, P1, (t), qrel, hi); } while (0)
    bool resc = false;
#define START(P0, P1) do { const float rm = rowmax(P0, P1); resc = false; \
    { const float dl = rm; mhat = fadd_s(mhat, dl); \
      _Pragma("unroll") for (int r = 0; r < 16; ++r) { P0[r] = fsub_s(P0[r], dl); P1[r] = fsub_s(P1[r], dl); } \
      _Pragma("unroll") for (int r = 0; r < 16; ++r) negm[r] = -mhat; asm volatile("" : "+v"(negm)); } \
    _Pragma("unroll") for (int r = 0; r < 16; ++r) P0[r] = __builtin_amdgcn_exp2f(P0[r]); } while (0)
#define RESC() do { if (resc) { asm volatile("s_waitcnt lgkmcnt(0)" ::: "memory"); \
      _Pragma("unroll") for (int d_ = 0; d_ < 2; ++d_) _Pragma("unroll") for (int r = 0; r < 16; ++r) o[d_][r] *= wsf[crow(r, hi)]; } } while (0)
    f32x16 pA0, pA1, pB0, pB1;
    int sl_prev = 0, sl_cur = 0, sl_next = SLOTB;
#define ROT() do { sl_prev = sl_cur; sl_cur = sl_next; sl_next = (sl_next == (NSLOT - 1) * SLOTB) ? 0 : sl_next + SLOTB; } while (0)
    DMA_K(2, 2 * SLOTB);
    WAIT_BAR(3);
    if (MOBA && qb >= 4) {
        float gate[8];
#pragma unroll
        for (int n = 0; n < 8; ++n) gate[n] = 0.f;
#pragma unroll
        for (int d0 = 0; d0 < 4; ++d0) {
            const h16x8 qv = __builtin_bit_cast(h16x8, qr[d0]);
#pragma unroll
            for (int n = 0; n < 7; ++n) {
                const f32x4 k0 = *(lds_cf32x4*)(shm3 + LDS_KM + n * 256 + d0 * 64 + hi * 32), k1 = *(lds_cf32x4*)(shm3 + LDS_KM + n * 256 + d0 * 64 + hi * 32 + 16);
                gate[n] += (float)qv[0] * k0[0] + (float)qv[1] * k0[1] + (float)qv[2] * k0[2] + (float)qv[3] * k0[3] + (float)qv[4] * k1[0] + (float)qv[5] * k1[1] + (float)qv[6] * k1[2] + (float)qv[7] * k1[3];
            }
        }
#pragma unroll
        for (int n = 0; n < 7; ++n) { gate[n] = half_sum(gate[n]); if (n >= qb) gate[n] = -INFINITY; }
        unsigned sb = 0u;
#pragma unroll
        for (int r = 0; r < 3; ++r) {
            float best = -INFINITY; int bi = 0;
#pragma unroll
            for (int n = 0; n < 7; ++n) { const bool fr_ = !((sb >> n) & 1u); if (fr_ && gate[n] > best) { best = gate[n]; bi = n; } }
            sb |= 1u << bi;
        }
        selbits = sb;
    }
    qkt(pA0, pA1, Kbase, qr, negm, r32, hi); asm volatile("s_nop 15\n\ts_nop 7" : "+v"(pA0), "+v"(pA1)); ADDB(pA0, pA1, 0); CMASK(pA0, pA1, 0);
    START(pA0, pA1);
    _Pragma("unroll") for (int r = 0; r < 16; ++r) pA1[r] = __builtin_amdgcn_exp2f(pA1[r]);
    WAIT_BAR(0);
    DMA_K(3, 0); DMA_V(1, SLOTB);
    ROT();
    kload8(kf, kp0 + sl_cur);
    WAIT_BAR(2);
    s16x4 vlo[8], vhi[8]; u32x4 pw0, pw1, pw2, pw3;
#define PKW(P, B) cvtpk_s(P[B], P[B + 1])
#define PAF(k) __builtin_bit_cast(s16x8, pw##k)
#define VFR(i) (s16x8){vlo[i][0], vlo[i][1], vlo[i][2], vlo[i][3], vhi[i][0], vhi[i][1], vhi[i][2], vhi[i][3]}
#define PIN(x) asm volatile("" : "+v"(x))
#define MX3(a, b, c) __builtin_fmaxf(__builtin_fmaxf((a), (b)), (c))
#define GAPA(MF, A0, A1, A2, A3, W0, W1, PW_) do { MF; sacc += A0; sacc += A1; sacc += A2; sacc += A3; PIN(sacc); W0; W1; PIN(PW_); SBAR(); } while (0)
#define EX(v) __builtin_amdgcn_exp2f(v)
#define GAPB(MF, X, B) do { MF; X[B] = EX(X[B]); X[B + 1] = EX(X[B + 1]); X[B + 2] = EX(X[B + 2]); X[B + 3] = EX(X[B + 3]); PIN(X); SBAR(); } while (0)
#define VRD(i) do { vlo[i] = vtr(vp_ + (((i) >> 2) * 4096 + ((i) & 3) * 1024)); vhi[i] = vtr(vp_ + (((i) >> 2) * 4096 + ((i) & 3) * 1024 + 512)); } while (0)
#define KRD(G, j) do { if (G) { kload2(kf, kp0 + sl_next, j); SBAR(); } } while (0)
#define STEP(C0, C1, P0, P1, t, GK, GV, GL) do { SBAR(); \
    const lds_cptr vp_ = vp0 + sl_prev; \
    VRD(0); SBAR(); float sacc = (P0[0] + P0[1]); \
    GAPA(C0 = MFMA32(kf[0], qr[0], negm), P0[2], P0[3], P0[4], P0[5],     pw0[0] = PKW(P0, 0), pw0[1] = PKW(P0, 2), pw0); \
    VRD(4); SBAR(); GAPA(C1 = MFMA32(kf[1], qr[0], negm), P0[6], P0[7], P0[8], P0[9],     pw0[2] = PKW(P0, 4), pw0[3] = PKW(P0, 6), pw0); \
    VRD(1); SBAR(); GAPA(C0 = MFMA32(kf[2], qr[1], C0),   P0[10], P0[11], P0[12], P0[13], pw1[0] = PKW(P0, 8), pw1[1] = PKW(P0, 10), pw1); \
    VRD(5); SBAR(); GAPA(C1 = MFMA32(kf[3], qr[1], C1),   P0[14], P0[15], P1[0], P1[1],   pw1[2] = PKW(P0, 12), pw1[3] = PKW(P0, 14), pw1); \
    VRD(2); SBAR(); GAPA(C0 = MFMA32(kf[4], qr[2], C0),   P1[2], P1[3], P1[4], P1[5],     pw2[0] = PKW(P1, 0), pw2[1] = PKW(P1, 2), pw2); \
    VRD(6); SBAR(); GAPA(C1 = MFMA32(kf[5], qr[2], C1),   P1[6], P1[7], P1[8], P1[9],     pw2[2] = PKW(P1, 4), pw2[3] = PKW(P1, 6), pw2); \
    VRD(3); SBAR(); GAPA(C0 = MFMA32(kf[6], qr[3], C0),   P1[10], P1[11], P1[12], P1[13], pw3[0] = PKW(P1, 8), pw3[1] = PKW(P1, 10), pw3); \
    VRD(7); SBAR(); GAPA(C1 = MFMA32(kf[7], qr[3], C1),   P1[14], P1[15], 0.f, 0.f,       pw3[2] = PKW(P1, 12), pw3[3] = PKW(P1, 14), pw3); \
    l_reg += sacc; \
    if (GK) { DMA_K((t) + 3, sl_cur); } if (GV) { DMA_V((t) + 1, sl_next); } \
    ADDB(C0, C1, t); CMASK(C0, C1, t); \
    { float a = MX3(C0[0], C0[1], C1[0]), b = MX3(C0[2], C0[3], C1[1]); a = MX3(a, C1[2], C1[3]); \
      _Pragma("unroll") for (int r = 4; r < 16; r += 4) { a = MX3(a, C0[r], C0[r + 1]); b = MX3(b, C0[r + 2], C0[r + 3]); a = MX3(a, C1[r], C1[r + 1]); b = MX3(b, C1[r + 2], C1[r + 3]); } \
      float rm = __builtin_fmaxf(a, b); { auto rr = __builtin_amdgcn_permlane32_swap(__float_as_uint(rm), __float_as_uint(rm), false, false); rm = __builtin_fmaxf(__uint_as_float(rr[0]), __uint_as_float(rr[1])); } \
      resc = false; \
      if (__builtin_expect(__any(rm > (float)THRL), 0)) { const float dl = __builtin_fmaxf(rm, 0.f); mhat += dl; \
        _Pragma("unroll") for (int r = 0; r < 16; ++r) { C0[r] -= dl; C1[r] -= dl; } \
        _Pragma("unroll") for (int r = 0; r < 16; ++r) negm[r] = -mhat; asm volatile("" : "+v"(negm)); \
        const float f = __builtin_amdgcn_exp2f(-dl); l_reg *= f; if (hi == 0) wsf[r32] = f; resc = true; } } \
    SBAR(); \
    GAPB(o[0] = MFMA32(PAF(0), VFR(0), o[0]), C0, 0); \
    GAPB(o[1] = MFMA32(PAF(0), VFR(4), o[1]), C0, 4); \
    KRD(GL, 0); GAPB(o[0] = MFMA32(PAF(1), VFR(1), o[0]), C0, 8); \
    KRD(GL, 1); GAPB(o[1] = MFMA32(PAF(1), VFR(5), o[1]), C0, 12); \
    KRD(GL, 2); GAPB(o[0] = MFMA32(PAF(2), VFR(2), o[0]), C1, 0); \
    KRD(GL, 3); GAPB(o[1] = MFMA32(PAF(2), VFR(6), o[1]), C1, 4); \
    GAPB(o[0] = MFMA32(PAF(3), VFR(3), o[0]), C1, 8); \
    GAPB(o[1] = MFMA32(PAF(3), VFR(7), o[1]), C1, 12); \
    } while (0)
    int t = 1;
#define ENDW(tt) do { if ((tt) + 3 < NT) { WAIT_BAR(2); } else if ((tt) + 2 < NT) { WAIT_BAR(1); } else { WAIT_BAR(0); } } while (0)
    for (; t + 1 < NT; t += 2) {
        STEP(pB0, pB1, pA0, pA1, t, (t + 3 < NT), (t + 1 < NT), (t + 1 < NT));       ENDW(t);     RESC(); ROT();
        STEP(pA0, pA1, pB0, pB1, t + 1, (t + 4 < NT), (t + 2 < NT), (t + 2 < NT));   ENDW(t + 1); RESC(); ROT();
    }
    STEP(pB0, pB1, pA0, pA1, NT - 1, false, false, false); RESC();
    { float sacc = pB0[0] + pB0[1]; _Pragma("unroll") for (int r = 2; r < 16; ++r) sacc += pB0[r]; _Pragma("unroll") for (int r = 0; r < 16; ++r) sacc += pB1[r]; l_reg += sacc;
      pw0 = (u32x4){PKW(pB0, 0), PKW(pB0, 2), PKW(pB0, 4), PKW(pB0, 6)}; pw1 = (u32x4){PKW(pB0, 8), PKW(pB0, 10), PKW(pB0, 12), PKW(pB0, 14)}; pw2 = (u32x4){PKW(pB1, 0), PKW(pB1, 2), PKW(pB1, 4), PKW(pB1, 6)}; pw3 = (u32x4){PKW(pB1, 8), PKW(pB1, 10), PKW(pB1, 12), PKW(pB1, 14)};
      int ln_ = threadIdx.x & 63; asm volatile("" : "+v"(ln_));
      const int vb0 = (int)(lds0 + LDS_V) + ((ln_ >> 4) & 1) * 32 + (ln_ & 3) * 8 + (4 * (ln_ >> 5) + ((ln_ & 15) >> 2)) * 64;
      SBAR(); pv(o, vb0 + sl_cur, PAF(0), PAF(1), PAF(2), PAF(3)); }
#undef PKW
#undef PAF
#undef VFR
#undef PIN
#undef MX3
#undef GAPA
#undef GAPB
#undef EX
#undef VRD
#undef KRD
#undef STEP
#undef ENDW
    { auto rr = __builtin_amdgcn_permlane32_swap(__float_as_uint(l_reg), __float_as_uint(l_reg), false, false); l_reg = __uint_as_float(rr[0]) + __uint_as_float(rr[1]); }
    if (hi == 0) wsf[32 + r32] = l_reg; asm volatile("s_waitcnt lgkmcnt(0)" ::: "memory");
    float rli[16];
#pragma unroll
    for (int r = 0; r < 16; ++r) rli[r] = __builtin_amdgcn_rcpf(wsf[32 + crow(r, hi)]);
    {
        int le = threadIdx.x & 63; asm volatile("" : "+v"(le));
        float* stg = (float*)(shm + LDS_OST) + wid * 1024;
        const h16* Zw = Z + (rowbase + q0 + wid * QBLK) * PQ + h * D;
        h16* Yw = Y + (rowbase + q0 + wid * QBLK) * 1536 + h * D;
#pragma unroll
        for (int d0 = 0; d0 < 2; ++d0) {
#pragma unroll
            for (int r = 0; r < 16; ++r) stg[crow(r, le >> 5) * 32 + (le & 31)] = o[d0][r] * rli[r];
            asm volatile("s_waitcnt lgkmcnt(0)" ::: "memory");
#pragma unroll
            for (int i = 0; i < 2; ++i) { const int row = i * 16 + (le >> 2), ch = le & 3;
                const f32x4 a0 = *(const f32x4*)(stg + row * 32 + ch * 8), a1 = *(const f32x4*)(stg + row * 32 + ch * 8 + 4);
                const h16x8 zv = *(const h16x8*)(Zw + (long)row * PQ + d0 * 32 + ch * 8);
                float ov[8] = {a0[0], a0[1], a0[2], a0[3], a1[0], a1[1], a1[2], a1[3]};
#pragma unroll
                for (int e = 0; e < 8; ++e) { const float zz = (float)zv[e]; ov[e] *= zz * __builtin_amdgcn_rcpf(1.f + __expf(-zz)); }
                u32x4 w; w.x = cvtpk_s(ov[0], ov[1]); w.y = cvtpk_s(ov[2], ov[3]); w.z = cvtpk_s(ov[4], ov[5]); w.w = cvtpk_s(ov[6], ov[7]);
                *(u32x4*)(Yw + (long)row * 1536 + d0 * 32 + ch * 8) = w; }
            asm volatile("s_waitcnt lgkmcnt(0)" ::: "memory");
        }
    }
    asm volatile("s_waitcnt vmcnt(0) lgkmcnt(0)\n\ts_barrier" ::: "memory");
#undef DMA_K
#undef DMA_V
#undef AMAP
#undef ADDB
#undef CMASK
#undef START
#undef RESC
#undef ROT
}
#undef SBAR
#undef WAIT_BAR
#undef MFMA32
#undef LDS8
}

constexpr int NWAVES = 8, NTHREADS = 512;
constexpr int MK_LDS_BYTES = 147456;
enum { PH_NORM = 0, PH_PROJ = 1, PH_PRE = 2, PH_SCAN = 3, PH_MIX = 4, PH_BR = 5, PH_OUT = 6, NPH = 7 };
constexpr int N_STEPS = 1 + NPH * 4 + 1;
struct MArgs { const float* in[11]; float* out; unsigned char* ws; int s_lo, s_hi; };

__device__ __forceinline__ void barrier_lds() { asm volatile("s_waitcnt vmcnt(0) lgkmcnt(0)" ::: "memory"); __syncthreads(); }
__device__ __forceinline__ void fox_cumsum_item(int item, int b0, const float* __restrict__ small, float* __restrict__ cb, char* shm) {
    int tid_ = threadIdx.x; asm volatile("" : "+v"(tid_));
    const int tid = tid_, lane = tid & 63, wid = tid >> 6, bl = item >> 3, h = item & 7;
    const float* sp = small + ((size_t)(b0 + bl) * SEQ + 4 * tid) * 16 + h;
    float v0 = sp[0], v1 = sp[16], v2 = sp[32], v3 = sp[48];
    v1 += v0; v2 += v1; v3 += v2;
    float tot = v3;
#pragma unroll
    for (int o = 1; o < 64; o <<= 1) { const float u = shfl_idx(tot, lane - o); if (lane >= o) tot += u; }
    float* wt = (float*)shm;
    if (lane == 63) wt[wid] = tot;
    __syncthreads();
    float base = tot - v3;
    for (int w = 0; w < wid; ++w) base += wt[w];
    float* o4 = cb + (size_t)((b0 + bl) * 8 + h) * SEQ + 4 * tid;
    *(f32x4*)o4 = (f32x4){-(base + v0) * LOG2E, -(base + v1) * LOG2E, -(base + v2) * LOG2E, -(base + v3) * LOG2E};
    __syncthreads();
}
__device__ __forceinline__ void moba_kmean_item(int item, int b0, const h16* __restrict__ proj, float* __restrict__ kmean, char* shm) {
    int tid_ = threadIdx.x; asm volatile("" : "+v"(tid_));
    const int tid = tid_, h = item & 7, blk = (item >> 3) & 7, bl = item >> 6, r8 = tid >> 3, c8 = tid & 7;
    const h16* kp = proj + ((size_t)bl * SEQ + blk * 256 + r8) * PW + PC_BK + h * 64 + c8 * 8;
    float acc[8];
#pragma unroll
    for (int e = 0; e < 8; ++e) acc[e] = 0.f;
#pragma unroll
    for (int j = 0; j < 4; ++j) { const h16x8 v = *(const h16x8*)(kp + (size_t)(64 * j) * PW);
#pragma unroll
        for (int e = 0; e < 8; ++e) acc[e] += (float)v[e]; }
    float* red = (float*)shm;
#pragma unroll
    for (int e = 0; e < 8; ++e) red[r8 * 65 + c8 * 8 + e] = acc[e];
    __syncthreads();
    if (tid < 64) { float sum = 0.f;
#pragma unroll 8
        for (int r = 0; r < 64; ++r) sum += red[r * 65 + tid];
        kmean[(((size_t)(b0 + bl) * 8 + h) * 8 + blk) * 64 + tid] = sum * (1.f / 256.f); }
    __syncthreads();
}

namespace mlstm {
typedef __attribute__((address_space(3))) char* lds_ptr;
typedef __attribute__((address_space(3))) const char* lds_cptr;
typedef short s16x8 __attribute__((ext_vector_type(8)));
typedef short s16x4 __attribute__((ext_vector_type(4)));
typedef short v4i16_t __attribute__((ext_vector_type(4)));
typedef float f32x16 __attribute__((ext_vector_type(16)));
typedef unsigned u32x4 __attribute__((ext_vector_type(4)));
constexpr int W_V = 0, W_K = 16384, W_SC = W_K + 8704, WREG = W_SC + 2048;
constexpr int NACT = 4;
__device__ __forceinline__ int crow(int r, int hi) { return (r & 3) + 8 * (r >> 2) + 4 * hi; }
#define MF32(a, b, c) __builtin_amdgcn_mfma_f32_32x32x16_f16(__builtin_bit_cast(h16x8, (a)), __builtin_bit_cast(h16x8, (b)), (c), 0, 0, 0)
#define LFW(off) ((__attribute__((address_space(3))) float*)(R + W_SC + (off)))
__device__ __forceinline__ s16x4 vtr(lds_cptr p) { return __builtin_bit_cast(s16x4, __builtin_amdgcn_ds_read_tr16_b64_v4i16((__attribute__((address_space(3))) v4i16_t*)p)); }
__device__ __forceinline__ s16x8 trfrag(lds_cptr img, int blk, int ks, int lb) {
    const s16x4 lo = vtr(img + blk * 4096 + ks * 1024 + lb), hi = vtr(img + blk * 4096 + ks * 1024 + 512 + lb);
    return (s16x8){lo[0], lo[1], lo[2], lo[3], hi[0], hi[1], hi[2], hi[3]};
}
__device__ __forceinline__ void stage_v(lds_ptr R, const h16* __restrict__ vsrc  , int lane) {
    int ln = lane; asm volatile("" : "+v"(ln));
    const h16* vp = vsrc + (size_t)(ln >> 2) * PW + (ln & 3) * 8;
#pragma unroll 1
    for (int sg = 0; sg < 4; ++sg) {
        h16x8 x[4];
#pragma unroll
        for (int vb = 0; vb < 4; ++vb) x[vb] = *(const h16x8*)(vp + 32 * vb);
#pragma unroll
        for (int vb = 0; vb < 4; ++vb) *(__attribute__((address_space(3))) h16x8*)(R + W_V + vb * 4096 + sg * 1024 + ln * 16) = x[vb];
        vp += (size_t)16 * PW; }
}
__device__ __forceinline__ void x1_wave(int item, int b0, const h16* __restrict__ proj, const float* __restrict__ small, const float* __restrict__ convw,
                                        h16* __restrict__ qkc, float* __restrict__ U, float* __restrict__ un, float* __restrict__ amax, float* __restrict__ blast, lds_ptr R, int lane_in) {
    int lane = threadIdx.x & 63; (void)lane_in; asm volatile("" : "+v"(lane));
    const int r32 = lane & 31, hi = lane >> 5;
    const int c = item & 31, hh = (item >> 5) & 3, bl = item >> 7;
    const size_t row0 = (size_t)bl * SEQ + c * 64;
    const int gbh = (b0 + bl) * 4 + hh, lbh = bl * 4 + hh;
    float ws;
    {   const float* sp = small + ((size_t)b0 * SEQ + row0 + lane) * 16;
        const float li = sp[8 + hh], lf = sp[12 + hh];
        float bc = lf;
#pragma unroll
        for (int o = 1; o < 64; o <<= 1) { const float u = shfl_idx(bc, lane - o); if (lane >= o) bc += u; }
        const float as = li - bc; float mx = as;
#pragma unroll
        for (int o = 1; o < 64; o <<= 1) mx = fmaxf(mx, shfl_idx(mx, lane ^ o));
        ws = __expf(as - mx);
        if (lane == 63) { amax[gbh * 32 + c] = mx; blast[gbh * 32 + c] = bc; } }
    stage_v(R, proj + row0 * PW + PC_CV + hh * 128, lane);
    const int t = c * 64 + lane;
#pragma unroll 1
    for (int dg = 0; dg < 16; ++dg) {
        const int isk = dg >> 3, pcol = isk ? 256 + hh * 64 + (dg - 8) * 8 : hh * 64 + dg * 8;
        float acc[8];
#pragma unroll
        for (int e = 0; e < 8; ++e) acc[e] = 0.f;
#pragma unroll
        for (int j = 0; j < 4; ++j) {
            const int tt = t - 3 + j, tc = tt < 0 ? 0 : tt;
            const h16x8 x = *(const h16x8*)(proj + ((size_t)bl * SEQ + tc) * PW + PC_CQK + pcol);
            const float m = tt < 0 ? 0.f : 1.f;
            const float* wp = convw + j * 512 + pcol;
#pragma unroll
            for (int e = 0; e < 8; ++e) acc[e] += wp[e] * m * (float)x[e];
        }
        h16x8 o, ow;
#pragma unroll
        for (int e = 0; e < 8; ++e) { float v = acc[e] * __builtin_amdgcn_rcpf(1.f + __expf(-acc[e])); if (isk) v *= 0.125f; o[e] = (h16)v; ow[e] = (h16)(v * ws); }
        *(h16x8*)(qkc + (row0 + lane) * 512 + pcol) = o;
        if (isk) { const int dgk = dg - 8; *(__attribute__((address_space(3))) h16x8*)(R + W_K + (dgk >> 2) * 4096 + lane * 64 + (dgk & 3) * 16) = ow; }
    }
    asm volatile("s_waitcnt lgkmcnt(0)" ::: "memory");
    const int lb = ((lane >> 4) & 1) * 32 + (lane & 3) * 8 + (4 * hi + ((lane & 15) >> 2)) * 64;
    float* up = U + ((size_t)lbh * 32 + c) * 8192;
#pragma unroll 1
    for (int vb = 0; vb < 4; ++vb) {
        f32x16 a0 = f32x16{}, a1 = f32x16{};
#pragma unroll
        for (int ks = 0; ks < 4; ++ks) { const s16x8 vf = trfrag((lds_cptr)(R + W_V), vb, ks, lb);
            a0 = MF32(vf, trfrag((lds_cptr)(R + W_K), 0, ks, lb), a0); a1 = MF32(vf, trfrag((lds_cptr)(R + W_K), 1, ks, lb), a1); }
#pragma unroll
        for (int r = 0; r < 16; ++r) { up[(vb * 32 + crow(r, hi)) * 64 + r32] = a0[r]; up[(vb * 32 + crow(r, hi)) * 64 + 32 + r32] = a1[r]; }
    }
    {   float sum = 0.f;
        lds_cptr kp = (lds_cptr)(R + W_K) + (lane >> 5) * 4096 + (lane & 31) * 2;
#pragma unroll 16
        for (int q = 0; q < 64; ++q) sum += (float)*(const __attribute__((address_space(3))) h16*)(kp + q * 64);
        un[((size_t)gbh * 32 + c) * 64 + lane] = sum; }
    asm volatile("s_waitcnt lgkmcnt(0)" ::: "memory");
}
__device__ __forceinline__ void x2_item(int item, int b0, const float* __restrict__ U, const float* __restrict__ un, const float* __restrict__ amax, const float* __restrict__ blast,
                                        h16* __restrict__ CS, float* __restrict__ ns, float* __restrict__ Ms, char* shm) {
    int tid_ = threadIdx.x; asm volatile("" : "+v"(tid_));
    const int tid = tid_, lbh = item >> 3, sl = item & 7, gbh = (b0 + (lbh >> 2)) * 4 + (lbh & 3);
    float* coef = (float*)shm;
    if (tid == 0) { float M = 0.f; if (sl == 0) Ms[gbh * 32] = 0.f;
        for (int c = 0; c < 31; ++c) { const float am = amax[gbh * 32 + c], bls = blast[gbh * 32 + c], Mn = bls + fmaxf(M, am);
            coef[2 * c] = __expf(bls + M - Mn); coef[2 * c + 1] = __expf(bls + am - Mn); M = Mn; if (sl == 0) Ms[gbh * 32 + c + 1] = M; } }
    __syncthreads();
    {   const int e2 = sl * 1024 + tid * 2;
        const float* up = U + (size_t)lbh * 32 * 8192 + e2; h16* cp = CS + (size_t)lbh * 32 * 8192 + e2;
        float c0 = 0.f, c1 = 0.f;
        *(pg8::h16x2*)cp = (pg8::h16x2){(h16)0.f, (h16)0.f};
#pragma unroll 1
        for (int cb = 0; cb < 31; cb += 8) {
            pg8::f32x2 u[8];
#pragma unroll
            for (int j = 0; j < 8; ++j) if (cb + j < 31) u[j] = *(const pg8::f32x2*)(up + (size_t)(cb + j) * 8192);
#pragma unroll
            for (int j = 0; j < 8; ++j) if (cb + j < 31) { const float fd = coef[2 * (cb + j)], fi = coef[2 * (cb + j) + 1];
                c0 = fd * c0 + fi * u[j].x; c1 = fd * c1 + fi * u[j].y;
                *(pg8::h16x2*)(cp + (size_t)(cb + j + 1) * 8192) = (pg8::h16x2){(h16)c0, (h16)c1}; }
        }
    }
    if (sl == 0 && tid < 64) { float n = 0.f; ns[((size_t)gbh * 32) * 64 + tid] = 0.f;
        for (int c = 0; c < 31; ++c) { n = coef[2 * c] * n + coef[2 * c + 1] * un[((size_t)gbh * 32 + c) * 64 + tid]; ns[((size_t)gbh * 32 + c + 1) * 64 + tid] = n; } }
    __syncthreads();
}
__device__ __forceinline__ void x3_wave(int item, int b0, const h16* __restrict__ proj, const float* __restrict__ small, const h16* __restrict__ qkc, const h16* __restrict__ CS,
                                        const float* __restrict__ ns, const float* __restrict__ Ms, const float* __restrict__ headg, h16* __restrict__ y, lds_ptr R, int lane_in) {
    int lane = threadIdx.x & 63; (void)lane_in; asm volatile("" : "+v"(lane));
    const int c = item & 31, hh = (item >> 5) & 3, bl = item >> 7;
    const size_t row0 = (size_t)bl * SEQ + c * 64;
    const int gbh = (b0 + bl) * 4 + hh, lbh = bl * 4 + hh;
    {   const float* sp = small + ((size_t)b0 * SEQ + row0 + lane) * 16;
        const float li = sp[8 + hh], lf = sp[12 + hh], Mc = Ms[gbh * 32 + c];
        float bc = lf;
#pragma unroll
        for (int o = 1; o < 64; o <<= 1) { const float u = shfl_idx(bc, lane - o); if (lane >= o) bc += u; }
        const float as = li - bc; float pm = as;
#pragma unroll
        for (int o = 1; o < 64; o <<= 1) { const float u = shfl_idx(pm, lane - o); if (lane >= o) pm = fmaxf(pm, u); }
        const float mx = fmaxf(Mc, pm);
        LFW(0)[lane] = as; LFW(256)[lane] = mx; LFW(512)[lane] = __expf(Mc - mx); LFW(768)[lane] = __expf(-(bc + mx));
        LFW(1280)[lane] = ns[((size_t)gbh * 32 + c) * 64 + lane]; }
    stage_v(R, proj + row0 * PW + PC_CV + hh * 128, lane);
    asm volatile("s_waitcnt lgkmcnt(0)" ::: "memory");
    const h16* cprev = CS + ((size_t)lbh * 32 + c) * 8192;
    typedef __attribute__((address_space(3))) const f32x4 lds_cf32x4;
#pragma unroll 1
    for (int tb = 0; tb < 2; ++tb) {
        int l2 = lane; asm volatile("" : "+v"(l2));
        const int r32 = l2 & 31, hi = l2 >> 5;
        const int lb = ((l2 >> 4) & 1) * 32 + (l2 & 3) * 8 + (4 * hi + ((l2 & 15) >> 2)) * 64;
        const int t = 32 * tb + r32;
        s16x8 qr[4];
#pragma unroll
        for (int ks = 0; ks < 4; ++ks) qr[ks] = *(const s16x8*)(qkc + (row0 + t) * 512 + hh * 64 + 16 * ks + 8 * hi);
        const float mxt = LFW(256)[t], wit = LFW(512)[t];
        float nq = 0.f;
#pragma unroll
        for (int ks = 0; ks < 4; ++ks) { const h16x8 qv = __builtin_bit_cast(h16x8, qr[ks]);
            const f32x4 n0 = *(lds_cf32x4*)(R + W_SC + 1280 + (16 * ks + 8 * hi) * 4), n1 = *(lds_cf32x4*)(R + W_SC + 1280 + (16 * ks + 8 * hi + 4) * 4);
            nq += (float)qv[0] * n0[0] + (float)qv[1] * n0[1] + (float)qv[2] * n0[2] + (float)qv[3] * n0[3] + (float)qv[4] * n1[0] + (float)qv[5] * n1[1] + (float)qv[6] * n1[2] + (float)qv[7] * n1[3]; }
        nq = half_sum(nq);
        f32x16 p0 = f32x16{}, p1 = f32x16{};
#pragma unroll
        for (int ks = 0; ks < 4; ++ks) { const s16x8 k0 = *(const s16x8*)(qkc + (row0 + r32) * 512 + 256 + hh * 64 + 16 * ks + 8 * hi); p0 = MF32(k0, qr[ks], p0); }
        if (tb == 1) {
#pragma unroll
            for (int ks = 0; ks < 4; ++ks) { const s16x8 k1 = *(const s16x8*)(qkc + (row0 + 32 + r32) * 512 + 256 + hh * 64 + 16 * ks + 8 * hi); p1 = MF32(k1, qr[ks], p1); } }
        float dsum = 0.f;
#pragma unroll
        for (int g = 0; g < 4; ++g) { const f32x4 a0 = *(lds_cf32x4*)(R + W_SC + (8 * g + 4 * hi) * 4), a1 = *(lds_cf32x4*)(R + W_SC + (32 + 8 * g + 4 * hi) * 4);
#pragma unroll
            for (int i = 0; i < 4; ++i) { const int s0 = 8 * g + 4 * hi + i;
                const float w0 = s0 <= t ? p0[4 * g + i] * __expf(a0[i] - mxt) : 0.f; p0[4 * g + i] = w0; dsum += w0;
                const float w1 = (tb == 1 && s0 + 32 <= t) ? p1[4 * g + i] * __expf(a1[i] - mxt) : 0.f; p1[4 * g + i] = w1; dsum += w1; } }
        dsum = half_sum(dsum);
        if (hi == 0) LFW(1024)[t] = dsum + wit * nq;
        u32x4 pw0, pw1, pw2, pw3;
#define PKW(P, B) pg8::cvt_pk_f16(P[B], P[B + 1])
        pw0 = (u32x4){PKW(p0, 0), PKW(p0, 2), PKW(p0, 4), PKW(p0, 6)}; pw1 = (u32x4){PKW(p0, 8), PKW(p0, 10), PKW(p0, 12), PKW(p0, 14)};
        pw2 = (u32x4){PKW(p1, 0), PKW(p1, 2), PKW(p1, 4), PKW(p1, 6)}; pw3 = (u32x4){PKW(p1, 8), PKW(p1, 10), PKW(p1, 12), PKW(p1, 14)};
#undef PKW
        s16x8 qs[4];
        { const h16 wh = (h16)wit;
#pragma unroll
          for (int ks = 0; ks < 4; ++ks) { h16x8 qv = __builtin_bit_cast(h16x8, qr[ks]);
#pragma unroll
              for (int e = 0; e < 8; ++e) qv[e] = qv[e] * wh;
              qs[ks] = __builtin_bit_cast(s16x8, qv); } }
        f32x16 acc[4];
#pragma unroll
        for (int vb = 0; vb < 4; ++vb) { acc[vb] = f32x16{};
#pragma unroll
            for (int ks = 0; ks < 4; ++ks) { const s16x8 cf = *(const s16x8*)(cprev + (32 * vb + r32) * 64 + 16 * ks + 8 * hi); acc[vb] = MF32(qs[ks], cf, acc[vb]); }
            acc[vb] = MF32(__builtin_bit_cast(s16x8, pw0), trfrag((lds_cptr)(R + W_V), vb, 0, lb), acc[vb]);
            acc[vb] = MF32(__builtin_bit_cast(s16x8, pw1), trfrag((lds_cptr)(R + W_V), vb, 1, lb), acc[vb]);
            if (tb == 1) { acc[vb] = MF32(__builtin_bit_cast(s16x8, pw2), trfrag((lds_cptr)(R + W_V), vb, 2, lb), acc[vb]);
                           acc[vb] = MF32(__builtin_bit_cast(s16x8, pw3), trfrag((lds_cptr)(R + W_V), vb, 3, lb), acc[vb]); } }
        asm volatile("s_waitcnt lgkmcnt(0)" ::: "memory");
#pragma unroll
        for (int g = 0; g < 4; ++g) { const f32x4 dn = *(lds_cf32x4*)(R + W_SC + 1024 + (32 * tb + 8 * g + 4 * hi) * 4), em = *(lds_cf32x4*)(R + W_SC + 768 + (32 * tb + 8 * g + 4 * hi) * 4);
#pragma unroll
            for (int i = 0; i < 4; ++i) { const float inv = __builtin_amdgcn_rcpf(fmaxf(fabsf(dn[i]), em[i])); const int rl = 8 * g + 4 * hi + i;
#pragma unroll
                for (int vb = 0; vb < 4; ++vb) *(__attribute__((address_space(3))) h16*)(R + W_K + rl * 272 + (32 * vb + r32) * 2) = (h16)(acc[vb][4 * g + i] * inv); } }
        asm volatile("s_waitcnt lgkmcnt(0)" ::: "memory");
#pragma unroll 1
        for (int ps = 0; ps < 2; ++ps) {
            int l3 = threadIdx.x & 63; asm volatile("" : "+v"(l3));
            const int rl = 16 * ps + (l3 >> 2), v0 = (l3 & 3) * 32;
            const size_t row = row0 + 32 * tb + rl;
            float hg[32]; float ss = 0.f;
#pragma unroll
            for (int q = 0; q < 4; ++q) { const h16x8 hv = *(const __attribute__((address_space(3))) h16x8*)(R + W_K + rl * 272 + (v0 + 8 * q) * 2);
                const h16x8 og = *(const h16x8*)(proj + row * PW + PC_CO + hh * 128 + v0 + 8 * q);
#pragma unroll
                for (int e = 0; e < 8; ++e) { const float x = (float)hv[e] * __builtin_amdgcn_rcpf(1.f + __expf(-(float)og[e])); hg[8 * q + e] = x; ss += x * x; } }
            ss += swz_xor<1>(ss); ss += swz_xor<2>(ss);
            const float rn = rsqrtf(ss * (1.f / 128.f) + RMS_EPS);
#pragma unroll
            for (int q = 0; q < 4; ++q) { const h16x8 zv = *(const h16x8*)(proj + row * PW + PC_CZ + hh * 128 + v0 + 8 * q);
                const f32x4 g0 = *(const f32x4*)(headg + hh * 128 + v0 + 8 * q), g1 = *(const f32x4*)(headg + hh * 128 + v0 + 8 * q + 4);
                float ov[8];
#pragma unroll
                for (int e = 0; e < 8; ++e) { const float zz = (float)zv[e]; ov[e] = hg[8 * q + e] * rn * (e < 4 ? g0[e] : g1[e - 4]) * zz * __builtin_amdgcn_rcpf(1.f + __expf(-zz)); }
                u32x4 w; w.x = pg8::cvt_pk_f16(ov[0], ov[1]); w.y = pg8::cvt_pk_f16(ov[2], ov[3]); w.z = pg8::cvt_pk_f16(ov[4], ov[5]); w.w = pg8::cvt_pk_f16(ov[6], ov[7]);
                *(u32x4*)(y + row * 1536 + 1024 + hh * 128 + v0 + 8 * q) = w; }
        }
        asm volatile("s_waitcnt lgkmcnt(0)" ::: "memory");
    }
}
#undef LFW
#undef MF32
}

#define LAS __attribute__((address_space(3)))
#define XB_TMO      128
#define XB_XCNT(j)  (256  + 64 * (j))
#define XB_XSUB(j)  (1280 + 64 * (j))
#define XB_XGEN(j)  (2304 + 64 * (j))
#define XB_TOP      3328
#define XB_TOPGEN   3392
#define XCD_BAR_WORDS 3456
#define XB_SPIN_CAP (1u << 18)
__device__ __forceinline__ unsigned xb_ld(unsigned* p)              { return __hip_atomic_load(p, __ATOMIC_RELAXED, __HIP_MEMORY_SCOPE_AGENT); }
__device__ __forceinline__ unsigned xb_add(unsigned* p, unsigned v) { return __hip_atomic_fetch_add(p, v, __ATOMIC_RELAXED, __HIP_MEMORY_SCOPE_AGENT); }
__device__ __forceinline__ unsigned xb_xcc_id() { return (unsigned)__builtin_amdgcn_s_getreg((3 << 11) | 20) & 0xFu; }
#define XB_SPIN(cond, bar) do { unsigned _sp = 0; while (cond) { __builtin_amdgcn_s_sleep(1); \
    if ((++_sp & 255u) == 0u) { if (xb_ld(&(bar)[XB_TMO])) break; if (_sp > XB_SPIN_CAP) { atomicAdd(&(bar)[XB_TMO], 1u); break; } } } } while (0)
struct XcdBarrier { unsigned* bar; unsigned x; volatile LAS unsigned* st; };
__device__ __forceinline__ XcdBarrier xcd_barrier_post(unsigned* bar, volatile LAS unsigned* st) {
    XcdBarrier b; b.bar = bar; b.x = xb_xcc_id(); b.st = st;
    if (threadIdx.x == 0) (void)xb_add(&bar[XB_XCNT(b.x)], 1u);
    return b;
}
__device__ __forceinline__ void xcd_barrier_complete(unsigned* bar, unsigned x, unsigned& nloc, unsigned& nx) {
    const unsigned G = gridDim.x * gridDim.y * gridDim.z;
    unsigned sum, cnt, mine, sp = 0u;
    for (;;) {
        sum = 0u; cnt = 0u; mine = 0u;
#pragma unroll
        for (unsigned j = 0; j < 16; ++j) { const unsigned c = xb_ld(&bar[XB_XCNT(j)]); sum += c; cnt += (c > 0u) ? 1u : 0u; mine = (j == x) ? c : mine; }
        if (sum == G) break;
        __builtin_amdgcn_s_sleep(1);
        if ((++sp & 255u) == 0u) { if (xb_ld(&bar[XB_TMO])) break; if (sp > XB_SPIN_CAP) { atomicAdd(&bar[XB_TMO], 1u); break; } }
    }
    nloc = mine > 0u ? mine : 1u; nx = cnt > 0u ? cnt : 1u;
}
__device__ __forceinline__ void xcd_barrier(const XcdBarrier& b) {
    asm volatile("s_waitcnt vmcnt(0)" ::: "memory");
    __syncthreads();
    if (threadIdx.x == 0) {
        unsigned* bar = b.bar;
        __builtin_amdgcn_s_waitcnt(0);
        unsigned nloc = b.st[0], nx = b.st[1];
        if (nloc == 0u) { xcd_barrier_complete(bar, b.x, nloc, nx); b.st[0] = nloc; b.st[1] = nx; }
        const unsigned old = xb_add(&bar[XB_XSUB(b.x)], 1u);
        const unsigned gen = old / nloc;
        if (old + 1u == (gen + 1u) * nloc) {
            __builtin_amdgcn_fence(__ATOMIC_RELEASE, "agent");
            asm volatile("s_waitcnt vmcnt(0)" ::: "memory");
            const unsigned og = xb_add(&bar[XB_TOP], 1u);
            const unsigned tg = og / nx;
            if (og + 1u == (tg + 1u) * nx) xb_add(&bar[XB_TOPGEN], 1u);
            else XB_SPIN(xb_ld(&bar[XB_TOPGEN]) == tg, bar);
            __builtin_amdgcn_fence(__ATOMIC_ACQUIRE, "agent");
            xb_add(&bar[XB_XGEN(b.x)], 1u);
            asm volatile("s_waitcnt vmcnt(0)" ::: "memory");
        } else {
            XB_SPIN(xb_ld(&bar[XB_XGEN(b.x)]) == gen, bar);
            __builtin_amdgcn_fence(__ATOMIC_ACQUIRE, "agent");
            asm volatile("s_waitcnt vmcnt(0)" ::: "memory");
        }
    }
    __syncthreads();
}
constexpr int LDSCTL_OFF = 131072, MISC_OFF = LDSCTL_OFF + 320;
constexpr int CW_BAR = 4096;
constexpr size_t CTL_ZERO_BYTES = 65536;

__device__ __forceinline__ void transpose_item(const float* __restrict__ W, int ldsrc, int K, h16* __restrict__ WT, int k0, int n0, int src_col0, float scale, PG8_LAS float* scr, int lane) {
    float tv[32];
#pragma unroll
    for (int i = 0; i < 32; ++i) { const int kk = 2 * i + (lane >> 5); tv[i] = W[(size_t)(k0 + kk) * ldsrc + src_col0 + (lane & 31)]; }
#pragma unroll
    for (int i = 0; i < 32; ++i) { const int kk = 2 * i + (lane >> 5); scr[kk * 33 + (lane & 31)] = tv[i]; }
    asm volatile("s_waitcnt lgkmcnt(0)" ::: "memory");
    const int c = lane & 7;
#pragma unroll
    for (int j = 0; j < 4; ++j) { const int n = (lane >> 3) + 8 * j; const PG8_LAS float* sp = scr + (8 * c) * 33 + n;
        pg8::u32x4 o; o.x = pg8::cvt_pk_f16(sp[0 * 33] * scale, sp[1 * 33] * scale); o.y = pg8::cvt_pk_f16(sp[2 * 33] * scale, sp[3 * 33] * scale);
        o.z = pg8::cvt_pk_f16(sp[4 * 33] * scale, sp[5 * 33] * scale); o.w = pg8::cvt_pk_f16(sp[6 * 33] * scale, sp[7 * 33] * scale);
        *(pg8::u32x4*)(WT + (size_t)(n0 + n) * K + k0 + 8 * c) = o; }
    asm volatile("s_waitcnt lgkmcnt(0)" ::: "memory");
}
__device__ __forceinline__ void prologue_phase(const MArgs& a, PG8_LAS unsigned char* L) {
    int tid_ = threadIdx.x; asm volatile("" : "+v"(tid_));
    const int lane = tid_ & 63, wave = tid_ >> 6;
    PG8_LAS float* scr = (PG8_LAS float*)(L + wave * 16384);
    const int gw = blockIdx.x * NWAVES + wave, NGW = gridDim.x * NWAVES;
    constexpr int I_IN = (DM / 64) * (PW / 32), I_BR = (512 / 64) * (1024 / 32), I_OUT = (DM / 64) * (DM / 32), I_L = I_IN + 3 * I_BR + I_OUT;
    unsigned char* ws = a.ws;
    for (int it = gw; it < DEPTH * I_L; it += NGW) {
        const int l = it / I_L; int r = it - l * I_L;
        if (r < I_IN) { const int nblk = PW / 32, kb = r / nblk, nb = r % nblk, n0 = nb * 32;
            const float sc = ((n0 >= PC_AQ && n0 < PC_AQ + 512) || (n0 >= PC_BQ && n0 < PC_BQ + 512)) ? C2 : 1.f;
            transpose_item(a.in[2] + (size_t)l * DM * INW, INW, DM, (h16*)(ws + WS_WIN) + (size_t)l * PW * DM, kb * 64, n0, orig_col(n0), sc, scr, lane); continue; }
        r -= I_IN;
        if (r < 3 * I_BR) { const int n3 = r / I_BR, q = r % I_BR, nblk = 1024 / 32, kb = q / nblk, nb = q % nblk;
            transpose_item(a.in[8] + ((size_t)l * 3 + n3) * 512 * 1024, 1024, 512, (h16*)(ws + WS_WBR) + ((size_t)l * 3 + n3) * 1024 * 512, kb * 64, nb * 32, nb * 32, 1.f, scr, lane); continue; }
        r -= 3 * I_BR;
        { const int nblk = DM / 32, kb = r / nblk, nb = r % nblk;
          transpose_item(a.in[9] + (size_t)l * DM * DM, DM, DM, (h16*)(ws + WS_WOUT) + (size_t)l * DM * DM, kb * 64, nb * 32, nb * 32, 1.f, scr, lane); }
    }
    float* wsmall = (float*)(ws + WS_WSMALL);
    for (int i = blockIdx.x * NTHREADS + tid_; i < DEPTH * 16 * DM; i += gridDim.x * NTHREADS) {
        const int l = i / (16 * DM), c = (i >> 10) & 15, k = i & 1023;
        wsmall[i] = a.in[2][(size_t)l * DM * INW + (size_t)k * INW + small_col(c)];
    }
}
__device__ __forceinline__ void norm_phase(const float* __restrict__ x, const float* __restrict__ g, const float* __restrict__ wsmall, const float* __restrict__ fox_bf,
                                           const float* __restrict__ ml_bi, const float* __restrict__ ml_bf, h16* __restrict__ hn, float* __restrict__ small, int row0) {
    int tid_ = threadIdx.x; asm volatile("" : "+v"(tid_));
    const int lane = tid_ & 63, gw = blockIdx.x * NWAVES + (tid_ >> 6), NGW = gridDim.x * NWAVES;
    for (int r4 = gw; r4 < TH / 4; r4 += NGW) {
        f32x4 v[4][4];
#pragma unroll
        for (int q = 0; q < 4; ++q) {
            const f32x4* xr = (const f32x4*)(x + (size_t)(row0 + 4 * r4 + q) * DM) + lane;
            float ssq = 0.f;
#pragma unroll
            for (int j = 0; j < 4; ++j) { v[q][j] = xr[64 * j]; ssq += v[q][j].x * v[q][j].x + v[q][j].y * v[q][j].y + v[q][j].z * v[q][j].z + v[q][j].w * v[q][j].w; }
            const float rstd = rsqrtf(wave_sum(ssq) * (1.f / DM) + RMS_EPS);
#pragma unroll
            for (int j = 0; j < 4; ++j) {
                const f32x4 gg = ((const f32x4*)g)[lane + 64 * j];
                v[q][j].x *= rstd * gg.x; v[q][j].y *= rstd * gg.y; v[q][j].z *= rstd * gg.z; v[q][j].w *= rstd * gg.w;
                pg8::u32x4 dummy; (void)dummy;
                typedef unsigned u32x2 __attribute__((ext_vector_type(2)));
                u32x2 o; o.x = pg8::cvt_pk_f16(v[q][j].x, v[q][j].y); o.y = pg8::cvt_pk_f16(v[q][j].z, v[q][j].w);
                *((u32x2*)(hn + (size_t)(4 * r4 + q) * DM) + lane + 64 * j) = o;
            }
        }
        float mine[4] = {0.f, 0.f, 0.f, 0.f};
#pragma unroll 1
        for (int c = 0; c < 16; ++c) {
            const f32x4* wr = (const f32x4*)(wsmall + c * DM) + lane;
            float acc[4] = {0.f, 0.f, 0.f, 0.f};
#pragma unroll
            for (int j = 0; j < 4; ++j) { const f32x4 w = wr[64 * j];
#pragma unroll
                for (int q = 0; q < 4; ++q) acc[q] += v[q][j].x * w.x + v[q][j].y * w.y + v[q][j].z * w.z + v[q][j].w * w.w; }
#pragma unroll
            for (int q = 0; q < 4; ++q) { const float t = wave_sum(acc[q]); if (lane == c) mine[q] = t; }
        }
        if (lane < 16) {
            const float bias = lane < 8 ? fox_bf[lane] : lane < 12 ? ml_bi[lane - 8] : ml_bf[lane - 12];
#pragma unroll
            for (int q = 0; q < 4; ++q) { const float pre = mine[q] + bias; small[(size_t)(row0 + 4 * r4 + q) * 16 + lane] = (lane >= 8 && lane < 12) ? pre : log_sigmoidf_(pre); }
        }
    }
}
__device__ __forceinline__ void final_norm_phase(float* __restrict__ x, const float* __restrict__ g) {
    int tid_ = threadIdx.x; asm volatile("" : "+v"(tid_));
    const int lane = tid_ & 63, gw = blockIdx.x * NWAVES + (tid_ >> 6), NGW = gridDim.x * NWAVES;
    for (int row = gw; row < TT; row += NGW) {
        f32x4* xr = (f32x4*)(x + (size_t)row * DM) + lane;
        f32x4 v[4]; float ssq = 0.f;
#pragma unroll
        for (int j = 0; j < 4; ++j) { v[j] = xr[64 * j]; ssq += v[j].x * v[j].x + v[j].y * v[j].y + v[j].z * v[j].z + v[j].w * v[j].w; }
        const float rstd = rsqrtf(wave_sum(ssq) * (1.f / DM) + RMS_EPS);
#pragma unroll
        for (int j = 0; j < 4; ++j) { const f32x4 gg = ((const f32x4*)g)[lane + 64 * j];
            xr[64 * j] = (f32x4){v[j].x * rstd * gg.x, v[j].y * rstd * gg.y, v[j].z * rstd * gg.z, v[j].w * rstd * gg.w}; }
    }
}

__global__ void __launch_bounds__(NTHREADS, 2) mega(MArgs a) {
    extern __shared__ __attribute__((aligned(16))) unsigned char lds[];
    PG8_LAS unsigned char* L = (PG8_LAS unsigned char*)lds;
    unsigned char* ws = a.ws;
    for (int u = threadIdx.x; u < (MK_LDS_BYTES - LDSCTL_OFF) / 4; u += NTHREADS) ((LAS unsigned*)(L + LDSCTL_OFF))[u] = 0u;
    __syncthreads();
    XcdBarrier bar = xcd_barrier_post((unsigned*)(ws + WS_CTL) + CW_BAR, (volatile LAS unsigned*)(L + MISC_OFF) + 8);
    for (int s = a.s_lo; s < a.s_hi; ++s) {
        if (s == a.s_lo + 1) { __builtin_amdgcn_fence(__ATOMIC_RELEASE, "agent"); cg::this_grid().sync(); __builtin_amdgcn_fence(__ATOMIC_ACQUIRE, "agent"); }
        else if (s > a.s_lo) xcd_barrier(bar);
        if (s == 0) { prologue_phase(a, L); barrier_lds(); continue; }
        if (s == N_STEPS - 1) { final_norm_phase(a.out, a.in[10]); continue; }
        const int li = (s - 1) / NPH, ph = (s - 1) % NPH, layer = li >> 1, hf = li & 1;
        const int row0 = hf * TH;
        if (ph == PH_NORM) {
            norm_phase(layer == 0 ? a.in[0] : a.out, a.in[1] + layer * DM, (const float*)(ws + WS_WSMALL) + layer * 16 * DM, a.in[3] + layer * 8, a.in[5] + layer * 4, a.in[6] + layer * 4,
                       (h16*)(ws + WS_HN), (float*)(ws + WS_SMALL), row0);
        } else if (ph == PH_PRE) {
            const int b0 = hf * HB;
            for (int it = blockIdx.x; it < HB * 8; it += gridDim.x) fox_cumsum_item(it, b0, (const float*)(ws + WS_SMALL), (float*)(ws + WS_CB), (char*)lds);
            for (int it = blockIdx.x; it < HB * 64; it += gridDim.x) moba_kmean_item(it, b0, (const h16*)(ws + WS_PROJ), (float*)(ws + WS_KMEAN), (char*)lds);
            {   int tid_ = threadIdx.x; asm volatile("" : "+v"(tid_));
                const int wv = __builtin_amdgcn_readfirstlane(tid_ >> 6), ln = tid_ & 63;
                if (wv < mlstm::NACT) for (int it = blockIdx.x * mlstm::NACT + wv; it < HB * 128; it += gridDim.x * mlstm::NACT)
                    mlstm::x1_wave(it, b0, (const h16*)(ws + WS_PROJ), (const float*)(ws + WS_SMALL), a.in[4] + (size_t)layer * 4 * 512, (h16*)(ws + WS_QKC), (float*)(ws + WS_U),
                                   (float*)(ws + WS_MUN), (float*)(ws + WS_MAMAX), (float*)(ws + WS_MBLAST), (mlstm::lds_ptr)L + wv * mlstm::WREG, ln);
                barrier_lds(); }
        } else if (ph == PH_SCAN) {
            for (int it = blockIdx.x; it < 32 * 8; it += gridDim.x)
                mlstm::x2_item(it, hf * HB, (const float*)(ws + WS_U), (const float*)(ws + WS_MUN), (const float*)(ws + WS_MAMAX), (const float*)(ws + WS_MBLAST),
                               (h16*)(ws + WS_CS), (float*)(ws + WS_MNS), (float*)(ws + WS_MMS), (char*)lds);
        } else if (ph == PH_MIX) {
            const int b0 = hf * HB, G = gridDim.x, bx = blockIdx.x;
            const int vcu = (G % 8 == 0) ? (bx % 8) * (G / 8) + bx / 8 : bx;
            const h16* proj = (const h16*)(ws + WS_PROJ); h16* y = (h16*)(ws + WS_Y);
            for (int v = vcu; v < 256; v += G) {
                const int bh = v >> 2, sidx = v & 3, bl = bh >> 3, h = bh & 7;
                const float* cbp = (const float*)(ws + WS_CB) + (size_t)((b0 + bl) * 8 + h) * SEQ;
                const float* kmp = (const float*)(ws + WS_KMEAN) + (size_t)((b0 + bl) * 8 + h) * 512;
                const float slope2 = exp2f(-(float)(h + 1)) * LOG2E;
#pragma unroll 1
                for (int i = 0; i < 4; ++i) {
                    const int qb = (i < 2) ? 7 - sidx : sidx;
                    if ((i & 1) == 0) attn_body::attn_unit<false, 8>(bl, h, qb, proj + PC_AQ, proj + PC_AK, proj + PC_AV, proj + PC_AZ, y, cbp, 0.f, kmp, (char*)lds);
                    else attn_body::attn_unit<true, 8>(bl, h, qb, proj + PC_BQ, proj + PC_BK, proj + PC_BV, proj + PC_BZ, y + 512, cbp, slope2, kmp, (char*)lds);
                }
            }
            {   int tid_ = threadIdx.x; asm volatile("" : "+v"(tid_));
                const int wv = __builtin_amdgcn_readfirstlane(tid_ >> 6), ln = tid_ & 63;
                if (wv < mlstm::NACT) for (int it = blockIdx.x * mlstm::NACT + wv; it < HB * 128; it += gridDim.x * mlstm::NACT)
                    mlstm::x3_wave(it, b0, proj, (const float*)(ws + WS_SMALL), (const h16*)(ws + WS_QKC), (const h16*)(ws + WS_CS), (const float*)(ws + WS_MNS), (const float*)(ws + WS_MMS),
                                   a.in[7] + (size_t)layer * 512, y, (mlstm::lds_ptr)L + wv * mlstm::WREG, ln);
                barrier_lds(); }
        } else if (ph == PH_PROJ) {
            pg8::Gemm g{(const h16*)(ws + WS_HN), (const h16*)(ws + WS_WIN) + (size_t)layer * PW * DM, DM, DM, DM, 0, 0};
            pg8::StaticOrder S; S.init(TH, PW, gridDim.x, blockIdx.x);
            pg8::EpiF16 E{(h16*)(ws + WS_PROJ), PW};
            pg8::gemm_phase(L, g, S, E);
        } else if (ph == PH_BR) {
            pg8::Gemm g{(const h16*)(ws + WS_Y), (const h16*)(ws + WS_WBR) + (size_t)layer * 3 * 1024 * 512, 1536, 512, 512, 512, 1024 * 512};
            pg8::BranchOrder S; S.init(TH, DM, gridDim.x, blockIdx.x, 3);
            pg8::EpiGate E{(h16*)(ws + WS_MRG), (const h16*)(ws + WS_PROJ) + PC_G, PW};
            pg8::gemm_phase(L, g, S, E);
        } else if (ph == PH_OUT) {
            pg8::Gemm g{(const h16*)(ws + WS_MRG), (const h16*)(ws + WS_WOUT) + (size_t)layer * DM * DM, DM, DM, DM, 0, 0};
            pg8::StaticOrder S; S.init(TH, DM, gridDim.x, blockIdx.x);
            const float* xsrc = layer == 0 ? a.in[0] : a.out;
            pg8::EpiRes E{xsrc + (size_t)row0 * DM, a.out + (size_t)row0 * DM, DM};
            pg8::gemm_phase(L, g, S, E);
        }
    }
}

extern "C" void kernel_launch(void* const* d_in, const int* in_sizes, int n_in, void* d_out, int out_size, void* d_ws, size_t ws_size, hipStream_t stream) {
    if (n_in != 11 || in_sizes[0] != TT * DM || out_size != TT * DM || ws_size < WS_END) {
        fprintf(stderr, "kernel_launch: unexpected shapes / workspace (n_in %d, in0 %d, out %d, ws %zu < %zu)\n", n_in, n_in > 0 ? in_sizes[0] : -1, out_size, ws_size, (size_t)WS_END);
        return;
    }
    static int grid = 0;
    if (grid == 0) {
        int dev = 0, cus = 0, per_cu = 0;
        hipGetDevice(&dev);
        hipDeviceGetAttribute(&cus, hipDeviceAttributeMultiprocessorCount, dev);
        if (hipFuncSetAttribute((const void*)mega, hipFuncAttributeMaxDynamicSharedMemorySize, MK_LDS_BYTES) != hipSuccess) fprintf(stderr, "kernel_launch: hipFuncSetAttribute failed\n");
        if (hipOccupancyMaxActiveBlocksPerMultiprocessor(&per_cu, (const void*)mega, NTHREADS, MK_LDS_BYTES) != hipSuccess || per_cu < 1) { fprintf(stderr, "kernel_launch: occupancy query says %d blocks per CU\n", per_cu); per_cu = 1; }
        (void)hipGetLastError();
        grid = cus;
        if (grid != 256) fprintf(stderr, "kernel_launch: note: %d CUs (tuned for 256)\n", grid);
    }
    MArgs ma{};
    for (int i = 0; i < 11; ++i) ma.in[i] = (const float*)d_in[i];
    ma.out = (float*)d_out; ma.ws = (unsigned char*)d_ws; ma.s_lo = 0; ma.s_hi = N_STEPS;
    if (hipMemsetAsync((char*)d_ws + WS_CTL, 0, CTL_ZERO_BYTES, stream) != hipSuccess) { fprintf(stderr, "kernel_launch: hipMemsetAsync of the control words failed\n"); return; }
    void* args[] = {&ma};
    hipError_t e = hipLaunchCooperativeKernel((const void*)mega, dim3(grid), dim3(NTHREADS), args, MK_LDS_BYTES, stream);
    if (e != hipSuccess) fprintf(stderr, "kernel_launch: cooperative launch failed: %s (grid %d)\n", hipGetErrorString(e), grid);
}
```

```cpp
#include <hip/hip_runtime.h>
#include <hip/hip_cooperative_groups.h>
#include <cstdio>
#include <cstdint>

namespace cg = cooperative_groups;
typedef _Float16 h16;
typedef _Float16 h16x4 __attribute__((ext_vector_type(4)));
typedef _Float16 h16x8 __attribute__((ext_vector_type(8)));
typedef float f32x4 __attribute__((ext_vector_type(4)));

constexpr int DM = 1024, BATCH = 16, SEQ = 2048, DEPTH = 2;
constexpr int TT = BATCH * SEQ;
constexpr int HB = 8;
constexpr int TH = HB * SEQ;
constexpr int INW = 9232;
constexpr int PW = 9216;
constexpr float RMS_EPS = 1e-6f;
constexpr float LOG2E = 1.4426950408889634f;
constexpr float C2 = 0.125f * LOG2E;
constexpr int PC_AQ = 0, PC_AK = 512, PC_AV = 1024, PC_AZ = 1536, PC_BQ = 2048, PC_BK = 2560, PC_BV = 3072, PC_BZ = 3584,
              PC_CQK = 4096, PC_CV = 4608, PC_CO = 5120, PC_CZ = 5632, PC_G = 6144;
__host__ __device__ inline int orig_col(int j) { return j < 2048 ? j : (j < 6144 ? j + 8 : j + 16); }
__host__ __device__ inline int small_col(int c) { return c < 8 ? 2048 + c : 6152 + (c - 8); }

constexpr size_t MiB = 1u << 20;
constexpr size_t WS_CTL = 0;
constexpr size_t WS_WSMALL = 512 * 1024;
constexpr size_t WS_SMALL = 1 * MiB;
constexpr size_t WS_CB = 3 * MiB;
constexpr size_t WS_KMEAN = 4 * MiB;
constexpr size_t WS_MSC = 5 * MiB;
constexpr size_t WS_MUN = WS_MSC, WS_MNS = WS_MSC + 512 * 1024;
constexpr size_t WS_MAMAX = 4 * MiB + 512 * 1024, WS_MBLAST = WS_MAMAX + 8192, WS_MMS = WS_MAMAX + 16384;
constexpr size_t WS_WBR = 6 * MiB;
constexpr size_t WS_WOUT = 12 * MiB;
constexpr size_t WS_WIN = 16 * MiB;
constexpr size_t WS_HN = 52 * MiB;
constexpr size_t WS_Y = 84 * MiB;
constexpr size_t WS_MRG = WS_HN;
constexpr size_t WS_U = 132 * MiB;
constexpr size_t WS_CS = 164 * MiB;
constexpr size_t WS_QKC = 180 * MiB;
constexpr size_t WS_PROJ = 196 * MiB;
constexpr size_t WS_END = 484 * MiB;

__device__ __forceinline__ float sigmoidf_(float x) { return 1.f / (1.f + __expf(-x)); }
__device__ __forceinline__ float siluf_(float x) { return x / (1.f + __expf(-x)); }
__device__ __forceinline__ float log_sigmoidf_(float x) {
    const float e = __expf(-fabsf(x)); const float l = e < 0.01f ? e * (1.f - 0.5f * e + 0.33333334f * e * e) : __logf(1.f + e); return fminf(x, 0.f) - l; }
template <int M> __device__ __forceinline__ float swz_xor(float v) { return __int_as_float(__builtin_amdgcn_ds_swizzle(__float_as_int(v), (M << 10) | 0x1f)); }
__device__ __forceinline__ float half_sum(float v) { auto rr = __builtin_amdgcn_permlane32_swap(__float_as_uint(v), __float_as_uint(v), false, false); return __uint_as_float(rr[0]) + __uint_as_float(rr[1]); }
__device__ __forceinline__ float shfl_idx(float x, int srclane) { return __int_as_float(__builtin_amdgcn_ds_bpermute(srclane << 2, __float_as_int(x))); }
__device__ __forceinline__ float wave_sum(float v) {
    v += swz_xor<1>(v); v += swz_xor<2>(v); v += swz_xor<4>(v); v += swz_xor<8>(v); v += swz_xor<16>(v);
    return half_sum(v);
}

__global__ void nv_convert_t(const float* __restrict__ src, int ldsrc, int K, h16* __restrict__ dst, int Nd, int mode) {
    __shared__ float tile[32][33];
    const int tx = threadIdx.x & 31, ty = threadIdx.x >> 5;
    const int j0 = blockIdx.x * 32, k0 = blockIdx.y * 32;
#pragma unroll
    for (int i = 0; i < 4; ++i) {
        const int k = k0 + ty + 8 * i, j = j0 + tx;
        const int sc = mode == 1 ? orig_col(j) : j;
        tile[ty + 8 * i][tx] = src[(size_t)k * ldsrc + sc];
    }
    __syncthreads();
#pragma unroll
    for (int i = 0; i < 4; ++i) {
        const int j = j0 + ty + 8 * i, k = k0 + tx;
        float v = tile[tx][ty + 8 * i];
        if (mode == 1 && ((j >= PC_AQ && j < PC_AQ + 512) || (j >= PC_BQ && j < PC_BQ + 512))) v *= C2;
        dst[(size_t)j * K + k] = (h16)v;
    }
}

__global__ void nv_small_w(const float* __restrict__ w_in, float* __restrict__ wsmall) {
    const int i = blockIdx.x * blockDim.x + threadIdx.x;
    if (i >= 16 * DM) return;
    const int c = i >> 10, k = i & 1023;
    wsmall[i] = w_in[(size_t)k * INW + small_col(c)];
}
__global__ void __launch_bounds__(256) nv_rmsnorm_small(const float* __restrict__ x, const float* __restrict__ g, const float* __restrict__ wsmall  ,
                                 const float* __restrict__ fox_bf, const float* __restrict__ ml_bi, const float* __restrict__ ml_bf,
                                 h16* __restrict__ hn, float* __restrict__ small, int row0, int nrows) {
    const int lane = threadIdx.x & 63, wv = (blockIdx.x * blockDim.x + threadIdx.x) >> 6, nw = (gridDim.x * blockDim.x) >> 6;
    for (int r = wv; r < nrows; r += nw) {
        const int row = row0 + r;
        const f32x4* xr = (const f32x4*)(x + (size_t)row * DM) + lane;
        f32x4 v[4]; float s = 0.f;
#pragma unroll
        for (int j = 0; j < 4; ++j) { v[j] = xr[64 * j]; s += v[j].x * v[j].x + v[j].y * v[j].y + v[j].z * v[j].z + v[j].w * v[j].w; }
        const float rstd = rsqrtf(wave_sum(s) * (1.f / DM) + RMS_EPS);
#pragma unroll
        for (int j = 0; j < 4; ++j) {
            const f32x4 gg = ((const f32x4*)g)[lane + 64 * j];
            v[j].x *= rstd * gg.x; v[j].y *= rstd * gg.y; v[j].z *= rstd * gg.z; v[j].w *= rstd * gg.w;
            h16x4 o = {(h16)v[j].x, (h16)v[j].y, (h16)v[j].z, (h16)v[j].w};
            *((h16x4*)(hn + (size_t)r * DM) + lane + 64 * j) = o;
        }
        float mine = 0.f;
#pragma unroll 1
        for (int c = 0; c < 16; ++c) {
            const f32x4* wr = (const f32x4*)(wsmall + c * DM) + lane;
            float a = 0.f;
#pragma unroll
            for (int j = 0; j < 4; ++j) { const f32x4 w = wr[64 * j]; a += v[j].x * w.x + v[j].y * w.y + v[j].z * w.z + v[j].w * w.w; }
            a = wave_sum(a);
            if (lane == c) mine = a;
        }
        if (lane < 16) {
            float o;
            if (lane < 8) o = log_sigmoidf_(mine + fox_bf[lane]);
            else if (lane < 12) o = mine + ml_bi[lane - 8];
            else o = log_sigmoidf_(mine + ml_bf[lane - 12]);
            small[(size_t)row * 16 + lane] = o;
        }
    }
}

struct GemmArgs {
    const h16* A; int lda; const h16* Bt; int ldb; int K;
    h16* C; int ldc;
    const h16* gates; int ldg;
    const float* xin; float* xout;
};
template <int EPI>
__global__ void __launch_bounds__(256) nv_gemm(GemmArgs g) {
    __shared__ float As[16][68], Bs[16][68];
    const int tid = threadIdx.x, tx = tid & 15, ty = tid >> 4;
    const int m0 = blockIdx.y * 64, n0 = blockIdx.x * 64;
    float res[4][4];
#pragma unroll
    for (int i = 0; i < 4; ++i)
#pragma unroll
        for (int j = 0; j < 4; ++j) res[i][j] = 0.f;
    const int NB = EPI == 1 ? 3 : 1;
    for (int nb = 0; nb < NB; ++nb) {
        float acc[4][4];
#pragma unroll
        for (int i = 0; i < 4; ++i)
#pragma unroll
            for (int j = 0; j < 4; ++j) acc[i][j] = 0.f;
        const h16* A = g.A + (EPI == 1 ? nb * 512 : 0);
        const h16* Bt = g.Bt + (EPI == 1 ? (size_t)nb * 1024 * 512 : 0);
        const int lr = tid >> 2, lk = (tid & 3) * 4;
        for (int k0 = 0; k0 < g.K; k0 += 16) {
            const h16x4 av = *(const h16x4*)(A + (size_t)(m0 + lr) * g.lda + k0 + lk);
            const h16x4 bv = *(const h16x4*)(Bt + (size_t)(n0 + lr) * g.ldb + k0 + lk);
            __syncthreads();
#pragma unroll
            for (int e = 0; e < 4; ++e) { As[lk + e][lr] = (float)av[e]; Bs[lk + e][lr] = (float)bv[e]; }
            __syncthreads();
#pragma unroll
            for (int kk = 0; kk < 16; ++kk) {
                float a[4], b[4];
#pragma unroll
                for (int i = 0; i < 4; ++i) { a[i] = As[kk][ty * 4 + i]; b[i] = Bs[kk][tx * 4 + i]; }
#pragma unroll
                for (int i = 0; i < 4; ++i)
#pragma unroll
                    for (int j = 0; j < 4; ++j) acc[i][j] += a[i] * b[j];
            }
        }
#pragma unroll
        for (int i = 0; i < 4; ++i)
#pragma unroll
            for (int j = 0; j < 4; ++j) {
                if (EPI == 1) {
                    const int m = m0 + ty * 4 + i, n = n0 + tx * 4 + j;
                    const float gt = (float)g.gates[(size_t)m * g.ldg + nb * 1024 + n];
                    res[i][j] += sigmoidf_(gt) * acc[i][j];
                } else res[i][j] = acc[i][j];
            }
    }
#pragma unroll
    for (int i = 0; i < 4; ++i)
#pragma unroll
        for (int j = 0; j < 4; ++j) {
            const int m = m0 + ty * 4 + i, n = n0 + tx * 4 + j;
            if (EPI == 2) g.xout[(size_t)m * DM + n] = g.xin[(size_t)m * DM + n] + res[i][j];
            else g.C[(size_t)m * g.ldc + n] = (h16)res[i][j];
        }
}

__global__ void nv_fox_cumsum(const float* __restrict__ small, float* __restrict__ cb, int b0) {
    const int i = blockIdx.x * blockDim.x + threadIdx.x;
    if (i >= HB * 8) return;
    const int bl = i >> 3, h = i & 7;
    const float* s = small + (size_t)(b0 + bl) * SEQ * 16 + h;
    float* o = cb + (size_t)((b0 + bl) * 8 + h) * SEQ;
    float c = 0.f;
    for (int t = 0; t < SEQ; ++t) { c += s[(size_t)t * 16]; o[t] = -c * LOG2E; }
}
__global__ void nv_moba_kmean(const h16* __restrict__ proj, float* __restrict__ kmean, int b0) {
    const int i = blockIdx.x * blockDim.x + threadIdx.x;
    if (i >= HB * 8 * 512) return;
    const int col = i & 511, blk = (i >> 9) & 7, bl = i >> 12;
    const h16* p = proj + (size_t)(bl * SEQ + blk * 256) * PW + PC_BK + col;
    float s = 0.f;
    for (int t = 0; t < 256; ++t) s += (float)p[(size_t)t * PW];
    const int h = col >> 6, d = col & 63;
    kmean[(((size_t)(b0 + bl) * 8 + h) * 8 + blk) * 64 + d] = s * (1.f / 256.f);
}

__global__ void __launch_bounds__(256) nv_fox_attn(const h16* __restrict__ proj, const float* __restrict__ cb, h16* __restrict__ y, int b0) {
    const int bh = blockIdx.y, bl = bh >> 3, h = bh & 7;
    const int t = blockIdx.x * 256 + threadIdx.x;
    const size_t rowb = (size_t)bl * SEQ;
    float q[64], o[64];
    {
        const h16* qp = proj + (rowb + t) * PW + PC_AQ + h * 64;
#pragma unroll
        for (int d = 0; d < 64; ++d) { q[d] = (float)qp[d]; o[d] = 0.f; }
    }
    const float* cbh = cb + (size_t)((b0 + bl) * 8 + h) * SEQ;
    float m = -INFINITY, l = 0.f;
    const int send = blockIdx.x * 256 + 255;
    for (int s = 0; s <= send; ++s) {
        const h16* kp = proj + (rowb + s) * PW + PC_AK + h * 64;
        const h16* vp = proj + (rowb + s) * PW + PC_AV + h * 64;
        float sd = 0.f;
#pragma unroll
        for (int d = 0; d < 64; ++d) sd += q[d] * (float)kp[d];
        sd += cbh[s];
        if (s <= t) {
            const float mn = fmaxf(m, sd), al = exp2f(m - mn), p = exp2f(sd - mn);
            l = l * al + p;
#pragma unroll
            for (int d = 0; d < 64; ++d) o[d] = o[d] * al + p * (float)vp[d];
            m = mn;
        }
    }
    const float il = 1.f / l;
    const h16* zp = proj + (rowb + t) * PW + PC_AZ + h * 64;
    h16* yp = y + (rowb + t) * 1536 + h * 64;
#pragma unroll
    for (int d = 0; d < 64; ++d) yp[d] = (h16)(o[d] * il * siluf_((float)zp[d]));
}

__global__ void __launch_bounds__(256) nv_moba_attn(const h16* __restrict__ proj, const float* __restrict__ kmean, h16* __restrict__ y, int b0) {
    const int bh = blockIdx.y, bl = bh >> 3, h = bh & 7;
    const int own = blockIdx.x;
    const int t = own * 256 + threadIdx.x;
    const size_t rowb = (size_t)bl * SEQ;
    float q[64], o[64];
    {
        const h16* qp = proj + (rowb + t) * PW + PC_BQ + h * 64;
#pragma unroll
        for (int d = 0; d < 64; ++d) { q[d] = (float)qp[d]; o[d] = 0.f; }
    }
    unsigned selmask = 0;
    if (own <= 3) selmask = (1u << own) - 1u;
    else {
        float gate[8];
        const float* km = kmean + ((size_t)(b0 + bl) * 8 + h) * 8 * 64;
#pragma unroll
        for (int n = 0; n < 8; ++n) {
            float sd = 0.f;
#pragma unroll
            for (int d = 0; d < 64; ++d) sd += q[d] * km[n * 64 + d];
            gate[n] = n < own ? sd : -INFINITY;
        }
        for (int r = 0; r < 3; ++r) {
            float best = -INFINITY; int bi = -1;
#pragma unroll
            for (int n = 0; n < 8; ++n) { const bool free_ = !((selmask >> n) & 1u); if (free_ && n < own && gate[n] > best) { best = gate[n]; bi = n; } }
            if (bi >= 0) selmask |= 1u << bi;
        }
    }
    const float slope2 = exp2f(-(float)(h + 1)) * LOG2E;
    float m = -INFINITY, l = 0.f;
    for (int n = 0; n <= own; ++n) {
        const bool isown = n == own;
        const bool sel = isown || ((selmask >> n) & 1u);
        for (int ss = 0; ss < 256; ++ss) {
            const int s = n * 256 + ss;
            const h16* kp = proj + (rowb + s) * PW + PC_BK + h * 64;
            const h16* vp = proj + (rowb + s) * PW + PC_BV + h * 64;
            if (sel && s <= t) {
                float sd = 0.f;
#pragma unroll
                for (int d = 0; d < 64; ++d) sd += q[d] * (float)kp[d];
                sd -= slope2 * (float)(t - s);
                const float mn = fmaxf(m, sd), al = exp2f(m - mn), p = exp2f(sd - mn);
                l = l * al + p;
#pragma unroll
                for (int d = 0; d < 64; ++d) o[d] = o[d] * al + p * (float)vp[d];
                m = mn;
            }
        }
    }
    const float il = 1.f / l;
    const h16* zp = proj + (rowb + t) * PW + PC_BZ + h * 64;
    h16* yp = y + (rowb + t) * 1536 + 512 + h * 64;
#pragma unroll
    for (int d = 0; d < 64; ++d) yp[d] = (h16)(o[d] * il * siluf_((float)zp[d]));
}

__global__ void __launch_bounds__(256) nv_mlstm(const h16* __restrict__ proj, const float* __restrict__ small, const float* __restrict__ convw  ,
                                                const float* __restrict__ headg  , h16* __restrict__ y, int b0) {
    __shared__ float qk[128];
    __shared__ float red[4];
    const int bl = blockIdx.x >> 2, hh = blockIdx.x & 3, tid = threadIdx.x, v = tid >> 1, kh = tid & 1;
    const size_t rowb = (size_t)bl * SEQ;
    float C[32], nn[32];
#pragma unroll
    for (int j = 0; j < 32; ++j) { C[j] = 0.f; nn[j] = 0.f; }
    float m = 0.f;
    const int ccol = tid < 64 ? hh * 64 + tid : 256 + hh * 64 + (tid - 64);
    float cw[4] = {0.f, 0.f, 0.f, 0.f};
    if (tid < 128) {
#pragma unroll
        for (int j = 0; j < 4; ++j) cw[j] = convw[j * 512 + ccol];
    }
    const float hg = headg[hh * 128 + v];
    for (int t = 0; t < SEQ; ++t) {
        if (tid < 128) {
            float a = 0.f;
#pragma unroll
            for (int j = 0; j < 4; ++j) { const int tt = t - 3 + j; if (tt >= 0) a += cw[j] * (float)proj[(rowb + tt) * PW + PC_CQK + ccol]; }
            a = siluf_(a);
            if (tid >= 64) a *= 0.125f;
            qk[tid] = a;
        }
        __syncthreads();
        const size_t row = rowb + t;
        const float li = small[((size_t)b0 * SEQ + row) * 16 + 8 + hh], lf = small[((size_t)b0 * SEQ + row) * 16 + 12 + hh];
        const float vt = (float)proj[row * PW + PC_CV + hh * 128 + v];
        const float mn = fmaxf(lf + m, li), fw = __expf(lf + m - mn), iw = __expf(li - mn);
        float nump = 0.f, denp = 0.f;
#pragma unroll
        for (int j = 0; j < 32; ++j) {
            const float kj = qk[64 + kh * 32 + j], qj = qk[kh * 32 + j];
            C[j] = fw * C[j] + iw * vt * kj; nn[j] = fw * nn[j] + iw * kj;
            nump += C[j] * qj; denp += nn[j] * qj;
        }
        nump += __shfl_xor(nump, 1); denp += __shfl_xor(denp, 1);
        m = mn;
        const float hval = nump / fmaxf(fabsf(denp), __expf(-mn));
        const float hgt = hval * sigmoidf_((float)proj[row * PW + PC_CO + hh * 128 + v]);
        float ss = kh == 0 ? hgt * hgt : 0.f;
        ss = wave_sum(ss);
        if ((tid & 63) == 0) red[tid >> 6] = ss;
        __syncthreads();
        const float tot = red[0] + red[1] + red[2] + red[3];
        if (kh == 0) {
            const float o = hgt * rsqrtf(tot * (1.f / 128.f) + RMS_EPS) * hg * siluf_((float)proj[row * PW + PC_CZ + hh * 128 + v]);
            y[row * 1536 + 1024 + hh * 128 + v] = (h16)o;
        }
    }
}

__global__ void nv_final_norm(float* __restrict__ x, const float* __restrict__ g) {
    const int lane = threadIdx.x & 63, wv = (blockIdx.x * blockDim.x + threadIdx.x) >> 6, nw = (gridDim.x * blockDim.x) >> 6;
    for (int row = wv; row < TT; row += nw) {
        f32x4* xr = (f32x4*)(x + (size_t)row * DM) + lane;
        f32x4 v[4]; float s = 0.f;
#pragma unroll
        for (int j = 0; j < 4; ++j) { v[j] = xr[64 * j]; s += v[j].x * v[j].x + v[j].y * v[j].y + v[j].z * v[j].z + v[j].w * v[j].w; }
        const float rstd = rsqrtf(wave_sum(s) * (1.f / DM) + RMS_EPS);
#pragma unroll
        for (int j = 0; j < 4; ++j) {
            const f32x4 gg = ((const f32x4*)g)[lane + 64 * j];
            f32x4 o = {v[j].x * rstd * gg.x, v[j].y * rstd * gg.y, v[j].z * rstd * gg.z, v[j].w * rstd * gg.w};
            xr[64 * j] = o;
        }
    }
}


namespace pg8 {
#define PG8_LAS __attribute__((address_space(3)))
typedef short s16x8 __attribute__((ext_vector_type(8)));
typedef unsigned u32x4 __attribute__((ext_vector_type(4)));
typedef float f32x2 __attribute__((ext_vector_type(2)));
typedef _Float16 h16x2 __attribute__((ext_vector_type(2)));
constexpr int BM = 256, BK = 64, HALF = 128, HTB = HALF * BK * 2  , STAGE_BYTES = 8 * HTB, NXCD = 8, WGM = 8;
__host__ __device__ __forceinline__ int lds_byte(int r, int c) { const int st = (r >> 4) * 2 + (c >> 5), rr = r & 15, cc = c & 31, ob = rr * 64 + cc * 2; return st * 1024 + (ob ^ (((ob >> 9) & 1) << 5)); }
__host__ __device__ __forceinline__ void stage_rc(int b, int& R, int& C) { const int st = b / 1024, sb = b % 1024, swz = sb ^ (((sb >> 9) & 1) << 5); R = (st >> 1) * 16 + swz / 64; C = (st & 1) * 32 + (swz % 64) / 2; }
__host__ __device__ __forceinline__ int perm32(int rho) { const int n = rho >> 4, i = rho & 15; return 8 * (i >> 2) + 4 * n + (i & 3); }
__device__ __forceinline__ unsigned cvt_pk_f16(float lo, float hi) { f32x2 v = {lo, hi}; h16x2 b = __builtin_convertvector(v, h16x2); return __builtin_bit_cast(unsigned, b); }

struct Unit { int pm, pn, z; };
struct Gemm { const h16* A; const h16* Bt; int lda, ldb, K; long zA, zB; };

__device__ __forceinline__ void tile_of(int L, int nM, int nN, int& pm, int& pn) {
    const int nwg = nM * nN; int wgid = L;
    { const int q = nwg / NXCD, r = nwg % NXCD, xcd = wgid % NXCD, off = wgid / NXCD; wgid = (xcd < r ? xcd * (q + 1) : r * (q + 1) + (xcd - r) * q) + off; }
    const int nig = WGM * nN, gid = wgid / nig, fm = gid * WGM, gsz = (nM - fm) < WGM ? (nM - fm) : WGM;
    pm = fm + ((wgid % nig) % gsz); pn = (wgid % nig) / gsz;
}
struct StaticOrder {
    int nM, nN, nwg, G, c;
    __device__ void init(int M, int N, int G_, int c_) { nM = M / BM; nN = N / BM; nwg = nM * nN; G = G_; c = c_; }
    __device__ bool next(int i, Unit& u) const { const long L = (long)i * G + c; if (L >= nwg) return false; tile_of((int)L, nM, nN, u.pm, u.pn); u.z = 0; return true; }
};
struct BranchOrder {
    int nM, nN, nwg, G, c, NZ;
    __device__ void init(int M, int N, int G_, int c_, int nz) { nM = M / BM; nN = N / BM; nwg = nM * nN; G = G_; c = c_; NZ = nz; }
    __device__ bool next(int i, Unit& u) const { const int j = i / NZ; const long L = (long)j * G + c; if (L >= nwg) return false; tile_of((int)L, nM, nN, u.pm, u.pn); u.z = i - j * NZ; return true; }
};

struct EpiF16 {
    static constexpr bool PERM = true;
    h16* C; int ldc;
    __device__ __forceinline__ void operator()(const f32x4 (&acc)[2][2][4][2], const Unit& u, int wr, int wc, int fr, int fq) const {
        const int row0 = u.pm * BM + wr * 64 + fr, col0 = u.pn * BM + wc * 32 + 8 * fq;
#pragma unroll
        for (int ai = 0; ai < 2; ++ai)
#pragma unroll
            for (int m = 0; m < 4; ++m) { h16* rowp = C + (size_t)(row0 + ai * HALF + m * 16) * ldc + col0;
#pragma unroll
                for (int bj = 0; bj < 2; ++bj) { const f32x4 v0 = acc[ai][bj][m][0], v1 = acc[ai][bj][m][1];
                    u32x4 w; w.x = cvt_pk_f16(v0[0], v0[1]); w.y = cvt_pk_f16(v0[2], v0[3]); w.z = cvt_pk_f16(v1[0], v1[1]); w.w = cvt_pk_f16(v1[2], v1[3]);
                    *(u32x4*)(rowp + bj * HALF) = w; } }
    }
};
struct EpiGate {
    static constexpr bool PERM = true;
    h16* Mg; const h16* G; int ldg;
    __device__ __forceinline__ void operator()(const f32x4 (&acc)[2][2][4][2], const Unit& u, int wr, int wc, int fr, int fq) const {
        const int row0 = u.pm * BM + wr * 64 + fr, col0 = u.pn * BM + wc * 32 + 8 * fq;
#pragma unroll
        for (int ai = 0; ai < 2; ++ai)
#pragma unroll
            for (int mp = 0; mp < 2; ++mp) {
                h16x8 gv[2][2], pv[2][2];
#pragma unroll
                for (int mm = 0; mm < 2; ++mm)
#pragma unroll
                    for (int bj = 0; bj < 2; ++bj) { const size_t row = (size_t)(row0 + ai * HALF + (2 * mp + mm) * 16);
                        gv[mm][bj] = *(const h16x8*)(G + row * ldg + u.z * 1024 + col0 + bj * HALF);
                        if (u.z > 0) pv[mm][bj] = *(const h16x8*)(Mg + row * 1024 + col0 + bj * HALF); }
#pragma unroll
                for (int mm = 0; mm < 2; ++mm)
#pragma unroll
                    for (int bj = 0; bj < 2; ++bj) { const int m = 2 * mp + mm; const size_t row = (size_t)(row0 + ai * HALF + m * 16);
                        float o[8];
#pragma unroll
                        for (int e = 0; e < 8; ++e) { const float a = e < 4 ? acc[ai][bj][m][0][e] : acc[ai][bj][m][1][e - 4]; o[e] = a * __builtin_amdgcn_rcpf(1.f + __expf(-(float)gv[mm][bj][e])); }
                        if (u.z > 0) {
#pragma unroll
                            for (int e = 0; e < 8; ++e) o[e] += (float)pv[mm][bj][e]; }
                        u32x4 w; w.x = cvt_pk_f16(o[0], o[1]); w.y = cvt_pk_f16(o[2], o[3]); w.z = cvt_pk_f16(o[4], o[5]); w.w = cvt_pk_f16(o[6], o[7]);
                        *(u32x4*)(Mg + row * 1024 + col0 + bj * HALF) = w; }
            }
    }
};
struct EpiRes {
    static constexpr bool PERM = false;
    const float* xin; float* out; int ldc;
    __device__ __forceinline__ void operator()(const f32x4 (&acc)[2][2][4][2], const Unit& u, int wr, int wc, int fr, int fq) const {
        const int row0 = u.pm * BM + wr * 64 + fr, col0 = u.pn * BM + wc * 32 + 4 * fq;
#pragma unroll
        for (int ai = 0; ai < 2; ++ai)
#pragma unroll
            for (int mp = 0; mp < 2; ++mp) {
                f32x4 xv[2][2][2];
#pragma unroll
                for (int mm = 0; mm < 2; ++mm) { const size_t off = (size_t)(row0 + ai * HALF + (2 * mp + mm) * 16) * ldc + col0;
#pragma unroll
                    for (int bj = 0; bj < 2; ++bj)
#pragma unroll
                        for (int n = 0; n < 2; ++n) xv[mm][bj][n] = *(const f32x4*)(xin + off + bj * HALF + n * 16); }
#pragma unroll
                for (int mm = 0; mm < 2; ++mm) { const int m = 2 * mp + mm; const size_t off = (size_t)(row0 + ai * HALF + m * 16) * ldc + col0;
#pragma unroll
                    for (int bj = 0; bj < 2; ++bj)
#pragma unroll
                        for (int n = 0; n < 2; ++n) *(f32x4*)(out + off + bj * HALF + n * 16) = xv[mm][bj][n] + acc[ai][bj][m][n]; }
            }
    }
};

template <class Epi, class Sched, bool ALIGN_EPI = true>
__device__ __forceinline__ void gemm_phase(PG8_LAS unsigned char* lds, const Gemm g, const Sched& S, const Epi& E) {
    int tid_ = threadIdx.x; asm volatile("" : "+v"(tid_));
    const int tid = tid_, wid = __builtin_amdgcn_readfirstlane(tid >> 6), lane = tid & 63, wr = wid >> 2, wc = wid & 3, fr = lane & 15, fq = lane >> 4;
    const int nt = g.K / BK;
    unsigned voffA[2], voffB[2];
#pragma unroll
    for (int i = 0; i < 2; ++i) { int R, C; stage_rc(tid * 16 + i * 8192, R, C); const int Rb = Epi::PERM ? ((R & ~31) + perm32(R & 31)) : R;
        voffA[i] = (unsigned)(R * g.lda + C) * 2u; voffB[i] = (unsigned)(Rb * g.ldb + C) * 2u; }
    const size_t kstep = (size_t)(BK * 2);
    const size_t hA = (size_t)HALF * g.lda * 2, hB = (size_t)HALF * g.ldb * 2;
    const size_t tA = 2 * hA, tB = 2 * hB;
    const unsigned ldsw = (unsigned)wid * 1024u;
    const int aoff = lds_byte(wr * 64 + fr, fq * 8), boff = lds_byte(wc * 32 + fr, fq * 8);
#define PG8_SA(b, h) (((b) * 2 + (h)) * HTB)
#define PG8_SB(b, h) ((4 + (b) * 2 + (h)) * HTB)
#define PG8_STAGE(bufoff, gbase, voff) do { _Pragma("unroll") for (int _i = 0; _i < 2; ++_i) \
        __builtin_amdgcn_global_load_lds((const unsigned*)((const char*)(gbase) + (voff)[_i]), (PG8_LAS unsigned*)(lds + (bufoff) + ldsw + _i * 8192), 16, 0, 0); } while (0)
#define PG8_LDA(dst, b, h) do { _Pragma("unroll") for (int m = 0; m < 4; ++m) _Pragma("unroll") for (int k = 0; k < 2; ++k) dst[m][k] = *(const PG8_LAS s16x8*)(lds + PG8_SA(b, h) + aoff + m * 2048 + k * 1024); } while (0)
#define PG8_LDB(dst, b, h) do { _Pragma("unroll") for (int n = 0; n < 2; ++n) _Pragma("unroll") for (int k = 0; k < 2; ++k) dst[n][k] = *(const PG8_LAS s16x8*)(lds + PG8_SB(b, h) + boff + n * 2048 + k * 1024); } while (0)
#define PG8_MMA(ai, bj, At, Bt) do { __builtin_amdgcn_s_setprio(1); _Pragma("unroll") for (int m = 0; m < 4; ++m) _Pragma("unroll") for (int n = 0; n < 2; ++n) _Pragma("unroll") for (int k = 0; k < 2; ++k) \
        acc[ai][bj][m][n] = __builtin_amdgcn_mfma_f32_16x16x32_f16(__builtin_bit_cast(h16x8, Bt[n][k]), __builtin_bit_cast(h16x8, At[m][k]), acc[ai][bj][m][n], 0, 0, 0); __builtin_amdgcn_s_setprio(0); } while (0)
#define PG8_WAIT_V(n) asm volatile("s_waitcnt vmcnt(" #n ")" ::: "memory")
#define PG8_WAIT_L(n) asm volatile("s_waitcnt lgkmcnt(" #n ")" ::: "memory")
#define PG8_BAR __builtin_amdgcn_s_barrier()
#define PG8_SCHED __builtin_amdgcn_sched_barrier(0)
    Unit cur, nxt; int ui = 0;
    if (!S.next(0, cur)) return;
    f32x4 acc[2][2][4][2];
#pragma unroll
    for (int a = 0; a < 2; ++a)
#pragma unroll
        for (int b = 0; b < 2; ++b)
#pragma unroll
            for (int m = 0; m < 4; ++m)
#pragma unroll
                for (int n = 0; n < 2; ++n) acc[a][b][m][n] = (f32x4){0.f, 0.f, 0.f, 0.f};
    s16x8 At[4][2], B0[2][2], B1[2][2];
    const char* cA = (const char*)(g.A + (long)cur.z * g.zA) + (size_t)cur.pm * tA; const char* cB = (const char*)(g.Bt + (long)cur.z * g.zB) + (size_t)cur.pn * tB;
    PG8_STAGE(PG8_SB(0, 0), cB, voffB); PG8_STAGE(PG8_SB(0, 1), cB + hB, voffB); PG8_STAGE(PG8_SA(0, 0), cA, voffA); PG8_STAGE(PG8_SA(0, 1), cA + hA, voffA);
    if (wr == 1) PG8_BAR;
    PG8_WAIT_V(2); PG8_BAR;
    PG8_STAGE(PG8_SB(1, 0), cB + kstep, voffB); PG8_STAGE(PG8_SA(1, 0), cA + kstep, voffA); PG8_STAGE(PG8_SB(1, 1), cB + hB + kstep, voffB);
    PG8_WAIT_V(6); PG8_BAR;
    for (;;) {
        const bool has_next = S.next(ui + 1, nxt);
        const char* nA = has_next ? (const char*)(g.A + (long)nxt.z * g.zA) + (size_t)nxt.pm * tA : cA; const char* nB = has_next ? (const char*)(g.Bt + (long)nxt.z * g.zB) + (size_t)nxt.pn * tB : cB;
        for (int t = 0; t < nt; t += 2) {
            const bool last = (t == nt - 2);
            const char* a1 = cA + (size_t)(t + 1) * kstep;
            const char* a2 = last ? nA : cA + (size_t)(t + 2) * kstep; const char* b2 = last ? nB : cB + (size_t)(t + 2) * kstep;
            const char* a3 = a2 + kstep; const char* b3 = b2 + kstep;
            PG8_LDB(B0, 0, 0); PG8_LDB(B1, 0, 1); PG8_SCHED; PG8_LDA(At, 0, 0); PG8_STAGE(PG8_SA(1, 1), a1 + hA, voffA);
            PG8_WAIT_V(8); PG8_WAIT_L(0); PG8_BAR; PG8_MMA(0, 0, At, B0); PG8_MMA(0, 1, At, B1); PG8_BAR; PG8_SCHED;
            PG8_LDA(At, 0, 1); PG8_STAGE(PG8_SB(0, 0), b2, voffB); PG8_STAGE(PG8_SB(0, 1), b2 + hB, voffB); PG8_STAGE(PG8_SA(0, 0), a2, voffA);
            PG8_WAIT_V(8); PG8_WAIT_L(0); PG8_BAR; PG8_MMA(1, 0, At, B0); PG8_MMA(1, 1, At, B1); PG8_BAR; PG8_SCHED;
            PG8_LDB(B0, 1, 0); PG8_LDB(B1, 1, 1); PG8_SCHED; PG8_LDA(At, 1, 0); PG8_STAGE(PG8_SA(0, 1), a2 + hA, voffA);
            PG8_WAIT_V(8); PG8_WAIT_L(0); PG8_BAR; PG8_MMA(0, 0, At, B0); PG8_MMA(0, 1, At, B1); PG8_BAR; PG8_SCHED;
            PG8_LDA(At, 1, 1); PG8_STAGE(PG8_SB(1, 0), b3, voffB); PG8_STAGE(PG8_SB(1, 1), b3 + hB, voffB); PG8_STAGE(PG8_SA(1, 0), a3, voffA);
            PG8_WAIT_V(8); PG8_WAIT_L(0); PG8_BAR; PG8_MMA(1, 0, At, B0); PG8_MMA(1, 1, At, B1); PG8_BAR; PG8_SCHED;
        }
        if constexpr (ALIGN_EPI) { if (wr == 0) PG8_BAR; }
        E(acc, cur, wr, wc, fr, fq);
        if (!has_next) break;
#pragma unroll
        for (int a = 0; a < 2; ++a)
#pragma unroll
            for (int b = 0; b < 2; ++b)
#pragma unroll
                for (int m = 0; m < 4; ++m)
#pragma unroll
                    for (int n = 0; n < 2; ++n) acc[a][b][m][n] = (f32x4){0.f, 0.f, 0.f, 0.f};
        cur = nxt; cA = nA; cB = nB; ++ui;
        if constexpr (ALIGN_EPI) { if (wr == 1) PG8_BAR; }
    }
    PG8_WAIT_V(0);
    if constexpr (!ALIGN_EPI) { if (wr == 0) PG8_BAR; }
    PG8_BAR;
#undef PG8_SA
#undef PG8_SB
#undef PG8_STAGE
#undef PG8_LDA
#undef PG8_LDB
#undef PG8_MMA
#undef PG8_WAIT_V
#undef PG8_WAIT_L
#undef PG8_BAR
#undef PG8_SCHED
}
}

namespace attn_body {
using s16x8 = __attribute__((ext_vector_type(8))) short;
using s16x4 = __attribute__((ext_vector_type(4))) short;
using f32x16 = __attribute__((ext_vector_type(16))) float;
using u32x4 = __attribute__((ext_vector_type(4))) unsigned;
constexpr int D = 64, NW = 8, QBLK = 32, QB = QBLK * NW, KVBLK = 64;
constexpr int PQ = PW;
__device__ __forceinline__ int crow(int r, int hi) { return (r & 3) + 8 * (r >> 2) + 4 * hi; }
#define SBAR() __builtin_amdgcn_sched_barrier(0)
__device__ __forceinline__ void cmask(f32x16& p0, f32x16& p1, int jb, int qrel, int hi) {
    const float NEG = -INFINITY; int kb = 64 * jb + 4 * hi;
#pragma unroll
    for (int r = 0; r < 16; ++r) { int kv = kb + (r & 3) + 8 * (r >> 2); if (kv > qrel) p0[r] = NEG; if (kv + 32 > qrel) p1[r] = NEG; }
}
constexpr int NSLOT = 3, SLOTB = 8192;
constexpr int LDS_K = 0, LDS_V = NSLOT * SLOTB, LDS_WS = 2 * NSLOT * SLOTB, LDS_OST = LDS_WS + NW * 64 * 4, LDS_BT = LDS_OST + NW * 4096, LDS_INF = LDS_BT + 2048 * 4, LDS_KM = LDS_INF + 256, LDS_BYTES = LDS_KM + 2048;
__device__ __forceinline__ void glds16(const void* gsrc, unsigned lds_dst) { unsigned keep;
    asm volatile("s_mov_b32 %0, m0\n\ts_mov_b32 m0, %2\n\ts_nop 0\n\tglobal_load_lds_dwordx4 %1, off\n\ts_mov_b32 m0, %0" : "=&s"(keep) : "v"(gsrc), "s"(lds_dst) : "memory"); }
__device__ __forceinline__ float max3f(float a, float b, float c) { float r; asm("v_max3_f32 %0, %1, %2, %3" : "=v"(r) : "v"(a), "v"(b), "v"(c)); return r; }
__device__ __forceinline__ float max2f(float a, float b) { float r; asm("v_max_f32_e32 %0, %1, %2" : "=v"(r) : "v"(a), "v"(b)); return r; }
__device__ __forceinline__ float fadd_s(float a, float b) { float r; asm("v_add_f32_e32 %0, %1, %2" : "=v"(r) : "v"(a), "v"(b)); return r; }
__device__ __forceinline__ float fsub_s(float a, float b) { float r; asm("v_sub_f32_e32 %0, %1, %2" : "=v"(r) : "v"(a), "v"(b)); return r; }
__device__ __forceinline__ unsigned cvtpk_s(float lo, float hi) { return pg8::cvt_pk_f16(lo, hi); }
#define MFMA32(a, b, c) __builtin_amdgcn_mfma_f32_32x32x16_f16(__builtin_bit_cast(h16x8, (a)), __builtin_bit_cast(h16x8, (b)), (c), 0, 0, 0)
#define WAIT_BAR(N) asm volatile("s_waitcnt vmcnt(" #N ") lgkmcnt(0)\n\ts_barrier" ::: "memory")
__device__ __forceinline__ void qkt(f32x16& p0, f32x16& p1, const char* Kslot, const s16x8* qr, const f32x16& negm, int r32, int hi) {
    const char* kb = Kslot + hi * 1024 + r32 * 16;
#pragma unroll
    for (int d0 = 0; d0 < 4; ++d0) {
        const s16x8 b0 = *reinterpret_cast<const s16x8*>(kb + d0 * 2048);
        const s16x8 b1 = *reinterpret_cast<const s16x8*>(kb + d0 * 2048 + 512);
        if (d0 == 0) { p0 = MFMA32(b0, qr[0], negm); p1 = MFMA32(b1, qr[0], negm); }
        else { p0 = MFMA32(b0, qr[d0], p0); p1 = MFMA32(b1, qr[d0], p1); } }
}
typedef __attribute__((address_space(3))) const char* lds_cptr;
typedef short v4i16_t __attribute__((ext_vector_type(4)));
#define LDS8(p) (*(const __attribute__((address_space(3))) s16x8*)(p))
__device__ __forceinline__ void kload8(s16x8* kf, lds_cptr kp) {
    kf[0] = LDS8(kp); kf[1] = LDS8(kp + 512); kf[2] = LDS8(kp + 2048); kf[3] = LDS8(kp + 2560);
    kf[4] = LDS8(kp + 4096); kf[5] = LDS8(kp + 4608); kf[6] = LDS8(kp + 6144); kf[7] = LDS8(kp + 6656);
}
__device__ __forceinline__ void kload2(s16x8* kf, lds_cptr kp, int j) { kf[2 * j] = LDS8(kp + j * 2048); kf[2 * j + 1] = LDS8(kp + j * 2048 + 512); }
__device__ __forceinline__ s16x4 vtr(lds_cptr p) { return __builtin_bit_cast(s16x4, __builtin_amdgcn_ds_read_tr16_b64_v4i16((__attribute__((address_space(3))) v4i16_t*)p)); }
__device__ __forceinline__ float rowmax(const f32x16& p0, const f32x16& p1) {
    float a = max3f(p0[0], p0[1], p1[0]), b = max3f(p0[2], p0[3], p1[1]); a = max3f(a, p1[2], p1[3]);
#pragma unroll
    for (int r = 4; r < 16; r += 4) { a = max3f(a, p0[r], p0[r + 1]); b = max3f(b, p0[r + 2], p0[r + 3]); a = max3f(a, p1[r], p1[r + 1]); b = max3f(b, p1[r + 2], p1[r + 3]); }
    const float m = max2f(a, b);
    auto rr = __builtin_amdgcn_permlane32_swap(__float_as_uint(m), __float_as_uint(m), false, false);
    return max2f(__uint_as_float(rr[0]), __uint_as_float(rr[1]));
}
__device__ __forceinline__ void pv(f32x16* o, int vb, s16x8 pa0, s16x8 pa1, s16x8 pa2, s16x8 pa3) {
#pragma unroll
    for (int d0 = 0; d0 < 2; ++d0) { s16x4 lo[4], hi[4];
#pragma unroll
        for (int ks = 0; ks < 4; ++ks) {
            asm volatile("ds_read_b64_tr_b16 %0,%1 offset:%c2" : "=&v"(lo[ks]) : "v"(vb), "i"(d0 * 4096 + ks * 1024) : "memory");
            asm volatile("ds_read_b64_tr_b16 %0,%1 offset:%c2" : "=&v"(hi[ks]) : "v"(vb), "i"(d0 * 4096 + ks * 1024 + 512) : "memory"); }
        asm volatile("s_waitcnt lgkmcnt(0)" ::: "memory"); SBAR();
#define PK(k) (s16x8){lo[k][0], lo[k][1], lo[k][2], lo[k][3], hi[k][0], hi[k][1], hi[k][2], hi[k][3]}
        o[d0] = MFMA32(pa0, PK(0), o[d0]);
        o[d0] = MFMA32(pa1, PK(1), o[d0]);
        o[d0] = MFMA32(pa2, PK(2), o[d0]);
        o[d0] = MFMA32(pa3, PK(3), o[d0]);
#undef PK
    }
}

template <bool MOBA, int THRL>
__device__ __forceinline__ void attn_unit(int bl, int h, int qb, const h16* Q, const h16* __restrict__ K, const h16* __restrict__ V, const h16* __restrict__ Z, h16* Y,
                                          const float* __restrict__ bsrc, float slope2, const float* __restrict__ kmean, char* shm) {
    int tid_ = threadIdx.x; asm volatile("" : "+v"(tid_));
    const int tid = tid_, lane = tid & 63, r32 = lane & 31, hi = lane >> 5; const int wid = __builtin_amdgcn_readfirstlane(tid >> 6);
    const long rowbase = (long)bl * SEQ; const int q0 = qb * QB;
    const h16* Qw = Q + (rowbase + q0 + wid * QBLK) * PQ + h * D;
    const h16* Kh = K + rowbase * PQ + h * D, *Vh = V + rowbase * PQ + h * D;
    const unsigned lds0 = (unsigned)(uintptr_t)shm;
    float* wsf = (float*)(shm + LDS_WS) + wid * 64;
    typedef __attribute__((address_space(3))) float lds_f32;
    typedef __attribute__((address_space(3))) const f32x4 lds_cf32x4;
    const lds_cptr shm3 = (lds_cptr)shm;
    {
        lds_f32* bt = (lds_f32*)(shm3 + LDS_BT);
        const int nkeys = q0 + QB;
        if (MOBA) { for (int i = tid; i < nkeys; i += NW * 64) bt[i] = slope2 * (float)(i - q0); }
        else { for (int i = tid; i < nkeys; i += NW * 64) bt[i] = bsrc[i]; }
        if (tid < 64) ((lds_f32*)(shm3 + LDS_INF))[tid] = -INFINITY;
        if (MOBA) { if (tid < 512) ((lds_f32*)(shm3 + LDS_KM))[tid] = kmean[tid]; }
    }
    const h16* ksrc = Kh + (long)lane * PQ + wid * 8;
    const h16* vsrc = Vh + (long)(16 * (wid & 3) + (lane >> 2)) * PQ + (wid >> 2) * 32 + (lane & 3) * 8;
    const unsigned kdst = lds0 + LDS_K + wid * 1024, vdst = lds0 + LDS_V + wid * 1024;
    const int NT = (q0 + QB) / KVBLK;
#define AMAP(t) ((t) < 4 ? 4 * qb + (t) : (MOBA ? (t) - 4 : 4 * qb + 3 - (t)))
#define DMA_K(t, slot) glds16(ksrc + (long)AMAP(t) * KVBLK * PQ, (unsigned)__builtin_amdgcn_readfirstlane(kdst + (slot)))
#define DMA_V(t, slot) glds16(vsrc + (long)AMAP(t) * KVBLK * PQ, (unsigned)__builtin_amdgcn_readfirstlane(vdst + (slot)))
    const char* Kbase = shm + LDS_K; s16x8 kf[8];
    const lds_cptr kp0 = shm3 + LDS_K + hi * 1024 + r32 * 16; const lds_cptr vp0 = shm3 + LDS_V + ((lane >> 4) & 1) * 32 + (lane & 3) * 8 + (4 * hi + ((lane & 15) >> 2)) * 64;
    DMA_K(0, 0); DMA_V(0, 0); DMA_K(1, SLOTB);
    s16x8 qr[4];
#pragma unroll
    for (int d0 = 0; d0 < 4; ++d0) qr[d0] = *reinterpret_cast<const s16x8*>(&Qw[(long)r32 * PQ + d0 * 16 + hi * 8]);
    float mhat = 0.f, l_reg = 0.f; f32x16 o[2]; o[0] = f32x16{}; o[1] = f32x16{}; f32x16 negm = f32x16{}; asm volatile("" : "+v"(negm));
    const int qrel = wid * QBLK + r32;
    unsigned selbits = 0xffu;
#define ADDB(P0, P1, t) do { const int kt_ = AMAP(t); lds_cptr tb_ = shm3 + LDS_BT + kt_ * 256; \
        if (MOBA) { const bool s_ = ((t) < 4) || ((selbits >> (kt_ >> 2)) & 1u); tb_ = s_ ? tb_ : (shm3 + LDS_INF); } \
        _Pragma("unroll") for (int g_ = 0; g_ < 4; ++g_) { const f32x4 b0_ = *(lds_cf32x4*)(tb_ + 16 * hi + 32 * g_), b1_ = *(lds_cf32x4*)(tb_ + 128 + 16 * hi + 32 * g_); \
            _Pragma("unroll") for (int i_ = 0; i_ < 4; ++i_) { P0[4 * g_ + i_] += b0_[i_]; P1[4 * g_ + i_] += b1_[i_]; } } } while (0)
#define CMASK(P0, P1, t) do { if ((t) < 4) cmask(P0, P1, (t), qrel, hi); } while (0)
    bool resc = false;
#define START(P0, P1) do { const float rm = rowmax(P0, P1); resc = false; \
    { const float dl = rm; mhat = fadd_s(mhat, dl); \
      _Pragma("unroll") for (int r = 0; r < 16; ++r) { P0[r] = fsub_s(P0[r], dl); P1[r] = fsub_s(P1[r], dl); } \
      _Pragma("unroll") for (int r = 0; r < 16; ++r) negm[r] = -mhat; asm volatile("" : "+v"(negm)); } \
    _Pragma("unroll") for (int r = 0; r < 16; ++r) P0[r] = __builtin_amdgcn_exp2f(P0[r]); } while (0)
#define RESC() do { if (resc) { asm volatile("s_waitcnt lgkmcnt(0)" ::: "memory"); \
      _Pragma("unroll") for (int d_ = 0; d_ < 2; ++d_) _Pragma("unroll") for (int r = 0; r < 16; ++r) o[d_][r] *= wsf[crow(r, hi)]; } } while (0)
    f32x16 pA0, pA1, pB0, pB1;
    int sl_prev = 0, sl_cur = 0, sl_next = SLOTB;
#define ROT() do { sl_prev = sl_cur; sl_cur = sl_next; sl_next = (sl_next == (NSLOT - 1) * SLOTB) ? 0 : sl_next + SLOTB; } while (0)
    DMA_K(2, 2 * SLOTB);
    WAIT_BAR(3);
    if (MOBA && qb >= 4) {
        float gate[8];
#pragma unroll
        for (int n = 0; n < 8; ++n) gate[n] = 0.f;
#pragma unroll
        for (int d0 = 0; d0 < 4; ++d0) {
            const h16x8 qv = __builtin_bit_cast(h16x8, qr[d0]);
#pragma unroll
            for (int n = 0; n < 7; ++n) {
                const f32x4 k0 = *(lds_cf32x4*)(shm3 + LDS_KM + n * 256 + d0 * 64 + hi * 32), k1 = *(lds_cf32x4*)(shm3 + LDS_KM + n * 256 + d0 * 64 + hi * 32 + 16);
                gate[n] += (float)qv[0] * k0[0] + (float)qv[1] * k0[1] + (float)qv[2] * k0[2] + (float)qv[3] * k0[3] + (float)qv[4] * k1[0] + (float)qv[5] * k1[1] + (float)qv[6] * k1[2] + (float)qv[7] * k1[3];
            }
        }
#pragma unroll
        for (int n = 0; n < 7; ++n) { gate[n] = half_sum(gate[n]); if (n >= qb) gate[n] = -INFINITY; }
        unsigned sb = 0u;
#pragma unroll
        for (int r = 0; r < 3; ++r) {
            float best = -INFINITY; int bi = 0;
#pragma unroll
            for (int n = 0; n < 7; ++n) { const bool fr_ = !((sb >> n) & 1u); if (fr_ && gate[n] > best) { best = gate[n]; bi = n; } }
            sb |= 1u << bi;
        }
        selbits = sb;
    }
    qkt(pA0, pA1, Kbase, qr, negm, r32, hi); asm volatile("s_nop 15\n\ts_nop 7" : "+v"(pA0), "+v"(pA1)); ADDB(pA0, pA1, 0); CMASK(pA0, pA1, 0);
    START(pA0, pA1);
    _Pragma("unroll") for (int r = 0; r < 16; ++r) pA1[r] = __builtin_amdgcn_exp2f(pA1[r]);
    WAIT_BAR(0);
    DMA_K(3, 0); DMA_V(1, SLOTB);
    ROT();
    kload8(kf, kp0 + sl_cur);
    WAIT_BAR(2);
    s16x4 vlo[8], vhi[8]; u32x4 pw0, pw1, pw2, pw3;
#define PKW(P, B) cvtpk_s(P[B], P[B + 1])
#define PAF(k) __builtin_bit_cast(s16x8, pw##k)
#define VFR(i) (s16x8){vlo[i][0], vlo[i][1], vlo[i][2], vlo[i][3], vhi[i][0], vhi[i][1], vhi[i][2], vhi[i][3]}
#define PIN(x) asm volatile("" : "+v"(x))
#define MX3(a, b, c) __builtin_fmaxf(__builtin_fmaxf((a), (b)), (c))
#define GAPA(MF, A0, A1, A2, A3, W0, W1, PW_) do { MF; sacc += A0; sacc += A1; sacc += A2; sacc += A3; PIN(sacc); W0; W1; PIN(PW_); SBAR(); } while (0)
#define EX(v) __builtin_amdgcn_exp2f(v)
#define GAPB(MF, X, B) do { MF; X[B] = EX(X[B]); X[B + 1] = EX(X[B + 1]); X[B + 2] = EX(X[B + 2]); X[B + 3] = EX(X[B + 3]); PIN(X); SBAR(); } while (0)
#define VRD(i) do { vlo[i] = vtr(vp_ + (((i) >> 2) * 4096 + ((i) & 3) * 1024)); vhi[i] = vtr(vp_ + (((i) >> 2) * 4096 + ((i) & 3) * 1024 + 512)); } while (0)
#define KRD(G, j) do { if (G) { kload2(kf, kp0 + sl_next, j); SBAR(); } } while (0)
#define STEP(C0, C1, P0, P1, t, GK, GV, GL) do { SBAR(); \
    const lds_cptr vp_ = vp0 + sl_prev; \
    VRD(0); SBAR(); float sacc = (P0[0] + P0[1]); \
    GAPA(C0 = MFMA32(kf[0], qr[0], negm), P0[2], P0[3], P0[4], P0[5],     pw0[0] = PKW(P0, 0), pw0[1] = PKW(P0, 2), pw0); \
    VRD(4); SBAR(); GAPA(C1 = MFMA32(kf[1], qr[0], negm), P0[6], P0[7], P0[8], P0[9],     pw0[2] = PKW(P0, 4), pw0[3] = PKW(P0, 6), pw0); \
    VRD(1); SBAR(); GAPA(C0 = MFMA32(kf[2], qr[1], C0),   P0[10], P0[11], P0[12], P0[13], pw1[0] = PKW(P0, 8), pw1[1] = PKW(P0, 10), pw1); \
    VRD(5); SBAR(); GAPA(C1 = MFMA32(kf[3], qr[1], C1),   P0[14], P0[15], P1[0], P1[1],   pw1[2] = PKW(P0, 12), pw1[3] = PKW(P0, 14), pw1); \
    VRD(2); SBAR(); GAPA(C0 = MFMA32(kf[4], qr[2], C0),   P1[2], P1[3], P1[4], P1[5],     pw2[0] = PKW(P1, 0), pw2[1] = PKW(P1, 2), pw2); \
    VRD(6); SBAR(); GAPA(C1 = MFMA32(kf[5], qr[2], C1),   P1[6], P1[7], P1[8], P1[9],     pw2[2] = PKW(P1, 4), pw2[3] = PKW(P1, 6), pw2); \
    VRD(3); SBAR(); GAPA(C0 = MFMA32(kf[6], qr[3], C0),   P1[10], P1[11], P1[12], P1[13], pw3[0] = PKW(P1, 8), pw3[1] = PKW(P1, 10), pw3); \
    VRD(7); SBAR(); GAPA(C1 = MFMA32(kf[7], qr[3], C1),   P1[14], P1[15], 0.f, 0.f,       pw3[2] = PKW(P1, 12), pw3[3] = PKW(P1, 14), pw3); \
    l_reg += sacc; \
    if (GK) { DMA_K((t) + 3, sl_cur); } if (GV) { DMA_V((t) + 1, sl_next); } \
    ADDB(C0, C1, t); CMASK(C0, C1, t); \
    { float a = MX3(C0[0], C0[1], C1[0]), b = MX3(C0[2], C0[3], C1[1]); a = MX3(a, C1[2], C1[3]); \
      _Pragma("unroll") for (int r = 4; r < 16; r += 4) { a = MX3(a, C0[r], C0[r + 1]); b = MX3(b, C0[r + 2], C0[r + 3]); a = MX3(a, C1[r], C1[r + 1]); b = MX3(b, C1[r + 2], C1[r + 3]); } \
      float rm = __builtin_fmaxf(a, b); { auto rr = __builtin_amdgcn_permlane32_swap(__float_as_uint(rm), __float_as_uint(rm), false, false); rm = __builtin_fmaxf(__uint_as_float(rr[0]), __uint_as_float(rr[1])); } \
      resc = false; \
      if (__builtin_expect(__any(rm > (float)THRL), 0)) { const float dl = __builtin_fmaxf(rm, 0.f); mhat += dl; \
        _Pragma("unroll") for (int r = 0; r < 16; ++r) { C0[r] -= dl; C1[r] -= dl; } \
        _Pragma("unroll") for (int r = 0; r < 16; ++r) negm[r] = -mhat; asm volatile("" : "+v"(negm)); \
        const float f = __builtin_amdgcn_exp2f(-dl); l_reg *= f; if (hi == 0) wsf[r32] = f; resc = true; } } \
    SBAR(); \
    GAPB(o[0] = MFMA32(PAF(0), VFR(0), o[0]), C0, 0); \
    GAPB(o[1] = MFMA32(PAF(0), VFR(4), o[1]), C0, 4); \
    KRD(GL, 0); GAPB(o[0] = MFMA32(PAF(1), VFR(1), o[0]), C0, 8); \
    KRD(GL, 1); GAPB(o[1] = MFMA32(PAF(1), VFR(5), o[1]), C0, 12); \
    KRD(GL, 2); GAPB(o[0] = MFMA32(PAF(2), VFR(2), o[0]), C1, 0); \
    KRD(GL, 3); GAPB(o[1] = MFMA32(PAF(2), VFR(6), o[1]), C1, 4); \
    GAPB(o[0] = MFMA32(PAF(3), VFR(3), o[0]), C1, 8); \
    GAPB(o[1] = MFMA32(PAF(3), VFR(7), o[1]), C1, 12); \
    } while (0)
    int t = 1;
#define ENDW(tt) do { if ((tt) + 3 < NT) { WAIT_BAR(2); } else if ((tt) + 2 < NT) { WAIT_BAR(1); } else { WAIT_BAR(0); } } while (0)
    for (; t + 1 < NT; t += 2) {
        STEP(pB0, pB1, pA0, pA1, t, (t + 3 < NT), (t + 1 < NT), (t + 1 < NT));       ENDW(t);     RESC(); ROT();
        STEP(pA0, pA1, pB0, pB1, t + 1, (t + 4 < NT), (t + 2 < NT), (t + 2 < NT));   ENDW(t + 1); RESC(); ROT();
    }
    STEP(pB0, pB1, pA0, pA1, NT - 1, false, false, false); RESC();
    { float sacc = pB0[0] + pB0[1]; _Pragma("unroll") for (int r = 2; r < 16; ++r) sacc += pB0[r]; _Pragma("unroll") for (int r = 0; r < 16; ++r) sacc += pB1[r]; l_reg += sacc;
      pw0 = (u32x4){PKW(pB0, 0), PKW(pB0, 2), PKW(pB0, 4), PKW(pB0, 6)}; pw1 = (u32x4){PKW(pB0, 8), PKW(pB0, 10), PKW(pB0, 12), PKW(pB0, 14)}; pw2 = (u32x4){PKW(pB1, 0), PKW(pB1, 2), PKW(pB1, 4), PKW(pB1, 6)}; pw3 = (u32x4){PKW(pB1, 8), PKW(pB1, 10), PKW(pB1, 12), PKW(pB1, 14)};
      int ln_ = threadIdx.x & 63; asm volatile("" : "+v"(ln_));
      const int vb0 = (int)(lds0 + LDS_V) + ((ln_ >> 4) & 1) * 32 + (ln_ & 3) * 8 + (4 * (ln_ >> 5) + ((ln_ & 15) >> 2)) * 64;
      SBAR(); pv(o, vb0 + sl_cur, PAF(0), PAF(1), PAF(2), PAF(3)); }
#undef PKW
#undef PAF
#undef VFR
#undef PIN
#undef MX3
#undef GAPA
#undef GAPB
#undef EX
#undef VRD
#undef KRD
#undef STEP
#undef ENDW
    { auto rr = __builtin_amdgcn_permlane32_swap(__float_as_uint(l_reg), __float_as_uint(l_reg), false, false); l_reg = __uint_as_float(rr[0]) + __uint_as_float(rr[1]); }
    if (hi == 0) wsf[32 + r32] = l_reg; asm volatile("s_waitcnt lgkmcnt(0)" ::: "memory");
    float rli[16];
#pragma unroll
    for (int r = 0; r < 16; ++r) rli[r] = __builtin_amdgcn_rcpf(wsf[32 + crow(r, hi)]);
    {
        int le = threadIdx.x & 63; asm volatile("" : "+v"(le));
        float* stg = (float*)(shm + LDS_OST) + wid * 1024;
        const h16* Zw = Z + (rowbase + q0 + wid * QBLK) * PQ + h * D;
        h16* Yw = Y + (rowbase + q0 + wid * QBLK) * 1536 + h * D;
#pragma unroll
        for (int d0 = 0; d0 < 2; ++d0) {
#pragma unroll
            for (int r = 0; r < 16; ++r) stg[crow(r, le >> 5) * 32 + (le & 31)] = o[d0][r] * rli[r];
            asm volatile("s_waitcnt lgkmcnt(0)" ::: "memory");
#pragma unroll
            for (int i = 0; i < 2; ++i) { const int row = i * 16 + (le >> 2), ch = le & 3;
                const f32x4 a0 = *(const f32x4*)(stg + row * 32 + ch * 8), a1 = *(const f32x4*)(stg + row * 32 + ch * 8 + 4);
                const h16x8 zv = *(const h16x8*)(Zw + (long)row * PQ + d0 * 32 + ch * 8);
                float ov[8] = {a0[0], a0[1], a0[2], a0[3], a1[0], a1[1], a1[2], a1[3]};
#pragma unroll
                for (int e = 0; e < 8; ++e) { const float zz = (float)zv[e]; ov[e] *= zz * __builtin_amdgcn_rcpf(1.f + __expf(-zz)); }
                u32x4 w; w.x = cvtpk_s(ov[0], ov[1]); w.y = cvtpk_s(ov[2], ov[3]); w.z = cvtpk_s(ov[4], ov[5]); w.w = cvtpk_s(ov[6], ov[7]);
                *(u32x4*)(Yw + (long)row * 1536 + d0 * 32 + ch * 8) = w; }
            asm volatile("s_waitcnt lgkmcnt(0)" ::: "memory");
        }
    }
    asm volatile("s_waitcnt vmcnt(0) lgkmcnt(0)\n\ts_barrier" ::: "memory");
#undef DMA_K
#undef DMA_V
#undef AMAP
#undef ADDB
#undef CMASK
#undef START
#undef RESC
#undef ROT
}
#undef SBAR
#undef WAIT_BAR
#undef MFMA32
#undef LDS8
}

constexpr int NWAVES = 8, NTHREADS = 512;
constexpr int MK_LDS_BYTES = 147456;
enum { PH_NORM = 0, PH_PROJ = 1, PH_PRE = 2, PH_SCAN = 3, PH_MIX = 4, PH_BR = 5, PH_OUT = 6, NPH = 7 };
constexpr int N_STEPS = 1 + NPH * 4 + 1;
struct MArgs { const float* in[11]; float* out; unsigned char* ws; int s_lo, s_hi; };

__device__ __forceinline__ void barrier_lds() { asm volatile("s_waitcnt vmcnt(0) lgkmcnt(0)" ::: "memory"); __syncthreads(); }
__device__ __forceinline__ void fox_cumsum_item(int item, int b0, const float* __restrict__ small, float* __restrict__ cb, char* shm) {
    int tid_ = threadIdx.x; asm volatile("" : "+v"(tid_));
    const int tid = tid_, lane = tid & 63, wid = tid >> 6, bl = item >> 3, h = item & 7;
    const float* sp = small + ((size_t)(b0 + bl) * SEQ + 4 * tid) * 16 + h;
    float v0 = sp[0], v1 = sp[16], v2 = sp[32], v3 = sp[48];
    v1 += v0; v2 += v1; v3 += v2;
    float tot = v3;
#pragma unroll
    for (int o = 1; o < 64; o <<= 1) { const float u = shfl_idx(tot, lane - o); if (lane >= o) tot += u; }
    float* wt = (float*)shm;
    if (lane == 63) wt[wid] = tot;
    __syncthreads();
    float base = tot - v3;
    for (int w = 0; w < wid; ++w) base += wt[w];
    float* o4 = cb + (size_t)((b0 + bl) * 8 + h) * SEQ + 4 * tid;
    *(f32x4*)o4 = (f32x4){-(base + v0) * LOG2E, -(base + v1) * LOG2E, -(base + v2) * LOG2E, -(base + v3) * LOG2E};
    __syncthreads();
}
__device__ __forceinline__ void moba_kmean_item(int item, int b0, const h16* __restrict__ proj, float* __restrict__ kmean, char* shm) {
    int tid_ = threadIdx.x; asm volatile("" : "+v"(tid_));
    const int tid = tid_, h = item & 7, blk = (item >> 3) & 7, bl = item >> 6, r8 = tid >> 3, c8 = tid & 7;
    const h16* kp = proj + ((size_t)bl * SEQ + blk * 256 + r8) * PW + PC_BK + h * 64 + c8 * 8;
    float acc[8];
#pragma unroll
    for (int e = 0; e < 8; ++e) acc[e] = 0.f;
#pragma unroll
    for (int j = 0; j < 4; ++j) { const h16x8 v = *(const h16x8*)(kp + (size_t)(64 * j) * PW);
#pragma unroll
        for (int e = 0; e < 8; ++e) acc[e] += (float)v[e]; }
    float* red = (float*)shm;
#pragma unroll
    for (int e = 0; e < 8; ++e) red[r8 * 65 + c8 * 8 + e] = acc[e];
    __syncthreads();
    if (tid < 64) { float sum = 0.f;
#pragma unroll 8
        for (int r = 0; r < 64; ++r) sum += red[r * 65 + tid];
        kmean[(((size_t)(b0 + bl) * 8 + h) * 8 + blk) * 64 + tid] = sum * (1.f / 256.f); }
    __syncthreads();
}

namespace mlstm {
typedef __attribute__((address_space(3))) char* lds_ptr;
typedef __attribute__((address_space(3))) const char* lds_cptr;
typedef short s16x8 __attribute__((ext_vector_type(8)));
typedef short s16x4 __attribute__((ext_vector_type(4)));
typedef short v4i16_t __attribute__((ext_vector_type(4)));
typedef float f32x16 __attribute__((ext_vector_type(16)));
typedef unsigned u32x4 __attribute__((ext_vector_type(4)));
constexpr int W_V = 0, W_K = 16384, W_SC = W_K + 8704, WREG = W_SC + 2048;
constexpr int NACT = 4;
__device__ __forceinline__ int crow(int r, int hi) { return (r & 3) + 8 * (r >> 2) + 4 * hi; }
#define MF32(a, b, c) __builtin_amdgcn_mfma_f32_32x32x16_f16(__builtin_bit_cast(h16x8, (a)), __builtin_bit_cast(h16x8, (b)), (c), 0, 0, 0)
#define LFW(off) ((__attribute__((address_space(3))) float*)(R + W_SC + (off)))
__device__ __forceinline__ s16x4 vtr(lds_cptr p) { return __builtin_bit_cast(s16x4, __builtin_amdgcn_ds_read_tr16_b64_v4i16((__attribute__((address_space(3))) v4i16_t*)p)); }
__device__ __forceinline__ s16x8 trfrag(lds_cptr img, int blk, int ks, int lb) {
    const s16x4 lo = vtr(img + blk * 4096 + ks * 1024 + lb), hi = vtr(img + blk * 4096 + ks * 1024 + 512 + lb);
    return (s16x8){lo[0], lo[1], lo[2], lo[3], hi[0], hi[1], hi[2], hi[3]};
}
__device__ __forceinline__ void stage_v(lds_ptr R, const h16* __restrict__ vsrc  , int lane) {
    int ln = lane; asm volatile("" : "+v"(ln));
    const h16* vp = vsrc + (size_t)(ln >> 2) * PW + (ln & 3) * 8;
#pragma unroll 1
    for (int sg = 0; sg < 4; ++sg) {
        h16x8 x[4];
#pragma unroll
        for (int vb = 0; vb < 4; ++vb) x[vb] = *(const h16x8*)(vp + 32 * vb);
#pragma unroll
        for (int vb = 0; vb < 4; ++vb) *(__attribute__((address_space(3))) h16x8*)(R + W_V + vb * 4096 + sg * 1024 + ln * 16) = x[vb];
        vp += (size_t)16 * PW; }
}
__device__ __forceinline__ void x1_wave(int item, int b0, const h16* __restrict__ proj, const float* __restrict__ small, const float* __restrict__ convw,
                                        h16* __restrict__ qkc, float* __restrict__ U, float* __restrict__ un, float* __restrict__ amax, float* __restrict__ blast, lds_ptr R, int lane_in) {
    int lane = threadIdx.x & 63; (void)lane_in; asm volatile("" : "+v"(lane));
    const int r32 = lane & 31, hi = lane >> 5;
    const int c = item & 31, hh = (item >> 5) & 3, bl = item >> 7;
    const size_t row0 = (size_t)bl * SEQ + c * 64;
    const int gbh = (b0 + bl) * 4 + hh, lbh = bl * 4 + hh;
    float ws;
    {   const float* sp = small + ((size_t)b0 * SEQ + row0 + lane) * 16;
        const float li = sp[8 + hh], lf = sp[12 + hh];
        float bc = lf;
#pragma unroll
        for (int o = 1; o < 64; o <<= 1) { const float u = shfl_idx(bc, lane - o); if (lane >= o) bc += u; }
        const float as = li - bc; float mx = as;
#pragma unroll
        for (int o = 1; o < 64; o <<= 1) mx = fmaxf(mx, shfl_idx(mx, lane ^ o));
        ws = __expf(as - mx);
        if (lane == 63) { amax[gbh * 32 + c] = mx; blast[gbh * 32 + c] = bc; } }
    stage_v(R, proj + row0 * PW + PC_CV + hh * 128, lane);
    const int t = c * 64 + lane;
#pragma unroll 1
    for (int dg = 0; dg < 16; ++dg) {
        const int isk = dg >> 3, pcol = isk ? 256 + hh * 64 + (dg - 8) * 8 : hh * 64 + dg * 8;
        float acc[8];
#pragma unroll
        for (int e = 0; e < 8; ++e) acc[e] = 0.f;
#pragma unroll
        for (int j = 0; j < 4; ++j) {
            const int tt = t - 3 + j, tc = tt < 0 ? 0 : tt;
            const h16x8 x = *(const h16x8*)(proj + ((size_t)bl * SEQ + tc) * PW + PC_CQK + pcol);
            const float m = tt < 0 ? 0.f : 1.f;
            const float* wp = convw + j * 512 + pcol;
#pragma unroll
            for (int e = 0; e < 8; ++e) acc[e] += wp[e] * m * (float)x[e];
        }
        h16x8 o, ow;
#pragma unroll
        for (int e = 0; e < 8; ++e) { float v = acc[e] * __builtin_amdgcn_rcpf(1.f + __expf(-acc[e])); if (isk) v *= 0.125f; o[e] = (h16)v; ow[e] = (h16)(v * ws); }
        *(h16x8*)(qkc + (row0 + lane) * 512 + pcol) = o;
        if (isk) { const int dgk = dg - 8; *(__attribute__((address_space(3))) h16x8*)(R + W_K + (dgk >> 2) * 4096 + lane * 64 + (dgk & 3) * 16) = ow; }
    }
    asm volatile("s_waitcnt lgkmcnt(0)" ::: "memory");
    const int lb = ((lane >> 4) & 1) * 32 + (lane & 3) * 8 + (4 * hi + ((lane & 15) >> 2)) * 64;
    float* up = U + ((size_t)lbh * 32 + c) * 8192;
#pragma unroll 1
    for (int vb = 0; vb < 4; ++vb) {
        f32x16 a0 = f32x16{}, a1 = f32x16{};
#pragma unroll
        for (int ks = 0; ks < 4; ++ks) { const s16x8 vf = trfrag((lds_cptr)(R + W_V), vb, ks, lb);
            a0 = MF32(vf, trfrag((lds_cptr)(R + W_K), 0, ks, lb), a0); a1 = MF32(vf, trfrag((lds_cptr)(R + W_K), 1, ks, lb), a1); }
#pragma unroll
        for (int r = 0; r < 16; ++r) { up[(vb * 32 + crow(r, hi)) * 64 + r32] = a0[r]; up[(vb * 32 + crow(r, hi)) * 64 + 32 + r32] = a1[r]; }
    }
    {   float sum = 0.f;
        lds_cptr kp = (lds_cptr)(R + W_K) + (lane >> 5) * 4096 + (lane & 31) * 2;
#pragma unroll 16
        for (int q = 0; q < 64; ++q) sum += (float)*(const __attribute__((address_space(3))) h16*)(kp + q * 64);
        un[((size_t)gbh * 32 + c) * 64 + lane] = sum; }
    asm volatile("s_waitcnt lgkmcnt(0)" ::: "memory");
}
__device__ __forceinline__ void x2_item(int item, int b0, const float* __restrict__ U, const float* __restrict__ un, const float* __restrict__ amax, const float* __restrict__ blast,
                                        h16* __restrict__ CS, float* __restrict__ ns, float* __restrict__ Ms, char* shm) {
    int tid_ = threadIdx.x; asm volatile("" : "+v"(tid_));
    const int tid = tid_, lbh = item >> 3, sl = item & 7, gbh = (b0 + (lbh >> 2)) * 4 + (lbh & 3);
    float* coef = (float*)shm;
    if (tid == 0) { float M = 0.f; if (sl == 0) Ms[gbh * 32] = 0.f;
        for (int c = 0; c < 31; ++c) { const float am = amax[gbh * 32 + c], bls = blast[gbh * 32 + c], Mn = bls + fmaxf(M, am);
            coef[2 * c] = __expf(bls + M - Mn); coef[2 * c + 1] = __expf(bls + am - Mn); M = Mn; if (sl == 0) Ms[gbh * 32 + c + 1] = M; } }
    __syncthreads();
    {   const int e2 = sl * 1024 + tid * 2;
        const float* up = U + (size_t)lbh * 32 * 8192 + e2; h16* cp = CS + (size_t)lbh * 32 * 8192 + e2;
        float c0 = 0.f, c1 = 0.f;
        *(pg8::h16x2*)cp = (pg8::h16x2){(h16)0.f, (h16)0.f};
#pragma unroll 1
        for (int cb = 0; cb < 31; cb += 8) {
            pg8::f32x2 u[8];
#pragma unroll
            for (int j = 0; j < 8; ++j) if (cb + j < 31) u[j] = *(const pg8::f32x2*)(up + (size_t)(cb + j) * 8192);
#pragma unroll
            for (int j = 0; j < 8; ++j) if (cb + j < 31) { const float fd = coef[2 * (cb + j)], fi = coef[2 * (cb + j) + 1];
                c0 = fd * c0 + fi * u[j].x; c1 = fd * c1 + fi * u[j].y;
                *(pg8::h16x2*)(cp + (size_t)(cb + j + 1) * 8192) = (pg8::h16x2){(h16)c0, (h16)c1}; }
        }
    }
    if (sl == 0 && tid < 64) { float n = 0.f; ns[((size_t)gbh * 32) * 64 + tid] = 0.f;
        for (int c = 0; c < 31; ++c) { n = coef[2 * c] * n + coef[2 * c + 1] * un[((size_t)gbh * 32 + c) * 64 + tid]; ns[((size_t)gbh * 32 + c + 1) * 64 + tid] = n; } }
    __syncthreads();
}
__device__ __forceinline__ void x3_wave(int item, int b0, const h16* __restrict__ proj, const float* __restrict__ small, const h16* __restrict__ qkc, const h16* __restrict__ CS,
                                        const float* __restrict__ ns, const float* __restrict__ Ms, const float* __restrict__ headg, h16* __restrict__ y, lds_ptr R, int lane_in) {
    int lane = threadIdx.x & 63; (void)lane_in; asm volatile("" : "+v"(lane));
    const int c = item & 31, hh = (item >> 5) & 3, bl = item >> 7;
    const size_t row0 = (size_t)bl * SEQ + c * 64;
    const int gbh = (b0 + bl) * 4 + hh, lbh = bl * 4 + hh;
    {   const float* sp = small + ((size_t)b0 * SEQ + row0 + lane) * 16;
        const float li = sp[8 + hh], lf = sp[12 + hh], Mc = Ms[gbh * 32 + c];
        float bc = lf;
#pragma unroll
        for (int o = 1; o < 64; o <<= 1) { const float u = shfl_idx(bc, lane - o); if (lane >= o) bc += u; }
        const float as = li - bc; float pm = as;
#pragma unroll
        for (int o = 1; o < 64; o <<= 1) { const float u = shfl_idx(pm, lane - o); if (lane >= o) pm = fmaxf(pm, u); }
        const float mx = fmaxf(Mc, pm);
        LFW(0)[lane] = as; LFW(256)[lane] = mx; LFW(512)[lane] = __expf(Mc - mx); LFW(768)[lane] = __expf(-(bc + mx));
        LFW(1280)[lane] = ns[((size_t)gbh * 32 + c) * 64 + lane]; }
    stage_v(R, proj + row0 * PW + PC_CV + hh * 128, lane);
    asm volatile("s_waitcnt lgkmcnt(0)" ::: "memory");
    const h16* cprev = CS + ((size_t)lbh * 32 + c) * 8192;
    typedef __attribute__((address_space(3))) const f32x4 lds_cf32x4;
#pragma unroll 1
    for (int tb = 0; tb < 2; ++tb) {
        int l2 = lane; asm volatile("" : "+v"(l2));
        const int r32 = l2 & 31, hi = l2 >> 5;
        const int lb = ((l2 >> 4) & 1) * 32 + (l2 & 3) * 8 + (4 * hi + ((l2 & 15) >> 2)) * 64;
        const int t = 32 * tb + r32;
        s16x8 qr[4];
#pragma unroll
        for (int ks = 0; ks < 4; ++ks) qr[ks] = *(const s16x8*)(qkc + (row0 + t) * 512 + hh * 64 + 16 * ks + 8 * hi);
        const float mxt = LFW(256)[t], wit = LFW(512)[t];
        float nq = 0.f;
#pragma unroll
        for (int ks = 0; ks < 4; ++ks) { const h16x8 qv = __builtin_bit_cast(h16x8, qr[ks]);
            const f32x4 n0 = *(lds_cf32x4*)(R + W_SC + 1280 + (16 * ks + 8 * hi) * 4), n1 = *(lds_cf32x4*)(R + W_SC + 1280 + (16 * ks + 8 * hi + 4) * 4);
            nq += (float)qv[0] * n0[0] + (float)qv[1] * n0[1] + (float)qv[2] * n0[2] + (float)qv[3] * n0[3] + (float)qv[4] * n1[0] + (float)qv[5] * n1[1] + (float)qv[6] * n1[2] + (float)qv[7] * n1[3]; }
        nq = half_sum(nq);
        f32x16 p0 = f32x16{}, p1 = f32x16{};
#pragma unroll
        for (int ks = 0; ks < 4; ++ks) { const s16x8 k0 = *(const s16x8*)(qkc + (row0 + r32) * 512 + 256 + hh * 64 + 16 * ks + 8 * hi); p0 = MF32(k0, qr[ks], p0); }
        if (tb == 1) {
#pragma unroll
            for (int ks = 0; ks < 4; ++ks) { const s16x8 k1 = *(const s16x8*)(qkc + (row0 + 32 + r32) * 512 + 256 + hh * 64 + 16 * ks + 8 * hi); p1 = MF32(k1, qr[ks], p1); } }
        float dsum = 0.f;
#pragma unroll
        for (int g = 0; g < 4; ++g) { const f32x4 a0 = *(lds_cf32x4*)(R + W_SC + (8 * g + 4 * hi) * 4), a1 = *(lds_cf32x4*)(R + W_SC + (32 + 8 * g + 4 * hi) * 4);
#pragma unroll
            for (int i = 0; i < 4; ++i) { const int s0 = 8 * g + 4 * hi + i;
                const float w0 = s0 <= t ? p0[4 * g + i] * __expf(a0[i] - mxt) : 0.f; p0[4 * g + i] = w0; dsum += w0;
                const float w1 = (tb == 1 && s0 + 32 <= t) ? p1[4 * g + i] * __expf(a1[i] - mxt) : 0.f; p1[4 * g + i] = w1; dsum += w1; } }
        dsum = half_sum(dsum);
        if (hi == 0) LFW(1024)[t] = dsum + wit * nq;
        u32x4 pw0, pw1, pw2, pw3;
#define PKW(P, B) pg8::cvt_pk_f16(P[B], P[B + 1])
        pw0 = (u32x4){PKW(p0, 0), PKW(p0, 2), PKW(p0, 4), PKW(p0, 6)}; pw1 = (u32x4){PKW(p0, 8), PKW(p0, 10), PKW(p0, 12), PKW(p0, 14)};
        pw2 = (u32x4){PKW(p1, 0), PKW(p1, 2), PKW(p1, 4), PKW(p1, 6)}; pw3 = (u32x4){PKW(p1, 8), PKW(p1, 10), PKW(p1, 12), PKW(p1, 14)};
#undef PKW
        s16x8 qs[4];
        { const h16 wh = (h16)wit;
#pragma unroll
          for (int ks = 0; ks < 4; ++ks) { h16x8 qv = __builtin_bit_cast(h16x8, qr[ks]);
#pragma unroll
              for (int e = 0; e < 8; ++e) qv[e] = qv[e] * wh;
              qs[ks] = __builtin_bit_cast(s16x8, qv); } }
        f32x16 acc[4];
#pragma unroll
        for (int vb = 0; vb < 4; ++vb) { acc[vb] = f32x16{};
#pragma unroll
            for (int ks = 0; ks < 4; ++ks) { const s16x8 cf = *(const s16x8*)(cprev + (32 * vb + r32) * 64 + 16 * ks + 8 * hi); acc[vb] = MF32(qs[ks], cf, acc[vb]); }
            acc[vb] = MF32(__builtin_bit_cast(s16x8, pw0), trfrag((lds_cptr)(R + W_V), vb, 0, lb), acc[vb]);
            acc[vb] = MF32(__builtin_bit_cast(s16x8, pw1), trfrag((lds_cptr)(R + W_V), vb, 1, lb), acc[vb]);
            if (tb == 1) { acc[vb] = MF32(__builtin_bit_cast(s16x8, pw2), trfrag((lds_cptr)(R + W_V), vb, 2, lb), acc[vb]);
                           acc[vb] = MF32(__builtin_bit_cast(s16x8, pw3), trfrag((lds_cptr)(R + W_V), vb, 3, lb), acc[vb]); } }
        asm volatile("s_waitcnt lgkmcnt(0)" ::: "memory");
#pragma unroll
        for (int g = 0; g < 4; ++g) { const f32x4 dn = *(lds_cf32x4*)(R + W_SC + 1024 + (32 * tb + 8 * g + 4 * hi) * 4), em = *(lds_cf32x4*)(R + W_SC + 768 + (32 * tb + 8 * g + 4 * hi) * 4);
#pragma unroll
            for (int i = 0; i < 4; ++i) { const float inv = __builtin_amdgcn_rcpf(fmaxf(fabsf(dn[i]), em[i])); const int rl = 8 * g + 4 * hi + i;
#pragma unroll
                for (int vb = 0; vb < 4; ++vb) *(__attribute__((address_space(3))) h16*)(R + W_K + rl * 272 + (32 * vb + r32) * 2) = (h16)(acc[vb][4 * g + i] * inv); } }
        asm volatile("s_waitcnt lgkmcnt(0)" ::: "memory");
#pragma unroll 1
        for (int ps = 0; ps < 2; ++ps) {
            int l3 = threadIdx.x & 63; asm volatile("" : "+v"(l3));
            const int rl = 16 * ps + (l3 >> 2), v0 = (l3 & 3) * 32;
            const size_t row = row0 + 32 * tb + rl;
            float hg[32]; float ss = 0.f;
#pragma unroll
            for (int q = 0; q < 4; ++q) { const h16x8 hv = *(const __attribute__((address_space(3))) h16x8*)(R + W_K + rl * 272 + (v0 + 8 * q) * 2);
                const h16x8 og = *(const h16x8*)(proj + row * PW + PC_CO + hh * 128 + v0 + 8 * q);
#pragma unroll
                for (int e = 0; e < 8; ++e) { const float x = (float)hv[e] * __builtin_amdgcn_rcpf(1.f + __expf(-(float)og[e])); hg[8 * q + e] = x; ss += x * x; } }
            ss += swz_xor<1>(ss); ss += swz_xor<2>(ss);
            const float rn = rsqrtf(ss * (1.f / 128.f) + RMS_EPS);
#pragma unroll
            for (int q = 0; q < 4; ++q) { const h16x8 zv = *(const h16x8*)(proj + row * PW + PC_CZ + hh * 128 + v0 + 8 * q);
                const f32x4 g0 = *(const f32x4*)(headg + hh * 128 + v0 + 8 * q), g1 = *(const f32x4*)(headg + hh * 128 + v0 + 8 * q + 4);
                float ov[8];
#pragma unroll
                for (int e = 0; e < 8; ++e) { const float zz = (float)zv[e]; ov[e] = hg[8 * q + e] * rn * (e < 4 ? g0[e] : g1[e - 4]) * zz * __builtin_amdgcn_rcpf(1.f + __expf(-zz)); }
                u32x4 w; w.x = pg8::cvt_pk_f16(ov[0], ov[1]); w.y = pg8::cvt_pk_f16(ov[2], ov[3]); w.z = pg8::cvt_pk_f16(ov[4], ov[5]); w.w = pg8::cvt_pk_f16(ov[6], ov[7]);
                *(u32x4*)(y + row * 1536 + 1024 + hh * 128 + v0 + 8 * q) = w; }
        }
        asm volatile("s_waitcnt lgkmcnt(0)" ::: "memory");
    }
}
#undef LFW
#undef MF32
}

#define LAS __attribute__((address_space(3)))
#define XB_TMO      128
#define XB_XCNT(j)  (256  + 64 * (j))
#define XB_XSUB(j)  (1280 + 64 * (j))
#define XB_XGEN(j)  (2304 + 64 * (j))
#define XB_TOP      3328
#define XB_TOPGEN   3392
#define XCD_BAR_WORDS 3456
#define XB_SPIN_CAP (1u << 18)
__device__ __forceinline__ unsigned xb_ld(unsigned* p)              { return __hip_atomic_load(p, __ATOMIC_RELAXED, __HIP_MEMORY_SCOPE_AGENT); }
__device__ __forceinline__ unsigned xb_add(unsigned* p, unsigned v) { return __hip_atomic_fetch_add(p, v, __ATOMIC_RELAXED, __HIP_MEMORY_SCOPE_AGENT); }
__device__ __forceinline__ unsigned xb_xcc_id() { return (unsigned)__builtin_amdgcn_s_getreg((3 << 11) | 20) & 0xFu; }
#define XB_SPIN(cond, bar) do { unsigned _sp = 0; while (cond) { __builtin_amdgcn_s_sleep(1); \
    if ((++_sp & 255u) == 0u) { if (xb_ld(&(bar)[XB_TMO])) break; if (_sp > XB_SPIN_CAP) { atomicAdd(&(bar)[XB_TMO], 1u); break; } } } } while (0)
struct XcdBarrier { unsigned* bar; unsigned x; volatile LAS unsigned* st; };
__device__ __forceinline__ XcdBarrier xcd_barrier_post(unsigned* bar, volatile LAS unsigned* st) {
    XcdBarrier b; b.bar = bar; b.x = xb_xcc_id(); b.st = st;
    if (threadIdx.x == 0) (void)xb_add(&bar[XB_XCNT(b.x)], 1u);
    return b;
}
__device__ __forceinline__ void xcd_barrier_complete(unsigned* bar, unsigned x, unsigned& nloc, unsigned& nx) {
    const unsigned G = gridDim.x * gridDim.y * gridDim.z;
    unsigned sum, cnt, mine, sp = 0u;
    for (;;) {
        sum = 0u; cnt = 0u; mine = 0u;
#pragma unroll
        for (unsigned j = 0; j < 16; ++j) { const unsigned c = xb_ld(&bar[XB_XCNT(j)]); sum += c; cnt += (c > 0u) ? 1u : 0u; mine = (j == x) ? c : mine; }
        if (sum == G) break;
        __builtin_amdgcn_s_sleep(1);
        if ((++sp & 255u) == 0u) { if (xb_ld(&bar[XB_TMO])) break; if (sp > XB_SPIN_CAP) { atomicAdd(&bar[XB_TMO], 1u); break; } }
    }
    nloc = mine > 0u ? mine : 1u; nx = cnt > 0u ? cnt : 1u;
}
__device__ __forceinline__ void xcd_barrier(const XcdBarrier& b) {
    asm volatile("s_waitcnt vmcnt(0)" ::: "memory");
    __syncthreads();
    if (threadIdx.x == 0) {
        unsigned* bar = b.bar;
        __builtin_amdgcn_s_waitcnt(0);
        unsigned nloc = b.st[0], nx = b.st[1];
        if (nloc == 0u) { xcd_barrier_complete(bar, b.x, nloc, nx); b.st[0] = nloc; b.st[1] = nx; }
        const unsigned old = xb_add(&bar[XB_XSUB(b.x)], 1u);
        const unsigned gen = old / nloc;
        if (old + 1u == (gen + 1u) * nloc) {
            __builtin_amdgcn_fence(__ATOMIC_RELEASE, "agent");
            asm volatile("s_waitcnt vmcnt(0)" ::: "memory");
            const unsigned og = xb_add(&bar[XB_TOP], 1u);
            const unsigned tg = og / nx;
            if (og + 1u == (tg + 1u) * nx) xb_add(&bar[XB_TOPGEN], 1u);
            else XB_SPIN(xb_ld(&bar[XB_TOPGEN]) == tg, bar);
            __builtin_amdgcn_fence(__ATOMIC_ACQUIRE, "agent");
            xb_add(&bar[XB_XGEN(b.x)], 1u);
            asm volatile("s_waitcnt vmcnt(0)" ::: "memory");
        } else {
            XB_SPIN(xb_ld(&bar[XB_XGEN(b.x)]) == gen, bar);
            __builtin_amdgcn_fence(__ATOMIC_ACQUIRE, "agent");
            asm volatile("s_waitcnt vmcnt(0)" ::: "memory");
        }
    }
    __syncthreads();
}
constexpr int LDSCTL_OFF = 131072, MISC_OFF = LDSCTL_OFF + 320;
constexpr int CW_BAR = 4096;
constexpr size_t CTL_ZERO_BYTES = 65536;

__device__ __forceinline__ void transpose_item(const float* __restrict__ W, int ldsrc, int K, h16* __restrict__ WT, int k0, int n0, int src_col0, float scale, PG8_LAS float* scr, int lane) {
    float tv[32];
#pragma unroll
    for (int i = 0; i < 32; ++i) { const int kk = 2 * i + (lane >> 5); tv[i] = W[(size_t)(k0 + kk) * ldsrc + src_col0 + (lane & 31)]; }
#pragma unroll
    for (int i = 0; i < 32; ++i) { const int kk = 2 * i + (lane >> 5); scr[kk * 33 + (lane & 31)] = tv[i]; }
    asm volatile("s_waitcnt lgkmcnt(0)" ::: "memory");
    const int c = lane & 7;
#pragma unroll
    for (int j = 0; j < 4; ++j) { const int n = (lane >> 3) + 8 * j; const PG8_LAS float* sp = scr + (8 * c) * 33 + n;
        pg8::u32x4 o; o.x = pg8::cvt_pk_f16(sp[0 * 33] * scale, sp[1 * 33] * scale); o.y = pg8::cvt_pk_f16(sp[2 * 33] * scale, sp[3 * 33] * scale);
        o.z = pg8::cvt_pk_f16(sp[4 * 33] * scale, sp[5 * 33] * scale); o.w = pg8::cvt_pk_f16(sp[6 * 33] * scale, sp[7 * 33] * scale);
        *(pg8::u32x4*)(WT + (size_t)(n0 + n) * K + k0 + 8 * c) = o; }
    asm volatile("s_waitcnt lgkmcnt(0)" ::: "memory");
}
__device__ __forceinline__ void prologue_phase(const MArgs& a, PG8_LAS unsigned char* L) {
    int tid_ = threadIdx.x; asm volatile("" : "+v"(tid_));
    const int lane = tid_ & 63, wave = tid_ >> 6;
    PG8_LAS float* scr = (PG8_LAS float*)(L + wave * 16384);
    const int gw = blockIdx.x * NWAVES + wave, NGW = gridDim.x * NWAVES;
    constexpr int I_IN = (DM / 64) * (PW / 32), I_BR = (512 / 64) * (1024 / 32), I_OUT = (DM / 64) * (DM / 32), I_L = I_IN + 3 * I_BR + I_OUT;
    unsigned char* ws = a.ws;
    for (int it = gw; it < DEPTH * I_L; it += NGW) {
        const int l = it / I_L; int r = it - l * I_L;
        if (r < I_IN) { const int nblk = PW / 32, kb = r / nblk, nb = r % nblk, n0 = nb * 32;
            const float sc = ((n0 >= PC_AQ && n0 < PC_AQ + 512) || (n0 >= PC_BQ && n0 < PC_BQ + 512)) ? C2 : 1.f;
            transpose_item(a.in[2] + (size_t)l * DM * INW, INW, DM, (h16*)(ws + WS_WIN) + (size_t)l * PW * DM, kb * 64, n0, orig_col(n0), sc, scr, lane); continue; }
        r -= I_IN;
        if (r < 3 * I_BR) { const int n3 = r / I_BR, q = r % I_BR, nblk = 1024 / 32, kb = q / nblk, nb = q % nblk;
            transpose_item(a.in[8] + ((size_t)l * 3 + n3) * 512 * 1024, 1024, 512, (h16*)(ws + WS_WBR) + ((size_t)l * 3 + n3) * 1024 * 512, kb * 64, nb * 32, nb * 32, 1.f, scr, lane); continue; }
        r -= 3 * I_BR;
        { const int nblk = DM / 32, kb = r / nblk, nb = r % nblk;
          transpose_item(a.in[9] + (size_t)l * DM * DM, DM, DM, (h16*)(ws + WS_WOUT) + (size_t)l * DM * DM, kb * 64, nb * 32, nb * 32, 1.f, scr, lane); }
    }
    float* wsmall = (float*)(ws + WS_WSMALL);
    for (int i = blockIdx.x * NTHREADS + tid_; i < DEPTH * 16 * DM; i += gridDim.x * NTHREADS) {
        const int l = i / (16 * DM), c = (i >> 10) & 15, k = i & 1023;
        wsmall[i] = a.in[2][(size_t)l * DM * INW + (size_t)k * INW + small_col(c)];
    }
}
__device__ __forceinline__ void norm_phase(const float* __restrict__ x, const float* __restrict__ g, const float* __restrict__ wsmall, const float* __restrict__ fox_bf,
                                           const float* __restrict__ ml_bi, const float* __restrict__ ml_bf, h16* __restrict__ hn, float* __restrict__ small, int row0) {
    int tid_ = threadIdx.x; asm volatile("" : "+v"(tid_));
    const int lane = tid_ & 63, gw = blockIdx.x * NWAVES + (tid_ >> 6), NGW = gridDim.x * NWAVES;
    for (int r4 = gw; r4 < TH / 4; r4 += NGW) {
        f32x4 v[4][4];
#pragma unroll
        for (int q = 0; q < 4; ++q) {
            const f32x4* xr = (const f32x4*)(x + (size_t)(row0 + 4 * r4 + q) * DM) + lane;
            float ssq = 0.f;
#pragma unroll
            for (int j = 0; j < 4; ++j) { v[q][j] = xr[64 * j]; ssq += v[q][j].x * v[q][j].x + v[q][j].y * v[q][j].y + v[q][j].z * v[q][j].z + v[q][j].w * v[q][j].w; }
            const float rstd = rsqrtf(wave_sum(ssq) * (1.f / DM) + RMS_EPS);
#pragma unroll
            for (int j = 0; j < 4; ++j) {
                const f32x4 gg = ((const f32x4*)g)[lane + 64 * j];
                v[q][j].x *= rstd * gg.x; v[q][j].y *= rstd * gg.y; v[q][j].z *= rstd * gg.z; v[q][j].w *= rstd * gg.w;
                pg8::u32x4 dummy; (void)dummy;
                typedef unsigned u32x2 __attribute__((ext_vector_type(2)));
                u32x2 o; o.x = pg8::cvt_pk_f16(v[q][j].x, v[q][j].y); o.y = pg8::cvt_pk_f16(v[q][j].z, v[q][j].w);
                *((u32x2*)(hn + (size_t)(4 * r4 + q) * DM) + lane + 64 * j) = o;
            }
        }
        float mine[4] = {0.f, 0.f, 0.f, 0.f};
#pragma unroll 1
        for (int c = 0; c < 16; ++c) {
            const f32x4* wr = (const f32x4*)(wsmall + c * DM) + lane;
            float acc[4] = {0.f, 0.f, 0.f, 0.f};
#pragma unroll
            for (int j = 0; j < 4; ++j) { const f32x4 w = wr[64 * j];
#pragma unroll
                for (int q = 0; q < 4; ++q) acc[q] += v[q][j].x * w.x + v[q][j].y * w.y + v[q][j].z * w.z + v[q][j].w * w.w; }
#pragma unroll
            for (int q = 0; q < 4; ++q) { const float t = wave_sum(acc[q]); if (lane == c) mine[q] = t; }
        }
        if (lane < 16) {
            const float bias = lane < 8 ? fox_bf[lane] : lane < 12 ? ml_bi[lane - 8] : ml_bf[lane - 12];
#pragma unroll
            for (int q = 0; q < 4; ++q) { const float pre = mine[q] + bias; small[(size_t)(row0 + 4 * r4 + q) * 16 + lane] = (lane >= 8 && lane < 12) ? pre : log_sigmoidf_(pre); }
        }
    }
}
__device__ __forceinline__ void final_norm_phase(float* __restrict__ x, const float* __restrict__ g) {
    int tid_ = threadIdx.x; asm volatile("" : "+v"(tid_));
    const int lane = tid_ & 63, gw = blockIdx.x * NWAVES + (tid_ >> 6), NGW = gridDim.x * NWAVES;
    for (int row = gw; row < TT; row += NGW) {
        f32x4* xr = (f32x4*)(x + (size_t)row * DM) + lane;
        f32x4 v[4]; float ssq = 0.f;
#pragma unroll
        for (int j = 0; j < 4; ++j) { v[j] = xr[64 * j]; ssq += v[j].x * v[j].x + v[j].y * v[j].y + v[j].z * v[j].z + v[j].w * v[j].w; }
        const float rstd = rsqrtf(wave_sum(ssq) * (1.f / DM) + RMS_EPS);
#pragma unroll
        for (int j = 0; j < 4; ++j) { const f32x4 gg = ((const f32x4*)g)[lane + 64 * j];
            xr[64 * j] = (f32x4){v[j].x * rstd * gg.x, v[j].y * rstd * gg.y, v[j].z * rstd * gg.z, v[j].w * rstd * gg.w}; }
    }
}

__global__ void __launch_bounds__(NTHREADS, 2) mega(MArgs a) {
    extern __shared__ __attribute__((aligned(16))) unsigned char lds[];
    PG8_LAS unsigned char* L = (PG8_LAS unsigned char*)lds;
    unsigned char* ws = a.ws;
    for (int u = threadIdx.x; u < (MK_LDS_BYTES - LDSCTL_OFF) / 4; u += NTHREADS) ((LAS unsigned*)(L + LDSCTL_OFF))[u] = 0u;
    __syncthreads();
    XcdBarrier bar = xcd_barrier_post((unsigned*)(ws + WS_CTL) + CW_BAR, (volatile LAS unsigned*)(L + MISC_OFF) + 8);
    for (int s = a.s_lo; s < a.s_hi; ++s) {
        if (s == a.s_lo + 1) { __builtin_amdgcn_fence(__ATOMIC_RELEASE, "agent"); cg::this_grid().sync(); __builtin_amdgcn_fence(__ATOMIC_ACQUIRE, "agent"); }
        else if (s > a.s_lo) xcd_barrier(bar);
        if (s == 0) { prologue_phase(a, L); barrier_lds(); continue; }
        if (s == N_STEPS - 1) { final_norm_phase(a.out, a.in[10]); continue; }
        const int li = (s - 1) / NPH, ph = (s - 1) % NPH, layer = li >> 1, hf = li & 1;
        const int row0 = hf * TH;
        if (ph == PH_NORM) {
            norm_phase(layer == 0 ? a.in[0] : a.out, a.in[1] + layer * DM, (const float*)(ws + WS_WSMALL) + layer * 16 * DM, a.in[3] + layer * 8, a.in[5] + layer * 4, a.in[6] + layer * 4,
                       (h16*)(ws + WS_HN), (float*)(ws + WS_SMALL), row0);
        } else if (ph == PH_PRE) {
            const int b0 = hf * HB;
            for (int it = blockIdx.x; it < HB * 8; it += gridDim.x) fox_cumsum_item(it, b0, (const float*)(ws + WS_SMALL), (float*)(ws + WS_CB), (char*)lds);
            for (int it = blockIdx.x; it < HB * 64; it += gridDim.x) moba_kmean_item(it, b0, (const h16*)(ws + WS_PROJ), (float*)(ws + WS_KMEAN), (char*)lds);
            {   int tid_ = threadIdx.x; asm volatile("" : "+v"(tid_));
                const int wv = __builtin_amdgcn_readfirstlane(tid_ >> 6), ln = tid_ & 63;
                if (wv < mlstm::NACT) for (int it = blockIdx.x * mlstm::NACT + wv; it < HB * 128; it += gridDim.x * mlstm::NACT)
                    mlstm::x1_wave(it, b0, (const h16*)(ws + WS_PROJ), (const float*)(ws + WS_SMALL), a.in[4] + (size_t)layer * 4 * 512, (h16*)(ws + WS_QKC), (float*)(ws + WS_U),
                                   (float*)(ws + WS_MUN), (float*)(ws + WS_MAMAX), (float*)(ws + WS_MBLAST), (mlstm::lds_ptr)L + wv * mlstm::WREG, ln);
                barrier_lds(); }
        } else if (ph == PH_SCAN) {
            for (int it = blockIdx.x; it < 32 * 8; it += gridDim.x)
                mlstm::x2_item(it, hf * HB, (const float*)(ws + WS_U), (const float*)(ws + WS_MUN), (const float*)(ws + WS_MAMAX), (const float*)(ws + WS_MBLAST),
                               (h16*)(ws + WS_CS), (float*)(ws + WS_MNS), (float*)(ws + WS_MMS), (char*)lds);
        } else if (ph == PH_MIX) {
            const int b0 = hf * HB, G = gridDim.x, bx = blockIdx.x;
            const int vcu = (G % 8 == 0) ? (bx % 8) * (G / 8) + bx / 8 : bx;
            const h16* proj = (const h16*)(ws + WS_PROJ); h16* y = (h16*)(ws + WS_Y);
            for (int v = vcu; v < 256; v += G) {
                const int bh = v >> 2, sidx = v & 3, bl = bh >> 3, h = bh & 7;
                const float* cbp = (const float*)(ws + WS_CB) + (size_t)((b0 + bl) * 8 + h) * SEQ;
                const float* kmp = (const float*)(ws + WS_KMEAN) + (size_t)((b0 + bl) * 8 + h) * 512;
                const float slope2 = exp2f(-(float)(h + 1)) * LOG2E;
#pragma unroll 1
                for (int i = 0; i < 4; ++i) {
                    const int qb = (i < 2) ? 7 - sidx : sidx;
                    if ((i & 1) == 0) attn_body::attn_unit<false, 8>(bl, h, qb, proj + PC_AQ, proj + PC_AK, proj + PC_AV, proj + PC_AZ, y, cbp, 0.f, kmp, (char*)lds);
                    else attn_body::attn_unit<true, 8>(bl, h, qb, proj + PC_BQ, proj + PC_BK, proj + PC_BV, proj + PC_BZ, y + 512, cbp, slope2, kmp, (char*)lds);
                }
            }
            {   int tid_ = threadIdx.x; asm volatile("" : "+v"(tid_));
                const int wv = __builtin_amdgcn_readfirstlane(tid_ >> 6), ln = tid_ & 63;
                if (wv < mlstm::NACT) for (int it = blockIdx.x * mlstm::NACT + wv; it < HB * 128; it += gridDim.x * mlstm::NACT)
                    mlstm::x3_wave(it, b0, proj, (const float*)(ws + WS_SMALL), (const h16*)(ws + WS_QKC), (const h16*)(ws + WS_CS), (const float*)(ws + WS_MNS), (const float*)(ws + WS_MMS),
                                   a.in[7] + (size_t)layer * 512, y, (mlstm::lds_ptr)L + wv * mlstm::WREG, ln);
                barrier_lds(); }
        } else if (ph == PH_PROJ) {
            pg8::Gemm g{(const h16*)(ws + WS_HN), (const h16*)(ws + WS_WIN) + (size_t)layer * PW * DM, DM, DM, DM, 0, 0};
            pg8::StaticOrder S; S.init(TH, PW, gridDim.x, blockIdx.x);
            pg8::EpiF16 E{(h16*)(ws + WS_PROJ), PW};
            pg8::gemm_phase(L, g, S, E);
        } else if (ph == PH_BR) {
            pg8::Gemm g{(const h16*)(ws + WS_Y), (const h16*)(ws + WS_WBR) + (size_t)layer * 3 * 1024 * 512, 1536, 512, 512, 512, 1024 * 512};
            pg8::BranchOrder S; S.init(TH, DM, gridDim.x, blockIdx.x, 3);
            pg8::EpiGate E{(h16*)(ws + WS_MRG), (const h16*)(ws + WS_PROJ) + PC_G, PW};
            pg8::gemm_phase<pg8::EpiGate, pg8::BranchOrder, false>(L, g, S, E);
        } else if (ph == PH_OUT) {
            pg8::Gemm g{(const h16*)(ws + WS_MRG), (const h16*)(ws + WS_WOUT) + (size_t)layer * DM * DM, DM, DM, DM, 0, 0};
            pg8::StaticOrder S; S.init(TH, DM, gridDim.x, blockIdx.x);
            const float* xsrc = layer == 0 ? a.in[0] : a.out;
            pg8::EpiRes E{xsrc + (size_t)row0 * DM, a.out + (size_t)row0 * DM, DM};
            pg8::gemm_phase(L, g, S, E);
        }
    }
}

extern "C" void kernel_launch(void* const* d_in, const int* in_sizes, int n_in, void* d_out, int out_size, void* d_ws, size_t ws_size, hipStream_t stream) {
    if (n_in != 11 || in_sizes[0] != TT * DM || out_size != TT * DM || ws_size < WS_END) {
        fprintf(stderr, "kernel_launch: unexpected shapes / workspace (n_in %d, in0 %d, out %d, ws %zu < %zu)\n", n_in, n_in > 0 ? in_sizes[0] : -1, out_size, ws_size, (size_t)WS_END);
        return;
    }
    static int grid = 0;
    if (grid == 0) {
        int dev = 0, cus = 0, per_cu = 0;
        hipGetDevice(&dev);
        hipDeviceGetAttribute(&cus, hipDeviceAttributeMultiprocessorCount, dev);
        if (hipFuncSetAttribute((const void*)mega, hipFuncAttributeMaxDynamicSharedMemorySize, MK_LDS_BYTES) != hipSuccess) fprintf(stderr, "kernel_launch: hipFuncSetAttribute failed\n");
        if (hipOccupancyMaxActiveBlocksPerMultiprocessor(&per_cu, (const void*)mega, NTHREADS, MK_LDS_BYTES) != hipSuccess || per_cu < 1) { fprintf(stderr, "kernel_launch: occupancy query says %d blocks per CU\n", per_cu); per_cu = 1; }
        (void)hipGetLastError();
        grid = cus;
        if (grid != 256) fprintf(stderr, "kernel_launch: note: %d CUs (tuned for 256)\n", grid);
    }
    MArgs ma{};
    for (int i = 0; i < 11; ++i) ma.in[i] = (const float*)d_in[i];
    ma.out = (float*)d_out; ma.ws = (unsigned char*)d_ws; ma.s_lo = 0; ma.s_hi = N_STEPS;
    if (hipMemsetAsync((char*)d_ws + WS_CTL, 0, CTL_ZERO_BYTES, stream) != hipSuccess) { fprintf(stderr, "kernel_launch: hipMemsetAsync of the control words failed\n"); return; }
    void* args[] = {&ma};
    hipError_t e = hipLaunchCooperativeKernel((const void*)mega, dim3(grid), dim3(NTHREADS), args, MK_LDS_BYTES, stream);
    if (e != hipSuccess) fprintf(stderr, "kernel_launch: cooperative launch failed: %s (grid %d)\n", hipGetErrorString(e), grid);
}
```

```cpp
#include <hip/hip_runtime.h>
#include <hip/hip_cooperative_groups.h>
#include <cstdio>
#include <cstdint>

namespace cg = cooperative_groups;
typedef _Float16 h16;
typedef _Float16 h16x4 __attribute__((ext_vector_type(4)));
typedef _Float16 h16x8 __attribute__((ext_vector_type(8)));
typedef float f32x4 __attribute__((ext_vector_type(4)));

constexpr int DM = 1024, BATCH = 16, SEQ = 2048, DEPTH = 2;
constexpr int TT = BATCH * SEQ;
constexpr int HB = 8;
constexpr int TH = HB * SEQ;
constexpr int INW = 9232;
constexpr int PW = 9216;
constexpr float RMS_EPS = 1e-6f;
constexpr float LOG2E = 1.4426950408889634f;
constexpr float C2 = 0.125f * LOG2E;
constexpr int PC_AQ = 0, PC_AK = 512, PC_AV = 1024, PC_AZ = 1536, PC_BQ = 2048, PC_BK = 2560, PC_BV = 3072, PC_BZ = 3584,
              PC_CQK = 4096, PC_CV = 4608, PC_CO = 5120, PC_CZ = 5632, PC_G = 6144;
__host__ __device__ inline int orig_col(int j) { return j < 2048 ? j : (j < 6144 ? j + 8 : j + 16); }
__host__ __device__ inline int small_col(int c) { return c < 8 ? 2048 + c : 6152 + (c - 8); }

constexpr size_t MiB = 1u << 20;
constexpr size_t WS_CTL = 0;
constexpr size_t WS_WSMALL = 512 * 1024;
constexpr size_t WS_SMALL = 1 * MiB;
constexpr size_t WS_CB = 3 * MiB;
constexpr size_t WS_KMEAN = 4 * MiB;
constexpr size_t WS_MSC = 5 * MiB;
constexpr size_t WS_MUN = WS_MSC, WS_MNS = WS_MSC + 512 * 1024;
constexpr size_t WS_MAMAX = 4 * MiB + 512 * 1024, WS_MBLAST = WS_MAMAX + 8192, WS_MMS = WS_MAMAX + 16384;
constexpr size_t WS_WBR = 6 * MiB;
constexpr size_t WS_WOUT = 12 * MiB;
constexpr size_t WS_WIN = 16 * MiB;
constexpr size_t WS_HN = 52 * MiB;
constexpr size_t WS_Y = 84 * MiB;
constexpr size_t WS_MRG = WS_HN;
constexpr size_t WS_U = 132 * MiB;
constexpr size_t WS_CS = 164 * MiB;
constexpr size_t WS_QKC = 180 * MiB;
constexpr size_t WS_PROJ = 196 * MiB;
constexpr size_t WS_END = 484 * MiB;

__device__ __forceinline__ float sigmoidf_(float x) { return 1.f / (1.f + __expf(-x)); }
__device__ __forceinline__ float siluf_(float x) { return x / (1.f + __expf(-x)); }
__device__ __forceinline__ float log_sigmoidf_(float x) {
    const float e = __expf(-fabsf(x)); const float l = e < 0.01f ? e * (1.f - 0.5f * e + 0.33333334f * e * e) : __logf(1.f + e); return fminf(x, 0.f) - l; }
template <int M> __device__ __forceinline__ float swz_xor(float v) { return __int_as_float(__builtin_amdgcn_ds_swizzle(__float_as_int(v), (M << 10) | 0x1f)); }
__device__ __forceinline__ float half_sum(float v) { auto rr = __builtin_amdgcn_permlane32_swap(__float_as_uint(v), __float_as_uint(v), false, false); return __uint_as_float(rr[0]) + __uint_as_float(rr[1]); }
__device__ __forceinline__ float shfl_idx(float x, int srclane) { return __int_as_float(__builtin_amdgcn_ds_bpermute(srclane << 2, __float_as_int(x))); }
__device__ __forceinline__ float wave_sum(float v) {
    v += swz_xor<1>(v); v += swz_xor<2>(v); v += swz_xor<4>(v); v += swz_xor<8>(v); v += swz_xor<16>(v);
    return half_sum(v);
}

__global__ void nv_convert_t(const float* __restrict__ src, int ldsrc, int K, h16* __restrict__ dst, int Nd, int mode) {
    __shared__ float tile[32][33];
    const int tx = threadIdx.x & 31, ty = threadIdx.x >> 5;
    const int j0 = blockIdx.x * 32, k0 = blockIdx.y * 32;
#pragma unroll
    for (int i = 0; i < 4; ++i) {
        const int k = k0 + ty + 8 * i, j = j0 + tx;
        const int sc = mode == 1 ? orig_col(j) : j;
        tile[ty + 8 * i][tx] = src[(size_t)k * ldsrc + sc];
    }
    __syncthreads();
#pragma unroll
    for (int i = 0; i < 4; ++i) {
        const int j = j0 + ty + 8 * i, k = k0 + tx;
        float v = tile[tx][ty + 8 * i];
        if (mode == 1 && ((j >= PC_AQ && j < PC_AQ + 512) || (j >= PC_BQ && j < PC_BQ + 512))) v *= C2;
        dst[(size_t)j * K + k] = (h16)v;
    }
}

__global__ void nv_small_w(const float* __restrict__ w_in, float* __restrict__ wsmall) {
    const int i = blockIdx.x * blockDim.x + threadIdx.x;
    if (i >= 16 * DM) return;
    const int c = i >> 10, k = i & 1023;
    wsmall[i] = w_in[(size_t)k * INW + small_col(c)];
}
__global__ void __launch_bounds__(256) nv_rmsnorm_small(const float* __restrict__ x, const float* __restrict__ g, const float* __restrict__ wsmall  ,
                                 const float* __restrict__ fox_bf, const float* __restrict__ ml_bi, const float* __restrict__ ml_bf,
                                 h16* __restrict__ hn, float* __restrict__ small, int row0, int nrows) {
    const int lane = threadIdx.x & 63, wv = (blockIdx.x * blockDim.x + threadIdx.x) >> 6, nw = (gridDim.x * blockDim.x) >> 6;
    for (int r = wv; r < nrows; r += nw) {
        const int row = row0 + r;
        const f32x4* xr = (const f32x4*)(x + (size_t)row * DM) + lane;
        f32x4 v[4]; float s = 0.f;
#pragma unroll
        for (int j = 0; j < 4; ++j) { v[j] = xr[64 * j]; s += v[j].x * v[j].x + v[j].y * v[j].y + v[j].z * v[j].z + v[j].w * v[j].w; }
        const float rstd = rsqrtf(wave_sum(s) * (1.f / DM) + RMS_EPS);
#pragma unroll
        for (int j = 0; j < 4; ++j) {
            const f32x4 gg = ((const f32x4*)g)[lane + 64 * j];
            v[j].x *= rstd * gg.x; v[j].y *= rstd * gg.y; v[j].z *= rstd * gg.z; v[j].w *= rstd * gg.w;
            h16x4 o = {(h16)v[j].x, (h16)v[j].y, (h16)v[j].z, (h16)v[j].w};
            *((h16x4*)(hn + (size_t)r * DM) + lane + 64 * j) = o;
        }
        float mine = 0.f;
#pragma unroll 1
        for (int c = 0; c < 16; ++c) {
            const f32x4* wr = (const f32x4*)(wsmall + c * DM) + lane;
            float a = 0.f;
#pragma unroll
            for (int j = 0; j < 4; ++j) { const f32x4 w = wr[64 * j]; a += v[j].x * w.x + v[j].y * w.y + v[j].z * w.z + v[j].w * w.w; }
            a = wave_sum(a);
            if (lane == c) mine = a;
        }
        if (lane < 16) {
            float o;
            if (lane < 8) o = log_sigmoidf_(mine + fox_bf[lane]);
            else if (lane < 12) o = mine + ml_bi[lane - 8];
            else o = log_sigmoidf_(mine + ml_bf[lane - 12]);
            small[(size_t)row * 16 + lane] = o;
        }
    }
}

struct GemmArgs {
    const h16* A; int lda; const h16* Bt; int ldb; int K;
    h16* C; int ldc;
    const h16* gates; int ldg;
    const float* xin; float* xout;
};
template <int EPI>
__global__ void __launch_bounds__(256) nv_gemm(GemmArgs g) {
    __shared__ float As[16][68], Bs[16][68];
    const int tid = threadIdx.x, tx = tid & 15, ty = tid >> 4;
    const int m0 = blockIdx.y * 64, n0 = blockIdx.x * 64;
    float res[4][4];
#pragma unroll
    for (int i = 0; i < 4; ++i)
#pragma unroll
        for (int j = 0; j < 4; ++j) res[i][j] = 0.f;
    const int NB = EPI == 1 ? 3 : 1;
    for (int nb = 0; nb < NB; ++nb) {
        float acc[4][4];
#pragma unroll
        for (int i = 0; i < 4; ++i)
#pragma unroll
            for (int j = 0; j < 4; ++j) acc[i][j] = 0.f;
        const h16* A = g.A + (EPI == 1 ? nb * 512 : 0);
        const h16* Bt = g.Bt + (EPI == 1 ? (size_t)nb * 1024 * 512 : 0);
        const int lr = tid >> 2, lk = (tid & 3) * 4;
        for (int k0 = 0; k0 < g.K; k0 += 16) {
            const h16x4 av = *(const h16x4*)(A + (size_t)(m0 + lr) * g.lda + k0 + lk);
            const h16x4 bv = *(const h16x4*)(Bt + (size_t)(n0 + lr) * g.ldb + k0 + lk);
            __syncthreads();
#pragma unroll
            for (int e = 0; e < 4; ++e) { As[lk + e][lr] = (float)av[e]; Bs[lk + e][lr] = (float)bv[e]; }
            __syncthreads();
#pragma unroll
            for (int kk = 0; kk < 16; ++kk) {
                float a[4], b[4];
#pragma unroll
                for (int i = 0; i < 4; ++i) { a[i] = As[kk][ty * 4 + i]; b[i] = Bs[kk][tx * 4 + i]; }
#pragma unroll
                for (int i = 0; i < 4; ++i)
#pragma unroll
                    for (int j = 0; j < 4; ++j) acc[i][j] += a[i] * b[j];
            }
        }
#pragma unroll
        for (int i = 0; i < 4; ++i)
#pragma unroll
            for (int j = 0; j < 4; ++j) {
                if (EPI == 1) {
                    const int m = m0 + ty * 4 + i, n = n0 + tx * 4 + j;
                    const float gt = (float)g.gates[(size_t)m * g.ldg + nb * 1024 + n];
                    res[i][j] += sigmoidf_(gt) * acc[i][j];
                } else res[i][j] = acc[i][j];
            }
    }
#pragma unroll
    for (int i = 0; i < 4; ++i)
#pragma unroll
        for (int j = 0; j < 4; ++j) {
            const int m = m0 + ty * 4 + i, n = n0 + tx * 4 + j;
            if (EPI == 2) g.xout[(size_t)m * DM + n] = g.xin[(size_t)m * DM + n] + res[i][j];
            else g.C[(size_t)m * g.ldc + n] = (h16)res[i][j];
        }
}

__global__ void nv_fox_cumsum(const float* __restrict__ small, float* __restrict__ cb, int b0) {
    const int i = blockIdx.x * blockDim.x + threadIdx.x;
    if (i >= HB * 8) return;
    const int bl = i >> 3, h = i & 7;
    const float* s = small + (size_t)(b0 + bl) * SEQ * 16 + h;
    float* o = cb + (size_t)((b0 + bl) * 8 + h) * SEQ;
    float c = 0.f;
    for (int t = 0; t < SEQ; ++t) { c += s[(size_t)t * 16]; o[t] = -c * LOG2E; }
}
__global__ void nv_moba_kmean(const h16* __restrict__ proj, float* __restrict__ kmean, int b0) {
    const int i = blockIdx.x * blockDim.x + threadIdx.x;
    if (i >= HB * 8 * 512) return;
    const int col = i & 511, blk = (i >> 9) & 7, bl = i >> 12;
    const h16* p = proj + (size_t)(bl * SEQ + blk * 256) * PW + PC_BK + col;
    float s = 0.f;
    for (int t = 0; t < 256; ++t) s += (float)p[(size_t)t * PW];
    const int h = col >> 6, d = col & 63;
    kmean[(((size_t)(b0 + bl) * 8 + h) * 8 + blk) * 64 + d] = s * (1.f / 256.f);
}

__global__ void __launch_bounds__(256) nv_fox_attn(const h16* __restrict__ proj, const float* __restrict__ cb, h16* __restrict__ y, int b0) {
    const int bh = blockIdx.y, bl = bh >> 3, h = bh & 7;
    const int t = blockIdx.x * 256 + threadIdx.x;
    const size_t rowb = (size_t)bl * SEQ;
    float q[64], o[64];
    {
        const h16* qp = proj + (rowb + t) * PW + PC_AQ + h * 64;
#pragma unroll
        for (int d = 0; d < 64; ++d) { q[d] = (float)qp[d]; o[d] = 0.f; }
    }
    const float* cbh = cb + (size_t)((b0 + bl) * 8 + h) * SEQ;
    float m = -INFINITY, l = 0.f;
    const int send = blockIdx.x * 256 + 255;
    for (int s = 0; s <= send; ++s) {
        const h16* kp = proj + (rowb + s) * PW + PC_AK + h * 64;
        const h16* vp = proj + (rowb + s) * PW + PC_AV + h * 64;
        float sd = 0.f;
#pragma unroll
        for (int d = 0; d < 64; ++d) sd += q[d] * (float)kp[d];
        sd += cbh[s];
        if (s <= t) {
            const float mn = fmaxf(m, sd), al = exp2f(m - mn), p = exp2f(sd - mn);
            l = l * al + p;
#pragma unroll
            for (int d = 0; d < 64; ++d) o[d] = o[d] * al + p * (float)vp[d];
            m = mn;
        }
    }
    const float il = 1.f / l;
    const h16* zp = proj + (rowb + t) * PW + PC_AZ + h * 64;
    h16* yp = y + (rowb + t) * 1536 + h * 64;
#pragma unroll
    for (int d = 0; d < 64; ++d) yp[d] = (h16)(o[d] * il * siluf_((float)zp[d]));
}

__global__ void __launch_bounds__(256) nv_moba_attn(const h16* __restrict__ proj, const float* __restrict__ kmean, h16* __restrict__ y, int b0) {
    const int bh = blockIdx.y, bl = bh >> 3, h = bh & 7;
    const int own = blockIdx.x;
    const int t = own * 256 + threadIdx.x;
    const size_t rowb = (size_t)bl * SEQ;
    float q[64], o[64];
    {
        const h16* qp = proj + (rowb + t) * PW + PC_BQ + h * 64;
#pragma unroll
        for (int d = 0; d < 64; ++d) { q[d] = (float)qp[d]; o[d] = 0.f; }
    }
    unsigned selmask = 0;
    if (own <= 3) selmask = (1u << own) - 1u;
    else {
        float gate[8];
        const float* km = kmean + ((size_t)(b0 + bl) * 8 + h) * 8 * 64;
#pragma unroll
        for (int n = 0; n < 8; ++n) {
            float sd = 0.f;
#pragma unroll
            for (int d = 0; d < 64; ++d) sd += q[d] * km[n * 64 + d];
            gate[n] = n < own ? sd : -INFINITY;
        }
        for (int r = 0; r < 3; ++r) {
            float best = -INFINITY; int bi = -1;
#pragma unroll
            for (int n = 0; n < 8; ++n) { const bool free_ = !((selmask >> n) & 1u); if (free_ && n < own && gate[n] > best) { best = gate[n]; bi = n; } }
            if (bi >= 0) selmask |= 1u << bi;
        }
    }
    const float slope2 = exp2f(-(float)(h + 1)) * LOG2E;
    float m = -INFINITY, l = 0.f;
    for (int n = 0; n <= own; ++n) {
        const bool isown = n == own;
        const bool sel = isown || ((selmask >> n) & 1u);
        for (int ss = 0; ss < 256; ++ss) {
            const int s = n * 256 + ss;
            const h16* kp = proj + (rowb + s) * PW + PC_BK + h * 64;
            const h16* vp = proj + (rowb + s) * PW + PC_BV + h * 64;
            if (sel && s <= t) {
                float sd = 0.f;
#pragma unroll
                for (int d = 0; d < 64; ++d) sd += q[d] * (float)kp[d];
                sd -= slope2 * (float)(t - s);
                const float mn = fmaxf(m, sd), al = exp2f(m - mn), p = exp2f(sd - mn);
                l = l * al + p;
#pragma unroll
                for (int d = 0; d < 64; ++d) o[d] = o[d] * al + p * (float)vp[d];
                m = mn;
            }
        }
    }
    const float il = 1.f / l;
    const h16* zp = proj + (rowb + t) * PW + PC_BZ + h * 64;
    h16* yp = y + (rowb + t) * 1536 + 512 + h * 64;
#pragma unroll
    for (int d = 0; d < 64; ++d) yp[d] = (h16)(o[d] * il * siluf_((float)zp[d]));
}

__global__ void __launch_bounds__(256) nv_mlstm(const h16* __restrict__ proj, const float* __restrict__ small, const float* __restrict__ convw  ,
                                                const float* __restrict__ headg  , h16* __restrict__ y, int b0) {
    __shared__ float qk[128];
    __shared__ float red[4];
    const int bl = blockIdx.x >> 2, hh = blockIdx.x & 3, tid = threadIdx.x, v = tid >> 1, kh = tid & 1;
    const size_t rowb = (size_t)bl * SEQ;
    float C[32], nn[32];
#pragma unroll
    for (int j = 0; j < 32; ++j) { C[j] = 0.f; nn[j] = 0.f; }
    float m = 0.f;
    const int ccol = tid < 64 ? hh * 64 + tid : 256 + hh * 64 + (tid - 64);
    float cw[4] = {0.f, 0.f, 0.f, 0.f};
    if (tid < 128) {
#pragma unroll
        for (int j = 0; j < 4; ++j) cw[j] = convw[j * 512 + ccol];
    }
    const float hg = headg[hh * 128 + v];
    for (int t = 0; t < SEQ; ++t) {
        if (tid < 128) {
            float a = 0.f;
#pragma unroll
            for (int j = 0; j < 4; ++j) { const int tt = t - 3 + j; if (tt >= 0) a += cw[j] * (float)proj[(rowb + tt) * PW + PC_CQK + ccol]; }
            a = siluf_(a);
            if (tid >= 64) a *= 0.125f;
            qk[tid] = a;
        }
        __syncthreads();
        const size_t row = rowb + t;
        const float li = small[((size_t)b0 * SEQ + row) * 16 + 8 + hh], lf = small[((size_t)b0 * SEQ + row) * 16 + 12 + hh];
        const float vt = (float)proj[row * PW + PC_CV + hh * 128 + v];
        const float mn = fmaxf(lf + m, li), fw = __expf(lf + m - mn), iw = __expf(li - mn);
        float nump = 0.f, denp = 0.f;
#pragma unroll
        for (int j = 0; j < 32; ++j) {
            const float kj = qk[64 + kh * 32 + j], qj = qk[kh * 32 + j];
            C[j] = fw * C[j] + iw * vt * kj; nn[j] = fw * nn[j] + iw * kj;
            nump += C[j] * qj; denp += nn[j] * qj;
        }
        nump += __shfl_xor(nump, 1); denp += __shfl_xor(denp, 1);
        m = mn;
        const float hval = nump / fmaxf(fabsf(denp), __expf(-mn));
        const float hgt = hval * sigmoidf_((float)proj[row * PW + PC_CO + hh * 128 + v]);
        float ss = kh == 0 ? hgt * hgt : 0.f;
        ss = wave_sum(ss);
        if ((tid & 63) == 0) red[tid >> 6] = ss;
        __syncthreads();
        const float tot = red[0] + red[1] + red[2] + red[3];
        if (kh == 0) {
            const float o = hgt * rsqrtf(tot * (1.f / 128.f) + RMS_EPS) * hg * siluf_((float)proj[row * PW + PC_CZ + hh * 128 + v]);
            y[row * 1536 + 1024 + hh * 128 + v] = (h16)o;
        }
    }
}

__global__ void nv_final_norm(float* __restrict__ x, const float* __restrict__ g) {
    const int lane = threadIdx.x & 63, wv = (blockIdx.x * blockDim.x + threadIdx.x) >> 6, nw = (gridDim.x * blockDim.x) >> 6;
    for (int row = wv; row < TT; row += nw) {
        f32x4* xr = (f32x4*)(x + (size_t)row * DM) + lane;
        f32x4 v[4]; float s = 0.f;
#pragma unroll
        for (int j = 0; j < 4; ++j) { v[j] = xr[64 * j]; s += v[j].x * v[j].x + v[j].y * v[j].y + v[j].z * v[j].z + v[j].w * v[j].w; }
        const float rstd = rsqrtf(wave_sum(s) * (1.f / DM) + RMS_EPS);
#pragma unroll
        for (int j = 0; j < 4; ++j) {
            const f32x4 gg = ((const f32x4*)g)[lane + 64 * j];
            f32x4 o = {v[j].x * rstd * gg.x, v[j].y * rstd * gg.y, v[j].z * rstd * gg.z, v[j].w * rstd * gg.w};
            xr[64 * j] = o;
        }
    }
}


namespace pg8 {
#define PG8_LAS __attribute__((address_space(3)))
typedef short s16x8 __attribute__((ext_vector_type(8)));
typedef unsigned u32x4 __attribute__((ext_vector_type(4)));
typedef float f32x2 __attribute__((ext_vector_type(2)));
typedef _Float16 h16x2 __attribute__((ext_vector_type(2)));
constexpr int BM = 256, BK = 64, HALF = 128, HTB = HALF * BK * 2  , STAGE_BYTES = 8 * HTB, NXCD = 8, WGM = 8;
__host__ __device__ __forceinline__ int lds_byte(int r, int c) { const int st = (r >> 4) * 2 + (c >> 5), rr = r & 15, cc = c & 31, ob = rr * 64 + cc * 2; return st * 1024 + (ob ^ (((ob >> 9) & 1) << 5)); }
__host__ __device__ __forceinline__ void stage_rc(int b, int& R, int& C) { const int st = b / 1024, sb = b % 1024, swz = sb ^ (((sb >> 9) & 1) << 5); R = (st >> 1) * 16 + swz / 64; C = (st & 1) * 32 + (swz % 64) / 2; }
__host__ __device__ __forceinline__ int perm32(int rho) { const int n = rho >> 4, i = rho & 15; return 8 * (i >> 2) + 4 * n + (i & 3); }
__device__ __forceinline__ unsigned cvt_pk_f16(float lo, float hi) { f32x2 v = {lo, hi}; h16x2 b = __builtin_convertvector(v, h16x2); return __builtin_bit_cast(unsigned, b); }

struct Unit { int pm, pn, z; };
struct Gemm { const h16* A; const h16* Bt; int lda, ldb, K; long zA, zB; };

__device__ __forceinline__ void tile_of(int L, int nM, int nN, int& pm, int& pn) {
    const int nwg = nM * nN; int wgid = L;
    { const int q = nwg / NXCD, r = nwg % NXCD, xcd = wgid % NXCD, off = wgid / NXCD; wgid = (xcd < r ? xcd * (q + 1) : r * (q + 1) + (xcd - r) * q) + off; }
    const int nig = WGM * nN, gid = wgid / nig, fm = gid * WGM, gsz = (nM - fm) < WGM ? (nM - fm) : WGM;
    pm = fm + ((wgid % nig) % gsz); pn = (wgid % nig) / gsz;
}
struct StaticOrder {
    int nM, nN, nwg, G, c;
    __device__ void init(int M, int N, int G_, int c_) { nM = M / BM; nN = N / BM; nwg = nM * nN; G = G_; c = c_; }
    __device__ bool next(int i, Unit& u) const { const long L = (long)i * G + c; if (L >= nwg) return false; tile_of((int)L, nM, nN, u.pm, u.pn); u.z = 0; return true; }
};
struct BranchOrder {
    int nM, nN, nwg, G, c, NZ;
    __device__ void init(int M, int N, int G_, int c_, int nz) { nM = M / BM; nN = N / BM; nwg = nM * nN; G = G_; c = c_; NZ = nz; }
    __device__ bool next(int i, Unit& u) const { const int j = i / NZ; const long L = (long)j * G + c; if (L >= nwg) return false; tile_of((int)L, nM, nN, u.pm, u.pn); u.z = i - j * NZ; return true; }
};

struct EpiF16 {
    static constexpr bool PERM = true;
    h16* C; int ldc;
    __device__ __forceinline__ void operator()(const f32x4 (&acc)[2][2][4][2], const Unit& u, int wr, int wc, int fr, int fq) const {
        const int row0 = u.pm * BM + wr * 64 + fr, col0 = u.pn * BM + wc * 32 + 8 * fq;
#pragma unroll
        for (int ai = 0; ai < 2; ++ai)
#pragma unroll
            for (int m = 0; m < 4; ++m) { h16* rowp = C + (size_t)(row0 + ai * HALF + m * 16) * ldc + col0;
#pragma unroll
                for (int bj = 0; bj < 2; ++bj) { const f32x4 v0 = acc[ai][bj][m][0], v1 = acc[ai][bj][m][1];
                    u32x4 w; w.x = cvt_pk_f16(v0[0], v0[1]); w.y = cvt_pk_f16(v0[2], v0[3]); w.z = cvt_pk_f16(v1[0], v1[1]); w.w = cvt_pk_f16(v1[2], v1[3]);
                    *(u32x4*)(rowp + bj * HALF) = w; } }
    }
};
struct EpiGate {
    static constexpr bool PERM = true;
    h16* Mg; const h16* G; int ldg;
    __device__ __forceinline__ void operator()(const f32x4 (&acc)[2][2][4][2], const Unit& u, int wr, int wc, int fr, int fq) const {
        const int row0 = u.pm * BM + wr * 64 + fr, col0 = u.pn * BM + wc * 32 + 8 * fq;
#pragma unroll
        for (int ai = 0; ai < 2; ++ai)
#pragma unroll
            for (int mp = 0; mp < 2; ++mp) {
                h16x8 gv[2][2], pv[2][2];
#pragma unroll
                for (int mm = 0; mm < 2; ++mm)
#pragma unroll
                    for (int bj = 0; bj < 2; ++bj) { const size_t row = (size_t)(row0 + ai * HALF + (2 * mp + mm) * 16);
                        gv[mm][bj] = *(const h16x8*)(G + row * ldg + u.z * 1024 + col0 + bj * HALF);
                        if (u.z > 0) pv[mm][bj] = *(const h16x8*)(Mg + row * 1024 + col0 + bj * HALF); }
#pragma unroll
                for (int mm = 0; mm < 2; ++mm)
#pragma unroll
                    for (int bj = 0; bj < 2; ++bj) { const int m = 2 * mp + mm; const size_t row = (size_t)(row0 + ai * HALF + m * 16);
                        float o[8];
#pragma unroll
                        for (int e = 0; e < 8; ++e) { const float a = e < 4 ? acc[ai][bj][m][0][e] : acc[ai][bj][m][1][e - 4]; o[e] = a * __builtin_amdgcn_rcpf(1.f + __expf(-(float)gv[mm][bj][e])); }
                        if (u.z > 0) {
#pragma unroll
                            for (int e = 0; e < 8; ++e) o[e] += (float)pv[mm][bj][e]; }
                        u32x4 w; w.x = cvt_pk_f16(o[0], o[1]); w.y = cvt_pk_f16(o[2], o[3]); w.z = cvt_pk_f16(o[4], o[5]); w.w = cvt_pk_f16(o[6], o[7]);
                        *(u32x4*)(Mg + row * 1024 + col0 + bj * HALF) = w; }
            }
    }
};
struct EpiRes {
    static constexpr bool PERM = false;
    const float* xin; float* out; int ldc;
    __device__ __forceinline__ void operator()(const f32x4 (&acc)[2][2][4][2], const Unit& u, int wr, int wc, int fr, int fq) const {
        const int row0 = u.pm * BM + wr * 64 + fr, col0 = u.pn * BM + wc * 32 + 4 * fq;
#pragma unroll
        for (int ai = 0; ai < 2; ++ai)
#pragma unroll
            for (int mp = 0; mp < 2; ++mp) {
                f32x4 xv[2][2][2];
#pragma unroll
                for (int mm = 0; mm < 2; ++mm) { const size_t off = (size_t)(row0 + ai * HALF + (2 * mp + mm) * 16) * ldc + col0;
#pragma unroll
                    for (int bj = 0; bj < 2; ++bj)
#pragma unroll
                        for (int n = 0; n < 2; ++n) xv[mm][bj][n] = *(const f32x4*)(xin + off + bj * HALF + n * 16); }
#pragma unroll
                for (int mm = 0; mm < 2; ++mm) { const int m = 2 * mp + mm; const size_t off = (size_t)(row0 + ai * HALF + m * 16) * ldc + col0;
#pragma unroll
                    for (int bj = 0; bj < 2; ++bj)
#pragma unroll
                        for (int n = 0; n < 2; ++n) *(f32x4*)(out + off + bj * HALF + n * 16) = xv[mm][bj][n] + acc[ai][bj][m][n]; }
            }
    }
};

template <class Epi, class Sched, bool ALIGN_EPI = true>
__device__ __forceinline__ void gemm_phase(PG8_LAS unsigned char* lds, const Gemm g, const Sched& S, const Epi& E) {
    int tid_ = threadIdx.x; asm volatile("" : "+v"(tid_));
    const int tid = tid_, wid = __builtin_amdgcn_readfirstlane(tid >> 6), lane = tid & 63, wr = wid >> 2, wc = wid & 3, fr = lane & 15, fq = lane >> 4;
    const int nt = g.K / BK;
    unsigned voffA[2], voffB[2];
#pragma unroll
    for (int i = 0; i < 2; ++i) { int R, C; stage_rc(tid * 16 + i * 8192, R, C); const int Rb = Epi::PERM ? ((R & ~31) + perm32(R & 31)) : R;
        voffA[i] = (unsigned)(R * g.lda + C) * 2u; voffB[i] = (unsigned)(Rb * g.ldb + C) * 2u; }
    const size_t kstep = (size_t)(BK * 2);
    const size_t hA = (size_t)HALF * g.lda * 2, hB = (size_t)HALF * g.ldb * 2;
    const size_t tA = 2 * hA, tB = 2 * hB;
    const unsigned ldsw = (unsigned)wid * 1024u;
    const int aoff = lds_byte(wr * 64 + fr, fq * 8), boff = lds_byte(wc * 32 + fr, fq * 8);
#define PG8_SA(b, h) (((b) * 2 + (h)) * HTB)
#define PG8_SB(b, h) ((4 + (b) * 2 + (h)) * HTB)
#define PG8_STAGE(bufoff, gbase, voff) do { _Pragma("unroll") for (int _i = 0; _i < 2; ++_i) \
        __builtin_amdgcn_global_load_lds((const unsigned*)((const char*)(gbase) + (voff)[_i]), (PG8_LAS unsigned*)(lds + (bufoff) + ldsw + _i * 8192), 16, 0, 0); } while (0)
#define PG8_LDA(dst, b, h) do { _Pragma("unroll") for (int m = 0; m < 4; ++m) _Pragma("unroll") for (int k = 0; k < 2; ++k) dst[m][k] = *(const PG8_LAS s16x8*)(lds + PG8_SA(b, h) + aoff + m * 2048 + k * 1024); } while (0)
#define PG8_LDB(dst, b, h) do { _Pragma("unroll") for (int n = 0; n < 2; ++n) _Pragma("unroll") for (int k = 0; k < 2; ++k) dst[n][k] = *(const PG8_LAS s16x8*)(lds + PG8_SB(b, h) + boff + n * 2048 + k * 1024); } while (0)
#define PG8_MMA(ai, bj, At, Bt) do { __builtin_amdgcn_s_setprio(1); _Pragma("unroll") for (int m = 0; m < 4; ++m) _Pragma("unroll") for (int n = 0; n < 2; ++n) _Pragma("unroll") for (int k = 0; k < 2; ++k) \
        acc[ai][bj][m][n] = __builtin_amdgcn_mfma_f32_16x16x32_f16(__builtin_bit_cast(h16x8, Bt[n][k]), __builtin_bit_cast(h16x8, At[m][k]), acc[ai][bj][m][n], 0, 0, 0); __builtin_amdgcn_s_setprio(0); } while (0)
#define PG8_WAIT_V(n) asm volatile("s_waitcnt vmcnt(" #n ")" ::: "memory")
#define PG8_WAIT_L(n) asm volatile("s_waitcnt lgkmcnt(" #n ")" ::: "memory")
#define PG8_BAR __builtin_amdgcn_s_barrier()
#define PG8_SCHED __builtin_amdgcn_sched_barrier(0)
    Unit cur, nxt; int ui = 0;
    if (!S.next(0, cur)) return;
    f32x4 acc[2][2][4][2];
#pragma unroll
    for (int a = 0; a < 2; ++a)
#pragma unroll
        for (int b = 0; b < 2; ++b)
#pragma unroll
            for (int m = 0; m < 4; ++m)
#pragma unroll
                for (int n = 0; n < 2; ++n) acc[a][b][m][n] = (f32x4){0.f, 0.f, 0.f, 0.f};
    s16x8 At[4][2], B0[2][2], B1[2][2];
    const char* cA = (const char*)(g.A + (long)cur.z * g.zA) + (size_t)cur.pm * tA; const char* cB = (const char*)(g.Bt + (long)cur.z * g.zB) + (size_t)cur.pn * tB;
    PG8_STAGE(PG8_SB(0, 0), cB, voffB); PG8_STAGE(PG8_SB(0, 1), cB + hB, voffB); PG8_STAGE(PG8_SA(0, 0), cA, voffA); PG8_STAGE(PG8_SA(0, 1), cA + hA, voffA);
    if (wr == 1) PG8_BAR;
    PG8_WAIT_V(2); PG8_BAR;
    PG8_STAGE(PG8_SB(1, 0), cB + kstep, voffB); PG8_STAGE(PG8_SA(1, 0), cA + kstep, voffA); PG8_STAGE(PG8_SB(1, 1), cB + hB + kstep, voffB);
    PG8_WAIT_V(6); PG8_BAR;
    for (;;) {
        const bool has_next = S.next(ui + 1, nxt);
        const char* nA = has_next ? (const char*)(g.A + (long)nxt.z * g.zA) + (size_t)nxt.pm * tA : cA; const char* nB = has_next ? (const char*)(g.Bt + (long)nxt.z * g.zB) + (size_t)nxt.pn * tB : cB;
        for (int t = 0; t < nt; t += 2) {
            const bool last = (t == nt - 2);
            const char* a1 = cA + (size_t)(t + 1) * kstep;
            const char* a2 = last ? nA : cA + (size_t)(t + 2) * kstep; const char* b2 = last ? nB : cB + (size_t)(t + 2) * kstep;
            const char* a3 = a2 + kstep; const char* b3 = b2 + kstep;
            PG8_LDB(B0, 0, 0); PG8_LDB(B1, 0, 1); PG8_SCHED; PG8_LDA(At, 0, 0); PG8_STAGE(PG8_SA(1, 1), a1 + hA, voffA);
            PG8_WAIT_V(8); PG8_WAIT_L(0); PG8_BAR; PG8_MMA(0, 0, At, B0); PG8_MMA(0, 1, At, B1); PG8_BAR; PG8_SCHED;
            PG8_LDA(At, 0, 1); PG8_STAGE(PG8_SB(0, 0), b2, voffB); PG8_STAGE(PG8_SB(0, 1), b2 + hB, voffB); PG8_STAGE(PG8_SA(0, 0), a2, voffA);
            PG8_WAIT_V(8); PG8_WAIT_L(0); PG8_BAR; PG8_MMA(1, 0, At, B0); PG8_MMA(1, 1, At, B1); PG8_BAR; PG8_SCHED;
            PG8_LDB(B0, 1, 0); PG8_LDB(B1, 1, 1); PG8_SCHED; PG8_LDA(At, 1, 0); PG8_STAGE(PG8_SA(0, 1), a2 + hA, voffA);
            PG8_WAIT_V(8); PG8_WAIT_L(0); PG8_BAR; PG8_MMA(0, 0, At, B0); PG8_MMA(0, 1, At, B1); PG8_BAR; PG8_SCHED;
            PG8_LDA(At, 1, 1); PG8_STAGE(PG8_SB(1, 0), b3, voffB); PG8_STAGE(PG8_SB(1, 1), b3 + hB, voffB); PG8_STAGE(PG8_SA(1, 0), a3, voffA);
            PG8_WAIT_V(8); PG8_WAIT_L(0); PG8_BAR; PG8_MMA(1, 0, At, B0); PG8_MMA(1, 1, At, B1); PG8_BAR; PG8_SCHED;
        }
        if constexpr (ALIGN_EPI) { if (wr == 0) PG8_BAR; }
        E(acc, cur, wr, wc, fr, fq);
        if (!has_next) break;
#pragma unroll
        for (int a = 0; a < 2; ++a)
#pragma unroll
            for (int b = 0; b < 2; ++b)
#pragma unroll
                for (int m = 0; m < 4; ++m)
#pragma unroll
                    for (int n = 0; n < 2; ++n) acc[a][b][m][n] = (f32x4){0.f, 0.f, 0.f, 0.f};
        cur = nxt; cA = nA; cB = nB; ++ui;
        if constexpr (ALIGN_EPI) { if (wr == 1) PG8_BAR; }
    }
    PG8_WAIT_V(0);
    if constexpr (!ALIGN_EPI) { if (wr == 0) PG8_BAR; }
    PG8_BAR;
#undef PG8_SA
#undef PG8_SB
#undef PG8_STAGE
#undef PG8_LDA
#undef PG8_LDB
#undef PG8_MMA
#undef PG8_WAIT_V
#undef PG8_WAIT_L
#undef PG8_BAR
#undef PG8_SCHED
}
}

namespace attn_body {
using s16x8 = __attribute__((ext_vector_type(8))) short;
using s16x4 = __attribute__((ext_vector_type(4))) short;
using f32x16 = __attribute__((ext_vector_type(16))) float;
using u32x4 = __attribute__((ext_vector_type(4))) unsigned;
constexpr int D = 64, NW = 8, QBLK = 32, QB = QBLK * NW, KVBLK = 64;
constexpr int PQ = PW;
__device__ __forceinline__ int crow(int r, int hi) { return (r & 3) + 8 * (r >> 2) + 4 * hi; }
#define SBAR() __builtin_amdgcn_sched_barrier(0)
__device__ __forceinline__ void cmask(f32x16& p0, f32x16& p1, int jb, int qrel, int hi) {
    const float NEG = -INFINITY; int kb = 64 * jb + 4 * hi;
#pragma unroll
    for (int r = 0; r < 16; ++r) { int kv = kb + (r & 3) + 8 * (r >> 2); if (kv > qrel) p0[r] = NEG; if (kv + 32 > qrel) p1[r] = NEG; }
}
constexpr int NSLOT = 3, SLOTB = 8192;
constexpr int LDS_K = 0, LDS_V = NSLOT * SLOTB, LDS_WS = 2 * NSLOT * SLOTB, LDS_OST = LDS_WS + NW * 64 * 4, LDS_BT = LDS_OST + NW * 4096, LDS_INF = LDS_BT + 2048 * 4, LDS_KM = LDS_INF + 256, LDS_BYTES = LDS_KM + 2048;
__device__ __forceinline__ void glds16(const void* gsrc, unsigned lds_dst) { unsigned keep;
    asm volatile("s_mov_b32 %0, m0\n\ts_mov_b32 m0, %2\n\ts_nop 0\n\tglobal_load_lds_dwordx4 %1, off\n\ts_mov_b32 m0, %0" : "=&s"(keep) : "v"(gsrc), "s"(lds_dst) : "memory"); }
__device__ __forceinline__ float max3f(float a, float b, float c) { float r; asm("v_max3_f32 %0, %1, %2, %3" : "=v"(r) : "v"(a), "v"(b), "v"(c)); return r; }
__device__ __forceinline__ float max2f(float a, float b) { float r; asm("v_max_f32_e32 %0, %1, %2" : "=v"(r) : "v"(a), "v"(b)); return r; }
__device__ __forceinline__ float fadd_s(float a, float b) { float r; asm("v_add_f32_e32 %0, %1, %2" : "=v"(r) : "v"(a), "v"(b)); return r; }
__device__ __forceinline__ float fsub_s(float a, float b) { float r; asm("v_sub_f32_e32 %0, %1, %2" : "=v"(r) : "v"(a), "v"(b)); return r; }
__device__ __forceinline__ unsigned cvtpk_s(float lo, float hi) { return pg8::cvt_pk_f16(lo, hi); }
#define MFMA32(a, b, c) __builtin_amdgcn_mfma_f32_32x32x16_f16(__builtin_bit_cast(h16x8, (a)), __builtin_bit_cast(h16x8, (b)), (c), 0, 0, 0)
#define WAIT_BAR(N) asm volatile("s_waitcnt vmcnt(" #N ") lgkmcnt(0)\n\ts_barrier" ::: "memory")
__device__ __forceinline__ void qkt(f32x16& p0, f32x16& p1, const char* Kslot, const s16x8* qr, const f32x16& negm, int r32, int hi) {
    const char* kb = Kslot + hi * 1024 + r32 * 16;
#pragma unroll
    for (int d0 = 0; d0 < 4; ++d0) {
        const s16x8 b0 = *reinterpret_cast<const s16x8*>(kb + d0 * 2048);
        const s16x8 b1 = *reinterpret_cast<const s16x8*>(kb + d0 * 2048 + 512);
        if (d0 == 0) { p0 = MFMA32(b0, qr[0], negm); p1 = MFMA32(b1, qr[0], negm); }
        else { p0 = MFMA32(b0, qr[d0], p0); p1 = MFMA32(b1, qr[d0], p1); } }
}
typedef __attribute__((address_space(3))) const char* lds_cptr;
typedef short v4i16_t __attribute__((ext_vector_type(4)));
#define LDS8(p) (*(const __attribute__((address_space(3))) s16x8*)(p))
__device__ __forceinline__ void kload8(s16x8* kf, lds_cptr kp) {
    kf[0] = LDS8(kp); kf[1] = LDS8(kp + 512); kf[2] = LDS8(kp + 2048); kf[3] = LDS8(kp + 2560);
    kf[4] = LDS8(kp + 4096); kf[5] = LDS8(kp + 4608); kf[6] = LDS8(kp + 6144); kf[7] = LDS8(kp + 6656);
}
__device__ __forceinline__ void kload2(s16x8* kf, lds_cptr kp, int j) { kf[2 * j] = LDS8(kp + j * 2048); kf[2 * j + 1] = LDS8(kp + j * 2048 + 512); }
__device__ __forceinline__ s16x4 vtr(lds_cptr p) { return __builtin_bit_cast(s16x4, __builtin_amdgcn_ds_read_tr16_b64_v4i16((__attribute__((address_space(3))) v4i16_t*)p)); }
__device__ __forceinline__ float rowmax(const f32x16& p0, const f32x16& p1) {
    float a = max3f(p0[0], p0[1], p1[0]), b = max3f(p0[2], p0[3], p1[1]); a = max3f(a, p1[2], p1[3]);
#pragma unroll
    for (int r = 4; r < 16; r += 4) { a = max3f(a, p0[r], p0[r + 1]); b = max3f(b, p0[r + 2], p0[r + 3]); a = max3f(a, p1[r], p1[r + 1]); b = max3f(b, p1[r + 2], p1[r + 3]); }
    const float m = max2f(a, b);
    auto rr = __builtin_amdgcn_permlane32_swap(__float_as_uint(m), __float_as_uint(m), false, false);
    return max2f(__uint_as_float(rr[0]), __uint_as_float(rr[1]));
}
__device__ __forceinline__ void pv(f32x16* o, int vb, s16x8 pa0, s16x8 pa1, s16x8 pa2, s16x8 pa3) {
#pragma unroll
    for (int d0 = 0; d0 < 2; ++d0) { s16x4 lo[4], hi[4];
#pragma unroll
        for (int ks = 0; ks < 4; ++ks) {
            asm volatile("ds_read_b64_tr_b16 %0,%1 offset:%c2" : "=&v"(lo[ks]) : "v"(vb), "i"(d0 * 4096 + ks * 1024) : "memory");
            asm volatile("ds_read_b64_tr_b16 %0,%1 offset:%c2" : "=&v"(hi[ks]) : "v"(vb), "i"(d0 * 4096 + ks * 1024 + 512) : "memory"); }
        asm volatile("s_waitcnt lgkmcnt(0)" ::: "memory"); SBAR();
#define PK(k) (s16x8){lo[k][0], lo[k][1], lo[k][2], lo[k][3], hi[k][0], hi[k][1], hi[k][2], hi[k][3]}
        o[d0] = MFMA32(pa0, PK(0), o[d0]);
        o[d0] = MFMA32(pa1, PK(1), o[d0]);
        o[d0] = MFMA32(pa2, PK(2), o[d0]);
        o[d0] = MFMA32(pa3, PK(3), o[d0]);
#undef PK
    }
}

template <bool MOBA, int THRL>
__device__ __forceinline__ void attn_unit(int bl, int h, int qb, const h16* Q, const h16* __restrict__ K, const h16* __restrict__ V, const h16* __restrict__ Z, h16* Y,
                                          const float* __restrict__ bsrc, float slope2, const float* __restrict__ kmean, char* shm) {
    int tid_ = threadIdx.x; asm volatile("" : "+v"(tid_));
    const int tid = tid_, lane = tid & 63, r32 = lane & 31, hi = lane >> 5; const int wid = __builtin_amdgcn_readfirstlane(tid >> 6);
    const long rowbase = (long)bl * SEQ; const int q0 = qb * QB;
    const h16* Qw = Q + (rowbase + q0 + wid * QBLK) * PQ + h * D;
    const h16* Kh = K + rowbase * PQ + h * D, *Vh = V + rowbase * PQ + h * D;
    const unsigned lds0 = (unsigned)(uintptr_t)shm;
    float* wsf = (float*)(shm + LDS_WS) + wid * 64;
    typedef __attribute__((address_space(3))) float lds_f32;
    typedef __attribute__((address_space(3))) const f32x4 lds_cf32x4;
    const lds_cptr shm3 = (lds_cptr)shm;
    {
        lds_f32* bt = (lds_f32*)(shm3 + LDS_BT);
        const int nkeys = q0 + QB;
        if (MOBA) { for (int i = tid; i < nkeys; i += NW * 64) bt[i] = slope2 * (float)(i - q0); }
        else { for (int i = tid; i < nkeys; i += NW * 64) bt[i] = bsrc[i]; }
        if (tid < 64) ((lds_f32*)(shm3 + LDS_INF))[tid] = -INFINITY;
        if (MOBA) { if (tid < 512) ((lds_f32*)(shm3 + LDS_KM))[tid] = kmean[tid]; }
    }
    const h16* ksrc = Kh + (long)lane * PQ + wid * 8;
    const h16* vsrc = Vh + (long)(16 * (wid & 3) + (lane >> 2)) * PQ + (wid >> 2) * 32 + (lane & 3) * 8;
    const unsigned kdst = lds0 + LDS_K + wid * 1024, vdst = lds0 + LDS_V + wid * 1024;
    const int NT = (q0 + QB) / KVBLK;
#define AMAP(t) ((t) < 4 ? 4 * qb + (t) : (MOBA ? (t) - 4 : 4 * qb + 3 - (t)))
#define DMA_K(t, slot) glds16(ksrc + (long)AMAP(t) * KVBLK * PQ, (unsigned)__builtin_amdgcn_readfirstlane(kdst + (slot)))
#define DMA_V(t, slot) glds16(vsrc + (long)AMAP(t) * KVBLK * PQ, (unsigned)__builtin_amdgcn_readfirstlane(vdst + (slot)))
    const char* Kbase = shm + LDS_K; s16x8 kf[8];
    const lds_cptr kp0 = shm3 + LDS_K + hi * 1024 + r32 * 16; const lds_cptr vp0 = shm3 + LDS_V + ((lane >> 4) & 1) * 32 + (lane & 3) * 8 + (4 * hi + ((lane & 15) >> 2)) * 64;
    DMA_K(0, 0); DMA_V(0, 0); DMA_K(1, SLOTB);
    s16x8 qr[4];
#pragma unroll
    for (int d0 = 0; d0 < 4; ++d0) qr[d0] = *reinterpret_cast<const s16x8*>(&Qw[(long)r32 * PQ + d0 * 16 + hi * 8]);
    float mhat = 0.f, l_reg = 0.f; f32x16 o[2]; o[0] = f32x16{}; o[1] = f32x16{}; f32x16 negm = f32x16{}; asm volatile("" : "+v"(negm));
    const int qrel = wid * QBLK + r32;
    unsigned selbits = 0xffu;
#define ADDB(P0, P1, t) do { const int kt_ = AMAP(t); lds_cptr tb_ = shm3 + LDS_BT + kt_ * 256; \
        if (MOBA) { const bool s_ = ((t) < 4) || ((selbits >> (kt_ >> 2)) & 1u); tb_ = s_ ? tb_ : (shm3 + LDS_INF); } \
        _Pragma("unroll") for (int g_ = 0; g_ < 4; ++g_) { const f32x4 b0_ = *(lds_cf32x4*)(tb_ + 16 * hi + 32 * g_), b1_ = *(lds_cf32x4*)(tb_ + 128 + 16 * hi + 32 * g_); \
            _Pragma("unroll") for (int i_ = 0; i_ < 4; ++i_) { P0[4 * g_ + i_] += b0_[i_]; P1[4 * g_ + i_] += b1_[i_]; } } } while (0)
#define CMASK(P0, P1, t) do { if ((t) < 4) cmask(P0, P1, (t), qrel, hi); } while (0)
    bool resc = false;
#define START(P0, P1) do { const float rm = rowmax(P0, P1); resc = false; \
    { const float dl = rm; mhat = fadd_s(mhat, dl); \
      _Pragma("unroll") for (int r = 0; r < 16; ++r) { P0[r] = fsub_s(P0[r], dl); P1[r] = fsub_s(P1[r], dl); } \
      _Pragma("unroll") for (int r = 0; r < 16; ++r) negm[r] = -mhat; asm volatile("" : "+v"(negm)); } \
    _Pragma("unroll") for (int r = 0; r < 16; ++r) P0[r] = __builtin_amdgcn_exp2f(P0[r]); } while (0)
#define RESC() do { if (resc) { asm volatile("s_waitcnt lgkmcnt(0)" ::: "memory"); \
      _Pragma("unroll") for (int d_ = 0; d_ < 2; ++d_) _Pragma("unroll") for (int r = 0; r < 16; ++r) o[d_][r] *= wsf[crow(r, hi)]; } } while (0)
    f32x16 pA0, pA1, pB0, pB1;
    int sl_prev = 0, sl_cur = 0, sl_next = SLOTB;
#define ROT() do { sl_prev = sl_cur; sl_cur = sl_next; sl_next = (sl_next == (NSLOT - 1) * SLOTB) ? 0 : sl_next + SLOTB; } while (0)
    DMA_K(2, 2 * SLOTB);
    WAIT_BAR(3);
    if (MOBA && qb >= 4) {
        float gate[8];
#pragma unroll
        for (int n = 0; n < 8; ++n) gate[n] = 0.f;
#pragma unroll
        for (int d0 = 0; d0 < 4; ++d0) {
            const h16x8 qv = __builtin_bit_cast(h16x8, qr[d0]);
#pragma unroll
            for (int n = 0; n < 7; ++n) {
                const f32x4 k0 = *(lds_cf32x4*)(shm3 + LDS_KM + n * 256 + d0 * 64 + hi * 32), k1 = *(lds_cf32x4*)(shm3 + LDS_KM + n * 256 + d0 * 64 + hi * 32 + 16);
                gate[n] += (float)qv[0] * k0[0] + (float)qv[1] * k0[1] + (float)qv[2] * k0[2] + (float)qv[3] * k0[3] + (float)qv[4] * k1[0] + (float)qv[5] * k1[1] + (float)qv[6] * k1[2] + (float)qv[7] * k1[3];
            }
        }
#pragma unroll
        for (int n = 0; n < 7; ++n) { gate[n] = half_sum(gate[n]); if (n >= qb) gate[n] = -INFINITY; }
        unsigned sb = 0u;
#pragma unroll
        for (int r = 0; r < 3; ++r) {
            float best = -INFINITY; int bi = 0;
#pragma unroll
            for (int n = 0; n < 7; ++n) { const bool fr_ = !((sb >> n) & 1u); if (fr_ && gate[n] > best) { best = gate[n]; bi = n; } }
            sb |= 1u << bi;
        }
        selbits = sb;
    }
    qkt(pA0, pA1, Kbase, qr, negm, r32, hi); asm volatile("s_nop 15\n\ts_nop 7" : "+v"(pA0), "+v"(pA1)); ADDB(pA0, pA1, 0); CMASK(pA0, pA1, 0);
    START(pA0, pA1);
    _Pragma("unroll") for (int r = 0; r < 16; ++r) pA1[r] = __builtin_amdgcn_exp2f(pA1[r]);
    WAIT_BAR(0);
    DMA_K(3, 0); DMA_V(1, SLOTB);
    ROT();
    kload8(kf, kp0 + sl_cur);
    WAIT_BAR(2);
    s16x4 vlo[8], vhi[8]; u32x4 pw0, pw1, pw2, pw3;
#define PKW(P, B) cvtpk_s(P[B], P[B + 1])
#define PAF(k) __builtin_bit_cast(s16x8, pw##k)
#define VFR(i) (s16x8){vlo[i][0], vlo[i][1], vlo[i][2], vlo[i][3], vhi[i][0], vhi[i][1], vhi[i][2], vhi[i][3]}
#define PIN(x) asm volatile("" : "+v"(x))
#define MX3(a, b, c) __builtin_fmaxf(__builtin_fmaxf((a), (b)), (c))
#define GAPA(MF, A0, A1, A2, A3, W0, W1, PW_) do { MF; sacc += A0; sacc += A1; sacc += A2; sacc += A3; PIN(sacc); W0; W1; PIN(PW_); SBAR(); } while (0)
#define EX(v) __builtin_amdgcn_exp2f(v)
#define GAPB(MF, X, B) do { MF; X[B] = EX(X[B]); X[B + 1] = EX(X[B + 1]); X[B + 2] = EX(X[B + 2]); X[B + 3] = EX(X[B + 3]); PIN(X); SBAR(); } while (0)
#define VRD(i) do { vlo[i] = vtr(vp_ + (((i) >> 2) * 4096 + ((i) & 3) * 1024)); vhi[i] = vtr(vp_ + (((i) >> 2) * 4096 + ((i) & 3) * 1024 + 512)); } while (0)
#define KRD(G, j) do { if (G) { kload2(kf, kp0 + sl_next, j); SBAR(); } } while (0)
#define STEP(C0, C1, P0, P1, t, GK, GV, GL) do { SBAR(); \
    const lds_cptr vp_ = vp0 + sl_prev; \
    VRD(0); SBAR(); float sacc = (P0[0] + P0[1]); \
    GAPA(C0 = MFMA32(kf[0], qr[0], negm), P0[2], P0[3], P0[4], P0[5],     pw0[0] = PKW(P0, 0), pw0[1] = PKW(P0, 2), pw0); \
    VRD(4); SBAR(); GAPA(C1 = MFMA32(kf[1], qr[0], negm), P0[6], P0[7], P0[8], P0[9],     pw0[2] = PKW(P0, 4), pw0[3] = PKW(P0, 6), pw0); \
    VRD(1); SBAR(); GAPA(C0 = MFMA32(kf[2], qr[1], C0),   P0[10], P0[11], P0[12], P0[13], pw1[0] = PKW(P0, 8), pw1[1] = PKW(P0, 10), pw1); \
    VRD(5); SBAR(); GAPA(C1 = MFMA32(kf[3], qr[1], C1),   P0[14], P0[15], P1[0], P1[1],   pw1[2] = PKW(P0, 12), pw1[3] = PKW(P0, 14), pw1); \
    VRD(2); SBAR(); GAPA(C0 = MFMA32(kf[4], qr[2], C0),   P1[2], P1[3], P1[4], P1[5],     pw2[0] = PKW(P1, 0), pw2[1] = PKW(P1, 2), pw2); \
    VRD(6); SBAR(); GAPA(C1 = MFMA32(kf[5], qr[2], C1),   P1[6], P1[7], P1[8], P1[9],     pw2[2] = PKW(P1, 4), pw2[3] = PKW(P1, 6), pw2); \
    VRD(3); SBAR(); GAPA(C0 = MFMA32(kf[6], qr[3], C0),   P1[10], P1[11], P1[12], P1[13], pw3[0] = PKW(P1, 8), pw3[1] = PKW(P1, 10), pw3); \
    VRD(7); SBAR(); GAPA(C1 = MFMA32(kf[7], qr[3], C1),   P1[14], P1[15], 0.f, 0.f,       pw3[2] = PKW(P1, 12), pw3[3] = PKW(P1, 14), pw3); \
    l_reg += sacc; \
    if (GK) { DMA_K((t) + 3, sl_cur); } if (GV) { DMA_V((t) + 1, sl_next); } \
    ADDB(C0, C1, t); CMASK(C0, C1, t); \
    { float a = MX3(C0[0], C0[1], C1[0]), b = MX3(C0[2], C0[3], C1[1]); a = MX3(a, C1[2], C1[3]); \
      _Pragma("unroll") for (int r = 4; r < 16; r += 4) { a = MX3(a, C0[r], C0[r + 1]); b = MX3(b, C0[r + 2], C0[r + 3]); a = MX3(a, C1[r], C1[r + 1]); b = MX3(b, C1[r + 2], C1[r + 3]); } \
      float rm = __builtin_fmaxf(a, b); { auto rr = __builtin_amdgcn_permlane32_swap(__float_as_uint(rm), __float_as_uint(rm), false, false); rm = __builtin_fmaxf(__uint_as_float(rr[0]), __uint_as_float(rr[1])); } \
      resc = false; \
      if (__builtin_expect(__any(rm > (float)THRL), 0)) { const float dl = __builtin_fmaxf(rm, 0.f); mhat += dl; \
        _Pragma("unroll") for (int r = 0; r < 16; ++r) { C0[r] -= dl; C1[r] -= dl; } \
        _Pragma("unroll") for (int r = 0; r < 16; ++r) negm[r] = -mhat; asm volatile("" : "+v"(negm)); \
        const float f = __builtin_amdgcn_exp2f(-dl); l_reg *= f; if (hi == 0) wsf[r32] = f; resc = true; } } \
    SBAR(); \
    GAPB(o[0] = MFMA32(PAF(0), VFR(0), o[0]), C0, 0); \
    GAPB(o[1] = MFMA32(PAF(0), VFR(4), o[1]), C0, 4); \
    KRD(GL, 0); GAPB(o[0] = MFMA32(PAF(1), VFR(1), o[0]), C0, 8); \
    KRD(GL, 1); GAPB(o[1] = MFMA32(PAF(1), VFR(5), o[1]), C0, 12); \
    KRD(GL, 2); GAPB(o[0] = MFMA32(PAF(2), VFR(2), o[0]), C1, 0); \
    KRD(GL, 3); GAPB(o[1] = MFMA32(PAF(2), VFR(6), o[1]), C1, 4); \
    GAPB(o[0] = MFMA32(PAF(3), VFR(3), o[0]), C1, 8); \
    GAPB(o[1] = MFMA32(PAF(3), VFR(7), o[1]), C1, 12); \
    } while (0)
    int t = 1;
#define ENDW(tt) do { if ((tt) + 3 < NT) { WAIT_BAR(2); } else if ((tt) + 2 < NT) { WAIT_BAR(1); } else { WAIT_BAR(0); } } while (0)
    for (; t + 1 < NT; t += 2) {
        STEP(pB0, pB1, pA0, pA1, t, (t + 3 < NT), (t + 1 < NT), (t + 1 < NT));       ENDW(t);     RESC(); ROT();
        STEP(pA0, pA1, pB0, pB1, t + 1, (t + 4 < NT), (t + 2 < NT), (t + 2 < NT));   ENDW(t + 1); RESC(); ROT();
    }
    STEP(pB0, pB1, pA0, pA1, NT - 1, false, false, false); RESC();
    { float sacc = pB0[0] + pB0[1]; _Pragma("unroll") for (int r = 2; r < 16; ++r) sacc += pB0[r]; _Pragma("unroll") for (int r = 0; r < 16; ++r) sacc += pB1[r]; l_reg += sacc;
      pw0 = (u32x4){PKW(pB0, 0), PKW(pB0, 2), PKW(pB0, 4), PKW(pB0, 6)}; pw1 = (u32x4){PKW(pB0, 8), PKW(pB0, 10), PKW(pB0, 12), PKW(pB0, 14)}; pw2 = (u32x4){PKW(pB1, 0), PKW(pB1, 2), PKW(pB1, 4), PKW(pB1, 6)}; pw3 = (u32x4){PKW(pB1, 8), PKW(pB1, 10), PKW(pB1, 12), PKW(pB1, 14)};
      int ln_ = threadIdx.x & 63; asm volatile("" : "+v"(ln_));
      const int vb0 = (int)(lds0 + LDS_V) + ((ln_ >> 4) & 1) * 32 + (ln_ & 3) * 8 + (4 * (ln_ >> 5) + ((ln_ & 15) >> 2)) * 64;
      SBAR(); pv(o, vb0 + sl_cur, PAF(0), PAF(1), PAF(2), PAF(3)); }
#undef PKW
#undef PAF
#undef VFR
#undef PIN
#undef MX3
#undef GAPA
#undef GAPB
#undef EX
#undef VRD
#undef KRD
#undef STEP
#undef ENDW
    { auto rr = __builtin_amdgcn_permlane32_swap(__float_as_uint(l_reg), __float_as_uint(l_reg), false, false); l_reg = __uint_as_float(rr[0]) + __uint_as_float(rr[1]); }
    if (hi == 0) wsf[32 + r32] = l_reg; asm volatile("s_waitcnt lgkmcnt(0)" ::: "memory");
    float rli[16];
#pragma unroll
    for (int r = 0; r < 16; ++r) rli[r] = __builtin_amdgcn_rcpf(wsf[32 + crow(r, hi)]);
    {
        int le = threadIdx.x & 63; asm volatile("" : "+v"(le));
        float* stg = (float*)(shm + LDS_OST) + wid * 1024;
        const h16* Zw = Z + (rowbase + q0 + wid * QBLK) * PQ + h * D;
        h16* Yw = Y + (rowbase + q0 + wid * QBLK) * 1536 + h * D;
#pragma unroll
        for (int d0 = 0; d0 < 2; ++d0) {
#pragma unroll
            for (int r = 0; r < 16; ++r) stg[crow(r, le >> 5) * 32 + (le & 31)] = o[d0][r] * rli[r];
            asm volatile("s_waitcnt lgkmcnt(0)" ::: "memory");
#pragma unroll
            for (int i = 0; i < 2; ++i) { const int row = i * 16 + (le >> 2), ch = le & 3;
                const f32x4 a0 = *(const f32x4*)(stg + row * 32 + ch * 8), a1 = *(const f32x4*)(stg + row * 32 + ch * 8 + 4);
                const h16x8 zv = *(const h16x8*)(Zw + (long)row * PQ + d0 * 32 + ch * 8);
                float ov[8] = {a0[0], a0[1], a0[2], a0[3], a1[0], a1[1], a1[2], a1[3]};
#pragma unroll
                for (int e = 0; e < 8; ++e) { const float zz = (float)zv[e]; ov[e] *= zz * __builtin_amdgcn_rcpf(1.f + __expf(-zz)); }
                u32x4 w; w.x = cvtpk_s(ov[0], ov[1]); w.y = cvtpk_s(ov[2], ov[3]); w.z = cvtpk_s(ov[4], ov[5]); w.w = cvtpk_s(ov[6], ov[7]);
                *(u32x4*)(Yw + (long)row * 1536 + d0 * 32 + ch * 8) = w; }
            asm volatile("s_waitcnt lgkmcnt(0)" ::: "memory");
        }
    }
    asm volatile("s_waitcnt vmcnt(0) lgkmcnt(0)\n\ts_barrier" ::: "memory");
#undef DMA_K
#undef DMA_V
#undef AMAP
#undef ADDB
#undef CMASK
#undef START
#undef RESC
#undef ROT
}
#undef SBAR
#undef WAIT_BAR
#undef MFMA32
#undef LDS8
}

constexpr int NWAVES = 8, NTHREADS = 512;
constexpr int MK_LDS_BYTES = 147456;
enum { PH_NORM = 0, PH_PROJ = 1, PH_PRE = 2, PH_SCAN = 3, PH_MIX = 4, PH_BR = 5, PH_OUT = 6, NPH = 7 };
constexpr int N_STEPS = 1 + NPH * 4 + 1;
struct MArgs { const float* in[11]; float* out; unsigned char* ws; int s_lo, s_hi; };

__device__ __forceinline__ void barrier_lds() { asm volatile("s_waitcnt vmcnt(0) lgkmcnt(0)" ::: "memory"); __syncthreads(); }
__device__ __forceinline__ void fox_cumsum_item(int item, int b0, const float* __restrict__ small, float* __restrict__ cb, char* shm) {
    int tid_ = threadIdx.x; asm volatile("" : "+v"(tid_));
    const int tid = tid_, lane = tid & 63, wid = tid >> 6, bl = item >> 3, h = item & 7;
    const float* sp = small + ((size_t)(b0 + bl) * SEQ + 4 * tid) * 16 + h;
    float v0 = sp[0], v1 = sp[16], v2 = sp[32], v3 = sp[48];
    v1 += v0; v2 += v1; v3 += v2;
    float tot = v3;
#pragma unroll
    for (int o = 1; o < 64; o <<= 1) { const float u = shfl_idx(tot, lane - o); if (lane >= o) tot += u; }
    float* wt = (float*)shm;
    if (lane == 63) wt[wid] = tot;
    __syncthreads();
    float base = tot - v3;
    for (int w = 0; w < wid; ++w) base += wt[w];
    float* o4 = cb + (size_t)((b0 + bl) * 8 + h) * SEQ + 4 * tid;
    *(f32x4*)o4 = (f32x4){-(base + v0) * LOG2E, -(base + v1) * LOG2E, -(base + v2) * LOG2E, -(base + v3) * LOG2E};
    __syncthreads();
}
__device__ __forceinline__ void moba_kmean_item(int item, int b0, const h16* __restrict__ proj, float* __restrict__ kmean, char* shm) {
    int tid_ = threadIdx.x; asm volatile("" : "+v"(tid_));
    const int tid = tid_, h = item & 7, blk = (item >> 3) & 7, bl = item >> 6, r8 = tid >> 3, c8 = tid & 7;
    const h16* kp = proj + ((size_t)bl * SEQ + blk * 256 + r8) * PW + PC_BK + h * 64 + c8 * 8;
    float acc[8];
#pragma unroll
    for (int e = 0; e < 8; ++e) acc[e] = 0.f;
#pragma unroll
    for (int j = 0; j < 4; ++j) { const h16x8 v = *(const h16x8*)(kp + (size_t)(64 * j) * PW);
#pragma unroll
        for (int e = 0; e < 8; ++e) acc[e] += (float)v[e]; }
    float* red = (float*)shm;
#pragma unroll
    for (int e = 0; e < 8; ++e) red[r8 * 65 + c8 * 8 + e] = acc[e];
    __syncthreads();
    if (tid < 64) { float sum = 0.f;
#pragma unroll 8
        for (int r = 0; r < 64; ++r) sum += red[r * 65 + tid];
        kmean[(((size_t)(b0 + bl) * 8 + h) * 8 + blk) * 64 + tid] = sum * (1.f / 256.f); }
    __syncthreads();
}

namespace mlstm {
typedef __attribute__((address_space(3))) char* lds_ptr;
typedef __attribute__((address_space(3))) const char* lds_cptr;
typedef short s16x8 __attribute__((ext_vector_type(8)));
typedef short s16x4 __attribute__((ext_vector_type(4)));
typedef short v4i16_t __attribute__((ext_vector_type(4)));
typedef float f32x16 __attribute__((ext_vector_type(16)));
typedef unsigned u32x4 __attribute__((ext_vector_type(4)));
constexpr int W_V = 0, W_K = 16384, W_SC = W_K + 8704, WREG = W_SC + 2048;
constexpr int NACT = 4;
__device__ __forceinline__ int crow(int r, int hi) { return (r & 3) + 8 * (r >> 2) + 4 * hi; }
#define MF32(a, b, c) __builtin_amdgcn_mfma_f32_32x32x16_f16(__builtin_bit_cast(h16x8, (a)), __builtin_bit_cast(h16x8, (b)), (c), 0, 0, 0)
#define LFW(off) ((__attribute__((address_space(3))) float*)(R + W_SC + (off)))
__device__ __forceinline__ s16x4 vtr(lds_cptr p) { return __builtin_bit_cast(s16x4, __builtin_amdgcn_ds_read_tr16_b64_v4i16((__attribute__((address_space(3))) v4i16_t*)p)); }
__device__ __forceinline__ s16x8 trfrag(lds_cptr img, int blk, int ks, int lb) {
    const s16x4 lo = vtr(img + blk * 4096 + ks * 1024 + lb), hi = vtr(img + blk * 4096 + ks * 1024 + 512 + lb);
    return (s16x8){lo[0], lo[1], lo[2], lo[3], hi[0], hi[1], hi[2], hi[3]};
}
__device__ __forceinline__ void stage_v(lds_ptr R, const h16* __restrict__ vsrc  , int lane) {
    int ln = lane; asm volatile("" : "+v"(ln));
    const h16* vp = vsrc + (size_t)(ln >> 2) * PW + (ln & 3) * 8;
#pragma unroll 1
    for (int sg = 0; sg < 4; ++sg) {
        h16x8 x[4];
#pragma unroll
        for (int vb = 0; vb < 4; ++vb) x[vb] = *(const h16x8*)(vp + 32 * vb);
#pragma unroll
        for (int vb = 0; vb < 4; ++vb) *(__attribute__((address_space(3))) h16x8*)(R + W_V + vb * 4096 + sg * 1024 + ln * 16) = x[vb];
        vp += (size_t)16 * PW; }
}
__device__ __forceinline__ void x1_wave(int item, int b0, const h16* __restrict__ proj, const float* __restrict__ small, const float* __restrict__ convw,
                                        h16* __restrict__ qkc, float* __restrict__ U, float* __restrict__ un, float* __restrict__ amax, float* __restrict__ blast, lds_ptr R, int lane_in) {
    int lane = threadIdx.x & 63; (void)lane_in; asm volatile("" : "+v"(lane));
    const int r32 = lane & 31, hi = lane >> 5;
    const int c = item & 31, hh = (item >> 5) & 3, bl = item >> 7;
    const size_t row0 = (size_t)bl * SEQ + c * 64;
    const int gbh = (b0 + bl) * 4 + hh, lbh = bl * 4 + hh;
    float ws;
    {   const float* sp = small + ((size_t)b0 * SEQ + row0 + lane) * 16;
        const float li = sp[8 + hh], lf = sp[12 + hh];
        float bc = lf;
#pragma unroll
        for (int o = 1; o < 64; o <<= 1) { const float u = shfl_idx(bc, lane - o); if (lane >= o) bc += u; }
        const float as = li - bc; float mx = as;
#pragma unroll
        for (int o = 1; o < 64; o <<= 1) mx = fmaxf(mx, shfl_idx(mx, lane ^ o));
        ws = __expf(as - mx);
        if (lane == 63) { amax[gbh * 32 + c] = mx; blast[gbh * 32 + c] = bc; } }
    stage_v(R, proj + row0 * PW + PC_CV + hh * 128, lane);
    const int t = c * 64 + lane;
#pragma unroll 1
    for (int dg = 0; dg < 16; ++dg) {
        const int isk = dg >> 3, pcol = isk ? 256 + hh * 64 + (dg - 8) * 8 : hh * 64 + dg * 8;
        float acc[8];
#pragma unroll
        for (int e = 0; e < 8; ++e) acc[e] = 0.f;
#pragma unroll
        for (int j = 0; j < 4; ++j) {
            const int tt = t - 3 + j, tc = tt < 0 ? 0 : tt;
            const h16x8 x = *(const h16x8*)(proj + ((size_t)bl * SEQ + tc) * PW + PC_CQK + pcol);
            const float m = tt < 0 ? 0.f : 1.f;
            const float* wp = convw + j * 512 + pcol;
#pragma unroll
            for (int e = 0; e < 8; ++e) acc[e] += wp[e] * m * (float)x[e];
        }
        h16x8 o, ow;
#pragma unroll
        for (int e = 0; e < 8; ++e) { float v = acc[e] * __builtin_amdgcn_rcpf(1.f + __expf(-acc[e])); if (isk) v *= 0.125f; o[e] = (h16)v; ow[e] = (h16)(v * ws); }
        *(h16x8*)(qkc + (row0 + lane) * 512 + pcol) = o;
        if (isk) { const int dgk = dg - 8; *(__attribute__((address_space(3))) h16x8*)(R + W_K + (dgk >> 2) * 4096 + lane * 64 + (dgk & 3) * 16) = ow; }
    }
    asm volatile("s_waitcnt lgkmcnt(0)" ::: "memory");
    const int lb = ((lane >> 4) & 1) * 32 + (lane & 3) * 8 + (4 * hi + ((lane & 15) >> 2)) * 64;
    float* up = U + ((size_t)lbh * 32 + c) * 8192;
#pragma unroll 1
    for (int vb = 0; vb < 4; ++vb) {
        f32x16 a0 = f32x16{}, a1 = f32x16{};
#pragma unroll
        for (int ks = 0; ks < 4; ++ks) { const s16x8 vf = trfrag((lds_cptr)(R + W_V), vb, ks, lb);
            a0 = MF32(vf, trfrag((lds_cptr)(R + W_K), 0, ks, lb), a0); a1 = MF32(vf, trfrag((lds_cptr)(R + W_K), 1, ks, lb), a1); }
#pragma unroll
        for (int r = 0; r < 16; ++r) { up[(vb * 32 + crow(r, hi)) * 64 + r32] = a0[r]; up[(vb * 32 + crow(r, hi)) * 64 + 32 + r32] = a1[r]; }
    }
    {   float sum = 0.f;
        lds_cptr kp = (lds_cptr)(R + W_K) + (lane >> 5) * 4096 + (lane & 31) * 2;
#pragma unroll 16
        for (int q = 0; q < 64; ++q) sum += (float)*(const __attribute__((address_space(3))) h16*)(kp + q * 64);
        un[((size_t)gbh * 32 + c) * 64 + lane] = sum; }
    asm volatile("s_waitcnt lgkmcnt(0)" ::: "memory");
}
__device__ __forceinline__ void x2_item(int item, int b0, const float* __restrict__ U, const float* __restrict__ un, const float* __restrict__ amax, const float* __restrict__ blast,
                                        h16* __restrict__ CS, float* __restrict__ ns, float* __restrict__ Ms, char* shm) {
    int tid_ = threadIdx.x; asm volatile("" : "+v"(tid_));
    const int tid = tid_, lbh = item >> 3, sl = item & 7, gbh = (b0 + (lbh >> 2)) * 4 + (lbh & 3);
    float* coef = (float*)shm;
    if (tid == 0) { float M = 0.f; if (sl == 0) Ms[gbh * 32] = 0.f;
        for (int c = 0; c < 31; ++c) { const float am = amax[gbh * 32 + c], bls = blast[gbh * 32 + c], Mn = bls + fmaxf(M, am);
            coef[2 * c] = __expf(bls + M - Mn); coef[2 * c + 1] = __expf(bls + am - Mn); M = Mn; if (sl == 0) Ms[gbh * 32 + c + 1] = M; } }
    __syncthreads();
    {   const int e2 = sl * 1024 + tid * 2;
        const float* up = U + (size_t)lbh * 32 * 8192 + e2; h16* cp = CS + (size_t)lbh * 32 * 8192 + e2;
        float c0 = 0.f, c1 = 0.f;
        *(pg8::h16x2*)cp = (pg8::h16x2){(h16)0.f, (h16)0.f};
#pragma unroll 1
        for (int cb = 0; cb < 31; cb += 8) {
            pg8::f32x2 u[8];
#pragma unroll
            for (int j = 0; j < 8; ++j) if (cb + j < 31) u[j] = *(const pg8::f32x2*)(up + (size_t)(cb + j) * 8192);
#pragma unroll
            for (int j = 0; j < 8; ++j) if (cb + j < 31) { const float fd = coef[2 * (cb + j)], fi = coef[2 * (cb + j) + 1];
                c0 = fd * c0 + fi * u[j].x; c1 = fd * c1 + fi * u[j].y;
                *(pg8::h16x2*)(cp + (size_t)(cb + j + 1) * 8192) = (pg8::h16x2){(h16)c0, (h16)c1}; }
        }
    }
    if (sl == 0 && tid < 64) { float n = 0.f; ns[((size_t)gbh * 32) * 64 + tid] = 0.f;
        for (int c = 0; c < 31; ++c) { n = coef[2 * c] * n + coef[2 * c + 1] * un[((size_t)gbh * 32 + c) * 64 + tid]; ns[((size_t)gbh * 32 + c + 1) * 64 + tid] = n; } }
    __syncthreads();
}
__device__ __forceinline__ void x3_wave(int item, int b0, const h16* __restrict__ proj, const float* __restrict__ small, const h16* __restrict__ qkc, const h16* __restrict__ CS,
                                        const float* __restrict__ ns, const float* __restrict__ Ms, const float* __restrict__ headg, h16* __restrict__ y, lds_ptr R, int lane_in) {
    int lane = threadIdx.x & 63; (void)lane_in; asm volatile("" : "+v"(lane));
    const int c = item & 31, hh = (item >> 5) & 3, bl = item >> 7;
    const size_t row0 = (size_t)bl * SEQ + c * 64;
    const int gbh = (b0 + bl) * 4 + hh, lbh = bl * 4 + hh;
    {   const float* sp = small + ((size_t)b0 * SEQ + row0 + lane) * 16;
        const float li = sp[8 + hh], lf = sp[12 + hh], Mc = Ms[gbh * 32 + c];
        float bc = lf;
#pragma unroll
        for (int o = 1; o < 64; o <<= 1) { const float u = shfl_idx(bc, lane - o); if (lane >= o) bc += u; }
        const float as = li - bc; float pm = as;
#pragma unroll
        for (int o = 1; o < 64; o <<= 1) { const float u = shfl_idx(pm, lane - o); if (lane >= o) pm = fmaxf(pm, u); }
        const float mx = fmaxf(Mc, pm);
        LFW(0)[lane] = as; LFW(256)[lane] = mx; LFW(512)[lane] = __expf(Mc - mx); LFW(768)[lane] = __expf(-(bc + mx));
        LFW(1280)[lane] = ns[((size_t)gbh * 32 + c) * 64 + lane]; }
    stage_v(R, proj + row0 * PW + PC_CV + hh * 128, lane);
    asm volatile("s_waitcnt lgkmcnt(0)" ::: "memory");
    const h16* cprev = CS + ((size_t)lbh * 32 + c) * 8192;
    typedef __attribute__((address_space(3))) const f32x4 lds_cf32x4;
#pragma unroll 1
    for (int tb = 0; tb < 2; ++tb) {
        int l2 = lane; asm volatile("" : "+v"(l2));
        const int r32 = l2 & 31, hi = l2 >> 5;
        const int lb = ((l2 >> 4) & 1) * 32 + (l2 & 3) * 8 + (4 * hi + ((l2 & 15) >> 2)) * 64;
        const int t = 32 * tb + r32;
        s16x8 qr[4];
#pragma unroll
        for (int ks = 0; ks < 4; ++ks) qr[ks] = *(const s16x8*)(qkc + (row0 + t) * 512 + hh * 64 + 16 * ks + 8 * hi);
        const float mxt = LFW(256)[t], wit = LFW(512)[t];
        float nq = 0.f;
#pragma unroll
        for (int ks = 0; ks < 4; ++ks) { const h16x8 qv = __builtin_bit_cast(h16x8, qr[ks]);
            const f32x4 n0 = *(lds_cf32x4*)(R + W_SC + 1280 + (16 * ks + 8 * hi) * 4), n1 = *(lds_cf32x4*)(R + W_SC + 1280 + (16 * ks + 8 * hi + 4) * 4);
            nq += (float)qv[0] * n0[0] + (float)qv[1] * n0[1] + (float)qv[2] * n0[2] + (float)qv[3] * n0[3] + (float)qv[4] * n1[0] + (float)qv[5] * n1[1] + (float)qv[6] * n1[2] + (float)qv[7] * n1[3]; }
        nq = half_sum(nq);
        f32x16 p0 = f32x16{}, p1 = f32x16{};
#pragma unroll
        for (int ks = 0; ks < 4; ++ks) { const s16x8 k0 = *(const s16x8*)(qkc + (row0 + r32) * 512 + 256 + hh * 64 + 16 * ks + 8 * hi); p0 = MF32(k0, qr[ks], p0); }
        if (tb == 1) {
#pragma unroll
            for (int ks = 0; ks < 4; ++ks) { const s16x8 k1 = *(const s16x8*)(qkc + (row0 + 32 + r32) * 512 + 256 + hh * 64 + 16 * ks + 8 * hi); p1 = MF32(k1, qr[ks], p1); } }
        float dsum = 0.f;
#pragma unroll
        for (int g = 0; g < 4; ++g) { const f32x4 a0 = *(lds_cf32x4*)(R + W_SC + (8 * g + 4 * hi) * 4), a1 = *(lds_cf32x4*)(R + W_SC + (32 + 8 * g + 4 * hi) * 4);
#pragma unroll
            for (int i = 0; i < 4; ++i) { const int s0 = 8 * g + 4 * hi + i;
                const float w0 = s0 <= t ? p0[4 * g + i] * __expf(a0[i] - mxt) : 0.f; p0[4 * g + i] = w0; dsum += w0;
                const float w1 = (tb == 1 && s0 + 32 <= t) ? p1[4 * g + i] * __expf(a1[i] - mxt) : 0.f; p1[4 * g + i] = w1; dsum += w1; } }
        dsum = half_sum(dsum);
        if (hi == 0) LFW(1024)[t] = dsum + wit * nq;
        u32x4 pw0, pw1, pw2, pw3;
#define PKW(P, B) pg8::cvt_pk_f16(P[B], P[B + 1])
        pw0 = (u32x4){PKW(p0, 0), PKW(p0, 2), PKW(p0, 4), PKW(p0, 6)}; pw1 = (u32x4){PKW(p0, 8), PKW(p0, 10), PKW(p0, 12), PKW(p0, 14)};
        pw2 = (u32x4){PKW(p1, 0), PKW(p1, 2), PKW(p1, 4), PKW(p1, 6)}; pw3 = (u32x4){PKW(p1, 8), PKW(p1, 10), PKW(p1, 12), PKW(p1, 14)};
#undef PKW
        s16x8 qs[4];
        { const h16 wh = (h16)wit;
#pragma unroll
          for (int ks = 0; ks < 4; ++ks) { h16x8 qv = __builtin_bit_cast(h16x8, qr[ks]);
#pragma unroll
              for (int e = 0; e < 8; ++e) qv[e] = qv[e] * wh;
              qs[ks] = __builtin_bit_cast(s16x8, qv); } }
        f32x16 acc[4];
#pragma unroll
        for (int vb = 0; vb < 4; ++vb) { acc[vb] = f32x16{};
#pragma unroll
            for (int ks = 0; ks < 4; ++ks) { const s16x8 cf = *(const s16x8*)(cprev + (32 * vb + r32) * 64 + 16 * ks + 8 * hi); acc[vb] = MF32(qs[ks], cf, acc[vb]); }
            acc[vb] = MF32(__builtin_bit_cast(s16x8, pw0), trfrag((lds_cptr)(R + W_V), vb, 0, lb), acc[vb]);
            acc[vb] = MF32(__builtin_bit_cast(s16x8, pw1), trfrag((lds_cptr)(R + W_V), vb, 1, lb), acc[vb]);
            if (tb == 1) { acc[vb] = MF32(__builtin_bit_cast(s16x8, pw2), trfrag((lds_cptr)(R + W_V), vb, 2, lb), acc[vb]);
                           acc[vb] = MF32(__builtin_bit_cast(s16x8, pw3), trfrag((lds_cptr)(R + W_V), vb, 3, lb), acc[vb]); } }
        asm volatile("s_waitcnt lgkmcnt(0)" ::: "memory");
#pragma unroll
        for (int g = 0; g < 4; ++g) { const f32x4 dn = *(lds_cf32x4*)(R + W_SC + 1024 + (32 * tb + 8 * g + 4 * hi) * 4), em = *(lds_cf32x4*)(R + W_SC + 768 + (32 * tb + 8 * g + 4 * hi) * 4);
#pragma unroll
            for (int i = 0; i < 4; ++i) { const float inv = __builtin_amdgcn_rcpf(fmaxf(fabsf(dn[i]), em[i])); const int rl = 8 * g + 4 * hi + i;
#pragma unroll
                for (int vb = 0; vb < 4; ++vb) *(__attribute__((address_space(3))) h16*)(R + W_K + rl * 272 + (32 * vb + r32) * 2) = (h16)(acc[vb][4 * g + i] * inv); } }
        asm volatile("s_waitcnt lgkmcnt(0)" ::: "memory");
#pragma unroll 1
        for (int ps = 0; ps < 2; ++ps) {
            int l3 = threadIdx.x & 63; asm volatile("" : "+v"(l3));
            const int rl = 16 * ps + (l3 >> 2), v0 = (l3 & 3) * 32;
            const size_t row = row0 + 32 * tb + rl;
            float hg[32]; float ss = 0.f;
#pragma unroll
            for (int q = 0; q < 4; ++q) { const h16x8 hv = *(const __attribute__((address_space(3))) h16x8*)(R + W_K + rl * 272 + (v0 + 8 * q) * 2);
                const h16x8 og = *(const h16x8*)(proj + row * PW + PC_CO + hh * 128 + v0 + 8 * q);
#pragma unroll
                for (int e = 0; e < 8; ++e) { const float x = (float)hv[e] * __builtin_amdgcn_rcpf(1.f + __expf(-(float)og[e])); hg[8 * q + e] = x; ss += x * x; } }
            ss += swz_xor<1>(ss); ss += swz_xor<2>(ss);
            const float rn = rsqrtf(ss * (1.f / 128.f) + RMS_EPS);
#pragma unroll
            for (int q = 0; q < 4; ++q) { const h16x8 zv = *(const h16x8*)(proj + row * PW + PC_CZ + hh * 128 + v0 + 8 * q);
                const f32x4 g0 = *(const f32x4*)(headg + hh * 128 + v0 + 8 * q), g1 = *(const f32x4*)(headg + hh * 128 + v0 + 8 * q + 4);
                float ov[8];
#pragma unroll
                for (int e = 0; e < 8; ++e) { const float zz = (float)zv[e]; ov[e] = hg[8 * q + e] * rn * (e < 4 ? g0[e] : g1[e - 4]) * zz * __builtin_amdgcn_rcpf(1.f + __expf(-zz)); }
                u32x4 w; w.x = pg8::cvt_pk_f16(ov[0], ov[1]); w.y = pg8::cvt_pk_f16(ov[2], ov[3]); w.z = pg8::cvt_pk_f16(ov[4], ov[5]); w.w = pg8::cvt_pk_f16(ov[6], ov[7]);
                *(u32x4*)(y + row * 1536 + 1024 + hh * 128 + v0 + 8 * q) = w; }
        }
        asm volatile("s_waitcnt lgkmcnt(0)" ::: "memory");
    }
}
#undef LFW
#undef MF32
}

#define LAS __attribute__((address_space(3)))
#define XB_TMO      128
#define XB_XCNT(j)  (256  + 64 * (j))
#define XB_XSUB(j)  (1280 + 64 * (j))
#define XB_XGEN(j)  (2304 + 64 * (j))
#define XB_TOP      3328
#define XB_TOPGEN   3392
#define XCD_BAR_WORDS 3456
#define XB_SPIN_CAP (1u << 18)
__device__ __forceinline__ unsigned xb_ld(unsigned* p)              { return __hip_atomic_load(p, __ATOMIC_RELAXED, __HIP_MEMORY_SCOPE_AGENT); }
__device__ __forceinline__ unsigned xb_add(unsigned* p, unsigned v) { return __hip_atomic_fetch_add(p, v, __ATOMIC_RELAXED, __HIP_MEMORY_SCOPE_AGENT); }
__device__ __forceinline__ unsigned xb_xcc_id() { return (unsigned)__builtin_amdgcn_s_getreg((3 << 11) | 20) & 0xFu; }
#define XB_SPIN(cond, bar) do { unsigned _sp = 0; while (cond) { __builtin_amdgcn_s_sleep(1); \
    if ((++_sp & 255u) == 0u) { if (xb_ld(&(bar)[XB_TMO])) break; if (_sp > XB_SPIN_CAP) { atomicAdd(&(bar)[XB_TMO], 1u); break; } } } } while (0)
struct XcdBarrier { unsigned* bar; unsigned x; volatile LAS unsigned* st; };
__device__ __forceinline__ XcdBarrier xcd_barrier_post(unsigned* bar, volatile LAS unsigned* st) {
    XcdBarrier b; b.bar = bar; b.x = xb_xcc_id(); b.st = st;
    if (threadIdx.x == 0) (void)xb_add(&bar[XB_XCNT(b.x)], 1u);
    return b;
}
__device__ __forceinline__ void xcd_barrier_complete(unsigned* bar, unsigned x, unsigned& nloc, unsigned& nx) {
    const unsigned G = gridDim.x * gridDim.y * gridDim.z;
    unsigned sum, cnt, mine, sp = 0u;
    for (;;) {
        sum = 0u; cnt = 0u; mine = 0u;
#pragma unroll
        for (unsigned j = 0; j < 16; ++j) { const unsigned c = xb_ld(&bar[XB_XCNT(j)]); sum += c; cnt += (c > 0u) ? 1u : 0u; mine = (j == x) ? c : mine; }
        if (sum == G) break;
        __builtin_amdgcn_s_sleep(1);
        if ((++sp & 255u) == 0u) { if (xb_ld(&bar[XB_TMO])) break; if (sp > XB_SPIN_CAP) { atomicAdd(&bar[XB_TMO], 1u); break; } }
    }
    nloc = mine > 0u ? mine : 1u; nx = cnt > 0u ? cnt : 1u;
}
__device__ __forceinline__ void xcd_barrier(const XcdBarrier& b) {
    asm volatile("s_waitcnt vmcnt(0)" ::: "memory");
    __syncthreads();
    if (threadIdx.x == 0) {
        unsigned* bar = b.bar;
        __builtin_amdgcn_s_waitcnt(0);
        unsigned nloc = b.st[0], nx = b.st[1];
        if (nloc == 0u) { xcd_barrier_complete(bar, b.x, nloc, nx); b.st[0] = nloc; b.st[1] = nx; }
        const unsigned old = xb_add(&bar[XB_XSUB(b.x)], 1u);
        const unsigned gen = old / nloc;
        if (old + 1u == (gen + 1u) * nloc) {
            __builtin_amdgcn_fence(__ATOMIC_RELEASE, "agent");
            asm volatile("s_waitcnt vmcnt(0)" ::: "memory");
            const unsigned og = xb_add(&bar[XB_TOP], 1u);
            const unsigned tg = og / nx;
            if (og + 1u == (tg + 1u) * nx) xb_add(&bar[XB_TOPGEN], 1u);
            else XB_SPIN(xb_ld(&bar[XB_TOPGEN]) == tg, bar);
            __builtin_amdgcn_fence(__ATOMIC_ACQUIRE, "agent");
            xb_add(&bar[XB_XGEN(b.x)], 1u);
            asm volatile("s_waitcnt vmcnt(0)" ::: "memory");
        } else {
            XB_SPIN(xb_ld(&bar[XB_XGEN(b.x)]) == gen, bar);
            __builtin_amdgcn_fence(__ATOMIC_ACQUIRE, "agent");
            asm volatile("s_waitcnt vmcnt(0)" ::: "memory");
        }
    }
    __syncthreads();
}
constexpr int LDSCTL_OFF = 131072, MISC_OFF = LDSCTL_OFF + 320;
constexpr int CW_BAR = 4096;
constexpr size_t CTL_ZERO_BYTES = 65536;

__device__ __forceinline__ void transpose_item(const float* __restrict__ W, int ldsrc, int K, h16* __restrict__ WT, int k0, int n0, int src_col0, float scale, PG8_LAS float* scr, int lane) {
    float tv[32];
#pragma unroll
    for (int i = 0; i < 32; ++i) { const int kk = 2 * i + (lane >> 5); tv[i] = W[(size_t)(k0 + kk) * ldsrc + src_col0 + (lane & 31)]; }
#pragma unroll
    for (int i = 0; i < 32; ++i) { const int kk = 2 * i + (lane >> 5); scr[kk * 33 + (lane & 31)] = tv[i]; }
    asm volatile("s_waitcnt lgkmcnt(0)" ::: "memory");
    const int c = lane & 7;
#pragma unroll
    for (int j = 0; j < 4; ++j) { const int n = (lane >> 3) + 8 * j; const PG8_LAS float* sp = scr + (8 * c) * 33 + n;
        pg8::u32x4 o; o.x = pg8::cvt_pk_f16(sp[0 * 33] * scale, sp[1 * 33] * scale); o.y = pg8::cvt_pk_f16(sp[2 * 33] * scale, sp[3 * 33] * scale);
        o.z = pg8::cvt_pk_f16(sp[4 * 33] * scale, sp[5 * 33] * scale); o.w = pg8::cvt_pk_f16(sp[6 * 33] * scale, sp[7 * 33] * scale);
        *(pg8::u32x4*)(WT + (size_t)(n0 + n) * K + k0 + 8 * c) = o; }
    asm volatile("s_waitcnt lgkmcnt(0)" ::: "memory");
}
__device__ __forceinline__ void prologue_phase(const MArgs& a, PG8_LAS unsigned char* L) {
    int tid_ = threadIdx.x; asm volatile("" : "+v"(tid_));
    const int lane = tid_ & 63, wave = tid_ >> 6;
    PG8_LAS float* scr = (PG8_LAS float*)(L + wave * 16384);
    const int gw = blockIdx.x * NWAVES + wave, NGW = gridDim.x * NWAVES;
    constexpr int I_IN = (DM / 64) * (PW / 32), I_BR = (512 / 64) * (1024 / 32), I_OUT = (DM / 64) * (DM / 32), I_L = I_IN + 3 * I_BR + I_OUT;
    unsigned char* ws = a.ws;
    for (int it = gw; it < DEPTH * I_L; it += NGW) {
        const int l = it / I_L; int r = it - l * I_L;
        if (r < I_IN) { const int nblk = PW / 32, kb = r / nblk, nb = r % nblk, n0 = nb * 32;
            const float sc = ((n0 >= PC_AQ && n0 < PC_AQ + 512) || (n0 >= PC_BQ && n0 < PC_BQ + 512)) ? C2 : 1.f;
            transpose_item(a.in[2] + (size_t)l * DM * INW, INW, DM, (h16*)(ws + WS_WIN) + (size_t)l * PW * DM, kb * 64, n0, orig_col(n0), sc, scr, lane); continue; }
        r -= I_IN;
        if (r < 3 * I_BR) { const int n3 = r / I_BR, q = r % I_BR, nblk = 1024 / 32, kb = q / nblk, nb = q % nblk;
            transpose_item(a.in[8] + ((size_t)l * 3 + n3) * 512 * 1024, 1024, 512, (h16*)(ws + WS_WBR) + ((size_t)l * 3 + n3) * 1024 * 512, kb * 64, nb * 32, nb * 32, 1.f, scr, lane); continue; }
        r -= 3 * I_BR;
        { const int nblk = DM / 32, kb = r / nblk, nb = r % nblk;
          transpose_item(a.in[9] + (size_t)l * DM * DM, DM, DM, (h16*)(ws + WS_WOUT) + (size_t)l * DM * DM, kb * 64, nb * 32, nb * 32, 1.f, scr, lane); }
    }
    float* wsmall = (float*)(ws + WS_WSMALL);
    for (int i = blockIdx.x * NTHREADS + tid_; i < DEPTH * 16 * DM; i += gridDim.x * NTHREADS) {
        const int l = i / (16 * DM), c = (i >> 10) & 15, k = i & 1023;
        wsmall[i] = a.in[2][(size_t)l * DM * INW + (size_t)k * INW + small_col(c)];
    }
}
__device__ __forceinline__ void norm_phase(const float* __restrict__ x, const float* __restrict__ g, const float* __restrict__ wsmall, const float* __restrict__ fox_bf,
                                           const float* __restrict__ ml_bi, const float* __restrict__ ml_bf, h16* __restrict__ hn, float* __restrict__ small, int row0) {
    int tid_ = threadIdx.x; asm volatile("" : "+v"(tid_));
    const int lane = tid_ & 63, gw = blockIdx.x * NWAVES + (tid_ >> 6), NGW = gridDim.x * NWAVES;
    for (int r4 = gw; r4 < TH / 4; r4 += NGW) {
        f32x4 v[4][4];
#pragma unroll
        for (int q = 0; q < 4; ++q) {
            const f32x4* xr = (const f32x4*)(x + (size_t)(row0 + 4 * r4 + q) * DM) + lane;
            float ssq = 0.f;
#pragma unroll
            for (int j = 0; j < 4; ++j) { v[q][j] = xr[64 * j]; ssq += v[q][j].x * v[q][j].x + v[q][j].y * v[q][j].y + v[q][j].z * v[q][j].z + v[q][j].w * v[q][j].w; }
            const float rstd = rsqrtf(wave_sum(ssq) * (1.f / DM) + RMS_EPS);
#pragma unroll
            for (int j = 0; j < 4; ++j) {
                const f32x4 gg = ((const f32x4*)g)[lane + 64 * j];
                v[q][j].x *= rstd * gg.x; v[q][j].y *= rstd * gg.y; v[q][j].z *= rstd * gg.z; v[q][j].w *= rstd * gg.w;
                pg8::u32x4 dummy; (void)dummy;
                typedef unsigned u32x2 __attribute__((ext_vector_type(2)));
                u32x2 o; o.x = pg8::cvt_pk_f16(v[q][j].x, v[q][j].y); o.y = pg8::cvt_pk_f16(v[q][j].z, v[q][j].w);
                *((u32x2*)(hn + (size_t)(4 * r4 + q) * DM) + lane + 64 * j) = o;
            }
        }
        float mine[4] = {0.f, 0.f, 0.f, 0.f};
#pragma unroll 1
        for (int c = 0; c < 16; ++c) {
            const f32x4* wr = (const f32x4*)(wsmall + c * DM) + lane;
            float acc[4] = {0.f, 0.f, 0.f, 0.f};
#pragma unroll
            for (int j = 0; j < 4; ++j) { const f32x4 w = wr[64 * j];
#pragma unroll
                for (int q = 0; q < 4; ++q) acc[q] += v[q][j].x * w.x + v[q][j].y * w.y + v[q][j].z * w.z + v[q][j].w * w.w; }
#pragma unroll
            for (int q = 0; q < 4; ++q) { const float t = wave_sum(acc[q]); if (lane == c) mine[q] = t; }
        }
        if (lane < 16) {
            const float bias = lane < 8 ? fox_bf[lane] : lane < 12 ? ml_bi[lane - 8] : ml_bf[lane - 12];
#pragma unroll
            for (int q = 0; q < 4; ++q) { const float pre = mine[q] + bias; small[(size_t)(row0 + 4 * r4 + q) * 16 + lane] = (lane >= 8 && lane < 12) ? pre : log_sigmoidf_(pre); }
        }
    }
}
__device__ __forceinline__ void final_norm_phase(float* __restrict__ x, const float* __restrict__ g) {
    int tid_ = threadIdx.x; asm volatile("" : "+v"(tid_));
    const int lane = tid_ & 63, gw = blockIdx.x * NWAVES + (tid_ >> 6), NGW = gridDim.x * NWAVES;
    for (int row = gw; row < TT; row += NGW) {
        f32x4* xr = (f32x4*)(x + (size_t)row * DM) + lane;
        f32x4 v[4]; float ssq = 0.f;
#pragma unroll
        for (int j = 0; j < 4; ++j) { v[j] = xr[64 * j]; ssq += v[j].x * v[j].x + v[j].y * v[j].y + v[j].z * v[j].z + v[j].w * v[j].w; }
        const float rstd = rsqrtf(wave_sum(ssq) * (1.f / DM) + RMS_EPS);
#pragma unroll
        for (int j = 0; j < 4; ++j) { const f32x4 gg = ((const f32x4*)g)[lane + 64 * j];
            xr[64 * j] = (f32x4){v[j].x * rstd * gg.x, v[j].y * rstd * gg.y, v[j].z * rstd * gg.z, v[j].w * rstd * gg.w}; }
    }
}

__global__ void __launch_bounds__(NTHREADS, 2) mega(MArgs a) {
    extern __shared__ __attribute__((aligned(16))) unsigned char lds[];
    PG8_LAS unsigned char* L = (PG8_LAS unsigned char*)lds;
    unsigned char* ws = a.ws;
    for (int u = threadIdx.x; u < (MK_LDS_BYTES - LDSCTL_OFF) / 4; u += NTHREADS) ((LAS unsigned*)(L + LDSCTL_OFF))[u] = 0u;
    __syncthreads();
    XcdBarrier bar = xcd_barrier_post((unsigned*)(ws + WS_CTL) + CW_BAR, (volatile LAS unsigned*)(L + MISC_OFF) + 8);
    for (int s = a.s_lo; s < a.s_hi; ++s) {
        if (s == a.s_lo + 1 && a.s_hi > 1000) { __builtin_amdgcn_fence(__ATOMIC_RELEASE, "agent"); cg::this_grid().sync(); __builtin_amdgcn_fence(__ATOMIC_ACQUIRE, "agent"); }
        if (s > a.s_lo) xcd_barrier(bar);
        if (s == 0) { prologue_phase(a, L); barrier_lds(); continue; }
        if (s == N_STEPS - 1) { final_norm_phase(a.out, a.in[10]); continue; }
        const int li = (s - 1) / NPH, ph = (s - 1) % NPH, layer = li >> 1, hf = li & 1;
        const int row0 = hf * TH;
        if (ph == PH_NORM) {
            norm_phase(layer == 0 ? a.in[0] : a.out, a.in[1] + layer * DM, (const float*)(ws + WS_WSMALL) + layer * 16 * DM, a.in[3] + layer * 8, a.in[5] + layer * 4, a.in[6] + layer * 4,
                       (h16*)(ws + WS_HN), (float*)(ws + WS_SMALL), row0);
        } else if (ph == PH_PRE) {
            const int b0 = hf * HB;
            for (int it = blockIdx.x; it < HB * 8; it += gridDim.x) fox_cumsum_item(it, b0, (const float*)(ws + WS_SMALL), (float*)(ws + WS_CB), (char*)lds);
            for (int it = blockIdx.x; it < HB * 64; it += gridDim.x) moba_kmean_item(it, b0, (const h16*)(ws + WS_PROJ), (float*)(ws + WS_KMEAN), (char*)lds);
            {   int tid_ = threadIdx.x; asm volatile("" : "+v"(tid_));
                const int wv = __builtin_amdgcn_readfirstlane(tid_ >> 6), ln = tid_ & 63;
                if (wv < mlstm::NACT) for (int it = blockIdx.x * mlstm::NACT + wv; it < HB * 128; it += gridDim.x * mlstm::NACT)
                    mlstm::x1_wave(it, b0, (const h16*)(ws + WS_PROJ), (const float*)(ws + WS_SMALL), a.in[4] + (size_t)layer * 4 * 512, (h16*)(ws + WS_QKC), (float*)(ws + WS_U),
                                   (float*)(ws + WS_MUN), (float*)(ws + WS_MAMAX), (float*)(ws + WS_MBLAST), (mlstm::lds_ptr)L + wv * mlstm::WREG, ln);
                barrier_lds(); }
        } else if (ph == PH_SCAN) {
            for (int it = blockIdx.x; it < 32 * 8; it += gridDim.x)
                mlstm::x2_item(it, hf * HB, (const float*)(ws + WS_U), (const float*)(ws + WS_MUN), (const float*)(ws + WS_MAMAX), (const float*)(ws + WS_MBLAST),
                               (h16*)(ws + WS_CS), (float*)(ws + WS_MNS), (float*)(ws + WS_MMS), (char*)lds);
        } else if (ph == PH_MIX) {
            const int b0 = hf * HB, G = gridDim.x, bx = blockIdx.x;
            const int vcu = (G % 8 == 0) ? (bx % 8) * (G / 8) + bx / 8 : bx;
            const h16* proj = (const h16*)(ws + WS_PROJ); h16* y = (h16*)(ws + WS_Y);
            for (int v = vcu; v < 256; v += G) {
                const int bh = v >> 2, sidx = v & 3, bl = bh >> 3, h = bh & 7;
                const float* cbp = (const float*)(ws + WS_CB) + (size_t)((b0 + bl) * 8 + h) * SEQ;
                const float* kmp = (const float*)(ws + WS_KMEAN) + (size_t)((b0 + bl) * 8 + h) * 512;
                const float slope2 = exp2f(-(float)(h + 1)) * LOG2E;
#pragma unroll 1
                for (int i = 0; i < 4; ++i) {
                    const int qb = (i < 2) ? 7 - sidx : sidx;
                    if ((i & 1) == 0) attn_body::attn_unit<false, 8>(bl, h, qb, proj + PC_AQ, proj + PC_AK, proj + PC_AV, proj + PC_AZ, y, cbp, 0.f, kmp, (char*)lds);
                    else attn_body::attn_unit<true, 8>(bl, h, qb, proj + PC_BQ, proj + PC_BK, proj + PC_BV, proj + PC_BZ, y + 512, cbp, slope2, kmp, (char*)lds);
                }
            }
            {   int tid_ = threadIdx.x; asm volatile("" : "+v"(tid_));
                const int wv = __builtin_amdgcn_readfirstlane(tid_ >> 6), ln = tid_ & 63;
                if (wv < mlstm::NACT) for (int it = blockIdx.x * mlstm::NACT + wv; it < HB * 128; it += gridDim.x * mlstm::NACT)
                    mlstm::x3_wave(it, b0, proj, (const float*)(ws + WS_SMALL), (const h16*)(ws + WS_QKC), (const h16*)(ws + WS_CS), (const float*)(ws + WS_MNS), (const float*)(ws + WS_MMS),
                                   a.in[7] + (size_t)layer * 512, y, (mlstm::lds_ptr)L + wv * mlstm::WREG, ln);
                barrier_lds(); }
        } else if (ph == PH_PROJ) {
            pg8::Gemm g{(const h16*)(ws + WS_HN), (const h16*)(ws + WS_WIN) + (size_t)layer * PW * DM, DM, DM, DM, 0, 0};
            pg8::StaticOrder S; S.init(TH, PW, gridDim.x, blockIdx.x);
            pg8::EpiF16 E{(h16*)(ws + WS_PROJ), PW};
            pg8::gemm_phase(L, g, S, E);
        } else if (ph == PH_BR) {
            pg8::Gemm g{(const h16*)(ws + WS_Y), (const h16*)(ws + WS_WBR) + (size_t)layer * 3 * 1024 * 512, 1536, 512, 512, 512, 1024 * 512};
            pg8::BranchOrder S; S.init(TH, DM, gridDim.x, blockIdx.x, 3);
            pg8::EpiGate E{(h16*)(ws + WS_MRG), (const h16*)(ws + WS_PROJ) + PC_G, PW};
            pg8::gemm_phase<pg8::EpiGate, pg8::BranchOrder, false>(L, g, S, E);
        } else if (ph == PH_OUT) {
            pg8::Gemm g{(const h16*)(ws + WS_MRG), (const h16*)(ws + WS_WOUT) + (size_t)layer * DM * DM, DM, DM, DM, 0, 0};
            pg8::StaticOrder S; S.init(TH, DM, gridDim.x, blockIdx.x);
            const float* xsrc = layer == 0 ? a.in[0] : a.out;
            pg8::EpiRes E{xsrc + (size_t)row0 * DM, a.out + (size_t)row0 * DM, DM};
            pg8::gemm_phase(L, g, S, E);
        }
    }
}

extern "C" void kernel_launch(void* const* d_in, const int* in_sizes, int n_in, void* d_out, int out_size, void* d_ws, size_t ws_size, hipStream_t stream) {
    if (n_in != 11 || in_sizes[0] != TT * DM || out_size != TT * DM || ws_size < WS_END) {
        fprintf(stderr, "kernel_launch: unexpected shapes / workspace (n_in %d, in0 %d, out %d, ws %zu < %zu)\n", n_in, n_in > 0 ? in_sizes[0] : -1, out_size, ws_size, (size_t)WS_END);
        return;
    }
    static int grid = 0;
    if (grid == 0) {
        int dev = 0, cus = 0, per_cu = 0;
        hipGetDevice(&dev);
        hipDeviceGetAttribute(&cus, hipDeviceAttributeMultiprocessorCount, dev);
        if (hipFuncSetAttribute((const void*)mega, hipFuncAttributeMaxDynamicSharedMemorySize, MK_LDS_BYTES) != hipSuccess) fprintf(stderr, "kernel_launch: hipFuncSetAttribute failed\n");
        if (hipOccupancyMaxActiveBlocksPerMultiprocessor(&per_cu, (const void*)mega, NTHREADS, MK_LDS_BYTES) != hipSuccess || per_cu < 1) { fprintf(stderr, "kernel_launch: occupancy query says %d blocks per CU\n", per_cu); per_cu = 1; }
        (void)hipGetLastError();
        grid = cus;
        if (grid != 256) fprintf(stderr, "kernel_launch: note: %d CUs (tuned for 256)\n", grid);
    }
    MArgs ma{};
    for (int i = 0; i < 11; ++i) ma.in[i] = (const float*)d_in[i];
    ma.out = (float*)d_out; ma.ws = (unsigned char*)d_ws; ma.s_lo = 0; ma.s_hi = N_STEPS;
    if (hipMemsetAsync((char*)d_ws + WS_CTL, 0, CTL_ZERO_BYTES, stream) != hipSuccess) { fprintf(stderr, "kernel_launch: hipMemsetAsync of the control words failed\n"); return; }
    void* args[] = {&ma};
    hipError_t e = hipLaunchCooperativeKernel((const void*)mega, dim3(grid), dim3(NTHREADS), args, MK_LDS_BYTES, stream);
    if (e != hipSuccess) fprintf(stderr, "kernel_launch: cooperative launch failed: %s (grid %d)\n", hipGetErrorString(e), grid);
}
```

```cpp
#include <hip/hip_runtime.h>
#include <hip/hip_cooperative_groups.h>
#include <cstdio>
#include <cstdint>

namespace cg = cooperative_groups;
typedef _Float16 h16;
typedef _Float16 h16x4 __attribute__((ext_vector_type(4)));
typedef _Float16 h16x8 __attribute__((ext_vector_type(8)));
typedef float f32x4 __attribute__((ext_vector_type(4)));

constexpr int DM = 1024, BATCH = 16, SEQ = 2048, DEPTH = 2;
constexpr int TT = BATCH * SEQ;
constexpr int HB = 8;
constexpr int TH = HB * SEQ;
constexpr int INW = 9232;
constexpr int PW = 9216;
constexpr float RMS_EPS = 1e-6f;
constexpr float LOG2E = 1.4426950408889634f;
constexpr float C2 = 0.125f * LOG2E;
constexpr int PC_AQ = 0, PC_AK = 512, PC_AV = 1024, PC_AZ = 1536, PC_BQ = 2048, PC_BK = 2560, PC_BV = 3072, PC_BZ = 3584,
              PC_CQK = 4096, PC_CV = 4608, PC_CO = 5120, PC_CZ = 5632, PC_G = 6144;
__host__ __device__ inline int orig_col(int j) { return j < 2048 ? j : (j < 6144 ? j + 8 : j + 16); }
__host__ __device__ inline int small_col(int c) { return c < 8 ? 2048 + c : 6152 + (c - 8); }

constexpr size_t MiB = 1u << 20;
constexpr size_t WS_CTL = 0;
constexpr size_t WS_WSMALL = 512 * 1024;
constexpr size_t WS_SMALL = 1 * MiB;
constexpr size_t WS_CB = 3 * MiB;
constexpr size_t WS_KMEAN = 4 * MiB;
constexpr size_t WS_MSC = 5 * MiB;
constexpr size_t WS_MUN = WS_MSC, WS_MNS = WS_MSC + 512 * 1024;
constexpr size_t WS_MAMAX = 4 * MiB + 512 * 1024, WS_MBLAST = WS_MAMAX + 8192, WS_MMS = WS_MAMAX + 16384;
constexpr size_t WS_WBR = 6 * MiB;
constexpr size_t WS_WOUT = 12 * MiB;
constexpr size_t WS_WIN = 16 * MiB;
constexpr size_t WS_HN = 52 * MiB;
constexpr size_t WS_Y = 84 * MiB;
constexpr size_t WS_MRG = WS_HN;
constexpr size_t WS_U = 132 * MiB;
constexpr size_t WS_CS = 164 * MiB;
constexpr size_t WS_QKC = 180 * MiB;
constexpr size_t WS_PROJ = 196 * MiB;
constexpr size_t WS_END = 484 * MiB;

__device__ __forceinline__ float sigmoidf_(float x) { return 1.f / (1.f + __expf(-x)); }
__device__ __forceinline__ float siluf_(float x) { return x / (1.f + __expf(-x)); }
__device__ __forceinline__ float log_sigmoidf_(float x) {
    const float e = __expf(-fabsf(x)); const float l = e < 0.01f ? e * (1.f - 0.5f * e + 0.33333334f * e * e) : __logf(1.f + e); return fminf(x, 0.f) - l; }
template <int M> __device__ __forceinline__ float swz_xor(float v) { return __int_as_float(__builtin_amdgcn_ds_swizzle(__float_as_int(v), (M << 10) | 0x1f)); }
__device__ __forceinline__ float half_sum(float v) { auto rr = __builtin_amdgcn_permlane32_swap(__float_as_uint(v), __float_as_uint(v), false, false); return __uint_as_float(rr[0]) + __uint_as_float(rr[1]); }
__device__ __forceinline__ float shfl_idx(float x, int srclane) { return __int_as_float(__builtin_amdgcn_ds_bpermute(srclane << 2, __float_as_int(x))); }
__device__ __forceinline__ float wave_sum(float v) {
    v += swz_xor<1>(v); v += swz_xor<2>(v); v += swz_xor<4>(v); v += swz_xor<8>(v); v += swz_xor<16>(v);
    return half_sum(v);
}

__global__ void nv_convert_t(const float* __restrict__ src, int ldsrc, int K, h16* __restrict__ dst, int Nd, int mode) {
    __shared__ float tile[32][33];
    const int tx = threadIdx.x & 31, ty = threadIdx.x >> 5;
    const int j0 = blockIdx.x * 32, k0 = blockIdx.y * 32;
#pragma unroll
    for (int i = 0; i < 4; ++i) {
        const int k = k0 + ty + 8 * i, j = j0 + tx;
        const int sc = mode == 1 ? orig_col(j) : j;
        tile[ty + 8 * i][tx] = src[(size_t)k * ldsrc + sc];
    }
    __syncthreads();
#pragma unroll
    for (int i = 0; i < 4; ++i) {
        const int j = j0 + ty + 8 * i, k = k0 + tx;
        float v = tile[tx][ty + 8 * i];
        if (mode == 1 && ((j >= PC_AQ && j < PC_AQ + 512) || (j >= PC_BQ && j < PC_BQ + 512))) v *= C2;
        dst[(size_t)j * K + k] = (h16)v;
    }
}

__global__ void nv_small_w(const float* __restrict__ w_in, float* __restrict__ wsmall) {
    const int i = blockIdx.x * blockDim.x + threadIdx.x;
    if (i >= 16 * DM) return;
    const int c = i >> 10, k = i & 1023;
    wsmall[i] = w_in[(size_t)k * INW + small_col(c)];
}
__global__ void __launch_bounds__(256) nv_rmsnorm_small(const float* __restrict__ x, const float* __restrict__ g, const float* __restrict__ wsmall  ,
                                 const float* __restrict__ fox_bf, const float* __restrict__ ml_bi, const float* __restrict__ ml_bf,
                                 h16* __restrict__ hn, float* __restrict__ small, int row0, int nrows) {
    const int lane = threadIdx.x & 63, wv = (blockIdx.x * blockDim.x + threadIdx.x) >> 6, nw = (gridDim.x * blockDim.x) >> 6;
    for (int r = wv; r < nrows; r += nw) {
        const int row = row0 + r;
        const f32x4* xr = (const f32x4*)(x + (size_t)row * DM) + lane;
        f32x4 v[4]; float s = 0.f;
#pragma unroll
        for (int j = 0; j < 4; ++j) { v[j] = xr[64 * j]; s += v[j].x * v[j].x + v[j].y * v[j].y + v[j].z * v[j].z + v[j].w * v[j].w; }
        const float rstd = rsqrtf(wave_sum(s) * (1.f / DM) + RMS_EPS);
#pragma unroll
        for (int j = 0; j < 4; ++j) {
            const f32x4 gg = ((const f32x4*)g)[lane + 64 * j];
            v[j].x *= rstd * gg.x; v[j].y *= rstd * gg.y; v[j].z *= rstd * gg.z; v[j].w *= rstd * gg.w;
            h16x4 o = {(h16)v[j].x, (h16)v[j].y, (h16)v[j].z, (h16)v[j].w};
            *((h16x4*)(hn + (size_t)r * DM) + lane + 64 * j) = o;
        }
        float mine = 0.f;
#pragma unroll 1
        for (int c = 0; c < 16; ++c) {
            const f32x4* wr = (const f32x4*)(wsmall + c * DM) + lane;
            float a = 0.f;
#pragma unroll
            for (int j = 0; j < 4; ++j) { const f32x4 w = wr[64 * j]; a += v[j].x * w.x + v[j].y * w.y + v[j].z * w.z + v[j].w * w.w; }
            a = wave_sum(a);
            if (lane == c) mine = a;
        }
        if (lane < 16) {
            float o;
            if (lane < 8) o = log_sigmoidf_(mine + fox_bf[lane]);
            else if (lane < 12) o = mine + ml_bi[lane - 8];
            else o = log_sigmoidf_(mine + ml_bf[lane - 12]);
            small[(size_t)row * 16 + lane] = o;
        }
    }
}

struct GemmArgs {
    const h16* A; int lda; const h16* Bt; int ldb; int K;
    h16* C; int ldc;
    const h16* gates; int ldg;
    const float* xin; float* xout;
};
template <int EPI>
__global__ void __launch_bounds__(256) nv_gemm(GemmArgs g) {
    __shared__ float As[16][68], Bs[16][68];
    const int tid = threadIdx.x, tx = tid & 15, ty = tid >> 4;
    const int m0 = blockIdx.y * 64, n0 = blockIdx.x * 64;
    float res[4][4];
#pragma unroll
    for (int i = 0; i < 4; ++i)
#pragma unroll
        for (int j = 0; j < 4; ++j) res[i][j] = 0.f;
    const int NB = EPI == 1 ? 3 : 1;
    for (int nb = 0; nb < NB; ++nb) {
        float acc[4][4];
#pragma unroll
        for (int i = 0; i < 4; ++i)
#pragma unroll
            for (int j = 0; j < 4; ++j) acc[i][j] = 0.f;
        const h16* A = g.A + (EPI == 1 ? nb * 512 : 0);
        const h16* Bt = g.Bt + (EPI == 1 ? (size_t)nb * 1024 * 512 : 0);
        const int lr = tid >> 2, lk = (tid & 3) * 4;
        for (int k0 = 0; k0 < g.K; k0 += 16) {
            const h16x4 av = *(const h16x4*)(A + (size_t)(m0 + lr) * g.lda + k0 + lk);
            const h16x4 bv = *(const h16x4*)(Bt + (size_t)(n0 + lr) * g.ldb + k0 + lk);
            __syncthreads();
#pragma unroll
            for (int e = 0; e < 4; ++e) { As[lk + e][lr] = (float)av[e]; Bs[lk + e][lr] = (float)bv[e]; }
            __syncthreads();
#pragma unroll
            for (int kk = 0; kk < 16; ++kk) {
                float a[4], b[4];
#pragma unroll
                for (int i = 0; i < 4; ++i) { a[i] = As[kk][ty * 4 + i]; b[i] = Bs[kk][tx * 4 + i]; }
#pragma unroll
                for (int i = 0; i < 4; ++i)
#pragma unroll
                    for (int j = 0; j < 4; ++j) acc[i][j] += a[i] * b[j];
            }
        }
#pragma unroll
        for (int i = 0; i < 4; ++i)
#pragma unroll
            for (int j = 0; j < 4; ++j) {
                if (EPI == 1) {
                    const int m = m0 + ty * 4 + i, n = n0 + tx * 4 + j;
                    const float gt = (float)g.gates[(size_t)m * g.ldg + nb * 1024 + n];
                    res[i][j] += sigmoidf_(gt) * acc[i][j];
                } else res[i][j] = acc[i][j];
            }
    }
#pragma unroll
    for (int i = 0; i < 4; ++i)
#pragma unroll
        for (int j = 0; j < 4; ++j) {
            const int m = m0 + ty * 4 + i, n = n0 + tx * 4 + j;
            if (EPI == 2) g.xout[(size_t)m * DM + n] = g.xin[(size_t)m * DM + n] + res[i][j];
            else g.C[(size_t)m * g.ldc + n] = (h16)res[i][j];
        }
}

__global__ void nv_fox_cumsum(const float* __restrict__ small, float* __restrict__ cb, int b0) {
    const int i = blockIdx.x * blockDim.x + threadIdx.x;
    if (i >= HB * 8) return;
    const int bl = i >> 3, h = i & 7;
    const float* s = small + (size_t)(b0 + bl) * SEQ * 16 + h;
    float* o = cb + (size_t)((b0 + bl) * 8 + h) * SEQ;
    float c = 0.f;
    for (int t = 0; t < SEQ; ++t) { c += s[(size_t)t * 16]; o[t] = -c * LOG2E; }
}
__global__ void nv_moba_kmean(const h16* __restrict__ proj, float* __restrict__ kmean, int b0) {
    const int i = blockIdx.x * blockDim.x + threadIdx.x;
    if (i >= HB * 8 * 512) return;
    const int col = i & 511, blk = (i >> 9) & 7, bl = i >> 12;
    const h16* p = proj + (size_t)(bl * SEQ + blk * 256) * PW + PC_BK + col;
    float s = 0.f;
    for (int t = 0; t < 256; ++t) s += (float)p[(size_t)t * PW];
    const int h = col >> 6, d = col & 63;
    kmean[(((size_t)(b0 + bl) * 8 + h) * 8 + blk) * 64 + d] = s * (1.f / 256.f);
}

__global__ void __launch_bounds__(256) nv_fox_attn(const h16* __restrict__ proj, const float* __restrict__ cb, h16* __restrict__ y, int b0) {
    const int bh = blockIdx.y, bl = bh >> 3, h = bh & 7;
    const int t = blockIdx.x * 256 + threadIdx.x;
    const size_t rowb = (size_t)bl * SEQ;
    float q[64], o[64];
    {
        const h16* qp = proj + (rowb + t) * PW + PC_AQ + h * 64;
#pragma unroll
        for (int d = 0; d < 64; ++d) { q[d] = (float)qp[d]; o[d] = 0.f; }
    }
    const float* cbh = cb + (size_t)((b0 + bl) * 8 + h) * SEQ;
    float m = -INFINITY, l = 0.f;
    const int send = blockIdx.x * 256 + 255;
    for (int s = 0; s <= send; ++s) {
        const h16* kp = proj + (rowb + s) * PW + PC_AK + h * 64;
        const h16* vp = proj + (rowb + s) * PW + PC_AV + h * 64;
        float sd = 0.f;
#pragma unroll
        for (int d = 0; d < 64; ++d) sd += q[d] * (float)kp[d];
        sd += cbh[s];
        if (s <= t) {
            const float mn = fmaxf(m, sd), al = exp2f(m - mn), p = exp2f(sd - mn);
            l = l * al + p;
#pragma unroll
            for (int d = 0; d < 64; ++d) o[d] = o[d] * al + p * (float)vp[d];
            m = mn;
        }
    }
    const float il = 1.f / l;
    const h16* zp = proj + (rowb + t) * PW + PC_AZ + h * 64;
    h16* yp = y + (rowb + t) * 1536 + h * 64;
#pragma unroll
    for (int d = 0; d < 64; ++d) yp[d] = (h16)(o[d] * il * siluf_((float)zp[d]));
}

__global__ void __launch_bounds__(256) nv_moba_attn(const h16* __restrict__ proj, const float* __restrict__ kmean, h16* __restrict__ y, int b0) {
    const int bh = blockIdx.y, bl = bh >> 3, h = bh & 7;
    const int own = blockIdx.x;
    const int t = own * 256 + threadIdx.x;
    const size_t rowb = (size_t)bl * SEQ;
    float q[64], o[64];
    {
        const h16* qp = proj + (rowb + t) * PW + PC_BQ + h * 64;
#pragma unroll
        for (int d = 0; d < 64; ++d) { q[d] = (float)qp[d]; o[d] = 0.f; }
    }
    unsigned selmask = 0;
    if (own <= 3) selmask = (1u << own) - 1u;
    else {
        float gate[8];
        const float* km = kmean + ((size_t)(b0 + bl) * 8 + h) * 8 * 64;
#pragma unroll
        for (int n = 0; n < 8; ++n) {
            float sd = 0.f;
#pragma unroll
            for (int d = 0; d < 64; ++d) sd += q[d] * km[n * 64 + d];
            gate[n] = n < own ? sd : -INFINITY;
        }
        for (int r = 0; r < 3; ++r) {
            float best = -INFINITY; int bi = -1;
#pragma unroll
            for (int n = 0; n < 8; ++n) { const bool free_ = !((selmask >> n) & 1u); if (free_ && n < own && gate[n] > best) { best = gate[n]; bi = n; } }
            if (bi >= 0) selmask |= 1u << bi;
        }
    }
    const float slope2 = exp2f(-(float)(h + 1)) * LOG2E;
    float m = -INFINITY, l = 0.f;
    for (int n = 0; n <= own; ++n) {
        const bool isown = n == own;
        const bool sel = isown || ((selmask >> n) & 1u);
        for (int ss = 0; ss < 256; ++ss) {
            const int s = n * 256 + ss;
            const h16* kp = proj + (rowb + s) * PW + PC_BK + h * 64;
            const h16* vp = proj + (rowb + s) * PW + PC_BV + h * 64;
            if (sel && s <= t) {
                float sd = 0.f;
#pragma unroll
                for (int d = 0; d < 64; ++d) sd += q[d] * (float)kp[d];
                sd -= slope2 * (float)(t - s);
                const float mn = fmaxf(m, sd), al = exp2f(m - mn), p = exp2f(sd - mn);
                l = l * al + p;
#pragma unroll
                for (int d = 0; d < 64; ++d) o[d] = o[d] * al + p * (float)vp[d];
                m = mn;
            }
        }
    }
    const float il = 1.f / l;
    const h16* zp = proj + (rowb + t) * PW + PC_BZ + h * 64;
    h16* yp = y + (rowb + t) * 1536 + 512 + h * 64;
#pragma unroll
    for (int d = 0; d < 64; ++d) yp[d] = (h16)(o[d] * il * siluf_((float)zp[d]));
}

__global__ void __launch_bounds__(256) nv_mlstm(const h16* __restrict__ proj, const float* __restrict__ small, const float* __restrict__ convw  ,
                                                const float* __restrict__ headg  , h16* __restrict__ y, int b0) {
    __shared__ float qk[128];
    __shared__ float red[4];
    const int bl = blockIdx.x >> 2, hh = blockIdx.x & 3, tid = threadIdx.x, v = tid >> 1, kh = tid & 1;
    const size_t rowb = (size_t)bl * SEQ;
    float C[32], nn[32];
#pragma unroll
    for (int j = 0; j < 32; ++j) { C[j] = 0.f; nn[j] = 0.f; }
    float m = 0.f;
    const int ccol = tid < 64 ? hh * 64 + tid : 256 + hh * 64 + (tid - 64);
    float cw[4] = {0.f, 0.f, 0.f, 0.f};
    if (tid < 128) {
#pragma unroll
        for (int j = 0; j < 4; ++j) cw[j] = convw[j * 512 + ccol];
    }
    const float hg = headg[hh * 128 + v];
    for (int t = 0; t < SEQ; ++t) {
        if (tid < 128) {
            float a = 0.f;
#pragma unroll
            for (int j = 0; j < 4; ++j) { const int tt = t - 3 + j; if (tt >= 0) a += cw[j] * (float)proj[(rowb + tt) * PW + PC_CQK + ccol]; }
            a = siluf_(a);
            if (tid >= 64) a *= 0.125f;
            qk[tid] = a;
        }
        __syncthreads();
        const size_t row = rowb + t;
        const float li = small[((size_t)b0 * SEQ + row) * 16 + 8 + hh], lf = small[((size_t)b0 * SEQ + row) * 16 + 12 + hh];
        const float vt = (float)proj[row * PW + PC_CV + hh * 128 + v];
        const float mn = fmaxf(lf + m, li), fw = __expf(lf + m - mn), iw = __expf(li - mn);
        float nump = 0.f, denp = 0.f;
#pragma unroll
        for (int j = 0; j < 32; ++j) {
            const float kj = qk[64 + kh * 32 + j], qj = qk[kh * 32 + j];
            C[j] = fw * C[j] + iw * vt * kj; nn[j] = fw * nn[j] + iw * kj;
            nump += C[j] * qj; denp += nn[j] * qj;
        }
        nump += __shfl_xor(nump, 1); denp += __shfl_xor(denp, 1);
        m = mn;
        const float hval = nump / fmaxf(fabsf(denp), __expf(-mn));
        const float hgt = hval * sigmoidf_((float)proj[row * PW + PC_CO + hh * 128 + v]);
        float ss = kh == 0 ? hgt * hgt : 0.f;
        ss = wave_sum(ss);
        if ((tid & 63) == 0) red[tid >> 6] = ss;
        __syncthreads();
        const float tot = red[0] + red[1] + red[2] + red[3];
        if (kh == 0) {
            const float o = hgt * rsqrtf(tot * (1.f / 128.f) + RMS_EPS) * hg * siluf_((float)proj[row * PW + PC_CZ + hh * 128 + v]);
            y[row * 1536 + 1024 + hh * 128 + v] = (h16)o;
        }
    }
}

__global__ void nv_final_norm(float* __restrict__ x, const float* __restrict__ g) {
    const int lane = threadIdx.x & 63, wv = (blockIdx.x * blockDim.x + threadIdx.x) >> 6, nw = (gridDim.x * blockDim.x) >> 6;
    for (int row = wv; row < TT; row += nw) {
        f32x4* xr = (f32x4*)(x + (size_t)row * DM) + lane;
        f32x4 v[4]; float s = 0.f;
#pragma unroll
        for (int j = 0; j < 4; ++j) { v[j] = xr[64 * j]; s += v[j].x * v[j].x + v[j].y * v[j].y + v[j].z * v[j].z + v[j].w * v[j].w; }
        const float rstd = rsqrtf(wave_sum(s) * (1.f / DM) + RMS_EPS);
#pragma unroll
        for (int j = 0; j < 4; ++j) {
            const f32x4 gg = ((const f32x4*)g)[lane + 64 * j];
            f32x4 o = {v[j].x * rstd * gg.x, v[j].y * rstd * gg.y, v[j].z * rstd * gg.z, v[j].w * rstd * gg.w};
            xr[64 * j] = o;
        }
    }
}


namespace pg8 {
#define PG8_LAS __attribute__((address_space(3)))
typedef short s16x8 __attribute__((ext_vector_type(8)));
typedef unsigned u32x4 __attribute__((ext_vector_type(4)));
typedef float f32x2 __attribute__((ext_vector_type(2)));
typedef _Float16 h16x2 __attribute__((ext_vector_type(2)));
constexpr int BM = 256, BK = 64, HALF = 128, HTB = HALF * BK * 2  , STAGE_BYTES = 8 * HTB, NXCD = 8, WGM = 8;
__host__ __device__ __forceinline__ int lds_byte(int r, int c) { const int st = (r >> 4) * 2 + (c >> 5), rr = r & 15, cc = c & 31, ob = rr * 64 + cc * 2; return st * 1024 + (ob ^ (((ob >> 9) & 1) << 5)); }
__host__ __device__ __forceinline__ void stage_rc(int b, int& R, int& C) { const int st = b / 1024, sb = b % 1024, swz = sb ^ (((sb >> 9) & 1) << 5); R = (st >> 1) * 16 + swz / 64; C = (st & 1) * 32 + (swz % 64) / 2; }
__host__ __device__ __forceinline__ int perm32(int rho) { const int n = rho >> 4, i = rho & 15; return 8 * (i >> 2) + 4 * n + (i & 3); }
__device__ __forceinline__ unsigned cvt_pk_f16(float lo, float hi) { f32x2 v = {lo, hi}; h16x2 b = __builtin_convertvector(v, h16x2); return __builtin_bit_cast(unsigned, b); }

struct Unit { int pm, pn, z; };
struct Gemm { const h16* A; const h16* Bt; int lda, ldb, K; long zA, zB; };

__device__ __forceinline__ void tile_of(int L, int nM, int nN, int& pm, int& pn) {
    const int nwg = nM * nN; int wgid = L;
    { const int q = nwg / NXCD, r = nwg % NXCD, xcd = wgid % NXCD, off = wgid / NXCD; wgid = (xcd < r ? xcd * (q + 1) : r * (q + 1) + (xcd - r) * q) + off; }
    const int nig = WGM * nN, gid = wgid / nig, fm = gid * WGM, gsz = (nM - fm) < WGM ? (nM - fm) : WGM;
    pm = fm + ((wgid % nig) % gsz); pn = (wgid % nig) / gsz;
}
struct StaticOrder {
    int nM, nN, nwg, G, c;
    __device__ void init(int M, int N, int G_, int c_) { nM = M / BM; nN = N / BM; nwg = nM * nN; G = G_; c = c_; }
    __device__ bool next(int i, Unit& u) const { const long L = (long)i * G + c; if (L >= nwg) return false; tile_of((int)L, nM, nN, u.pm, u.pn); u.z = 0; return true; }
};
struct BranchOrder {
    int nM, nN, nwg, G, c, NZ;
    __device__ void init(int M, int N, int G_, int c_, int nz) { nM = M / BM; nN = N / BM; nwg = nM * nN; G = G_; c = c_; NZ = nz; }
    __device__ bool next(int i, Unit& u) const { const int j = i / NZ; const long L = (long)j * G + c; if (L >= nwg) return false; tile_of((int)L, nM, nN, u.pm, u.pn); u.z = i - j * NZ; return true; }
};

struct EpiF16 {
    static constexpr bool PERM = true;
    h16* C; int ldc;
    __device__ __forceinline__ void operator()(const f32x4 (&acc)[2][2][4][2], const Unit& u, int wr, int wc, int fr, int fq) const {
        const int row0 = u.pm * BM + wr * 64 + fr, col0 = u.pn * BM + wc * 32 + 8 * fq;
#pragma unroll
        for (int ai = 0; ai < 2; ++ai)
#pragma unroll
            for (int m = 0; m < 4; ++m) { h16* rowp = C + (size_t)(row0 + ai * HALF + m * 16) * ldc + col0;
#pragma unroll
                for (int bj = 0; bj < 2; ++bj) { const f32x4 v0 = acc[ai][bj][m][0], v1 = acc[ai][bj][m][1];
                    u32x4 w; w.x = cvt_pk_f16(v0[0], v0[1]); w.y = cvt_pk_f16(v0[2], v0[3]); w.z = cvt_pk_f16(v1[0], v1[1]); w.w = cvt_pk_f16(v1[2], v1[3]);
                    *(u32x4*)(rowp + bj * HALF) = w; } }
    }
};
struct EpiGate {
    static constexpr bool PERM = true;
    h16* Mg; const h16* G; int ldg;
    __device__ __forceinline__ void operator()(const f32x4 (&acc)[2][2][4][2], const Unit& u, int wr, int wc, int fr, int fq) const {
        const int row0 = u.pm * BM + wr * 64 + fr, col0 = u.pn * BM + wc * 32 + 8 * fq;
#pragma unroll
        for (int ai = 0; ai < 2; ++ai)
#pragma unroll
            for (int mp = 0; mp < 2; ++mp) {
                h16x8 gv[2][2], pv[2][2];
#pragma unroll
                for (int mm = 0; mm < 2; ++mm)
#pragma unroll
                    for (int bj = 0; bj < 2; ++bj) { const size_t row = (size_t)(row0 + ai * HALF + (2 * mp + mm) * 16);
                        gv[mm][bj] = *(const h16x8*)(G + row * ldg + u.z * 1024 + col0 + bj * HALF);
                        if (u.z > 0) pv[mm][bj] = *(const h16x8*)(Mg + row * 1024 + col0 + bj * HALF); }
#pragma unroll
                for (int mm = 0; mm < 2; ++mm)
#pragma unroll
                    for (int bj = 0; bj < 2; ++bj) { const int m = 2 * mp + mm; const size_t row = (size_t)(row0 + ai * HALF + m * 16);
                        float o[8];
#pragma unroll
                        for (int e = 0; e < 8; ++e) { const float a = e < 4 ? acc[ai][bj][m][0][e] : acc[ai][bj][m][1][e - 4]; o[e] = a * __builtin_amdgcn_rcpf(1.f + __expf(-(float)gv[mm][bj][e])); }
                        if (u.z > 0) {
#pragma unroll
                            for (int e = 0; e < 8; ++e) o[e] += (float)pv[mm][bj][e]; }
                        u32x4 w; w.x = cvt_pk_f16(o[0], o[1]); w.y = cvt_pk_f16(o[2], o[3]); w.z = cvt_pk_f16(o[4], o[5]); w.w = cvt_pk_f16(o[6], o[7]);
                        *(u32x4*)(Mg + row * 1024 + col0 + bj * HALF) = w; }
            }
    }
};
struct EpiRes {
    static constexpr bool PERM = false;
    const float* xin; float* out; int ldc;
    __device__ __forceinline__ void operator()(const f32x4 (&acc)[2][2][4][2], const Unit& u, int wr, int wc, int fr, int fq) const {
        const int row0 = u.pm * BM + wr * 64 + fr, col0 = u.pn * BM + wc * 32 + 4 * fq;
#pragma unroll
        for (int ai = 0; ai < 2; ++ai)
#pragma unroll
            for (int mp = 0; mp < 2; ++mp) {
                f32x4 xv[2][2][2];
#pragma unroll
                for (int mm = 0; mm < 2; ++mm) { const size_t off = (size_t)(row0 + ai * HALF + (2 * mp + mm) * 16) * ldc + col0;
#pragma unroll
                    for (int bj = 0; bj < 2; ++bj)
#pragma unroll
                        for (int n = 0; n < 2; ++n) xv[mm][bj][n] = *(const f32x4*)(xin + off + bj * HALF + n * 16); }
#pragma unroll
                for (int mm = 0; mm < 2; ++mm) { const int m = 2 * mp + mm; const size_t off = (size_t)(row0 + ai * HALF + m * 16) * ldc + col0;
#pragma unroll
                    for (int bj = 0; bj < 2; ++bj)
#pragma unroll
                        for (int n = 0; n < 2; ++n) *(f32x4*)(out + off + bj * HALF + n * 16) = xv[mm][bj][n] + acc[ai][bj][m][n]; }
            }
    }
};

template <class Epi, class Sched, bool ALIGN_EPI = true>
__device__ __forceinline__ void gemm_phase(PG8_LAS unsigned char* lds, const Gemm g, const Sched& S, const Epi& E) {
    int tid_ = threadIdx.x; asm volatile("" : "+v"(tid_));
    const int tid = tid_, wid = __builtin_amdgcn_readfirstlane(tid >> 6), lane = tid & 63, wr = wid >> 2, wc = wid & 3, fr = lane & 15, fq = lane >> 4;
    const int nt = g.K / BK;
    unsigned voffA[2], voffB[2];
#pragma unroll
    for (int i = 0; i < 2; ++i) { int R, C; stage_rc(tid * 16 + i * 8192, R, C); const int Rb = Epi::PERM ? ((R & ~31) + perm32(R & 31)) : R;
        voffA[i] = (unsigned)(R * g.lda + C) * 2u; voffB[i] = (unsigned)(Rb * g.ldb + C) * 2u; }
    const size_t kstep = (size_t)(BK * 2);
    const size_t hA = (size_t)HALF * g.lda * 2, hB = (size_t)HALF * g.ldb * 2;
    const size_t tA = 2 * hA, tB = 2 * hB;
    const unsigned ldsw = (unsigned)wid * 1024u;
    const int aoff = lds_byte(wr * 64 + fr, fq * 8), boff = lds_byte(wc * 32 + fr, fq * 8);
#define PG8_SA(b, h) (((b) * 2 + (h)) * HTB)
#define PG8_SB(b, h) ((4 + (b) * 2 + (h)) * HTB)
#define PG8_STAGE(bufoff, gbase, voff) do { _Pragma("unroll") for (int _i = 0; _i < 2; ++_i) \
        __builtin_amdgcn_global_load_lds((const unsigned*)((const char*)(gbase) + (voff)[_i]), (PG8_LAS unsigned*)(lds + (bufoff) + ldsw + _i * 8192), 16, 0, 0); } while (0)
#define PG8_LDA(dst, b, h) do { _Pragma("unroll") for (int m = 0; m < 4; ++m) _Pragma("unroll") for (int k = 0; k < 2; ++k) dst[m][k] = *(const PG8_LAS s16x8*)(lds + PG8_SA(b, h) + aoff + m * 2048 + k * 1024); } while (0)
#define PG8_LDB(dst, b, h) do { _Pragma("unroll") for (int n = 0; n < 2; ++n) _Pragma("unroll") for (int k = 0; k < 2; ++k) dst[n][k] = *(const PG8_LAS s16x8*)(lds + PG8_SB(b, h) + boff + n * 2048 + k * 1024); } while (0)
#define PG8_MMA(ai, bj, At, Bt) do { __builtin_amdgcn_s_setprio(1); _Pragma("unroll") for (int m = 0; m < 4; ++m) _Pragma("unroll") for (int n = 0; n < 2; ++n) _Pragma("unroll") for (int k = 0; k < 2; ++k) \
        acc[ai][bj][m][n] = __builtin_amdgcn_mfma_f32_16x16x32_f16(__builtin_bit_cast(h16x8, Bt[n][k]), __builtin_bit_cast(h16x8, At[m][k]), acc[ai][bj][m][n], 0, 0, 0); __builtin_amdgcn_s_setprio(0); } while (0)
#define PG8_WAIT_V(n) asm volatile("s_waitcnt vmcnt(" #n ")" ::: "memory")
#define PG8_WAIT_L(n) asm volatile("s_waitcnt lgkmcnt(" #n ")" ::: "memory")
#define PG8_BAR __builtin_amdgcn_s_barrier()
#define PG8_SCHED __builtin_amdgcn_sched_barrier(0)
    Unit cur, nxt; int ui = 0;
    if (!S.next(0, cur)) return;
    f32x4 acc[2][2][4][2];
#pragma unroll
    for (int a = 0; a < 2; ++a)
#pragma unroll
        for (int b = 0; b < 2; ++b)
#pragma unroll
            for (int m = 0; m < 4; ++m)
#pragma unroll
                for (int n = 0; n < 2; ++n) acc[a][b][m][n] = (f32x4){0.f, 0.f, 0.f, 0.f};
    s16x8 At[4][2], B0[2][2], B1[2][2];
    const char* cA = (const char*)(g.A + (long)cur.z * g.zA) + (size_t)cur.pm * tA; const char* cB = (const char*)(g.Bt + (long)cur.z * g.zB) + (size_t)cur.pn * tB;
    PG8_STAGE(PG8_SB(0, 0), cB, voffB); PG8_STAGE(PG8_SB(0, 1), cB + hB, voffB); PG8_STAGE(PG8_SA(0, 0), cA, voffA); PG8_STAGE(PG8_SA(0, 1), cA + hA, voffA);
    if (wr == 1) PG8_BAR;
    PG8_WAIT_V(2); PG8_BAR;
    PG8_STAGE(PG8_SB(1, 0), cB + kstep, voffB); PG8_STAGE(PG8_SA(1, 0), cA + kstep, voffA); PG8_STAGE(PG8_SB(1, 1), cB + hB + kstep, voffB);
    PG8_WAIT_V(6); PG8_BAR;
    for (;;) {
        const bool has_next = S.next(ui + 1, nxt);
        const char* nA = has_next ? (const char*)(g.A + (long)nxt.z * g.zA) + (size_t)nxt.pm * tA : cA; const char* nB = has_next ? (const char*)(g.Bt + (long)nxt.z * g.zB) + (size_t)nxt.pn * tB : cB;
        for (int t = 0; t < nt; t += 2) {
            const bool last = (t == nt - 2);
            const char* a1 = cA + (size_t)(t + 1) * kstep;
            const char* a2 = last ? nA : cA + (size_t)(t + 2) * kstep; const char* b2 = last ? nB : cB + (size_t)(t + 2) * kstep;
            const char* a3 = a2 + kstep; const char* b3 = b2 + kstep;
            PG8_LDB(B0, 0, 0); PG8_LDB(B1, 0, 1); PG8_SCHED; PG8_LDA(At, 0, 0); PG8_STAGE(PG8_SA(1, 1), a1 + hA, voffA);
            PG8_WAIT_V(8); PG8_WAIT_L(0); PG8_BAR; PG8_MMA(0, 0, At, B0); PG8_MMA(0, 1, At, B1); PG8_BAR; PG8_SCHED;
            PG8_LDA(At, 0, 1); PG8_STAGE(PG8_SB(0, 0), b2, voffB); PG8_STAGE(PG8_SB(0, 1), b2 + hB, voffB); PG8_STAGE(PG8_SA(0, 0), a2, voffA);
            PG8_WAIT_V(8); PG8_WAIT_L(0); PG8_BAR; PG8_MMA(1, 0, At, B0); PG8_MMA(1, 1, At, B1); PG8_BAR; PG8_SCHED;
            PG8_LDB(B0, 1, 0); PG8_LDB(B1, 1, 1); PG8_SCHED; PG8_LDA(At, 1, 0); PG8_STAGE(PG8_SA(0, 1), a2 + hA, voffA);
            PG8_WAIT_V(8); PG8_WAIT_L(0); PG8_BAR; PG8_MMA(0, 0, At, B0); PG8_MMA(0, 1, At, B1); PG8_BAR; PG8_SCHED;
            PG8_LDA(At, 1, 1); PG8_STAGE(PG8_SB(1, 0), b3, voffB); PG8_STAGE(PG8_SB(1, 1), b3 + hB, voffB); PG8_STAGE(PG8_SA(1, 0), a3, voffA);
            PG8_WAIT_V(8); PG8_WAIT_L(0); PG8_BAR; PG8_MMA(1, 0, At, B0); PG8_MMA(1, 1, At, B1); PG8_BAR; PG8_SCHED;
        }
        if constexpr (ALIGN_EPI) { if (wr == 0) PG8_BAR; }
        E(acc, cur, wr, wc, fr, fq);
        if (!has_next) break;
#pragma unroll
        for (int a = 0; a < 2; ++a)
#pragma unroll
            for (int b = 0; b < 2; ++b)
#pragma unroll
                for (int m = 0; m < 4; ++m)
#pragma unroll
                    for (int n = 0; n < 2; ++n) acc[a][b][m][n] = (f32x4){0.f, 0.f, 0.f, 0.f};
        cur = nxt; cA = nA; cB = nB; ++ui;
        if constexpr (ALIGN_EPI) { if (wr == 1) PG8_BAR; }
    }
    PG8_WAIT_V(0);
    if constexpr (!ALIGN_EPI) { if (wr == 0) PG8_BAR; }
    PG8_BAR;
#undef PG8_SA
#undef PG8_SB
#undef PG8_STAGE
#undef PG8_LDA
#undef PG8_LDB
#undef PG8_MMA
#undef PG8_WAIT_V
#undef PG8_WAIT_L
#undef PG8_BAR
#undef PG8_SCHED
}
}

namespace attn_body {
using s16x8 = __attribute__((ext_vector_type(8))) short;
using s16x4 = __attribute__((ext_vector_type(4))) short;
using f32x16 = __attribute__((ext_vector_type(16))) float;
using u32x4 = __attribute__((ext_vector_type(4))) unsigned;
constexpr int D = 64, NW = 8, QBLK = 32, QB = QBLK * NW, KVBLK = 64;
constexpr int PQ = PW;
__device__ __forceinline__ int crow(int r, int hi) { return (r & 3) + 8 * (r >> 2) + 4 * hi; }
#define SBAR() __builtin_amdgcn_sched_barrier(0)
__device__ __forceinline__ void cmask(f32x16& p0, f32x16& p1, int jb, int qrel, int hi) {
    const float NEG = -INFINITY; int kb = 64 * jb + 4 * hi;
#pragma unroll
    for (int r = 0; r < 16; ++r) { int kv = kb + (r & 3) + 8 * (r >> 2); if (kv > qrel) p0[r] = NEG; if (kv + 32 > qrel) p1[r] = NEG; }
}
constexpr int NSLOT = 3, SLOTB = 8192;
constexpr int LDS_K = 0, LDS_V = NSLOT * SLOTB, LDS_WS = 2 * NSLOT * SLOTB, LDS_OST = LDS_WS + NW * 64 * 4, LDS_BT = LDS_OST + NW * 4096, LDS_INF = LDS_BT + 2048 * 4, LDS_KM = LDS_INF + 256, LDS_BYTES = LDS_KM + 2048;
__device__ __forceinline__ void glds16(const void* gsrc, unsigned lds_dst) { unsigned keep;
    asm volatile("s_mov_b32 %0, m0\n\ts_mov_b32 m0, %2\n\ts_nop 0\n\tglobal_load_lds_dwordx4 %1, off\n\ts_mov_b32 m0, %0" : "=&s"(keep) : "v"(gsrc), "s"(lds_dst) : "memory"); }
__device__ __forceinline__ float max3f(float a, float b, float c) { float r; asm("v_max3_f32 %0, %1, %2, %3" : "=v"(r) : "v"(a), "v"(b), "v"(c)); return r; }
__device__ __forceinline__ float max2f(float a, float b) { float r; asm("v_max_f32_e32 %0, %1, %2" : "=v"(r) : "v"(a), "v"(b)); return r; }
__device__ __forceinline__ float fadd_s(float a, float b) { float r; asm("v_add_f32_e32 %0, %1, %2" : "=v"(r) : "v"(a), "v"(b)); return r; }
__device__ __forceinline__ float fsub_s(float a, float b) { float r; asm("v_sub_f32_e32 %0, %1, %2" : "=v"(r) : "v"(a), "v"(b)); return r; }
__device__ __forceinline__ unsigned cvtpk_s(float lo, float hi) { return pg8::cvt_pk_f16(lo, hi); }
#define MFMA32(a, b, c) __builtin_amdgcn_mfma_f32_32x32x16_f16(__builtin_bit_cast(h16x8, (a)), __builtin_bit_cast(h16x8, (b)), (c), 0, 0, 0)
#define WAIT_BAR(N) asm volatile("s_waitcnt vmcnt(" #N ") lgkmcnt(0)\n\ts_barrier" ::: "memory")
__device__ __forceinline__ void qkt(f32x16& p0, f32x16& p1, const char* Kslot, const s16x8* qr, const f32x16& negm, int r32, int hi) {
    const char* kb = Kslot + hi * 1024 + r32 * 16;
#pragma unroll
    for (int d0 = 0; d0 < 4; ++d0) {
        const s16x8 b0 = *reinterpret_cast<const s16x8*>(kb + d0 * 2048);
        const s16x8 b1 = *reinterpret_cast<const s16x8*>(kb + d0 * 2048 + 512);
        if (d0 == 0) { p0 = MFMA32(b0, qr[0], negm); p1 = MFMA32(b1, qr[0], negm); }
        else { p0 = MFMA32(b0, qr[d0], p0); p1 = MFMA32(b1, qr[d0], p1); } }
}
typedef __attribute__((address_space(3))) const char* lds_cptr;
typedef short v4i16_t __attribute__((ext_vector_type(4)));
#define LDS8(p) (*(const __attribute__((address_space(3))) s16x8*)(p))
__device__ __forceinline__ void kload8(s16x8* kf, lds_cptr kp) {
    kf[0] = LDS8(kp); kf[1] = LDS8(kp + 512); kf[2] = LDS8(kp + 2048); kf[3] = LDS8(kp + 2560);
    kf[4] = LDS8(kp + 4096); kf[5] = LDS8(kp + 4608); kf[6] = LDS8(kp + 6144); kf[7] = LDS8(kp + 6656);
}
__device__ __forceinline__ void kload2(s16x8* kf, lds_cptr kp, int j) { kf[2 * j] = LDS8(kp + j * 2048); kf[2 * j + 1] = LDS8(kp + j * 2048 + 512); }
__device__ __forceinline__ s16x4 vtr(lds_cptr p) { return __builtin_bit_cast(s16x4, __builtin_amdgcn_ds_read_tr16_b64_v4i16((__attribute__((address_space(3))) v4i16_t*)p)); }
__device__ __forceinline__ float rowmax(const f32x16& p0, const f32x16& p1) {
    float a = max3f(p0[0], p0[1], p1[0]), b = max3f(p0[2], p0[3], p1[1]); a = max3f(a, p1[2], p1[3]);
#pragma unroll
    for (int r = 4; r < 16; r += 4) { a = max3f(a, p0[r], p0[r + 1]); b = max3f(b, p0[r + 2], p0[r + 3]); a = max3f(a, p1[r], p1[r + 1]); b = max3f(b, p1[r + 2], p1[r + 3]); }
    const float m = max2f(a, b);
    auto rr = __builtin_amdgcn_permlane32_swap(__float_as_uint(m), __float_as_uint(m), false, false);
    return max2f(__uint_as_float(rr[0]), __uint_as_float(rr[1]));
}
__device__ __forceinline__ void pv(f32x16* o, int vb, s16x8 pa0, s16x8 pa1, s16x8 pa2, s16x8 pa3) {
#pragma unroll
    for (int d0 = 0; d0 < 2; ++d0) { s16x4 lo[4], hi[4];
#pragma unroll
        for (int ks = 0; ks < 4; ++ks) {
            asm volatile("ds_read_b64_tr_b16 %0,%1 offset:%c2" : "=&v"(lo[ks]) : "v"(vb), "i"(d0 * 4096 + ks * 1024) : "memory");
            asm volatile("ds_read_b64_tr_b16 %0,%1 offset:%c2" : "=&v"(hi[ks]) : "v"(vb), "i"(d0 * 4096 + ks * 1024 + 512) : "memory"); }
        asm volatile("s_waitcnt lgkmcnt(0)" ::: "memory"); SBAR();
#define PK(k) (s16x8){lo[k][0], lo[k][1], lo[k][2], lo[k][3], hi[k][0], hi[k][1], hi[k][2], hi[k][3]}
        o[d0] = MFMA32(pa0, PK(0), o[d0]);
        o[d0] = MFMA32(pa1, PK(1), o[d0]);
        o[d0] = MFMA32(pa2, PK(2), o[d0]);
        o[d0] = MFMA32(pa3, PK(3), o[d0]);
#undef PK
    }
}

template <bool MOBA, int THRL>
__device__ __forceinline__ void attn_unit(int bl, int h, int qb, const h16* Q, const h16* __restrict__ K, const h16* __restrict__ V, const h16* __restrict__ Z, h16* Y,
                                          const float* __restrict__ bsrc, float slope2, const float* __restrict__ kmean, char* shm) {
    int tid_ = threadIdx.x; asm volatile("" : "+v"(tid_));
    const int tid = tid_, lane = tid & 63, r32 = lane & 31, hi = lane >> 5; const int wid = __builtin_amdgcn_readfirstlane(tid >> 6);
    const long rowbase = (long)bl * SEQ; const int q0 = qb * QB;
    const h16* Qw = Q + (rowbase + q0 + wid * QBLK) * PQ + h * D;
    const h16* Kh = K + rowbase * PQ + h * D, *Vh = V + rowbase * PQ + h * D;
    const unsigned lds0 = (unsigned)(uintptr_t)shm;
    float* wsf = (float*)(shm + LDS_WS) + wid * 64;
    typedef __attribute__((address_space(3))) float lds_f32;
    typedef __attribute__((address_space(3))) const f32x4 lds_cf32x4;
    const lds_cptr shm3 = (lds_cptr)shm;
    {
        lds_f32* bt = (lds_f32*)(shm3 + LDS_BT);
        const int nkeys = q0 + QB;
        if (MOBA) { for (int i = tid; i < nkeys; i += NW * 64) bt[i] = slope2 * (float)(i - q0); }
        else { for (int i = tid; i < nkeys; i += NW * 64) bt[i] = bsrc[i]; }
        if (tid < 64) ((lds_f32*)(shm3 + LDS_INF))[tid] = -INFINITY;
        if (MOBA) { if (tid < 512) ((lds_f32*)(shm3 + LDS_KM))[tid] = kmean[tid]; }
    }
    const h16* ksrc = Kh + (long)lane * PQ + wid * 8;
    const h16* vsrc = Vh + (long)(16 * (wid & 3) + (lane >> 2)) * PQ + (wid >> 2) * 32 + (lane & 3) * 8;
    const unsigned kdst = lds0 + LDS_K + wid * 1024, vdst = lds0 + LDS_V + wid * 1024;
    const int NT = (q0 + QB) / KVBLK;
#define AMAP(t) ((t) < 4 ? 4 * qb + (t) : (MOBA ? (t) - 4 : 4 * qb + 3 - (t)))
#define DMA_K(t, slot) glds16(ksrc + (long)AMAP(t) * KVBLK * PQ, (unsigned)__builtin_amdgcn_readfirstlane(kdst + (slot)))
#define DMA_V(t, slot) glds16(vsrc + (long)AMAP(t) * KVBLK * PQ, (unsigned)__builtin_amdgcn_readfirstlane(vdst + (slot)))
    const char* Kbase = shm + LDS_K; s16x8 kf[8];
    const lds_cptr kp0 = shm3 + LDS_K + hi * 1024 + r32 * 16; const lds_cptr vp0 = shm3 + LDS_V + ((lane >> 4) & 1) * 32 + (lane & 3) * 8 + (4 * hi + ((lane & 15) >> 2)) * 64;
    DMA_K(0, 0); DMA_V(0, 0); DMA_K(1, SLOTB);
    s16x8 qr[4];
#pragma unroll
    for (int d0 = 0; d0 < 4; ++d0) qr[d0] = *reinterpret_cast<const s16x8*>(&Qw[(long)r32 * PQ + d0 * 16 + hi * 8]);
    float mhat = 0.f, l_reg = 0.f; f32x16 o[2]; o[0] = f32x16{}; o[1] = f32x16{};
    const int qrel = wid * QBLK + r32;
    unsigned selbits = 0xffu;
#define ADDB(P0, P1, t) do { const int kt_ = AMAP(t); lds_cptr tb_ = shm3 + LDS_BT + kt_ * 256; \
        if (MOBA) { const bool s_ = ((t) < 4) || ((selbits >> (kt_ >> 2)) & 1u); tb_ = s_ ? tb_ : (shm3 + LDS_INF); } \
        _Pragma("unroll") for (int g_ = 0; g_ < 4; ++g_) { const f32x4 b0_ = *(lds_cf32x4*)(tb_ + 16 * hi + 32 * g_), b1_ = *(lds_cf32x4*)(tb_ + 128 + 16 * hi + 32 * g_); \
            _Pragma("unroll") for (int i_ = 0; i_ < 4; ++i_) { P0[4 * g_ + i_] += b0_[i_]; P1[4 * g_ + i_] += b1_[i_]; } } } while (0)
#define CMASK(P0, P1, t) do { if ((t) < 4) cmask(P0, P1, (t), qrel, hi); } while (0)
#define BIASPTR(t) ([&]() -> lds_cptr { const int kt_ = AMAP(t); lds_cptr tb_ = shm3 + LDS_BT + kt_ * 256 + 16 * hi; \
        if (MOBA) { const bool s_ = ((t) < 4) || ((selbits >> (kt_ >> 2)) & 1u); tb_ = s_ ? tb_ : (shm3 + LDS_INF + 16 * hi); } return tb_; }())
#define INITLD(P0, P1, bp, g_) do { const f32x4 b0_ = *(lds_cf32x4*)((bp) + 32 * (g_)), b1_ = *(lds_cf32x4*)((bp) + 128 + 32 * (g_)); \
        _Pragma("unroll") for (int i_ = 0; i_ < 4; ++i_) { P0[4 * (g_) + i_] = b0_[i_]; P1[4 * (g_) + i_] = b1_[i_]; } } while (0)
#define INITSUB(P, h_) do { _Pragma("unroll") for (int i_ = 0; i_ < 8; ++i_) P[8 * (h_) + i_] -= mhat; asm volatile("" : "+v"(P)); } while (0)
    bool resc = false;
#define START(P0, P1) do { const float rm = rowmax(P0, P1); resc = false; \
    { const float dl = rm; mhat = fadd_s(mhat, dl); \
      _Pragma("unroll") for (int r = 0; r < 16; ++r) { P0[r] = fsub_s(P0[r], dl); P1[r] = fsub_s(P1[r], dl); } } \
    _Pragma("unroll") for (int r = 0; r < 16; ++r) P0[r] = __builtin_amdgcn_exp2f(P0[r]); } while (0)
#define RESC() do { if (resc) { asm volatile("s_waitcnt lgkmcnt(0)" ::: "memory"); \
      _Pragma("unroll") for (int d_ = 0; d_ < 2; ++d_) _Pragma("unroll") for (int r = 0; r < 16; ++r) o[d_][r] *= wsf[crow(r, hi)]; } } while (0)
    f32x16 pA0, pA1, pB0, pB1;
    int sl_prev = 0, sl_cur = 0, sl_next = SLOTB;
#define ROT() do { sl_prev = sl_cur; sl_cur = sl_next; sl_next = (sl_next == (NSLOT - 1) * SLOTB) ? 0 : sl_next + SLOTB; } while (0)
    DMA_K(2, 2 * SLOTB);
    WAIT_BAR(3);
    if (MOBA && qb >= 4) {
        float gate[8];
#pragma unroll
        for (int n = 0; n < 8; ++n) gate[n] = 0.f;
#pragma unroll
        for (int d0 = 0; d0 < 4; ++d0) {
            const h16x8 qv = __builtin_bit_cast(h16x8, qr[d0]);
#pragma unroll
            for (int n = 0; n < 7; ++n) {
                const f32x4 k0 = *(lds_cf32x4*)(shm3 + LDS_KM + n * 256 + d0 * 64 + hi * 32), k1 = *(lds_cf32x4*)(shm3 + LDS_KM + n * 256 + d0 * 64 + hi * 32 + 16);
                gate[n] += (float)qv[0] * k0[0] + (float)qv[1] * k0[1] + (float)qv[2] * k0[2] + (float)qv[3] * k0[3] + (float)qv[4] * k1[0] + (float)qv[5] * k1[1] + (float)qv[6] * k1[2] + (float)qv[7] * k1[3];
            }
        }
#pragma unroll
        for (int n = 0; n < 7; ++n) { gate[n] = half_sum(gate[n]); if (n >= qb) gate[n] = -INFINITY; }
        unsigned sb = 0u;
#pragma unroll
        for (int r = 0; r < 3; ++r) {
            float best = -INFINITY; int bi = 0;
#pragma unroll
            for (int n = 0; n < 7; ++n) { const bool fr_ = !((sb >> n) & 1u); if (fr_ && gate[n] > best) { best = gate[n]; bi = n; } }
            sb |= 1u << bi;
        }
        selbits = sb;
    }
    { const f32x16 z16 = f32x16{}; qkt(pA0, pA1, Kbase, qr, z16, r32, hi); } asm volatile("s_nop 15\n\ts_nop 7" : "+v"(pA0), "+v"(pA1)); ADDB(pA0, pA1, 0); CMASK(pA0, pA1, 0);
    START(pA0, pA1);
    { const lds_cptr bp_ = BIASPTR(1); INITLD(pB0, pB1, bp_, 0); INITLD(pB0, pB1, bp_, 1); INITLD(pB0, pB1, bp_, 2); INITLD(pB0, pB1, bp_, 3);
      INITSUB(pB0, 0); INITSUB(pB0, 1); INITSUB(pB1, 0); INITSUB(pB1, 1); }
    _Pragma("unroll") for (int r = 0; r < 16; ++r) pA1[r] = __builtin_amdgcn_exp2f(pA1[r]);
    WAIT_BAR(0);
    DMA_K(3, 0); DMA_V(1, SLOTB);
    ROT();
    kload8(kf, kp0 + sl_cur);
    WAIT_BAR(2);
    s16x4 vlo[8], vhi[8]; u32x4 pw0, pw1, pw2, pw3;
#define PKW(P, B) cvtpk_s(P[B], P[B + 1])
#define PAF(k) __builtin_bit_cast(s16x8, pw##k)
#define VFR(i) (s16x8){vlo[i][0], vlo[i][1], vlo[i][2], vlo[i][3], vhi[i][0], vhi[i][1], vhi[i][2], vhi[i][3]}
#define PIN(x) asm volatile("" : "+v"(x))
#define MX3(a, b, c) __builtin_fmaxf(__builtin_fmaxf((a), (b)), (c))
#define GAPA(MF, A0, A1, A2, A3, W0, W1, PW_) do { MF; sacc += A0; sacc += A1; sacc += A2; sacc += A3; PIN(sacc); W0; W1; PIN(PW_); SBAR(); } while (0)
#define EX(v) __builtin_amdgcn_exp2f(v)
#define GAPB(MF, X, B, XTRA) do { MF; X[B] = EX(X[B]); X[B + 1] = EX(X[B + 1]); X[B + 2] = EX(X[B + 2]); X[B + 3] = EX(X[B + 3]); PIN(X); XTRA; SBAR(); } while (0)
#define VRD(i) do { vlo[i] = vtr(vp_ + (((i) >> 2) * 4096 + ((i) & 3) * 1024)); vhi[i] = vtr(vp_ + (((i) >> 2) * 4096 + ((i) & 3) * 1024 + 512)); } while (0)
#define KRD(G, j) do { if (G) { kload2(kf, kp0 + sl_next, j); SBAR(); } } while (0)
#define STEP(C0, C1, P0, P1, t, GK, GV, GL) do { SBAR(); \
    const lds_cptr vp_ = vp0 + sl_prev; \
    VRD(0); SBAR(); float sacc = (P0[0] + P0[1]); \
    GAPA(C0 = MFMA32(kf[0], qr[0], C0), P0[2], P0[3], P0[4], P0[5],     pw0[0] = PKW(P0, 0), pw0[1] = PKW(P0, 2), pw0); \
    VRD(4); SBAR(); GAPA(C1 = MFMA32(kf[1], qr[0], C1), P0[6], P0[7], P0[8], P0[9],     pw0[2] = PKW(P0, 4), pw0[3] = PKW(P0, 6), pw0); \
    VRD(1); SBAR(); GAPA(C0 = MFMA32(kf[2], qr[1], C0),   P0[10], P0[11], P0[12], P0[13], pw1[0] = PKW(P0, 8), pw1[1] = PKW(P0, 10), pw1); \
    VRD(5); SBAR(); GAPA(C1 = MFMA32(kf[3], qr[1], C1),   P0[14], P0[15], P1[0], P1[1],   pw1[2] = PKW(P0, 12), pw1[3] = PKW(P0, 14), pw1); \
    VRD(2); SBAR(); GAPA(C0 = MFMA32(kf[4], qr[2], C0),   P1[2], P1[3], P1[4], P1[5],     pw2[0] = PKW(P1, 0), pw2[1] = PKW(P1, 2), pw2); \
    VRD(6); SBAR(); GAPA(C1 = MFMA32(kf[5], qr[2], C1),   P1[6], P1[7], P1[8], P1[9],     pw2[2] = PKW(P1, 4), pw2[3] = PKW(P1, 6), pw2); \
    VRD(3); SBAR(); GAPA(C0 = MFMA32(kf[6], qr[3], C0),   P1[10], P1[11], P1[12], P1[13], pw3[0] = PKW(P1, 8), pw3[1] = PKW(P1, 10), pw3); \
    VRD(7); SBAR(); GAPA(C1 = MFMA32(kf[7], qr[3], C1),   P1[14], P1[15], 0.f, 0.f,       pw3[2] = PKW(P1, 12), pw3[3] = PKW(P1, 14), pw3); \
    l_reg += sacc; \
    if (GK) { DMA_K((t) + 3, sl_cur); } if (GV) { DMA_V((t) + 1, sl_next); } \
    CMASK(C0, C1, t); const lds_cptr bp_ = (GL) ? BIASPTR((t) + 1) : (shm3 + LDS_INF); \
    { float a = MX3(C0[0], C0[1], C1[0]), b = MX3(C0[2], C0[3], C1[1]); a = MX3(a, C1[2], C1[3]); \
      _Pragma("unroll") for (int r = 4; r < 16; r += 4) { a = MX3(a, C0[r], C0[r + 1]); b = MX3(b, C0[r + 2], C0[r + 3]); a = MX3(a, C1[r], C1[r + 1]); b = MX3(b, C1[r + 2], C1[r + 3]); } \
      float rm = __builtin_fmaxf(a, b); { auto rr = __builtin_amdgcn_permlane32_swap(__float_as_uint(rm), __float_as_uint(rm), false, false); rm = __builtin_fmaxf(__uint_as_float(rr[0]), __uint_as_float(rr[1])); } \
      resc = false; \
      if (__builtin_expect(__any(rm > (float)THRL), 0)) { const float dl = __builtin_fmaxf(rm, 0.f); mhat += dl; \
        _Pragma("unroll") for (int r = 0; r < 16; ++r) { C0[r] -= dl; C1[r] -= dl; } \
        const float f = __builtin_amdgcn_exp2f(-dl); l_reg *= f; if (hi == 0) wsf[r32] = f; resc = true; } } \
    SBAR(); \
    GAPB(o[0] = MFMA32(PAF(0), VFR(0), o[0]), C0, 0, if (GL) INITLD(P0, P1, bp_, 0)); \
    GAPB(o[1] = MFMA32(PAF(0), VFR(4), o[1]), C0, 4, if (GL) INITLD(P0, P1, bp_, 1)); \
    KRD(GL, 0); GAPB(o[0] = MFMA32(PAF(1), VFR(1), o[0]), C0, 8, if (GL) INITLD(P0, P1, bp_, 2)); \
    KRD(GL, 1); GAPB(o[1] = MFMA32(PAF(1), VFR(5), o[1]), C0, 12, if (GL) INITLD(P0, P1, bp_, 3)); \
    KRD(GL, 2); GAPB(o[0] = MFMA32(PAF(2), VFR(2), o[0]), C1, 0, if (GL) INITSUB(P0, 0)); \
    KRD(GL, 3); GAPB(o[1] = MFMA32(PAF(2), VFR(6), o[1]), C1, 4, if (GL) INITSUB(P0, 1)); \
    GAPB(o[0] = MFMA32(PAF(3), VFR(3), o[0]), C1, 8, if (GL) INITSUB(P1, 0)); \
    GAPB(o[1] = MFMA32(PAF(3), VFR(7), o[1]), C1, 12, if (GL) INITSUB(P1, 1)); \
    } while (0)
    int t = 1;
#define ENDW(tt) do { if ((tt) + 3 < NT) { WAIT_BAR(2); } else if ((tt) + 2 < NT) { WAIT_BAR(1); } else { WAIT_BAR(0); } } while (0)
    for (; t + 1 < NT; t += 2) {
        STEP(pB0, pB1, pA0, pA1, t, (t + 3 < NT), (t + 1 < NT), (t + 1 < NT));       ENDW(t);     RESC(); ROT();
        STEP(pA0, pA1, pB0, pB1, t + 1, (t + 4 < NT), (t + 2 < NT), (t + 2 < NT));   ENDW(t + 1); RESC(); ROT();
    }
    STEP(pB0, pB1, pA0, pA1, NT - 1, false, false, false); RESC();
    { float sacc = pB0[0] + pB0[1]; _Pragma("unroll") for (int r = 2; r < 16; ++r) sacc += pB0[r]; _Pragma("unroll") for (int r = 0; r < 16; ++r) sacc += pB1[r]; l_reg += sacc;
      pw0 = (u32x4){PKW(pB0, 0), PKW(pB0, 2), PKW(pB0, 4), PKW(pB0, 6)}; pw1 = (u32x4){PKW(pB0, 8), PKW(pB0, 10), PKW(pB0, 12), PKW(pB0, 14)}; pw2 = (u32x4){PKW(pB1, 0), PKW(pB1, 2), PKW(pB1, 4), PKW(pB1, 6)}; pw3 = (u32x4){PKW(pB1, 8), PKW(pB1, 10), PKW(pB1, 12), PKW(pB1, 14)};
      int ln_ = threadIdx.x & 63; asm volatile("" : "+v"(ln_));
      const int vb0 = (int)(lds0 + LDS_V) + ((ln_ >> 4) & 1) * 32 + (ln_ & 3) * 8 + (4 * (ln_ >> 5) + ((ln_ & 15) >> 2)) * 64;
      SBAR(); pv(o, vb0 + sl_cur, PAF(0), PAF(1), PAF(2), PAF(3)); }
#undef PKW
#undef PAF
#undef VFR
#undef PIN
#undef MX3
#undef GAPA
#undef GAPB
#undef EX
#undef VRD
#undef KRD
#undef STEP
#undef ENDW
    { auto rr = __builtin_amdgcn_permlane32_swap(__float_as_uint(l_reg), __float_as_uint(l_reg), false, false); l_reg = __uint_as_float(rr[0]) + __uint_as_float(rr[1]); }
    if (hi == 0) wsf[32 + r32] = l_reg; asm volatile("s_waitcnt lgkmcnt(0)" ::: "memory");
    float rli[16];
#pragma unroll
    for (int r = 0; r < 16; ++r) rli[r] = __builtin_amdgcn_rcpf(wsf[32 + crow(r, hi)]);
    {
        int le = threadIdx.x & 63; asm volatile("" : "+v"(le));
        float* stg = (float*)(shm + LDS_OST) + wid * 1024;
        const h16* Zw = Z + (rowbase + q0 + wid * QBLK) * PQ + h * D;
        h16* Yw = Y + (rowbase + q0 + wid * QBLK) * 1536 + h * D;
#pragma unroll
        for (int d0 = 0; d0 < 2; ++d0) {
#pragma unroll
            for (int r = 0; r < 16; ++r) stg[crow(r, le >> 5) * 32 + (le & 31)] = o[d0][r] * rli[r];
            asm volatile("s_waitcnt lgkmcnt(0)" ::: "memory");
#pragma unroll
            for (int i = 0; i < 2; ++i) { const int row = i * 16 + (le >> 2), ch = le & 3;
                const f32x4 a0 = *(const f32x4*)(stg + row * 32 + ch * 8), a1 = *(const f32x4*)(stg + row * 32 + ch * 8 + 4);
                const h16x8 zv = *(const h16x8*)(Zw + (long)row * PQ + d0 * 32 + ch * 8);
                float ov[8] = {a0[0], a0[1], a0[2], a0[3], a1[0], a1[1], a1[2], a1[3]};
#pragma unroll
                for (int e = 0; e < 8; ++e) { const float zz = (float)zv[e]; ov[e] *= zz * __builtin_amdgcn_rcpf(1.f + __expf(-zz)); }
                u32x4 w; w.x = cvtpk_s(ov[0], ov[1]); w.y = cvtpk_s(ov[2], ov[3]); w.z = cvtpk_s(ov[4], ov[5]); w.w = cvtpk_s(ov[6], ov[7]);
                *(u32x4*)(Yw + (long)row * 1536 + d0 * 32 + ch * 8) = w; }
            asm volatile("s_waitcnt lgkmcnt(0)" ::: "memory");
        }
    }
    asm volatile("s_waitcnt vmcnt(0) lgkmcnt(0)\n\ts_barrier" ::: "memory");
#undef DMA_K
#undef DMA_V
#undef AMAP
#undef ADDB
#undef CMASK
#undef BIASPTR
#undef INITLD
#undef INITSUB
#undef START
#undef RESC
#undef ROT
}
#undef SBAR
#undef WAIT_BAR
#undef MFMA32
#undef LDS8
}

constexpr int NWAVES = 8, NTHREADS = 512;
constexpr int MK_LDS_BYTES = 147456;
enum { PH_NORM = 0, PH_PROJ = 1, PH_PRE = 2, PH_SCAN = 3, PH_MIX = 4, PH_BR = 5, PH_OUT = 6, NPH = 7 };
constexpr int N_STEPS = 1 + NPH * 4 + 1;
struct MArgs { const float* in[11]; float* out; unsigned char* ws; int s_lo, s_hi; };

__device__ __forceinline__ void barrier_lds() { asm volatile("s_waitcnt vmcnt(0) lgkmcnt(0)" ::: "memory"); __syncthreads(); }
__device__ __forceinline__ void fox_cumsum_item(int item, int b0, const float* __restrict__ small, float* __restrict__ cb, char* shm) {
    int tid_ = threadIdx.x; asm volatile("" : "+v"(tid_));
    const int tid = tid_, lane = tid & 63, wid = tid >> 6, bl = item >> 3, h = item & 7;
    const float* sp = small + ((size_t)(b0 + bl) * SEQ + 4 * tid) * 16 + h;
    float v0 = sp[0], v1 = sp[16], v2 = sp[32], v3 = sp[48];
    v1 += v0; v2 += v1; v3 += v2;
    float tot = v3;
#pragma unroll
    for (int o = 1; o < 64; o <<= 1) { const float u = shfl_idx(tot, lane - o); if (lane >= o) tot += u; }
    float* wt = (float*)shm;
    if (lane == 63) wt[wid] = tot;
    __syncthreads();
    float base = tot - v3;
    for (int w = 0; w < wid; ++w) base += wt[w];
    float* o4 = cb + (size_t)((b0 + bl) * 8 + h) * SEQ + 4 * tid;
    *(f32x4*)o4 = (f32x4){-(base + v0) * LOG2E, -(base + v1) * LOG2E, -(base + v2) * LOG2E, -(base + v3) * LOG2E};
    __syncthreads();
}
__device__ __forceinline__ void moba_kmean_item(int item, int b0, const h16* __restrict__ proj, float* __restrict__ kmean, char* shm) {
    int tid_ = threadIdx.x; asm volatile("" : "+v"(tid_));
    const int tid = tid_, h = item & 7, blk = (item >> 3) & 7, bl = item >> 6, r8 = tid >> 3, c8 = tid & 7;
    const h16* kp = proj + ((size_t)bl * SEQ + blk * 256 + r8) * PW + PC_BK + h * 64 + c8 * 8;
    float acc[8];
#pragma unroll
    for (int e = 0; e < 8; ++e) acc[e] = 0.f;
#pragma unroll
    for (int j = 0; j < 4; ++j) { const h16x8 v = *(const h16x8*)(kp + (size_t)(64 * j) * PW);
#pragma unroll
        for (int e = 0; e < 8; ++e) acc[e] += (float)v[e]; }
    float* red = (float*)shm;
#pragma unroll
    for (int e = 0; e < 8; ++e) red[r8 * 65 + c8 * 8 + e] = acc[e];
    __syncthreads();
    if (tid < 64) { float sum = 0.f;
#pragma unroll 8
        for (int r = 0; r < 64; ++r) sum += red[r * 65 + tid];
        kmean[(((size_t)(b0 + bl) * 8 + h) * 8 + blk) * 64 + tid] = sum * (1.f / 256.f); }
    __syncthreads();
}

namespace mlstm {
typedef __attribute__((address_space(3))) char* lds_ptr;
typedef __attribute__((address_space(3))) const char* lds_cptr;
typedef short s16x8 __attribute__((ext_vector_type(8)));
typedef short s16x4 __attribute__((ext_vector_type(4)));
typedef short v4i16_t __attribute__((ext_vector_type(4)));
typedef float f32x16 __attribute__((ext_vector_type(16)));
typedef unsigned u32x4 __attribute__((ext_vector_type(4)));
constexpr int W_V = 0, W_K = 16384, W_SC = W_K + 8704, WREG = W_SC + 2048;
constexpr int NACT = 4;
__device__ __forceinline__ int crow(int r, int hi) { return (r & 3) + 8 * (r >> 2) + 4 * hi; }
#define MF32(a, b, c) __builtin_amdgcn_mfma_f32_32x32x16_f16(__builtin_bit_cast(h16x8, (a)), __builtin_bit_cast(h16x8, (b)), (c), 0, 0, 0)
#define LFW(off) ((__attribute__((address_space(3))) float*)(R + W_SC + (off)))
__device__ __forceinline__ s16x4 vtr(lds_cptr p) { return __builtin_bit_cast(s16x4, __builtin_amdgcn_ds_read_tr16_b64_v4i16((__attribute__((address_space(3))) v4i16_t*)p)); }
__device__ __forceinline__ s16x8 trfrag(lds_cptr img, int blk, int ks, int lb) {
    const s16x4 lo = vtr(img + blk * 4096 + ks * 1024 + lb), hi = vtr(img + blk * 4096 + ks * 1024 + 512 + lb);
    return (s16x8){lo[0], lo[1], lo[2], lo[3], hi[0], hi[1], hi[2], hi[3]};
}
__device__ __forceinline__ void stage_v(lds_ptr R, const h16* __restrict__ vsrc  , int lane) {
    int ln = lane; asm volatile("" : "+v"(ln));
    const h16* vp = vsrc + (size_t)(ln >> 2) * PW + (ln & 3) * 8;
#pragma unroll 1
    for (int sg = 0; sg < 4; ++sg) {
        h16x8 x[4];
#pragma unroll
        for (int vb = 0; vb < 4; ++vb) x[vb] = *(const h16x8*)(vp + 32 * vb);
#pragma unroll
        for (int vb = 0; vb < 4; ++vb) *(__attribute__((address_space(3))) h16x8*)(R + W_V + vb * 4096 + sg * 1024 + ln * 16) = x[vb];
        vp += (size_t)16 * PW; }
}
__device__ __forceinline__ void x1_wave(int item, int b0, const h16* __restrict__ proj, const float* __restrict__ small, const float* __restrict__ convw,
                                        h16* __restrict__ qkc, float* __restrict__ U, float* __restrict__ un, float* __restrict__ amax, float* __restrict__ blast, lds_ptr R, int lane_in) {
    int lane = threadIdx.x & 63; (void)lane_in; asm volatile("" : "+v"(lane));
    const int r32 = lane & 31, hi = lane >> 5;
    const int c = item & 31, hh = (item >> 5) & 3, bl = item >> 7;
    const size_t row0 = (size_t)bl * SEQ + c * 64;
    const int gbh = (b0 + bl) * 4 + hh, lbh = bl * 4 + hh;
    float ws;
    {   const float* sp = small + ((size_t)b0 * SEQ + row0 + lane) * 16;
        const float li = sp[8 + hh], lf = sp[12 + hh];
        float bc = lf;
#pragma unroll
        for (int o = 1; o < 64; o <<= 1) { const float u = shfl_idx(bc, lane - o); if (lane >= o) bc += u; }
        const float as = li - bc; float mx = as;
#pragma unroll
        for (int o = 1; o < 64; o <<= 1) mx = fmaxf(mx, shfl_idx(mx, lane ^ o));
        ws = __expf(as - mx);
        if (lane == 63) { amax[gbh * 32 + c] = mx; blast[gbh * 32 + c] = bc; } }
    stage_v(R, proj + row0 * PW + PC_CV + hh * 128, lane);
    const int t = c * 64 + lane;
#pragma unroll 1
    for (int dg = 0; dg < 16; ++dg) {
        const int isk = dg >> 3, pcol = isk ? 256 + hh * 64 + (dg - 8) * 8 : hh * 64 + dg * 8;
        float acc[8];
#pragma unroll
        for (int e = 0; e < 8; ++e) acc[e] = 0.f;
#pragma unroll
        for (int j = 0; j < 4; ++j) {
            const int tt = t - 3 + j, tc = tt < 0 ? 0 : tt;
            const h16x8 x = *(const h16x8*)(proj + ((size_t)bl * SEQ + tc) * PW + PC_CQK + pcol);
            const float m = tt < 0 ? 0.f : 1.f;
            const float* wp = convw + j * 512 + pcol;
#pragma unroll
            for (int e = 0; e < 8; ++e) acc[e] += wp[e] * m * (float)x[e];
        }
        h16x8 o, ow;
#pragma unroll
        for (int e = 0; e < 8; ++e) { float v = acc[e] * __builtin_amdgcn_rcpf(1.f + __expf(-acc[e])); if (isk) v *= 0.125f; o[e] = (h16)v; ow[e] = (h16)(v * ws); }
        *(h16x8*)(qkc + (row0 + lane) * 512 + pcol) = o;
        if (isk) { const int dgk = dg - 8; *(__attribute__((address_space(3))) h16x8*)(R + W_K + (dgk >> 2) * 4096 + lane * 64 + (dgk & 3) * 16) = ow; }
    }
    asm volatile("s_waitcnt lgkmcnt(0)" ::: "memory");
    const int lb = ((lane >> 4) & 1) * 32 + (lane & 3) * 8 + (4 * hi + ((lane & 15) >> 2)) * 64;
    float* up = U + ((size_t)lbh * 32 + c) * 8192;
#pragma unroll 1
    for (int vb = 0; vb < 4; ++vb) {
        f32x16 a0 = f32x16{}, a1 = f32x16{};
#pragma unroll
        for (int ks = 0; ks < 4; ++ks) { const s16x8 vf = trfrag((lds_cptr)(R + W_V), vb, ks, lb);
            a0 = MF32(vf, trfrag((lds_cptr)(R + W_K), 0, ks, lb), a0); a1 = MF32(vf, trfrag((lds_cptr)(R + W_K), 1, ks, lb), a1); }
#pragma unroll
        for (int r = 0; r < 16; ++r) { up[(vb * 32 + crow(r, hi)) * 64 + r32] = a0[r]; up[(vb * 32 + crow(r, hi)) * 64 + 32 + r32] = a1[r]; }
    }
    {   float sum = 0.f;
        lds_cptr kp = (lds_cptr)(R + W_K) + (lane >> 5) * 4096 + (lane & 31) * 2;
#pragma unroll 16
        for (int q = 0; q < 64; ++q) sum += (float)*(const __attribute__((address_space(3))) h16*)(kp + q * 64);
        un[((size_t)gbh * 32 + c) * 64 + lane] = sum; }
    asm volatile("s_waitcnt lgkmcnt(0)" ::: "memory");
}
__device__ __forceinline__ void x2_item(int item, int b0, const float* __restrict__ U, const float* __restrict__ un, const float* __restrict__ amax, const float* __restrict__ blast,
                                        h16* __restrict__ CS, float* __restrict__ ns, float* __restrict__ Ms, char* shm) {
    int tid_ = threadIdx.x; asm volatile("" : "+v"(tid_));
    const int tid = tid_, lbh = item >> 3, sl = item & 7, gbh = (b0 + (lbh >> 2)) * 4 + (lbh & 3);
    float* coef = (float*)shm;
    if (tid == 0) { float M = 0.f; if (sl == 0) Ms[gbh * 32] = 0.f;
        for (int c = 0; c < 31; ++c) { const float am = amax[gbh * 32 + c], bls = blast[gbh * 32 + c], Mn = bls + fmaxf(M, am);
            coef[2 * c] = __expf(bls + M - Mn); coef[2 * c + 1] = __expf(bls + am - Mn); M = Mn; if (sl == 0) Ms[gbh * 32 + c + 1] = M; } }
    __syncthreads();
    {   const int e2 = sl * 1024 + tid * 2;
        const float* up = U + (size_t)lbh * 32 * 8192 + e2; h16* cp = CS + (size_t)lbh * 32 * 8192 + e2;
        float c0 = 0.f, c1 = 0.f;
        *(pg8::h16x2*)cp = (pg8::h16x2){(h16)0.f, (h16)0.f};
#pragma unroll 1
        for (int cb = 0; cb < 31; cb += 8) {
            pg8::f32x2 u[8];
#pragma unroll
            for (int j = 0; j < 8; ++j) if (cb + j < 31) u[j] = *(const pg8::f32x2*)(up + (size_t)(cb + j) * 8192);
#pragma unroll
            for (int j = 0; j < 8; ++j) if (cb + j < 31) { const float fd = coef[2 * (cb + j)], fi = coef[2 * (cb + j) + 1];
                c0 = fd * c0 + fi * u[j].x; c1 = fd * c1 + fi * u[j].y;
                *(pg8::h16x2*)(cp + (size_t)(cb + j + 1) * 8192) = (pg8::h16x2){(h16)c0, (h16)c1}; }
        }
    }
    if (sl == 0 && tid < 64) { float n = 0.f; ns[((size_t)gbh * 32) * 64 + tid] = 0.f;
        for (int c = 0; c < 31; ++c) { n = coef[2 * c] * n + coef[2 * c + 1] * un[((size_t)gbh * 32 + c) * 64 + tid]; ns[((size_t)gbh * 32 + c + 1) * 64 + tid] = n; } }
    __syncthreads();
}
__device__ __forceinline__ void x3_wave(int item, int b0, const h16* __restrict__ proj, const float* __restrict__ small, const h16* __restrict__ qkc, const h16* __restrict__ CS,
                                        const float* __restrict__ ns, const float* __restrict__ Ms, const float* __restrict__ headg, h16* __restrict__ y, lds_ptr R, int lane_in) {
    int lane = threadIdx.x & 63; (void)lane_in; asm volatile("" : "+v"(lane));
    const int c = item & 31, hh = (item >> 5) & 3, bl = item >> 7;
    const size_t row0 = (size_t)bl * SEQ + c * 64;
    const int gbh = (b0 + bl) * 4 + hh, lbh = bl * 4 + hh;
    {   const float* sp = small + ((size_t)b0 * SEQ + row0 + lane) * 16;
        const float li = sp[8 + hh], lf = sp[12 + hh], Mc = Ms[gbh * 32 + c];
        float bc = lf;
#pragma unroll
        for (int o = 1; o < 64; o <<= 1) { const float u = shfl_idx(bc, lane - o); if (lane >= o) bc += u; }
        const float as = li - bc; float pm = as;
#pragma unroll
        for (int o = 1; o < 64; o <<= 1) { const float u = shfl_idx(pm, lane - o); if (lane >= o) pm = fmaxf(pm, u); }
        const float mx = fmaxf(Mc, pm);
        LFW(0)[lane] = as; LFW(256)[lane] = mx; LFW(512)[lane] = __expf(Mc - mx); LFW(768)[lane] = __expf(-(bc + mx));
        LFW(1280)[lane] = ns[((size_t)gbh * 32 + c) * 64 + lane]; }
    stage_v(R, proj + row0 * PW + PC_CV + hh * 128, lane);
    asm volatile("s_waitcnt lgkmcnt(0)" ::: "memory");
    const h16* cprev = CS + ((size_t)lbh * 32 + c) * 8192;
    typedef __attribute__((address_space(3))) const f32x4 lds_cf32x4;
#pragma unroll 1
    for (int tb = 0; tb < 2; ++tb) {
        int l2 = lane; asm volatile("" : "+v"(l2));
        const int r32 = l2 & 31, hi = l2 >> 5;
        const int lb = ((l2 >> 4) & 1) * 32 + (l2 & 3) * 8 + (4 * hi + ((l2 & 15) >> 2)) * 64;
        const int t = 32 * tb + r32;
        s16x8 qr[4];
#pragma unroll
        for (int ks = 0; ks < 4; ++ks) qr[ks] = *(const s16x8*)(qkc + (row0 + t) * 512 + hh * 64 + 16 * ks + 8 * hi);
        const float mxt = LFW(256)[t], wit = LFW(512)[t];
        float nq = 0.f;
#pragma unroll
        for (int ks = 0; ks < 4; ++ks) { const h16x8 qv = __builtin_bit_cast(h16x8, qr[ks]);
            const f32x4 n0 = *(lds_cf32x4*)(R + W_SC + 1280 + (16 * ks + 8 * hi) * 4), n1 = *(lds_cf32x4*)(R + W_SC + 1280 + (16 * ks + 8 * hi + 4) * 4);
            nq += (float)qv[0] * n0[0] + (float)qv[1] * n0[1] + (float)qv[2] * n0[2] + (float)qv[3] * n0[3] + (float)qv[4] * n1[0] + (float)qv[5] * n1[1] + (float)qv[6] * n1[2] + (float)qv[7] * n1[3]; }
        nq = half_sum(nq);
        f32x16 p0 = f32x16{}, p1 = f32x16{};
#pragma unroll
        for (int ks = 0; ks < 4; ++ks) { const s16x8 k0 = *(const s16x8*)(qkc + (row0 + r32) * 512 + 256 + hh * 64 + 16 * ks + 8 * hi); p0 = MF32(k0, qr[ks], p0); }
        if (tb == 1) {
#pragma unroll
            for (int ks = 0; ks < 4; ++ks) { const s16x8 k1 = *(const s16x8*)(qkc + (row0 + 32 + r32) * 512 + 256 + hh * 64 + 16 * ks + 8 * hi); p1 = MF32(k1, qr[ks], p1); } }
        float dsum = 0.f;
#pragma unroll
        for (int g = 0; g < 4; ++g) { const f32x4 a0 = *(lds_cf32x4*)(R + W_SC + (8 * g + 4 * hi) * 4), a1 = *(lds_cf32x4*)(R + W_SC + (32 + 8 * g + 4 * hi) * 4);
#pragma unroll
            for (int i = 0; i < 4; ++i) { const int s0 = 8 * g + 4 * hi + i;
                const float w0 = s0 <= t ? p0[4 * g + i] * __expf(a0[i] - mxt) : 0.f; p0[4 * g + i] = w0; dsum += w0;
                const float w1 = (tb == 1 && s0 + 32 <= t) ? p1[4 * g + i] * __expf(a1[i] - mxt) : 0.f; p1[4 * g + i] = w1; dsum += w1; } }
        dsum = half_sum(dsum);
        if (hi == 0) LFW(1024)[t] = dsum + wit * nq;
        u32x4 pw0, pw1, pw2, pw3;
#define PKW(P, B) pg8::cvt_pk_f16(P[B], P[B + 1])
        pw0 = (u32x4){PKW(p0, 0), PKW(p0, 2), PKW(p0, 4), PKW(p0, 6)}; pw1 = (u32x4){PKW(p0, 8), PKW(p0, 10), PKW(p0, 12), PKW(p0, 14)};
        pw2 = (u32x4){PKW(p1, 0), PKW(p1, 2), PKW(p1, 4), PKW(p1, 6)}; pw3 = (u32x4){PKW(p1, 8), PKW(p1, 10), PKW(p1, 12), PKW(p1, 14)};
#undef PKW
        s16x8 qs[4];
        { const h16 wh = (h16)wit;
#pragma unroll
          for (int ks = 0; ks < 4; ++ks) { h16x8 qv = __builtin_bit_cast(h16x8, qr[ks]);
#pragma unroll
              for (int e = 0; e < 8; ++e) qv[e] = qv[e] * wh;
              qs[ks] = __builtin_bit_cast(s16x8, qv); } }
        f32x16 acc[4];
#pragma unroll
        for (int vb = 0; vb < 4; ++vb) { acc[vb] = f32x16{};
#pragma unroll
            for (int ks = 0; ks < 4; ++ks) { const s16x8 cf = *(const s16x8*)(cprev + (32 * vb + r32) * 64 + 16 * ks + 8 * hi); acc[vb] = MF32(qs[ks], cf, acc[vb]); }
            acc[vb] = MF32(__builtin_bit_cast(s16x8, pw0), trfrag((lds_cptr)(R + W_V), vb, 0, lb), acc[vb]);
            acc[vb] = MF32(__builtin_bit_cast(s16x8, pw1), trfrag((lds_cptr)(R + W_V), vb, 1, lb), acc[vb]);
            if (tb == 1) { acc[vb] = MF32(__builtin_bit_cast(s16x8, pw2), trfrag((lds_cptr)(R + W_V), vb, 2, lb), acc[vb]);
                           acc[vb] = MF32(__builtin_bit_cast(s16x8, pw3), trfrag((lds_cptr)(R + W_V), vb, 3, lb), acc[vb]); } }
        asm volatile("s_waitcnt lgkmcnt(0)" ::: "memory");
#pragma unroll
        for (int g = 0; g < 4; ++g) { const f32x4 dn = *(lds_cf32x4*)(R + W_SC + 1024 + (32 * tb + 8 * g + 4 * hi) * 4), em = *(lds_cf32x4*)(R + W_SC + 768 + (32 * tb + 8 * g + 4 * hi) * 4);
#pragma unroll
            for (int i = 0; i < 4; ++i) { const float inv = __builtin_amdgcn_rcpf(fmaxf(fabsf(dn[i]), em[i])); const int rl = 8 * g + 4 * hi + i;
#pragma unroll
                for (int vb = 0; vb < 4; ++vb) *(__attribute__((address_space(3))) h16*)(R + W_K + rl * 272 + (32 * vb + r32) * 2) = (h16)(acc[vb][4 * g + i] * inv); } }
        asm volatile("s_waitcnt lgkmcnt(0)" ::: "memory");
#pragma unroll 1
        for (int ps = 0; ps < 2; ++ps) {
            int l3 = threadIdx.x & 63; asm volatile("" : "+v"(l3));
            const int rl = 16 * ps + (l3 >> 2), v0 = (l3 & 3) * 32;
            const size_t row = row0 + 32 * tb + rl;
            float hg[32]; float ss = 0.f;
#pragma unroll
            for (int q = 0; q < 4; ++q) { const h16x8 hv = *(const __attribute__((address_space(3))) h16x8*)(R + W_K + rl * 272 + (v0 + 8 * q) * 2);
                const h16x8 og = *(const h16x8*)(proj + row * PW + PC_CO + hh * 128 + v0 + 8 * q);
#pragma unroll
                for (int e = 0; e < 8; ++e) { const float x = (float)hv[e] * __builtin_amdgcn_rcpf(1.f + __expf(-(float)og[e])); hg[8 * q + e] = x; ss += x * x; } }
            ss += swz_xor<1>(ss); ss += swz_xor<2>(ss);
            const float rn = rsqrtf(ss * (1.f / 128.f) + RMS_EPS);
#pragma unroll
            for (int q = 0; q < 4; ++q) { const h16x8 zv = *(const h16x8*)(proj + row * PW + PC_CZ + hh * 128 + v0 + 8 * q);
                const f32x4 g0 = *(const f32x4*)(headg + hh * 128 + v0 + 8 * q), g1 = *(const f32x4*)(headg + hh * 128 + v0 + 8 * q + 4);
                float ov[8];
#pragma unroll
                for (int e = 0; e < 8; ++e) { const float zz = (float)zv[e]; ov[e] = hg[8 * q + e] * rn * (e < 4 ? g0[e] : g1[e - 4]) * zz * __builtin_amdgcn_rcpf(1.f + __expf(-zz)); }
                u32x4 w; w.x = pg8::cvt_pk_f16(ov[0], ov[1]); w.y = pg8::cvt_pk_f16(ov[2], ov[3]); w.z = pg8::cvt_pk_f16(ov[4], ov[5]); w.w = pg8::cvt_pk_f16(ov[6], ov[7]);
                *(u32x4*)(y + row * 1536 + 1024 + hh * 128 + v0 + 8 * q) = w; }
        }
        asm volatile("s_waitcnt lgkmcnt(0)" ::: "memory");
    }
}
#undef LFW
#undef MF32
}

#define LAS __attribute__((address_space(3)))
#define XB_TMO      128
#define XB_XCNT(j)  (256  + 64 * (j))
#define XB_XSUB(j)  (1280 + 64 * (j))
#define XB_XGEN(j)  (2304 + 64 * (j))
#define XB_TOP      3328
#define XB_TOPGEN   3392
#define XCD_BAR_WORDS 3456
#define XB_SPIN_CAP (1u << 18)
__device__ __forceinline__ unsigned xb_ld(unsigned* p)              { return __hip_atomic_load(p, __ATOMIC_RELAXED, __HIP_MEMORY_SCOPE_AGENT); }
__device__ __forceinline__ unsigned xb_add(unsigned* p, unsigned v) { return __hip_atomic_fetch_add(p, v, __ATOMIC_RELAXED, __HIP_MEMORY_SCOPE_AGENT); }
__device__ __forceinline__ unsigned xb_xcc_id() { return (unsigned)__builtin_amdgcn_s_getreg((3 << 11) | 20) & 0xFu; }
#define XB_SPIN(cond, bar) do { unsigned _sp = 0; while (cond) { __builtin_amdgcn_s_sleep(1); \
    if ((++_sp & 255u) == 0u) { if (xb_ld(&(bar)[XB_TMO])) break; if (_sp > XB_SPIN_CAP) { atomicAdd(&(bar)[XB_TMO], 1u); break; } } } } while (0)
struct XcdBarrier { unsigned* bar; unsigned x; volatile LAS unsigned* st; };
__device__ __forceinline__ XcdBarrier xcd_barrier_post(unsigned* bar, volatile LAS unsigned* st) {
    XcdBarrier b; b.bar = bar; b.x = xb_xcc_id(); b.st = st;
    if (threadIdx.x == 0) (void)xb_add(&bar[XB_XCNT(b.x)], 1u);
    return b;
}
__device__ __forceinline__ void xcd_barrier_complete(unsigned* bar, unsigned x, unsigned& nloc, unsigned& nx) {
    const unsigned G = gridDim.x * gridDim.y * gridDim.z;
    unsigned sum, cnt, mine, sp = 0u;
    for (;;) {
        sum = 0u; cnt = 0u; mine = 0u;
#pragma unroll
        for (unsigned j = 0; j < 16; ++j) { const unsigned c = xb_ld(&bar[XB_XCNT(j)]); sum += c; cnt += (c > 0u) ? 1u : 0u; mine = (j == x) ? c : mine; }
        if (sum == G) break;
        __builtin_amdgcn_s_sleep(1);
        if ((++sp & 255u) == 0u) { if (xb_ld(&bar[XB_TMO])) break; if (sp > XB_SPIN_CAP) { atomicAdd(&bar[XB_TMO], 1u); break; } }
    }
    nloc = mine > 0u ? mine : 1u; nx = cnt > 0u ? cnt : 1u;
}
__device__ __forceinline__ void xcd_barrier(const XcdBarrier& b) {
    asm volatile("s_waitcnt vmcnt(0)" ::: "memory");
    __syncthreads();
    if (threadIdx.x == 0) {
        unsigned* bar = b.bar;
        __builtin_amdgcn_s_waitcnt(0);
        unsigned nloc = b.st[0], nx = b.st[1];
        if (nloc == 0u) { xcd_barrier_complete(bar, b.x, nloc, nx); b.st[0] = nloc; b.st[1] = nx; }
        const unsigned old = xb_add(&bar[XB_XSUB(b.x)], 1u);
        const unsigned gen = old / nloc;
        if (old + 1u == (gen + 1u) * nloc) {
            __builtin_amdgcn_fence(__ATOMIC_RELEASE, "agent");
            asm volatile("s_waitcnt vmcnt(0)" ::: "memory");
            const unsigned og = xb_add(&bar[XB_TOP], 1u);
            const unsigned tg = og / nx;
            if (og + 1u == (tg + 1u) * nx) xb_add(&bar[XB_TOPGEN], 1u);
            else XB_SPIN(xb_ld(&bar[XB_TOPGEN]) == tg, bar);
            __builtin_amdgcn_fence(__ATOMIC_ACQUIRE, "agent");
            xb_add(&bar[XB_XGEN(b.x)], 1u);
            asm volatile("s_waitcnt vmcnt(0)" ::: "memory");
        } else {
            XB_SPIN(xb_ld(&bar[XB_XGEN(b.x)]) == gen, bar);
            __builtin_amdgcn_fence(__ATOMIC_ACQUIRE, "agent");
            asm volatile("s_waitcnt vmcnt(0)" ::: "memory");
        }
    }
    __syncthreads();
}
constexpr int LDSCTL_OFF = 131072, MISC_OFF = LDSCTL_OFF + 320;
constexpr int CW_BAR = 4096;
constexpr size_t CTL_ZERO_BYTES = 65536;

__device__ __forceinline__ void transpose_item(const float* __restrict__ W, int ldsrc, int K, h16* __restrict__ WT, int k0, int n0, int src_col0, float scale, PG8_LAS float* scr, int lane) {
    float tv[32];
#pragma unroll
    for (int i = 0; i < 32; ++i) { const int kk = 2 * i + (lane >> 5); tv[i] = W[(size_t)(k0 + kk) * ldsrc + src_col0 + (lane & 31)]; }
#pragma unroll
    for (int i = 0; i < 32; ++i) { const int kk = 2 * i + (lane >> 5); scr[kk * 33 + (lane & 31)] = tv[i]; }
    asm volatile("s_waitcnt lgkmcnt(0)" ::: "memory");
    const int c = lane & 7;
#pragma unroll
    for (int j = 0; j < 4; ++j) { const int n = (lane >> 3) + 8 * j; const PG8_LAS float* sp = scr + (8 * c) * 33 + n;
        pg8::u32x4 o; o.x = pg8::cvt_pk_f16(sp[0 * 33] * scale, sp[1 * 33] * scale); o.y = pg8::cvt_pk_f16(sp[2 * 33] * scale, sp[3 * 33] * scale);
        o.z = pg8::cvt_pk_f16(sp[4 * 33] * scale, sp[5 * 33] * scale); o.w = pg8::cvt_pk_f16(sp[6 * 33] * scale, sp[7 * 33] * scale);
        *(pg8::u32x4*)(WT + (size_t)(n0 + n) * K + k0 + 8 * c) = o; }
    asm volatile("s_waitcnt lgkmcnt(0)" ::: "memory");
}
__device__ __forceinline__ void prologue_phase(const MArgs& a, PG8_LAS unsigned char* L) {
    int tid_ = threadIdx.x; asm volatile("" : "+v"(tid_));
    const int lane = tid_ & 63, wave = tid_ >> 6;
    PG8_LAS float* scr = (PG8_LAS float*)(L + wave * 16384);
    const int gw = blockIdx.x * NWAVES + wave, NGW = gridDim.x * NWAVES;
    constexpr int I_IN = (DM / 64) * (PW / 32), I_BR = (512 / 64) * (1024 / 32), I_OUT = (DM / 64) * (DM / 32), I_L = I_IN + 3 * I_BR + I_OUT;
    unsigned char* ws = a.ws;
    for (int it = gw; it < DEPTH * I_L; it += NGW) {
        const int l = it / I_L; int r = it - l * I_L;
        if (r < I_IN) { const int nblk = PW / 32, kb = r / nblk, nb = r % nblk, n0 = nb * 32;
            const float sc = ((n0 >= PC_AQ && n0 < PC_AQ + 512) || (n0 >= PC_BQ && n0 < PC_BQ + 512)) ? C2 : 1.f;
            transpose_item(a.in[2] + (size_t)l * DM * INW, INW, DM, (h16*)(ws + WS_WIN) + (size_t)l * PW * DM, kb * 64, n0, orig_col(n0), sc, scr, lane); continue; }
        r -= I_IN;
        if (r < 3 * I_BR) { const int n3 = r / I_BR, q = r % I_BR, nblk = 1024 / 32, kb = q / nblk, nb = q % nblk;
            transpose_item(a.in[8] + ((size_t)l * 3 + n3) * 512 * 1024, 1024, 512, (h16*)(ws + WS_WBR) + ((size_t)l * 3 + n3) * 1024 * 512, kb * 64, nb * 32, nb * 32, 1.f, scr, lane); continue; }
        r -= 3 * I_BR;
        { const int nblk = DM / 32, kb = r / nblk, nb = r % nblk;
          transpose_item(a.in[9] + (size_t)l * DM * DM, DM, DM, (h16*)(ws + WS_WOUT) + (size_t)l * DM * DM, kb * 64, nb * 32, nb * 32, 1.f, scr, lane); }
    }
    float* wsmall = (float*)(ws + WS_WSMALL);
    for (int i = blockIdx.x * NTHREADS + tid_; i < DEPTH * 16 * DM; i += gridDim.x * NTHREADS) {
        const int l = i / (16 * DM), c = (i >> 10) & 15, k = i & 1023;
        wsmall[i] = a.in[2][(size_t)l * DM * INW + (size_t)k * INW + small_col(c)];
    }
}
__device__ __forceinline__ void norm_phase(const float* __restrict__ x, const float* __restrict__ g, const float* __restrict__ wsmall, const float* __restrict__ fox_bf,
                                           const float* __restrict__ ml_bi, const float* __restrict__ ml_bf, h16* __restrict__ hn, float* __restrict__ small, int row0) {
    int tid_ = threadIdx.x; asm volatile("" : "+v"(tid_));
    const int lane = tid_ & 63, gw = blockIdx.x * NWAVES + (tid_ >> 6), NGW = gridDim.x * NWAVES;
    for (int r4 = gw; r4 < TH / 4; r4 += NGW) {
        f32x4 v[4][4];
#pragma unroll
        for (int q = 0; q < 4; ++q) {
            const f32x4* xr = (const f32x4*)(x + (size_t)(row0 + 4 * r4 + q) * DM) + lane;
            float ssq = 0.f;
#pragma unroll
            for (int j = 0; j < 4; ++j) { v[q][j] = xr[64 * j]; ssq += v[q][j].x * v[q][j].x + v[q][j].y * v[q][j].y + v[q][j].z * v[q][j].z + v[q][j].w * v[q][j].w; }
            const float rstd = rsqrtf(wave_sum(ssq) * (1.f / DM) + RMS_EPS);
#pragma unroll
            for (int j = 0; j < 4; ++j) {
                const f32x4 gg = ((const f32x4*)g)[lane + 64 * j];
                v[q][j].x *= rstd * gg.x; v[q][j].y *= rstd * gg.y; v[q][j].z *= rstd * gg.z; v[q][j].w *= rstd * gg.w;
                pg8::u32x4 dummy; (void)dummy;
                typedef unsigned u32x2 __attribute__((ext_vector_type(2)));
                u32x2 o; o.x = pg8::cvt_pk_f16(v[q][j].x, v[q][j].y); o.y = pg8::cvt_pk_f16(v[q][j].z, v[q][j].w);
                *((u32x2*)(hn + (size_t)(4 * r4 + q) * DM) + lane + 64 * j) = o;
            }
        }
        float mine[4] = {0.f, 0.f, 0.f, 0.f};
#pragma unroll 1
        for (int c = 0; c < 16; ++c) {
            const f32x4* wr = (const f32x4*)(wsmall + c * DM) + lane;
            float acc[4] = {0.f, 0.f, 0.f, 0.f};
#pragma unroll
            for (int j = 0; j < 4; ++j) { const f32x4 w = wr[64 * j];
#pragma unroll
                for (int q = 0; q < 4; ++q) acc[q] += v[q][j].x * w.x + v[q][j].y * w.y + v[q][j].z * w.z + v[q][j].w * w.w; }
#pragma unroll
            for (int q = 0; q < 4; ++q) { const float t = wave_sum(acc[q]); if (lane == c) mine[q] = t; }
        }
        if (lane < 16) {
            const float bias = lane < 8 ? fox_bf[lane] : lane < 12 ? ml_bi[lane - 8] : ml_bf[lane - 12];
#pragma unroll
            for (int q = 0; q < 4; ++q) { const float pre = mine[q] + bias; small[(size_t)(row0 + 4 * r4 + q) * 16 + lane] = (lane >= 8 && lane < 12) ? pre : log_sigmoidf_(pre); }
        }
    }
}
__device__ __forceinline__ void final_norm_phase(float* __restrict__ x, const float* __restrict__ g) {
    int tid_ = threadIdx.x; asm volatile("" : "+v"(tid_));
    const int lane = tid_ & 63, gw = blockIdx.x * NWAVES + (tid_ >> 6), NGW = gridDim.x * NWAVES;
    for (int row = gw; row < TT; row += NGW) {
        f32x4* xr = (f32x4*)(x + (size_t)row * DM) + lane;
        f32x4 v[4]; float ssq = 0.f;
#pragma unroll
        for (int j = 0; j < 4; ++j) { v[j] = xr[64 * j]; ssq += v[j].x * v[j].x + v[j].y * v[j].y + v[j].z * v[j].z + v[j].w * v[j].w; }
        const float rstd = rsqrtf(wave_sum(ssq) * (1.f / DM) + RMS_EPS);
#pragma unroll
        for (int j = 0; j < 4; ++j) { const f32x4 gg = ((const f32x4*)g)[lane + 64 * j];
            xr[64 * j] = (f32x4){v[j].x * rstd * gg.x, v[j].y * rstd * gg.y, v[j].z * rstd * gg.z, v[j].w * rstd * gg.w}; }
    }
}

__global__ void __launch_bounds__(NTHREADS, 2) mega(MArgs a) {
    extern __shared__ __attribute__((aligned(16))) unsigned char lds[];
    PG8_LAS unsigned char* L = (PG8_LAS unsigned char*)lds;
    unsigned char* ws = a.ws;
    for (int u = threadIdx.x; u < (MK_LDS_BYTES - LDSCTL_OFF) / 4; u += NTHREADS) ((LAS unsigned*)(L + LDSCTL_OFF))[u] = 0u;
    __syncthreads();
    XcdBarrier bar = xcd_barrier_post((unsigned*)(ws + WS_CTL) + CW_BAR, (volatile LAS unsigned*)(L + MISC_OFF) + 8);
    for (int s = a.s_lo; s < a.s_hi; ++s) {
        if (s == a.s_lo + 1 && a.s_hi > 1000) { __builtin_amdgcn_fence(__ATOMIC_RELEASE, "agent"); cg::this_grid().sync(); __builtin_amdgcn_fence(__ATOMIC_ACQUIRE, "agent"); }
        if (s > a.s_lo) xcd_barrier(bar);
        if (s == 0) { prologue_phase(a, L); barrier_lds(); continue; }
        if (s == N_STEPS - 1) { final_norm_phase(a.out, a.in[10]); continue; }
        const int li = (s - 1) / NPH, ph = (s - 1) % NPH, layer = li >> 1, hf = li & 1;
        const int row0 = hf * TH;
        if (ph == PH_NORM) {
            norm_phase(layer == 0 ? a.in[0] : a.out, a.in[1] + layer * DM, (const float*)(ws + WS_WSMALL) + layer * 16 * DM, a.in[3] + layer * 8, a.in[5] + layer * 4, a.in[6] + layer * 4,
                       (h16*)(ws + WS_HN), (float*)(ws + WS_SMALL), row0);
        } else if (ph == PH_PRE) {
            const int b0 = hf * HB;
            for (int it = blockIdx.x; it < HB * 8; it += gridDim.x) fox_cumsum_item(it, b0, (const float*)(ws + WS_SMALL), (float*)(ws + WS_CB), (char*)lds);
            for (int it = blockIdx.x; it < HB * 64; it += gridDim.x) moba_kmean_item(it, b0, (const h16*)(ws + WS_PROJ), (float*)(ws + WS_KMEAN), (char*)lds);
            {   int tid_ = threadIdx.x; asm volatile("" : "+v"(tid_));
                const int wv = __builtin_amdgcn_readfirstlane(tid_ >> 6), ln = tid_ & 63;
                if (wv < mlstm::NACT) for (int it = blockIdx.x * mlstm::NACT + wv; it < HB * 128; it += gridDim.x * mlstm::NACT)
                    mlstm::x1_wave(it, b0, (const h16*)(ws + WS_PROJ), (const float*)(ws + WS_SMALL), a.in[4] + (size_t)layer * 4 * 512, (h16*)(ws + WS_QKC), (float*)(ws + WS_U),
                                   (float*)(ws + WS_MUN), (float*)(ws + WS_MAMAX), (float*)(ws + WS_MBLAST), (mlstm::lds_ptr)L + wv * mlstm::WREG, ln);
                barrier_lds(); }
        } else if (ph == PH_SCAN) {
            for (int it = blockIdx.x; it < 32 * 8; it += gridDim.x)
                mlstm::x2_item(it, hf * HB, (const float*)(ws + WS_U), (const float*)(ws + WS_MUN), (const float*)(ws + WS_MAMAX), (const float*)(ws + WS_MBLAST),
                               (h16*)(ws + WS_CS), (float*)(ws + WS_MNS), (float*)(ws + WS_MMS), (char*)lds);
        } else if (ph == PH_MIX) {
            const int b0 = hf * HB, G = gridDim.x, bx = blockIdx.x;
            const int vcu = (G % 8 == 0) ? (bx % 8) * (G / 8) + bx / 8 : bx;
            const h16* proj = (const h16*)(ws + WS_PROJ); h16* y = (h16*)(ws + WS_Y);
            for (int v = vcu; v < 256; v += G) {
                const int bh = v >> 2, sidx = v & 3, bl = bh >> 3, h = bh & 7;
                const float* cbp = (const float*)(ws + WS_CB) + (size_t)((b0 + bl) * 8 + h) * SEQ;
                const float* kmp = (const float*)(ws + WS_KMEAN) + (size_t)((b0 + bl) * 8 + h) * 512;
                const float slope2 = exp2f(-(float)(h + 1)) * LOG2E;
#pragma unroll 1
                for (int i = 0; i < 4; ++i) {
                    const int qb = (i < 2) ? 7 - sidx : sidx;
                    if ((i & 1) == 0) attn_body::attn_unit<false, 8>(bl, h, qb, proj + PC_AQ, proj + PC_AK, proj + PC_AV, proj + PC_AZ, y, cbp, 0.f, kmp, (char*)lds);
                    else attn_body::attn_unit<true, 8>(bl, h, qb, proj + PC_BQ, proj + PC_BK, proj + PC_BV, proj + PC_BZ, y + 512, cbp, slope2, kmp, (char*)lds);
                }
            }
            {   int tid_ = threadIdx.x; asm volatile("" : "+v"(tid_));
                const int wv = __builtin_amdgcn_readfirstlane(tid_ >> 6), ln = tid_ & 63;
                if (wv < mlstm::NACT) for (int it = blockIdx.x * mlstm::NACT + wv; it < HB * 128; it += gridDim.x * mlstm::NACT)
                    mlstm::x3_wave(it, b0, proj, (const float*)(ws + WS_SMALL), (const h16*)(ws + WS_QKC), (const h16*)(ws + WS_CS), (const float*)(ws + WS_MNS), (const float*)(ws + WS_MMS),
                                   a.in[7] + (size_t)layer * 512, y, (mlstm::lds_ptr)L + wv * mlstm::WREG, ln);
                barrier_lds(); }
        } else if (ph == PH_PROJ) {
            pg8::Gemm g{(const h16*)(ws + WS_HN), (const h16*)(ws + WS_WIN) + (size_t)layer * PW * DM, DM, DM, DM, 0, 0};
            pg8::StaticOrder S; S.init(TH, PW, gridDim.x, blockIdx.x);
            pg8::EpiF16 E{(h16*)(ws + WS_PROJ), PW};
            pg8::gemm_phase(L, g, S, E);
        } else if (ph == PH_BR) {
            pg8::Gemm g{(const h16*)(ws + WS_Y), (const h16*)(ws + WS_WBR) + (size_t)layer * 3 * 1024 * 512, 1536, 512, 512, 512, 1024 * 512};
            pg8::BranchOrder S; S.init(TH, DM, gridDim.x, blockIdx.x, 3);
            pg8::EpiGate E{(h16*)(ws + WS_MRG), (const h16*)(ws + WS_PROJ) + PC_G, PW};
            pg8::gemm_phase<pg8::EpiGate, pg8::BranchOrder, false>(L, g, S, E);
        } else if (ph == PH_OUT) {
            pg8::Gemm g{(const h16*)(ws + WS_MRG), (const h16*)(ws + WS_WOUT) + (size_t)layer * DM * DM, DM, DM, DM, 0, 0};
            pg8::StaticOrder S; S.init(TH, DM, gridDim.x, blockIdx.x);
            const float* xsrc = layer == 0 ? a.in[0] : a.out;
            pg8::EpiRes E{xsrc + (size_t)row0 * DM, a.out + (size_t)row0 * DM, DM};
            pg8::gemm_phase(L, g, S, E);
        }
    }
}

extern "C" void kernel_launch(void* const* d_in, const int* in_sizes, int n_in, void* d_out, int out_size, void* d_ws, size_t ws_size, hipStream_t stream) {
    if (n_in != 11 || in_sizes[0] != TT * DM || out_size != TT * DM || ws_size < WS_END) {
        fprintf(stderr, "kernel_launch: unexpected shapes / workspace (n_in %d, in0 %d, out %d, ws %zu < %zu)\n", n_in, n_in > 0 ? in_sizes[0] : -1, out_size, ws_size, (size_t)WS_END);
        return;
    }
    static int grid = 0;
    if (grid == 0) {
        int dev = 0, cus = 0, per_cu = 0;
        hipGetDevice(&dev);
        hipDeviceGetAttribute(&cus, hipDeviceAttributeMultiprocessorCount, dev);
        if (hipFuncSetAttribute((const void*)mega, hipFuncAttributeMaxDynamicSharedMemorySize, MK_LDS_BYTES) != hipSuccess) fprintf(stderr, "kernel_launch: hipFuncSetAttribute failed\n");
        if (hipOccupancyMaxActiveBlocksPerMultiprocessor(&per_cu, (const void*)mega, NTHREADS, MK_LDS_BYTES) != hipSuccess || per_cu < 1) { fprintf(stderr, "kernel_launch: occupancy query says %d blocks per CU\n", per_cu); per_cu = 1; }
        (void)hipGetLastError();
        grid = cus;
        if (grid != 256) fprintf(stderr, "kernel_launch: note: %d CUs (tuned for 256)\n", grid);
    }
    MArgs ma{};
    for (int i = 0; i < 11; ++i) ma.in[i] = (const float*)d_in[i];
    ma.out = (float*)d_out; ma.ws = (unsigned char*)d_ws; ma.s_lo = 0; ma.s_hi = N_STEPS;
    if (hipMemsetAsync((char*)d_ws + WS_CTL, 0, CTL_ZERO_BYTES, stream) != hipSuccess) { fprintf(stderr, "kernel_launch: hipMemsetAsync of the control words failed\n"); return; }
    void* args[] = {&ma};
    hipError_t e = hipLaunchCooperativeKernel((const void*)mega, dim3(grid), dim3(NTHREADS), args, MK_LDS_BYTES, stream);
    if (e != hipSuccess) fprintf(stderr, "kernel_launch: cooperative launch failed: %s (grid %d)\n", hipGetErrorString(e), grid);
}
```
